# Optimizing an MI355X kernel written in HIP

```python
import math
import jax
import jax.numpy as jnp
from jax import lax
import numpy as np


D_MODEL = 1024
BATCH = 2
SEQ = 8192
DEPTH = 2

HEAD_DIM = 64
CHUNK = 128
EPS = 1e-6

SSD_HEADS = 8
SSD_GROUPS = 2
SSD_STATE = 64
SSD_CONV = 4
SSD_WIDTH = SSD_HEADS * HEAD_DIM
SSD_XBC = SSD_WIDTH + 2 * SSD_GROUPS * SSD_STATE
SSD_COLS = SSD_WIDTH + SSD_XBC + SSD_HEADS
RET_HEADS = 8
RET_WIDTH = RET_HEADS * HEAD_DIM
RET_COLS = 4 * RET_WIDTH
EVEN_COLS = SSD_COLS + RET_COLS

RWKV_HEADS = 8
RWKV_WIDTH = RWKV_HEADS * HEAD_DIM
RWKV_DECAY_RANK = 64
RWKV_ICLR_RANK = 64
RWKV_GATE_RANK = 128
RWKV_COLS = 3 * RWKV_WIDTH + RWKV_DECAY_RANK + RWKV_ICLR_RANK + RWKV_GATE_RANK
RWKV_SPLITS = [RWKV_WIDTH, 2 * RWKV_WIDTH, 3 * RWKV_WIDTH,
               3 * RWKV_WIDTH + RWKV_DECAY_RANK,
               3 * RWKV_WIDTH + RWKV_DECAY_RANK + RWKV_ICLR_RANK]
RWKV_LN_EPS = 64e-5
RWKV_DECAY_SCALE = 0.606531
FOX_HEADS = 8
FOX_WIDTH = FOX_HEADS * HEAD_DIM
FOX_COLS = 3 * FOX_WIDTH + FOX_HEADS
ODD_COLS = RWKV_COLS + FOX_COLS

MIX_WIDTH = 1024
D_FF = 2816
FFN_CONV = 3
N_EVEN = (DEPTH + 1) // 2
N_ODD = DEPTH // 2

kernel_name = 'hybrid_ssd_retnet_rwkv7_fox_convffn'


def rms_norm(x, w, eps=EPS):
    xf = x.astype(jnp.float32)
    y = xf * lax.rsqrt(jnp.mean(xf * xf, axis=-1, keepdims=True) + eps)
    return (y * w.astype(jnp.float32)).astype(x.dtype)


def causal_dwconv(x, w, b):
    K = w.shape[0]
    S = x.shape[1]
    xp = jnp.pad(x, ((0, 0), (K - 1, 0), (0, 0)))
    out = b
    for k in range(K):
        out = out + w[k] * xp[:, k:k + S]
    return out


def rotary(x, pos):
    half = x.shape[-1] // 2
    inv = 1.0 / (10000.0 ** (jnp.arange(half, dtype=jnp.float32) / half))
    ang = pos.astype(jnp.float32)[:, None] * inv[None, :]
    cos = jnp.cos(ang)[None, :, None, :]
    sin = jnp.sin(ang)[None, :, None, :]
    x1, x2 = x[..., :half], x[..., half:]
    return jnp.concatenate([x1 * cos - x2 * sin, x1 * sin + x2 * cos], axis=-1)


def ssd_mixer(proj, conv_w, conv_b, dt_bias, a_log, d_skip, norm_w):
    b_, s_, _ = proj.shape
    nc = s_ // CHUNK
    r_ = SSD_HEADS // SSD_GROUPS
    z = proj[..., :SSD_WIDTH]
    xbc = jax.nn.silu(causal_dwconv(proj[..., SSD_WIDTH:SSD_WIDTH + SSD_XBC], conv_w, conv_b))
    dt = jax.nn.softplus(proj[..., SSD_WIDTH + SSD_XBC:] + dt_bias)
    x = xbc[..., :SSD_WIDTH].reshape(b_, nc, CHUNK, SSD_GROUPS, r_, HEAD_DIM)
    n_bc = SSD_GROUPS * SSD_STATE
    bm = xbc[..., SSD_WIDTH:SSD_WIDTH + n_bc].reshape(b_, nc, CHUNK, SSD_GROUPS, SSD_STATE)
    cm = xbc[..., SSD_WIDTH + n_bc:].reshape(b_, nc, CHUNK, SSD_GROUPS, SSD_STATE)
    dt = dt.reshape(b_, nc, CHUNK, SSD_GROUPS, r_)
    a = dt * (-jnp.exp(a_log)).reshape(SSD_GROUPS, r_)
    a_cum = jnp.cumsum(a, axis=2)
    xdt = x * dt[..., None]
    causal = jnp.tril(jnp.ones((CHUNK, CHUNK), dtype=bool))
    seg = a_cum[:, :, :, None] - a_cum[:, :, None, :]
    decay = jnp.exp(jnp.where(causal[:, :, None, None], seg, -jnp.inf))
    cb = jnp.einsum('bclgn,bcsgn->bclsg', cm, bm)
    y_diag = jnp.einsum('bclsg,bclsgr,bcsgrp->bclgrp', cb, decay, xdt)
    to_end = jnp.exp(a_cum[:, :, -1:] - a_cum)
    chunk_states = jnp.einsum('bclgn,bclgr,bclgrp->bcgrpn', bm, to_end, xdt)
    chunk_decay = jnp.exp(a_cum[:, :, -1])

    def step(h, inp):
        st, dc = inp
        return h * dc[..., None, None] + st, h

    _, states_in = lax.scan(step, jnp.zeros_like(chunk_states[:, 0]),
                            (jnp.moveaxis(chunk_states, 1, 0), jnp.moveaxis(chunk_decay, 1, 0)))
    states_in = jnp.moveaxis(states_in, 0, 1)
    y_off = jnp.einsum('bclgn,bcgrpn,bclgr->bclgrp', cm, states_in, jnp.exp(a_cum))
    y = y_diag + y_off + d_skip.reshape(SSD_GROUPS, r_)[:, :, None] * x
    y = y.reshape(b_, s_, SSD_WIDTH)
    return rms_norm(y * jax.nn.silu(z), norm_w)


def retention_mixer(proj, pos, norm_w):
    b_, s_, _ = proj.shape
    nc = s_ // CHUNK
    q, k, v, g = jnp.split(proj, 4, axis=-1)
    hs = (b_, s_, RET_HEADS, HEAD_DIM)
    cs = (b_, nc, CHUNK, RET_HEADS, HEAD_DIM)
    q = rotary(q.reshape(hs), pos).reshape(cs)
    k = (rotary(k.reshape(hs), pos) * HEAD_DIM ** -0.5).reshape(cs)
    v = v.reshape(cs)
    log_gamma = jnp.log1p(-(2.0 ** (-5.0 - jnp.arange(RET_HEADS, dtype=jnp.float32))))
    idx = jnp.arange(CHUNK, dtype=jnp.float32)
    rel = idx[:, None] - idx[None, :]
    intra = jnp.where(rel[None] >= 0,
                      jnp.exp(jnp.maximum(rel, 0.0)[None] * log_gamma[:, None, None]), 0.0)
    scores = jnp.einsum('bclhd,bcshd->bchls', q, k) * intra
    y_in = jnp.einsum('bchls,bcshe->bclhe', scores, v)
    k_to_end = jnp.exp((CHUNK - 1 - idx)[:, None] * log_gamma[None, :])
    chunk_kv = jnp.einsum('bcshd,sh,bcshe->bchde', k, k_to_end, v)
    chunk_gamma = jnp.exp(CHUNK * log_gamma)[:, None, None]

    def step(r, kv):
        return r * chunk_gamma + kv, r

    _, r_in = lax.scan(step, jnp.zeros_like(chunk_kv[:, 0]), jnp.moveaxis(chunk_kv, 1, 0))
    r_in = jnp.moveaxis(r_in, 0, 1)
    q_decay = jnp.exp((idx + 1.0)[:, None] * log_gamma[None, :])
    y_x = jnp.einsum('bclhd,bchde,lh->bclhe', q, r_in, q_decay)
    y = (y_in + y_x).reshape(hs)
    y = rms_norm(y, norm_w.reshape(RET_HEADS, HEAD_DIM)).reshape(b_, s_, RET_WIDTH)
    return jax.nn.silu(g) * y


def rwkv7_mixer(proj, mu, w0, w_up, a0, a_up, g_up, k_k, k_a, r_k, ln_w, ln_b):
    b_, s_, _ = proj.shape
    prev = jnp.pad(proj, ((0, 0), (1, 0), (0, 0)))[:, :-1]
    proj = proj + (prev - proj) * mu
    r, k, v, w_lo, a_lo, g_lo = jnp.split(proj, RWKV_SPLITS, axis=-1)
    w = jnp.exp(-RWKV_DECAY_SCALE * jax.nn.sigmoid(w0 + jnp.tanh(w_lo) @ w_up))
    a = jax.nn.sigmoid(a0 + a_lo @ a_up)
    g = jax.nn.sigmoid(g_lo) @ g_up
    hs = (b_, s_, RWKV_HEADS, HEAD_DIM)
    r, k, v, w, a = (t.reshape(hs) for t in (r, k, v, w, a))
    kk = k * k_k.reshape(RWKV_HEADS, HEAD_DIM)
    kk = kk / jnp.maximum(jnp.sqrt(jnp.sum(kk * kk, axis=-1, keepdims=True)), 1e-12)
    k = k * (1.0 + (a - 1.0) * k_a.reshape(RWKV_HEADS, HEAD_DIM))

    def step(state, inp):
        r_t, w_t, k_t, v_t, kk_t, a_t = inp
        sa = jnp.einsum('bhvk,bhk->bhv', state, -kk_t)
        state = (state * w_t[:, :, None, :] + sa[..., None] * (kk_t * a_t)[:, :, None, :]
                 + v_t[..., None] * k_t[:, :, None, :])
        return state, jnp.einsum('bhvk,bhk->bhv', state, r_t)

    state0 = jnp.zeros((b_, RWKV_HEADS, HEAD_DIM, HEAD_DIM), dtype=r.dtype)
    seq_first = lambda t: jnp.moveaxis(t, 1, 0)
    _, y = lax.scan(step, state0, (seq_first(r), seq_first(w), seq_first(k),
                                   seq_first(v), seq_first(kk), seq_first(a)))
    y = jnp.moveaxis(y, 0, 1)
    mean = jnp.mean(y, axis=-1, keepdims=True)
    var = jnp.mean(jnp.square(y - mean), axis=-1, keepdims=True)
    y = ((y - mean) * lax.rsqrt(var + RWKV_LN_EPS) * ln_w.reshape(RWKV_HEADS, HEAD_DIM)
         + ln_b.reshape(RWKV_HEADS, HEAD_DIM))
    bonus = jnp.sum(r * k * r_k, axis=-1, keepdims=True) * v
    return (y + bonus).reshape(b_, s_, RWKV_WIDTH) * g


def fox_mixer(proj, q_norm_w, k_norm_w, f_bias):
    b_, s_, _ = proj.shape
    nb = s_ // CHUNK
    q, k, v, f = jnp.split(proj, [FOX_WIDTH, 2 * FOX_WIDTH, 3 * FOX_WIDTH], axis=-1)
    hs = (b_, s_, FOX_HEADS, HEAD_DIM)
    q = rms_norm(q.reshape(hs), q_norm_w) * HEAD_DIM ** -0.5
    k = rms_norm(k.reshape(hs), k_norm_w)
    v = v.reshape(hs)
    log_f = jax.nn.log_sigmoid((f + f_bias).astype(jnp.float32))
    c = jnp.cumsum(log_f, axis=1)
    c_hs = jnp.moveaxis(c, -1, 1)
    qb = jnp.moveaxis(q.reshape(b_, nb, CHUNK, FOX_HEADS, HEAD_DIM), 1, 0)
    cb = jnp.moveaxis(c.reshape(b_, nb, CHUNK, FOX_HEADS), 1, 0)
    k_pos = jnp.arange(s_)

    def block(args):
        i, q_i, c_i = args
        logits = jnp.einsum('bqhd,bkhd->bhqk', q_i, k).astype(jnp.float32)
        logits = logits + jnp.moveaxis(c_i, -1, 1)[..., None] - c_hs[:, :, None, :]
        q_pos = i * CHUNK + jnp.arange(CHUNK)
        logits = jnp.where(q_pos[:, None] >= k_pos[None, :], logits, -jnp.inf)
        p = jax.nn.softmax(logits, axis=-1)
        return jnp.einsum('bhqk,bkhd->bqhd', p.astype(v.dtype), v)

    out = lax.map(block, (jnp.arange(nb), qb, cb))
    return jnp.moveaxis(out, 0, 1).reshape(b_, s_, FOX_WIDTH)


def even_layer(x, pos, norm_w, w_in, conv_w, conv_b, dt_bias, a_log, d_skip, ssd_norm_w, ret_norm_w, w_out):
    h = (rms_norm(x, norm_w) @ w_in).astype(jnp.float32)
    y_ssd = ssd_mixer(h[..., :SSD_COLS], conv_w, conv_b, dt_bias, a_log, d_skip, ssd_norm_w)
    y_ret = retention_mixer(h[..., SSD_COLS:], pos, ret_norm_w)
    y = jnp.concatenate([y_ssd, y_ret], axis=-1).astype(x.dtype)
    return x + y @ w_out


def odd_layer(x, norm_w, w_in, mu, w0, w_up, a0, a_up, g_up, k_k, k_a, r_k, ln_w, ln_b,
              q_norm_w, k_norm_w, f_bias, w_out):
    h = (rms_norm(x, norm_w) @ w_in).astype(jnp.float32)
    y_rwkv = rwkv7_mixer(h[..., :RWKV_COLS], mu, w0, w_up, a0, a_up, g_up, k_k, k_a, r_k, ln_w, ln_b)
    y_fox = fox_mixer(h[..., RWKV_COLS:], q_norm_w, k_norm_w, f_bias)
    y = jnp.concatenate([y_rwkv, y_fox], axis=-1).astype(x.dtype)
    return x + y @ w_out


def conv_ffn(x, w_up, conv_w, conv_b, w_down):
    gate, up = jnp.split(x @ w_up, 2, axis=-1)
    gate = causal_dwconv(gate, conv_w, conv_b)
    return (jax.nn.silu(gate) * up) @ w_down


def setup_inputs(seed: int = 0) -> dict:
    key = jax.random.key(seed)
    ks = iter(jax.random.split(key, 48))
    f32 = jnp.float32

    def nrm(shape, scale):
        return jax.random.normal(next(ks), shape, f32) * scale

    def uni(shape, lo, hi):
        return jax.random.uniform(next(ks), shape, f32, minval=lo, maxval=hi)

    dt0 = jnp.exp(uni((N_EVEN, SSD_HEADS), math.log(1e-3), math.log(1e-1)))
    return {
        'x': nrm((BATCH, SEQ, D_MODEL), 1.0),
        'ev_norm_w': 1.0 + nrm((N_EVEN, D_MODEL), 0.02),
        'ev_w_in': nrm((N_EVEN, D_MODEL, EVEN_COLS), D_MODEL ** -0.5),
        'ev_ssd_conv_w': nrm((N_EVEN, SSD_CONV, SSD_XBC), SSD_CONV ** -0.5),
        'ev_ssd_conv_b': nrm((N_EVEN, SSD_XBC), 0.02),
        'ev_ssd_dt_bias': dt0 + jnp.log(-jnp.expm1(-dt0)),
        'ev_ssd_a_log': jnp.log(uni((N_EVEN, SSD_HEADS), 1.0, 16.0)),
        'ev_ssd_d': 1.0 + nrm((N_EVEN, SSD_HEADS), 0.1),
        'ev_ssd_norm_w': 1.0 + nrm((N_EVEN, SSD_WIDTH), 0.02),
        'ev_ret_norm_w': 1.0 + nrm((N_EVEN, RET_WIDTH), 0.02),
        'ev_w_out': nrm((N_EVEN, MIX_WIDTH, D_MODEL), MIX_WIDTH ** -0.5),
        'od_norm_w': 1.0 + nrm((N_ODD, D_MODEL), 0.02),
        'od_w_in': nrm((N_ODD, D_MODEL, ODD_COLS), D_MODEL ** -0.5),
        'od_rwkv_mu': uni((N_ODD, RWKV_COLS), 0.0, 1.0),
        'od_rwkv_w0': uni((N_ODD, RWKV_WIDTH), -4.0, 2.0),
        'od_rwkv_w_up': nrm((N_ODD, RWKV_DECAY_RANK, RWKV_WIDTH), 0.1),
        'od_rwkv_a0': nrm((N_ODD, RWKV_WIDTH), 0.5),
        'od_rwkv_a_up': nrm((N_ODD, RWKV_ICLR_RANK, RWKV_WIDTH), 0.1),
        'od_rwkv_g_up': nrm((N_ODD, RWKV_GATE_RANK, RWKV_WIDTH), RWKV_GATE_RANK ** -0.5),
        'od_rwkv_k_k': 0.85 + nrm((N_ODD, RWKV_WIDTH), 0.05),
        'od_rwkv_k_a': 1.0 + nrm((N_ODD, RWKV_WIDTH), 0.05),
        'od_rwkv_r_k': nrm((N_ODD, RWKV_HEADS, HEAD_DIM), 0.1),
        'od_rwkv_ln_w': 1.0 + nrm((N_ODD, RWKV_WIDTH), 0.02),
        'od_rwkv_ln_b': nrm((N_ODD, RWKV_WIDTH), 0.02),
        'od_fox_q_norm_w': 1.0 + nrm((N_ODD, HEAD_DIM), 0.02),
        'od_fox_k_norm_w': 1.0 + nrm((N_ODD, HEAD_DIM), 0.02),
        'od_fox_f_bias': uni((N_ODD, FOX_HEADS), 1.0, 5.0),
        'od_w_out': nrm((N_ODD, MIX_WIDTH, D_MODEL), MIX_WIDTH ** -0.5),
        'ffn_norm_w': 1.0 + nrm((DEPTH, D_MODEL), 0.02),
        'ffn_w_up': nrm((DEPTH, D_MODEL, 2 * D_FF), D_MODEL ** -0.5),
        'ffn_conv_w': nrm((DEPTH, FFN_CONV, D_FF), FFN_CONV ** -0.5),
        'ffn_conv_b': nrm((DEPTH, D_FF), 0.02),
        'ffn_w_down': nrm((DEPTH, D_FF, D_MODEL), D_FF ** -0.5),
    }


def reference(x, ev_norm_w, ev_w_in, ev_ssd_conv_w, ev_ssd_conv_b, ev_ssd_dt_bias, ev_ssd_a_log,
              ev_ssd_d, ev_ssd_norm_w, ev_ret_norm_w, ev_w_out,
              od_norm_w, od_w_in, od_rwkv_mu, od_rwkv_w0, od_rwkv_w_up, od_rwkv_a0, od_rwkv_a_up,
              od_rwkv_g_up, od_rwkv_k_k, od_rwkv_k_a, od_rwkv_r_k, od_rwkv_ln_w, od_rwkv_ln_b,
              od_fox_q_norm_w, od_fox_k_norm_w, od_fox_f_bias, od_w_out,
              ffn_norm_w, ffn_w_up, ffn_conv_w, ffn_conv_b, ffn_w_down):
    pos = jnp.arange(x.shape[1])
    for layer in range(DEPTH):
        i = layer // 2
        if layer % 2 == 0:
            x = even_layer(x, pos, ev_norm_w[i], ev_w_in[i], ev_ssd_conv_w[i], ev_ssd_conv_b[i],
                           ev_ssd_dt_bias[i], ev_ssd_a_log[i], ev_ssd_d[i], ev_ssd_norm_w[i],
                           ev_ret_norm_w[i], ev_w_out[i])
        else:
            x = odd_layer(x, od_norm_w[i], od_w_in[i], od_rwkv_mu[i], od_rwkv_w0[i], od_rwkv_w_up[i],
                          od_rwkv_a0[i], od_rwkv_a_up[i], od_rwkv_g_up[i], od_rwkv_k_k[i],
                          od_rwkv_k_a[i], od_rwkv_r_k[i], od_rwkv_ln_w[i], od_rwkv_ln_b[i],
                          od_fox_q_norm_w[i], od_fox_k_norm_w[i], od_fox_f_bias[i], od_w_out[i])
        x = x + conv_ffn(rms_norm(x, ffn_norm_w[layer]), ffn_w_up[layer], ffn_conv_w[layer],
                         ffn_conv_b[layer], ffn_w_down[layer])
    return x
```

```cpp
#include <hip/hip_runtime.h>
#include <hip/hip_cooperative_groups.h>
#include <cstdio>
namespace cg = cooperative_groups;
namespace pg8 {
#define PG8_LAS __attribute__((address_space(3)))
typedef unsigned short bf16_t;
typedef short bf16x8 __attribute__((ext_vector_type(8)));
typedef float f32x4 __attribute__((ext_vector_type(4)));
typedef unsigned u32x4 __attribute__((ext_vector_type(4)));
constexpr int BM = 256, BK = 64, HALF = 128, HTB = HALF * BK * 2  , STAGE_BYTES = 8 * HTB, NXCD = 8, WGM = 8;

__host__ __device__ __forceinline__ int lds_byte(int r, int c) { const int st = (r >> 4) * 2 + (c >> 5), rr = r & 15, cc = c & 31, ob = rr * 64 + cc * 2; return st * 1024 + (ob ^ (((ob >> 9) & 1) << 5)); }
__host__ __device__ __forceinline__ void stage_rc(int b, int& R, int& C) { const int st = b / 1024, sb = b % 1024, swz = sb ^ (((sb >> 9) & 1) << 5); R = (st >> 1) * 16 + swz / 64; C = (st & 1) * 32 + (swz % 64) / 2; }
__host__ __device__ __forceinline__ int perm32(int rho) { const int n = rho >> 4, i = rho & 15; return 8 * (i >> 2) + 4 * n + (i & 3); }

struct Unit { int pm, pn; };
struct Gemm { const bf16_t* A; const bf16_t* Bt; int M, N, K; };

struct StaticOrder {
    int nM, nN, nwg, G, c;
    __host__ __device__ void init(int M, int N, int G_, int c_) { nM = M / BM; nN = N / BM; nwg = nM * nN; G = G_; c = c_; }
    __host__ __device__ bool next(int i, Unit& u) const {
        const long L = (long)i * G + c; if (L >= nwg) return false;
        int wgid = (int)L; { const int q = nwg / NXCD, r = nwg % NXCD, xcd = wgid % NXCD, off = wgid / NXCD; wgid = (xcd < r ? xcd * (q + 1) : r * (q + 1) + (xcd - r) * q) + off; }
        const int nig = WGM * nN, gid = wgid / nig, fm = gid * WGM, gsz = (nM - fm) < WGM ? (nM - fm) : WGM;
        u.pm = fm + ((wgid % nig) % gsz); u.pn = (wgid % nig) / gsz; return true;
    }
    __device__ __forceinline__ void a_ready(const Unit&) const {}
    __device__ __forceinline__ void done(const Unit&) const {}
};
__device__ __forceinline__ unsigned cvt_pk_bf16(float lo, float hi) { unsigned r; asm volatile("v_cvt_pk_bf16_f32 %0, %1, %2" : "=v"(r) : "v"(lo), "v"(hi)); return r; }

template <class Epi, class Sched, bool STAMP = false>
__device__ __forceinline__ void gemm_phase(PG8_LAS unsigned char* lds, const Gemm g, const Sched& S, const Epi& E, unsigned long long* stamps) {
    int tid_ = threadIdx.x; asm volatile("" : "+v"(tid_)); const int tid = tid_, wid = __builtin_amdgcn_readfirstlane(tid >> 6), lane = tid & 63, wr = wid >> 2, wc = wid & 3, fr = lane & 15, fq = lane >> 4;
    const int K = g.K, nt = K / BK;
    int ts_lo = 0, ts_hi = 0, nts = 0; const unsigned long long rt_entry = STAMP ? (unsigned long long)wall_clock64() : 0ull;
#define PG8_STAMP() do { if (STAMP && wid == 0 && nts < 64) { const unsigned long long _c = (unsigned long long)clock64(); \
        ts_lo = (lane == nts) ? (int)(unsigned)_c : ts_lo; ts_hi = (lane == nts) ? (int)(unsigned)(_c >> 32) : ts_hi; ++nts; } } while (0)
    PG8_STAMP();
    unsigned voffA[2], voffB[2];
#pragma unroll
    for (int i = 0; i < 2; ++i) { int R, C; stage_rc(tid * 16 + i * 8192, R, C); const int Rb = Epi::PERM ? ((R & ~31) + perm32(R & 31)) : R;
        voffA[i] = (unsigned)(R * K + C) * 2u; voffB[i] = (unsigned)(Rb * K + C) * 2u; }
    const size_t kstep = (size_t)(BK * 2);
    const size_t hstep = (size_t)HALF * K * 2;
    const size_t tstep = 2 * hstep;
    const unsigned ldsw = (unsigned)wid * 1024u;
    const int aoff = lds_byte(wr * 64 + fr, fq * 8), boff = lds_byte(wc * 32 + fr, fq * 8);
#define PG8_SA(b, h) (((b) * 2 + (h)) * HTB)
#define PG8_SB(b, h) ((4 + (b) * 2 + (h)) * HTB)
#define PG8_STAGE(bufoff, gbase, voff) do { _Pragma("unroll") for (int _i = 0; _i < 2; ++_i) \
        __builtin_amdgcn_global_load_lds((const unsigned*)((const char*)(gbase) + (voff)[_i]), (PG8_LAS unsigned*)(lds + (bufoff) + ldsw + _i * 8192), 16, 0, 0); } while (0)
#define PG8_LDA(dst, b, h) do { _Pragma("unroll") for (int m = 0; m < 4; ++m) _Pragma("unroll") for (int k = 0; k < 2; ++k) dst[m][k] = *(const PG8_LAS bf16x8*)(lds + PG8_SA(b, h) + aoff + m * 2048 + k * 1024); } while (0)
#define PG8_LDB(dst, b, h) do { _Pragma("unroll") for (int n = 0; n < 2; ++n) _Pragma("unroll") for (int k = 0; k < 2; ++k) dst[n][k] = *(const PG8_LAS bf16x8*)(lds + PG8_SB(b, h) + boff + n * 2048 + k * 1024); } while (0)
#define PG8_MMA(ai, bj, At, Bt) do { __builtin_amdgcn_s_setprio(1); _Pragma("unroll") for (int m = 0; m < 4; ++m) _Pragma("unroll") for (int n = 0; n < 2; ++n) _Pragma("unroll") for (int k = 0; k < 2; ++k) \
        acc[ai][bj][m][n] = __builtin_amdgcn_mfma_f32_16x16x32_bf16(Bt[n][k], At[m][k], acc[ai][bj][m][n], 0, 0, 0); __builtin_amdgcn_s_setprio(0); } while (0)
#define PG8_WAIT_V(n) asm volatile("s_waitcnt vmcnt(" #n ")" ::: "memory")
#define PG8_WAIT_L(n) asm volatile("s_waitcnt lgkmcnt(" #n ")" ::: "memory")
#define PG8_BAR __builtin_amdgcn_s_barrier()
#define PG8_SCHED __builtin_amdgcn_sched_barrier(0)
    Unit cur, nxt; int ui = 0;
    if (!S.next(0, cur)) return;
    f32x4 acc[2][2][4][2];
#pragma unroll
    for (int a = 0; a < 2; ++a)
#pragma unroll
        for (int b = 0; b < 2; ++b)
#pragma unroll
            for (int m = 0; m < 4; ++m)
#pragma unroll
                for (int n = 0; n < 2; ++n) acc[a][b][m][n] = (f32x4){0.f, 0.f, 0.f, 0.f};
    bf16x8 At[4][2], B0[2][2], B1[2][2];
    const char* cA = (const char*)g.A + (size_t)cur.pm * tstep; const char* cB = (const char*)g.Bt + (size_t)cur.pn * tstep;
    S.a_ready(cur);
    PG8_STAGE(PG8_SB(0, 0), cB, voffB); PG8_STAGE(PG8_SA(0, 0), cA, voffA); PG8_STAGE(PG8_SB(0, 1), cB + hstep, voffB); PG8_STAGE(PG8_SA(0, 1), cA + hstep, voffA);
    if (wr == 1) PG8_BAR;
    PG8_WAIT_V(4); PG8_BAR;
    PG8_STAGE(PG8_SB(1, 0), cB + kstep, voffB); PG8_STAGE(PG8_SA(1, 0), cA + kstep, voffA); PG8_STAGE(PG8_SB(1, 1), cB + hstep + kstep, voffB);
    PG8_WAIT_V(6); PG8_BAR;
    PG8_STAMP();
    for (;;) {
        const bool has_next = S.next(ui + 1, nxt);
        const char* nA = has_next ? (const char*)g.A + (size_t)nxt.pm * tstep : cA; const char* nB = has_next ? (const char*)g.Bt + (size_t)nxt.pn * tstep : cB;
        for (int t = 0; t < nt; t += 2) {
            const bool last = (t == nt - 2);
            const char* a1 = cA + (size_t)(t + 1) * kstep;
            const char* a2 = last ? nA : cA + (size_t)(t + 2) * kstep; const char* b2 = last ? nB : cB + (size_t)(t + 2) * kstep;
            const char* a3 = a2 + kstep; const char* b3 = b2 + kstep;
            if (last && has_next) S.a_ready(nxt);
            PG8_LDB(B0, 0, 0); PG8_SCHED; PG8_LDA(At, 0, 0); PG8_STAGE(PG8_SA(1, 1), a1 + hstep, voffA);
            PG8_WAIT_L(8); PG8_BAR; PG8_WAIT_L(0); PG8_MMA(0, 0, At, B0); PG8_BAR; PG8_SCHED;
            PG8_LDB(B1, 0, 1); PG8_STAGE(PG8_SB(0, 0), b2, voffB);
            PG8_BAR; PG8_WAIT_L(0); PG8_MMA(0, 1, At, B1); PG8_BAR;
            PG8_LDA(At, 0, 1); PG8_STAGE(PG8_SA(0, 0), a2, voffA);
            PG8_BAR; PG8_WAIT_L(0); PG8_MMA(1, 0, At, B0); PG8_BAR; PG8_SCHED;
            PG8_STAGE(PG8_SB(0, 1), b2 + hstep, voffB);
            PG8_WAIT_V(6); PG8_BAR; PG8_MMA(1, 1, At, B1); PG8_BAR;
            PG8_LDB(B0, 1, 0); PG8_SCHED; PG8_LDA(At, 1, 0); PG8_STAGE(PG8_SA(0, 1), a2 + hstep, voffA);
            PG8_WAIT_L(8); PG8_BAR; PG8_WAIT_L(0); PG8_MMA(0, 0, At, B0); PG8_BAR; PG8_SCHED;
            PG8_LDB(B1, 1, 1); PG8_STAGE(PG8_SB(1, 0), b3, voffB);
            PG8_BAR; PG8_WAIT_L(0); PG8_MMA(0, 1, At, B1); PG8_BAR;
            PG8_LDA(At, 1, 1); PG8_STAGE(PG8_SA(1, 0), a3, voffA);
            PG8_BAR; PG8_WAIT_L(0); PG8_MMA(1, 0, At, B0); PG8_BAR; PG8_SCHED;
            PG8_STAGE(PG8_SB(1, 1), b3 + hstep, voffB);
            PG8_WAIT_V(6); PG8_BAR; PG8_MMA(1, 1, At, B1); PG8_BAR;
        }
        PG8_STAMP();
        if constexpr (!Epi::AFTER_DRAIN) { E(acc, cur, wr, wc, fr, fq); S.done(cur); }
        PG8_STAMP();
        if (!has_next) break;
#pragma unroll
        for (int a = 0; a < 2; ++a)
#pragma unroll
            for (int b = 0; b < 2; ++b)
#pragma unroll
                for (int m = 0; m < 4; ++m)
#pragma unroll
                    for (int n = 0; n < 2; ++n) acc[a][b][m][n] = (f32x4){0.f, 0.f, 0.f, 0.f};
        cur = nxt; cA = nA; cB = nB; ++ui;
    }
    PG8_WAIT_V(0);
    if (wr == 0) PG8_BAR;
    PG8_BAR;
    if constexpr (Epi::AFTER_DRAIN) { E.fused(acc, cur, wr, wc, fr, fq, lds, wid, lane); S.done(cur); }
    PG8_STAMP();
    if (STAMP && wid == 0) { stamps[lane] = lane < nts ? (((unsigned long long)(unsigned)ts_hi << 32) | (unsigned)ts_lo) : 0ull;
        if (lane == 62) stamps[62] = rt_entry; if (lane == 63) stamps[63] = (unsigned long long)wall_clock64(); }
#undef PG8_STAMP
#undef PG8_SA
#undef PG8_SB
#undef PG8_STAGE
#undef PG8_LDA
#undef PG8_LDB
#undef PG8_MMA
#undef PG8_WAIT_V
#undef PG8_WAIT_L
#undef PG8_BAR
#undef PG8_SCHED
}
}

using pg8::bf16_t; using pg8::bf16x8; using pg8::f32x4; using pg8::Unit; using pg8::cvt_pk_bf16;
#define DI __device__ __forceinline__
constexpr int TOK = 16384, SEQ = 8192, DM = 1024, HS = 3336, DFF = 2816;
constexpr size_t O_CTL = 0, O_CD = 256, O_AUX = 4352, O_ROPE = 528640, O_FC = 2625792, O_WT = 3150080;
constexpr size_t O_WT_IN = O_WT, O_WT_OUT = O_WT_IN + 7340032, O_WT_UP = O_WT_OUT + 2097152, O_WT_DN = O_WT_UP + 11534336, O_WT_LR = O_WT_DN + 5767168;
constexpr size_t O_XN = O_WT + 27525120, O_R1 = O_XN + 33554432;
constexpr size_t O_H = O_R1, O_ST = O_R1 + 109314048, O_YG = O_ST + 33554432;
constexpr size_t O_G = O_R1, O_U = O_R1 + 92274688;
constexpr size_t O_LW = O_R1 + 109314048, O_KN = O_LW + 50331648, O_VT = O_KN + 16777216, O_AP = O_VT + 16777216;
constexpr size_t WS_NEED = O_AP + 8388608;
constexpr int LDS_BYTES = 131072;

struct Params {
    const float* x; const float* ev_norm_w; const float* ev_w_in; const float* ev_conv_w; const float* ev_conv_b; const float* ev_dt_bias; const float* ev_a_log;
    const float* ev_d; const float* ev_ssd_norm_w; const float* ev_ret_norm_w; const float* ev_w_out;
    const float* od_norm_w; const float* od_w_in; const float* od_mu; const float* od_w0; const float* od_w_up; const float* od_a0; const float* od_a_up;
    const float* od_g_up; const float* od_k_k; const float* od_k_a; const float* od_r_k; const float* od_ln_w; const float* od_ln_b;
    const float* od_qn_w; const float* od_kn_w; const float* od_f_bias; const float* od_w_out;
    const float* ffn_norm_w; const float* ffn_w_up; const float* ffn_conv_w; const float* ffn_conv_b; const float* ffn_w_down;
    float* out; unsigned char* ws;
};

DI unsigned short f2bf(float f) { unsigned u = __float_as_uint(f); u += 0x7fffu + ((u >> 16) & 1u); return (unsigned short)(u >> 16); }
DI float bf2f(unsigned short b) { return __uint_as_float(((unsigned)b) << 16); }
DI unsigned pack2(float lo, float hi) { return (unsigned)f2bf(lo) | ((unsigned)f2bf(hi) << 16); }
DI float bflo(unsigned w) { return __uint_as_float(w << 16); }
DI float bfhi(unsigned w) { return __uint_as_float(w & 0xffff0000u); }
DI void unpack8(const uint4 r, float (&o)[8]) { o[0] = bflo(r.x); o[1] = bfhi(r.x); o[2] = bflo(r.y); o[3] = bfhi(r.y); o[4] = bflo(r.z); o[5] = bfhi(r.z); o[6] = bflo(r.w); o[7] = bfhi(r.w); }
DI uint4 pack8(const float (&o)[8]) { uint4 r; r.x = pack2(o[0], o[1]); r.y = pack2(o[2], o[3]); r.z = pack2(o[4], o[5]); r.w = pack2(o[6], o[7]); return r; }
DI float silu_(float x) { return x / (1.f + __expf(-x)); }
DI float sigm_(float x) { return 1.f / (1.f + __expf(-x)); }
DI float softplus_(float x) { return fmaxf(x, 0.f) + log1pf(__expf(-fabsf(x))); }
DI bf16x8 ldfrag(const bf16_t* base, int row0, int ld, int k0, int lane) { return *(const bf16x8*)(base + (row0 + (lane & 15)) * ld + k0 + (lane >> 4) * 8); }
#define MFMA16(a, b, c) __builtin_amdgcn_mfma_f32_16x16x32_bf16((a), (b), (c), 0, 0, 0)
DI float red16(float v) { v += __shfl_xor(v, 1); v += __shfl_xor(v, 2); v += __shfl_xor(v, 4); v += __shfl_xor(v, 8); return v; }
DI float max16(float v) { v = fmaxf(v, __shfl_xor(v, 1)); v = fmaxf(v, __shfl_xor(v, 2)); v = fmaxf(v, __shfl_xor(v, 4)); v = fmaxf(v, __shfl_xor(v, 8)); return v; }
DI float red64(float v) { v += __shfl_xor(v, 32); v += __shfl_xor(v, 16); return red16(v); }
DI float dpp_red16(float x) {
    x += __builtin_bit_cast(float, __builtin_amdgcn_update_dpp(0, __builtin_bit_cast(int, x), 0xB1, 0xF, 0xF, true));
    x += __builtin_bit_cast(float, __builtin_amdgcn_update_dpp(0, __builtin_bit_cast(int, x), 0x4E, 0xF, 0xF, true));
    x += __builtin_bit_cast(float, __builtin_amdgcn_update_dpp(0, __builtin_bit_cast(int, x), 0x141, 0xF, 0xF, true));
    x += __builtin_bit_cast(float, __builtin_amdgcn_update_dpp(0, __builtin_bit_cast(int, x), 0x140, 0xF, 0xF, true));
    return x;
}

DI int otid() { int t = threadIdx.x; asm volatile("" : "+v"(t)); return t; }
DI int obid() { int b = blockIdx.x; asm volatile("" : "+s"(b)); return b; }
struct EpiH {
    static constexpr bool PERM = false, AFTER_DRAIN = false;
    bf16_t* H; float* aux; int auxc;
    DI void operator()(const f32x4 (&acc)[2][2][4][2], const Unit& u, int wr, int wc, int fr, int fq) const {
        const int row0 = u.pm * 256 + wr * 64 + fr, col0 = u.pn * 256 + wc * 32 + 4 * fq;
#pragma unroll
        for (int ai = 0; ai < 2; ++ai)
#pragma unroll
            for (int m = 0; m < 4; ++m) { const size_t r = (size_t)(row0 + ai * 128 + m * 16);
#pragma unroll
                for (int bj = 0; bj < 2; ++bj)
#pragma unroll
                    for (int n = 0; n < 2; ++n) { const int c = col0 + bj * 128 + n * 16; const f32x4 v = acc[ai][bj][m][n];
                        if (c < HS) { uint2 w; w.x = cvt_pk_bf16(v[0], v[1]); w.y = cvt_pk_bf16(v[2], v[3]); *(uint2*)(H + r * HS + c) = w;
                            if (c == auxc || c == auxc + 4) *(f32x4*)(aux + r * 8 + (c - auxc)) = v; } } }
    }
};
struct EpiRes {
    static constexpr bool PERM = false, AFTER_DRAIN = false;
    const float* res; float* out;
    DI void operator()(const f32x4 (&acc)[2][2][4][2], const Unit& u, int wr, int wc, int fr, int fq) const {
        const int row0 = u.pm * 256 + wr * 64 + fr, col0 = u.pn * 256 + wc * 32 + 4 * fq;
#pragma unroll
        for (int ai = 0; ai < 2; ++ai)
#pragma unroll
            for (int m = 0; m < 4; ++m) { const size_t r = (size_t)(row0 + ai * 128 + m * 16);
#pragma unroll
                for (int bj = 0; bj < 2; ++bj)
#pragma unroll
                    for (int n = 0; n < 2; ++n) { const int c = col0 + bj * 128 + n * 16;
                        const f32x4 rv = *(const f32x4*)(res + r * DM + c); *(f32x4*)(out + r * DM + c) = rv + acc[ai][bj][m][n]; } }
    }
};
struct EpiGU {
    static constexpr bool PERM = false, AFTER_DRAIN = false;
    bf16_t* G; bf16_t* U;
    DI void operator()(const f32x4 (&acc)[2][2][4][2], const Unit& u, int wr, int wc, int fr, int fq) const {
        const int row0 = u.pm * 256 + wr * 64 + fr, col0 = u.pn * 128 + wc * 32 + 4 * fq;
#pragma unroll
        for (int ai = 0; ai < 2; ++ai)
#pragma unroll
            for (int m = 0; m < 4; ++m) { const size_t r = (size_t)(row0 + ai * 128 + m * 16);
#pragma unroll
                for (int n = 0; n < 2; ++n) { const int c = col0 + n * 16; const f32x4 g = acc[ai][0][m][n], v = acc[ai][1][m][n];
                    uint2 w; w.x = cvt_pk_bf16(g[0], g[1]); w.y = cvt_pk_bf16(g[2], g[3]); *(uint2*)(G + r * DFF + c) = w;
                    w.x = cvt_pk_bf16(v[0], v[1]); w.y = cvt_pk_bf16(v[2], v[3]); *(uint2*)(U + r * DFF + c) = w; } }
    }
};
struct EpiLR {
    static constexpr bool PERM = false, AFTER_DRAIN = false;
    bf16_t* LW; const float* w0; const float* a0;
    DI void operator()(const f32x4 (&acc)[2][2][4][2], const Unit& u, int wr, int wc, int fr, int fq) const {
        const int row0 = u.pm * 256 + wr * 64 + fr, col0 = u.pn * 256 + wc * 32 + 4 * fq;
#pragma unroll
        for (int ai = 0; ai < 2; ++ai)
#pragma unroll
            for (int m = 0; m < 4; ++m) { const size_t r = (size_t)(row0 + ai * 128 + m * 16);
#pragma unroll
                for (int bj = 0; bj < 2; ++bj)
#pragma unroll
                    for (int n = 0; n < 2; ++n) { const int c = col0 + bj * 128 + n * 16; f32x4 v = acc[ai][bj][m][n];
                        if (c < 512) { const f32x4 b = *(const f32x4*)(w0 + c);
#pragma unroll
                            for (int j = 0; j < 4; ++j) v[j] = 1.f - __expf(-0.606531f * sigm_(b[j] + v[j])); }
                        else if (c < 1024) { const f32x4 b = *(const f32x4*)(a0 + c - 512);
#pragma unroll
                            for (int j = 0; j < 4; ++j) v[j] = sigm_(b[j] + v[j]); }
                        uint2 w; w.x = cvt_pk_bf16(v[0], v[1]); w.y = cvt_pk_bf16(v[2], v[3]); *(uint2*)(LW + r * 1536 + c) = w; } }
    }
};
template <class Epi> DI void run_gemm(unsigned char* smem, const bf16_t* A, const bf16_t* Bt, int N, int K, const Epi& E) {
    pg8::Gemm g; g.A = A; g.Bt = Bt; g.M = TOK; g.N = N; g.K = K;
    pg8::StaticOrder S; S.init(TOK, N, (int)gridDim.x, obid());
    pg8::gemm_phase<Epi, pg8::StaticOrder, false>((PG8_LAS unsigned char*)smem, g, S, E, nullptr);
}

DI void conv_tile(const float* W, int Nsrc, int K, bf16_t* Wt, int nd0, int sc0, int nvalid, int k0, float* tile) {
    const int tid = otid(), j = tid & 63, kb = tid >> 6;
#pragma unroll
    for (int i = 0; i < 8; ++i) { const int kk = kb + 8 * i; tile[kk * 65 + j] = (j < nvalid) ? W[(size_t)(k0 + kk) * Nsrc + sc0 + j] : 0.f; }
    __syncthreads();
    const int nl = tid >> 3, ks = (tid & 7) * 8;
    uint4 o;
    o.x = pack2(tile[(ks + 0) * 65 + nl], tile[(ks + 1) * 65 + nl]); o.y = pack2(tile[(ks + 2) * 65 + nl], tile[(ks + 3) * 65 + nl]);
    o.z = pack2(tile[(ks + 4) * 65 + nl], tile[(ks + 5) * 65 + nl]); o.w = pack2(tile[(ks + 6) * 65 + nl], tile[(ks + 7) * 65 + nl]);
    *(uint4*)(Wt + (size_t)(nd0 + nl) * K + k0 + ks) = o;
    __syncthreads();
}
DI void phase_weights(const Params& p, unsigned char* smem, int layer) {
    float* tile = (float*)smem;
    const float* w_in = layer ? p.od_w_in : p.ev_w_in; const float* w_out = layer ? p.od_w_out : p.ev_w_out;
    const float* w_up = p.ffn_w_up + (size_t)layer * DM * 2 * DFF; const float* w_dn = p.ffn_w_down + (size_t)layer * DFF * DM;
    bf16_t* t_in = (bf16_t*)(p.ws + O_WT_IN); bf16_t* t_out = (bf16_t*)(p.ws + O_WT_OUT); bf16_t* t_up = (bf16_t*)(p.ws + O_WT_UP); bf16_t* t_dn = (bf16_t*)(p.ws + O_WT_DN);
    for (int job = obid(); job < 3264; job += gridDim.x) {
        if (job < 896) { const int nt = job >> 4, kt = job & 15, nd0 = nt * 64; int nv = HS - nd0; nv = nv < 0 ? 0 : (nv > 64 ? 64 : nv);
            conv_tile(w_in, HS, 1024, t_in, nd0, nd0, nv, kt * 64, tile); }
        else if (job < 1152) { const int j2 = job - 896, nt = j2 >> 4, kt = j2 & 15; conv_tile(w_out, 1024, 1024, t_out, nt * 64, nt * 64, 64, kt * 64, tile); }
        else if (job < 2560) { const int j2 = job - 1152, nt = j2 >> 4, kt = j2 & 15, nd0 = nt * 64; const int pn = nd0 >> 8, bj = (nd0 >> 7) & 1, j0 = nd0 & 127;
            conv_tile(w_up, 2 * DFF, 1024, t_up, nd0, bj * DFF + 128 * pn + j0, 64, kt * 64, tile); }
        else { const int j2 = job - 2560, nt = j2 / 44, kt = j2 % 44; conv_tile(w_dn, 1024, DFF, t_dn, nt * 64, nt * 64, 64, kt * 64, tile); }
    }
    const int gtid = obid() * 512 + otid(), gsz = gridDim.x * 512;
    if (layer == 0) {
        float* rc = (float*)(p.ws + O_ROPE); float* rs = rc + SEQ * 32;
        for (int idx = gtid; idx < SEQ * 32; idx += gsz) { const int pos = idx >> 5, i = idx & 31;
            const float inv = (float)exp(-(double)i * (9.210340371976184 / 32.0)); const float ang = (float)pos * inv;
            const double a = (double)ang; const double n = rint(a * 0.15915494309189535); const double r = a - n * 6.283185307179586; const double r2 = r * r;
            double sn = 1.0 / 121645100408832000.0, cs = 1.0 / 2432902008176640000.0;
            sn = sn * r2 - 1.0 / 355687428096000.0; sn = sn * r2 + 1.0 / 1307674368000.0; sn = sn * r2 - 1.0 / 6227020800.0; sn = sn * r2 + 1.0 / 39916800.0;
            sn = sn * r2 - 1.0 / 362880.0; sn = sn * r2 + 1.0 / 5040.0; sn = sn * r2 - 1.0 / 120.0; sn = sn * r2 + 1.0 / 6.0; sn = sn * r2 * -1.0 + 1.0; sn = sn * r;
            cs = cs * r2 - 1.0 / 6402373705728000.0; cs = cs * r2 + 1.0 / 20922789888000.0; cs = cs * r2 - 1.0 / 87178291200.0; cs = cs * r2 + 1.0 / 479001600.0;
            cs = cs * r2 - 1.0 / 3628800.0; cs = cs * r2 + 1.0 / 40320.0; cs = cs * r2 - 1.0 / 720.0; cs = cs * r2 + 1.0 / 24.0; cs = cs * r2 - 0.5; cs = cs * r2 + 1.0;
            rc[idx] = (float)cs; rs[idx] = (float)sn; }
    } else {
        bf16_t* t_lr = (bf16_t*)(p.ws + O_WT_LR);
        for (int idx = gtid; idx < 1536 * 256; idx += gsz) { const int n = idx >> 8, k = idx & 255; float v = 0.f;
            if (n < 512) { if (k < 64) v = p.od_w_up[k * 512 + n]; }
            else if (n < 1024) { if (k >= 64 && k < 128) v = p.od_a_up[(k - 64) * 512 + n - 512]; }
            else { if (k >= 128) v = p.od_g_up[(k - 128) * 512 + n - 1024]; }
            t_lr[idx] = f2bf(v); }
    }
}
DI void phase_rmsnorm(const float* x, const float* w, bf16_t* xn) {
    const int lane = otid() & 63, wv = otid() >> 6;
    for (int r = obid() * 8 + wv; r < TOK; r += gridDim.x * 8) {
        const float* xr = x + (size_t)r * DM; f32x4 v[4]; float ss = 0.f;
#pragma unroll
        for (int i = 0; i < 4; ++i) { v[i] = *(const f32x4*)(xr + i * 256 + lane * 4); ss += v[i][0] * v[i][0] + v[i][1] * v[i][1] + v[i][2] * v[i][2] + v[i][3] * v[i][3]; }
        ss = red64(ss); const float rstd = rsqrtf(ss * (1.f / DM) + 1e-6f);
#pragma unroll
        for (int i = 0; i < 4; ++i) { const f32x4 ww = *(const f32x4*)(w + i * 256 + lane * 4); uint2 o; o.x = pack2(v[i][0] * rstd * ww[0], v[i][1] * rstd * ww[1]); o.y = pack2(v[i][2] * rstd * ww[2], v[i][3] * rstd * ww[3]);
            *(uint2*)(xn + (size_t)r * DM + i * 256 + lane * 4) = o; }
    }
}
DI void ssd_conv8(const Params& p, const bf16_t* H, int b, int t, int ch, float (&o)[8]) {
    float acc[8];
    { const f32x4 b0 = *(const f32x4*)(p.ev_conv_b + ch), b1 = *(const f32x4*)(p.ev_conv_b + ch + 4);
      acc[0] = b0[0]; acc[1] = b0[1]; acc[2] = b0[2]; acc[3] = b0[3]; acc[4] = b1[0]; acc[5] = b1[1]; acc[6] = b1[2]; acc[7] = b1[3]; }
#pragma unroll
    for (int k = 0; k < 4; ++k) { const int tt = t - 3 + k;
        if (tt >= 0) { float xv[8]; unpack8(*(const uint4*)(H + ((size_t)b * SEQ + tt) * HS + 512 + ch), xv);
            const f32x4 w0 = *(const f32x4*)(p.ev_conv_w + k * 768 + ch), w1 = *(const f32x4*)(p.ev_conv_w + k * 768 + ch + 4);
            acc[0] += w0[0] * xv[0]; acc[1] += w0[1] * xv[1]; acc[2] += w0[2] * xv[2]; acc[3] += w0[3] * xv[3];
            acc[4] += w1[0] * xv[4]; acc[5] += w1[1] * xv[5]; acc[6] += w1[2] * xv[6]; acc[7] += w1[3] * xv[7]; } }
#pragma unroll
    for (int e = 0; e < 8; ++e) o[e] = silu_(acc[e]);
}
DI float ret_lg(int hh) { return log1pf(-exp2f(-5.f - (float)hh)); }
DI void chunk_decay(const Params& p, int mixer, int b, int hh, int t0, float* acs, float* dts) {
    const int tid = otid(); const float* aux = (const float*)(p.ws + O_AUX);
    if (tid < 128) {
        if (mixer == 0) { const float dt = softplus_(aux[((size_t)b * SEQ + t0 + tid) * 8 + hh] + p.ev_dt_bias[hh]); dts[tid] = dt; acs[tid] = -expf(p.ev_a_log[hh]) * dt; }
        else { dts[tid] = 1.f; acs[tid] = 0.f; }
    }
    __syncthreads();
    float my = 0.f;
    if (tid < 128) { if (mixer == 0) { for (int i = 0; i <= tid; ++i) my += acs[i]; } else my = (float)(tid + 1) * ret_lg(hh); }
    __syncthreads();
    if (tid < 128) acs[tid] = my;
    __syncthreads();
}
DI void phase_m1(const Params& p, unsigned char* smem) {
    bf16_t* Kt = (bf16_t*)smem; bf16_t* Vt = (bf16_t*)(smem + 17408); float* acs = (float*)(smem + 34816); float* dts = acs + 128;
    const bf16_t* H = (const bf16_t*)(p.ws + O_H); float* ST = (float*)(p.ws + O_ST); float* CD = (float*)(p.ws + O_CD);
    const float* rc = (const float*)(p.ws + O_ROPE); const float* rs = rc + SEQ * 32;
    const int tid = otid(), lane = tid & 63, w = tid >> 6;
    for (int u = obid(); u < 2048; u += gridDim.x) {
        const int mixer = u >> 10, bh = (u >> 6) & 15, c = u & 63, b = bh >> 3, hh = bh & 7, t0 = c * 128;
        chunk_decay(p, mixer, b, hh, t0, acs, dts);
        const float aend = acs[127];
        if (mixer == 0) {
#pragma unroll
            for (int it = 0; it < 2; ++it) { const int g = tid + it * 512, s = g >> 3, c8 = (g & 7) * 8; float o[8];
                const float sc = __expf(aend - acs[s]) * dts[s];
                ssd_conv8(p, H, b, t0 + s, 512 + (hh >> 2) * 64 + c8, o);
#pragma unroll
                for (int e = 0; e < 8; ++e) Kt[(c8 + e) * 136 + s] = f2bf(o[e] * sc);
                ssd_conv8(p, H, b, t0 + s, hh * 64 + c8, o);
#pragma unroll
                for (int e = 0; e < 8; ++e) Vt[(c8 + e) * 136 + s] = f2bf(o[e]); }
            if (tid == 0) CD[bh * 64 + c] = __expf(aend);
        } else {
            { const int s = tid >> 2, i0 = (tid & 3) * 8; const size_t r = (size_t)b * SEQ + t0 + s; float k1[8], k2[8];
              unpack8(*(const uint4*)(H + r * HS + 1800 + hh * 64 + i0), k1); unpack8(*(const uint4*)(H + r * HS + 1800 + hh * 64 + 32 + i0), k2);
              const float sc = __expf(aend - acs[s]) * 0.125f;
#pragma unroll
              for (int e = 0; e < 8; ++e) { const float cs = rc[(t0 + s) * 32 + i0 + e], sn = rs[(t0 + s) * 32 + i0 + e];
                  Kt[(i0 + e) * 136 + s] = f2bf((k1[e] * cs - k2[e] * sn) * sc); Kt[(32 + i0 + e) * 136 + s] = f2bf((k1[e] * sn + k2[e] * cs) * sc); } }
#pragma unroll
            for (int it = 0; it < 2; ++it) { const int g = tid + it * 512, s = g >> 3, c8 = (g & 7) * 8; const size_t r = (size_t)b * SEQ + t0 + s; float v[8];
                unpack8(*(const uint4*)(H + r * HS + 2312 + hh * 64 + c8), v);
#pragma unroll
                for (int e = 0; e < 8; ++e) Vt[(c8 + e) * 136 + s] = (unsigned short)f2bf(v[e]); }
        }
        __syncthreads();
        { const int mt = w & 3, nt0 = (w >> 2) * 2; f32x4 a0 = {0.f, 0.f, 0.f, 0.f}, a1 = {0.f, 0.f, 0.f, 0.f};
#pragma unroll
          for (int ks = 0; ks < 4; ++ks) { const bf16x8 af = ldfrag(Kt, mt * 16, 136, ks * 32, lane);
              a0 = MFMA16(af, ldfrag(Vt, nt0 * 16, 136, ks * 32, lane), a0); a1 = MFMA16(af, ldfrag(Vt, nt0 * 16 + 16, 136, ks * 32, lane), a1); }
          float* dst = ST + (size_t)u * 4096 + mt * 16 + (lane >> 4) * 4;
          *(f32x4*)(dst + (nt0 * 16 + (lane & 15)) * 64) = a0; *(f32x4*)(dst + (nt0 * 16 + 16 + (lane & 15)) * 64) = a1; }
        __syncthreads();
    }
}
DI void phase_m2(const Params& p) {
    float* ST = (float*)(p.ws + O_ST); const float* CD = (const float*)(p.ws + O_CD);
    for (int idx = obid() * 512 + otid(); idx < 32 * 4096; idx += gridDim.x * 512) {
        const int mb = idx >> 12, e = idx & 4095, mixer = mb >> 4, bh = mb & 15; float run = 0.f;
        const float gdec = __expf(128.f * ret_lg(bh & 7));
#pragma unroll 8
        for (int c = 0; c < 64; ++c) { const size_t o = ((size_t)(mb * 64 + c)) * 4096 + e; const float v = ST[o]; ST[o] = run;
            const float dec = mixer == 0 ? CD[bh * 64 + c] : gdec; run = run * dec + v; }
    }
}
template <int MIXER> DI void m3_head(const Params& p, unsigned char* smem, int b, int c, int hh, float (&ssq)[4]) {
    bf16_t* Qs = (bf16_t*)smem; bf16_t* Ks = (bf16_t*)(smem + 18432); bf16_t* Vt = (bf16_t*)(smem + 36864); bf16_t* Rt = (bf16_t*)(smem + 54272); bf16_t* Ps = (bf16_t*)(smem + 63488);
    float* acs = (float*)(smem + 98304); float* dts = acs + 128;
    const bf16_t* H = (const bf16_t*)(p.ws + O_H); const float* ST = (const float*)(p.ws + O_ST); float* YG = (float*)(p.ws + O_YG); bf16_t* Y = (bf16_t*)(p.ws + O_XN);
    const float* rc = (const float*)(p.ws + O_ROPE); const float* rs = rc + SEQ * 32;
    const int tid = otid(), lane = tid & 63, w = tid >> 6, t0 = c * 128, bh = b * 8 + hh;
    const size_t u = (size_t)((MIXER * 16 + bh) * 64 + c);
    __syncthreads();
    chunk_decay(p, MIXER, b, hh, t0, acs, dts);
    if (MIXER == 0) {
#pragma unroll
        for (int it = 0; it < 2; ++it) { const int g = tid + it * 512, s = g >> 3, c8 = (g & 7) * 8; float o[8];
            ssd_conv8(p, H, b, t0 + s, 640 + (hh >> 2) * 64 + c8, o); *(uint4*)(Qs + s * 72 + c8) = pack8(o);
            ssd_conv8(p, H, b, t0 + s, 512 + (hh >> 2) * 64 + c8, o); *(uint4*)(Ks + s * 72 + c8) = pack8(o);
            ssd_conv8(p, H, b, t0 + s, hh * 64 + c8, o);
#pragma unroll
            for (int e = 0; e < 8; ++e) Vt[(c8 + e) * 136 + s] = f2bf(o[e]); }
    } else {
        { const int s = tid >> 2, i0 = (tid & 3) * 8; const size_t r = (size_t)b * SEQ + t0 + s; float a1[8], a2[8], o1[8], o2[8];
          unpack8(*(const uint4*)(H + r * HS + 1288 + hh * 64 + i0), a1); unpack8(*(const uint4*)(H + r * HS + 1288 + hh * 64 + 32 + i0), a2);
#pragma unroll
          for (int e = 0; e < 8; ++e) { const float cs = rc[(t0 + s) * 32 + i0 + e], sn = rs[(t0 + s) * 32 + i0 + e]; o1[e] = a1[e] * cs - a2[e] * sn; o2[e] = a1[e] * sn + a2[e] * cs; }
          *(uint4*)(Qs + s * 72 + i0) = pack8(o1); *(uint4*)(Qs + s * 72 + 32 + i0) = pack8(o2);
          unpack8(*(const uint4*)(H + r * HS + 1800 + hh * 64 + i0), a1); unpack8(*(const uint4*)(H + r * HS + 1800 + hh * 64 + 32 + i0), a2);
#pragma unroll
          for (int e = 0; e < 8; ++e) { const float cs = rc[(t0 + s) * 32 + i0 + e], sn = rs[(t0 + s) * 32 + i0 + e]; o1[e] = (a1[e] * cs - a2[e] * sn) * 0.125f; o2[e] = (a1[e] * sn + a2[e] * cs) * 0.125f; }
          *(uint4*)(Ks + s * 72 + i0) = pack8(o1); *(uint4*)(Ks + s * 72 + 32 + i0) = pack8(o2); }
#pragma unroll
        for (int it = 0; it < 2; ++it) { const int g = tid + it * 512, s = g >> 3, c8 = (g & 7) * 8; const size_t r = (size_t)b * SEQ + t0 + s;
            const uint4 raw = *(const uint4*)(H + r * HS + 2312 + hh * 64 + c8); const unsigned short* rv = (const unsigned short*)&raw;
#pragma unroll
            for (int e = 0; e < 8; ++e) Vt[(c8 + e) * 136 + s] = rv[e]; }
    }
    { const int pr = tid >> 3, n8 = (tid & 7) * 8; const float* src = ST + u * 4096 + pr * 64 + n8; const f32x4 x0 = *(const f32x4*)src, x1 = *(const f32x4*)(src + 4);
      uint4 o; o.x = pack2(x0[0], x0[1]); o.y = pack2(x0[2], x0[3]); o.z = pack2(x1[0], x1[1]); o.w = pack2(x1[2], x1[3]); *(uint4*)(Rt + pr * 72 + n8) = o; }
    __syncthreads();
    const int nks = (w >> 1) + 1;
    const int lrow = 16 * w + (lane >> 4) * 4;
    {
        const bf16x8 q0 = ldfrag(Qs, 16 * w, 72, 0, lane), q1 = ldfrag(Qs, 16 * w, 72, 32, lane);
        float al[4];
#pragma unroll
        for (int j = 0; j < 4; ++j) al[j] = acs[lrow + j];
        for (int nt = 0; nt < 2 * nks; ++nt) { f32x4 sacc = {0.f, 0.f, 0.f, 0.f};
            sacc = MFMA16(q0, ldfrag(Ks, nt * 16, 72, 0, lane), sacc); sacc = MFMA16(q1, ldfrag(Ks, nt * 16, 72, 32, lane), sacc);
            const int s = nt * 16 + (lane & 15); const float as = acs[s], ds = dts[s];
#pragma unroll
            for (int j = 0; j < 4; ++j) { const float pv = (s <= lrow + j) ? sacc[j] * __expf(al[j] - as) * ds : 0.f; Ps[(lrow + j) * 136 + s] = f2bf(pv); } }
    }
    __syncthreads();
    f32x4 yd[4], yo[4];
#pragma unroll
    for (int nt = 0; nt < 4; ++nt) { yd[nt] = (f32x4){0.f, 0.f, 0.f, 0.f}; yo[nt] = (f32x4){0.f, 0.f, 0.f, 0.f}; }
    for (int ks = 0; ks < nks; ++ks) { const bf16x8 pf = ldfrag(Ps, 16 * w, 136, ks * 32, lane);
#pragma unroll
        for (int nt = 0; nt < 4; ++nt) yd[nt] = MFMA16(pf, ldfrag(Vt, nt * 16, 136, ks * 32, lane), yd[nt]); }
#pragma unroll
    for (int ks = 0; ks < 2; ++ks) { const bf16x8 qf = ldfrag(Qs, 16 * w, 72, ks * 32, lane);
#pragma unroll
        for (int nt = 0; nt < 4; ++nt) yo[nt] = MFMA16(qf, ldfrag(Rt, nt * 16, 72, ks * 32, lane), yo[nt]); }
    float ea[4];
#pragma unroll
    for (int j = 0; j < 4; ++j) ea[j] = __expf(acs[lrow + j]);
    if (MIXER == 0) {
        const float dsk = p.ev_d[hh];
#pragma unroll
        for (int nt = 0; nt < 4; ++nt) { const int pc = nt * 16 + (lane & 15);
#pragma unroll
            for (int j = 0; j < 4; ++j) { const size_t r = (size_t)b * SEQ + t0 + lrow + j;
                const float y = yd[nt][j] + ea[j] * yo[nt][j] + dsk * bf2f(Vt[pc * 136 + lrow + j]);
                const float z = bf2f(H[r * HS + hh * 64 + pc]); const float yg = y * silu_(z); ssq[j] += yg * yg; YG[r * 512 + hh * 64 + pc] = yg; } }
    } else {
        float s2[4];
#pragma unroll
        for (int j = 0; j < 4; ++j) { float a = 0.f;
#pragma unroll
            for (int nt = 0; nt < 4; ++nt) { const float y = yd[nt][j] + ea[j] * yo[nt][j]; yd[nt][j] = y; a += y * y; }
            s2[j] = rsqrtf(red16(a) * (1.f / 64.f) + 1e-6f); }
#pragma unroll
        for (int nt = 0; nt < 4; ++nt) { const int pc = nt * 16 + (lane & 15); const float nw = p.ev_ret_norm_w[hh * 64 + pc];
#pragma unroll
            for (int j = 0; j < 4; ++j) { const size_t r = (size_t)b * SEQ + t0 + lrow + j; const float g = bf2f(H[r * HS + 2824 + hh * 64 + pc]);
                Y[r * DM + 512 + hh * 64 + pc] = f2bf(silu_(g) * yd[nt][j] * s2[j] * nw); } }
    }
}
DI void phase_m3(const Params& p, unsigned char* smem) {
    const int lane = otid() & 63, w = otid() >> 6;
    for (int u = obid(); u < 256; u += gridDim.x) {
        const int mixer = u >> 7, b = (u >> 6) & 1, c = u & 63; float ssq[4] = {0.f, 0.f, 0.f, 0.f};
        if (mixer == 0) {
            for (int hh = 0; hh < 8; ++hh) m3_head<0>(p, smem, b, c, hh, ssq);
            float* YG = (float*)(p.ws + O_YG); bf16_t* Y = (bf16_t*)(p.ws + O_XN); const int lrow = 16 * w + (lane >> 4) * 4;
            float rstd[4];
#pragma unroll
            for (int j = 0; j < 4; ++j) rstd[j] = rsqrtf(red16(ssq[j]) * (1.f / 512.f) + 1e-6f);
            for (int cc = 0; cc < 32; ++cc) { const int col = cc * 16 + (lane & 15); const float nw = p.ev_ssd_norm_w[col];
#pragma unroll
                for (int j = 0; j < 4; ++j) { const size_t r = (size_t)b * SEQ + c * 128 + lrow + j;
                    const float v = __hip_atomic_load(YG + r * 512 + col, __ATOMIC_RELAXED, __HIP_MEMORY_SCOPE_AGENT); Y[r * DM + col] = f2bf(v * rstd[j] * nw); } }
        } else {
            for (int hh = 0; hh < 8; ++hh) m3_head<1>(p, smem, b, c, hh, ssq);
        }
    }
}
DI void phase_ffn_act(const Params& p, int layer) {
    const bf16_t* G = (const bf16_t*)(p.ws + O_G); bf16_t* U = (bf16_t*)(p.ws + O_U);
    const float* cw = p.ffn_conv_w + (size_t)layer * 3 * DFF; const float* cb = p.ffn_conv_b + (size_t)layer * DFF;
    for (int idx = obid() * 512 + otid(); idx < TOK * (DFF / 8); idx += gridDim.x * 512) {
        const int r = idx / (DFF / 8), c8 = (idx % (DFF / 8)) * 8, t = r & (SEQ - 1);
        float acc[8], g[8], uv[8];
        { const f32x4 b0 = *(const f32x4*)(cb + c8), b1 = *(const f32x4*)(cb + c8 + 4); acc[0] = b0[0]; acc[1] = b0[1]; acc[2] = b0[2]; acc[3] = b0[3]; acc[4] = b1[0]; acc[5] = b1[1]; acc[6] = b1[2]; acc[7] = b1[3]; }
#pragma unroll
        for (int k = 0; k < 3; ++k) { if (t - 2 + k >= 0) { unpack8(*(const uint4*)(G + (size_t)(r - 2 + k) * DFF + c8), g);
            const f32x4 w0 = *(const f32x4*)(cw + k * DFF + c8), w1 = *(const f32x4*)(cw + k * DFF + c8 + 4);
            acc[0] += w0[0] * g[0]; acc[1] += w0[1] * g[1]; acc[2] += w0[2] * g[2]; acc[3] += w0[3] * g[3]; acc[4] += w1[0] * g[4]; acc[5] += w1[1] * g[5]; acc[6] += w1[2] * g[6]; acc[7] += w1[3] * g[7]; } }
        unpack8(*(const uint4*)(U + (size_t)r * DFF + c8), uv);
#pragma unroll
        for (int e = 0; e < 8; ++e) acc[e] = silu_(acc[e]) * uv[e];
        *(uint4*)(U + (size_t)r * DFF + c8) = pack8(acc);
    }
}
DI void phase_l1_prep(const Params& p, unsigned char* smem) {
    const bf16_t* H = (const bf16_t*)(p.ws + O_H); const float* aux = (const float*)(p.ws + O_AUX); float* FC = (float*)(p.ws + O_FC);
    bf16_t* KN = (bf16_t*)(p.ws + O_KN); bf16_t* VT = (bf16_t*)(p.ws + O_VT); bf16_t* AP = (bf16_t*)(p.ws + O_AP);
    const int tid = otid();
    for (int u = obid(); u < 16 + 1024; u += gridDim.x) {
        __syncthreads();
        if (u < 16) {
            float* tot = (float*)smem; const int bh = u, b = bh >> 3, hh = bh & 7; const float fb = p.od_f_bias[hh]; float loc[16]; float run = 0.f;
#pragma unroll
            for (int i = 0; i < 16; ++i) { const float xv = aux[((size_t)b * SEQ + tid * 16 + i) * 8 + hh] + fb; run += -softplus_(-xv); loc[i] = run; }
            tot[tid] = run; __syncthreads();
            float off = 0.f; for (int i = 0; i < tid; ++i) off += tot[i];
#pragma unroll
            for (int i = 0; i < 16; ++i) FC[(size_t)bh * SEQ + tid * 16 + i] = off + loc[i];
        } else {
            bf16_t* Vl = (bf16_t*)smem; const int v2 = u - 16, bh = v2 >> 6, blk = v2 & 63, b = bh >> 3, hh = bh & 7, t0 = blk * 128;
            { const int l = tid >> 2, c16 = (tid & 3) * 16; const size_t r = (size_t)b * SEQ + t0 + l; float a[8], c[8];
              unpack8(*(const uint4*)(H + r * HS + 2304 + hh * 64 + c16), a); unpack8(*(const uint4*)(H + r * HS + 2304 + hh * 64 + c16 + 8), c);
              float ss = 0.f;
#pragma unroll
              for (int e = 0; e < 8; ++e) ss += a[e] * a[e] + c[e] * c[e];
              ss += __shfl_xor(ss, 1); ss += __shfl_xor(ss, 2); const float rstd = rsqrtf(ss * (1.f / 64.f) + 1e-6f);
#pragma unroll
              for (int e = 0; e < 8; ++e) { a[e] *= rstd * p.od_kn_w[c16 + e]; c[e] *= rstd * p.od_kn_w[c16 + 8 + e]; }
              bf16_t* dst = KN + ((size_t)bh * SEQ + t0 + l) * 64 + c16; *(uint4*)dst = pack8(a); *(uint4*)(dst + 8) = pack8(c); }
#pragma unroll
            for (int it = 0; it < 2; ++it) { const int g = tid + it * 512, s = g >> 3, c8 = (g & 7) * 8; const size_t r = (size_t)b * SEQ + t0 + s;
                *(uint4*)(Vl + s * 72 + c8) = *(const uint4*)(H + r * HS + 2816 + hh * 64 + c8); }
            __syncthreads();
#pragma unroll
            for (int it = 0; it < 2; ++it) { const int g = tid + it * 512, e = g >> 4, s8 = (g & 15) * 8; uint4 o;
                o.x = (unsigned)Vl[(s8 + 0) * 72 + e] | ((unsigned)Vl[(s8 + 1) * 72 + e] << 16); o.y = (unsigned)Vl[(s8 + 2) * 72 + e] | ((unsigned)Vl[(s8 + 3) * 72 + e] << 16);
                o.z = (unsigned)Vl[(s8 + 4) * 72 + e] | ((unsigned)Vl[(s8 + 5) * 72 + e] << 16); o.w = (unsigned)Vl[(s8 + 6) * 72 + e] | ((unsigned)Vl[(s8 + 7) * 72 + e] << 16);
                *(uint4*)(VT + ((size_t)bh * 64 + e) * SEQ + t0 + s8) = o; }
        }
    }
    for (int idx = obid() * 512 + tid; idx < TOK * 32; idx += gridDim.x * 512) {
        const int r = idx >> 5, j8 = (idx & 31) * 8, t = r & (SEQ - 1); float cur[8], prv[8], o[8];
        unpack8(*(const uint4*)(H + (size_t)r * HS + 1536 + j8), cur);
        if (t > 0) unpack8(*(const uint4*)(H + (size_t)(r - 1) * HS + 1536 + j8), prv); else {
#pragma unroll
            for (int e = 0; e < 8; ++e) prv[e] = 0.f; }
#pragma unroll
        for (int e = 0; e < 8; ++e) { const float v = cur[e] + (prv[e] - cur[e]) * p.od_mu[1536 + j8 + e];
            o[e] = (j8 < 64) ? tanhf(v) : ((j8 < 128) ? v : sigm_(v)); }
        *(uint4*)(AP + (size_t)r * 256 + j8) = pack8(o);
    }
}
DI void fox_unit(const Params& p, unsigned char* smem, int bh, int qb) {
    bf16_t* Qs = (bf16_t*)smem; bf16_t* Ks = (bf16_t*)(smem + 18432); bf16_t* Vts = (bf16_t*)(smem + 36864); bf16_t* Ps = (bf16_t*)(smem + 54272);
    float* cq = (float*)(smem + 89088); float* ck = (float*)(smem + 89600);
    const bf16_t* H = (const bf16_t*)(p.ws + O_H); const float* FC = (const float*)(p.ws + O_FC); const bf16_t* KN = (const bf16_t*)(p.ws + O_KN); const bf16_t* VT = (const bf16_t*)(p.ws + O_VT);
    bf16_t* Y = (bf16_t*)(p.ws + O_XN);
    const int tid = otid(), lane = tid & 63, w = tid >> 6, b = bh >> 3, hh = bh & 7; const size_t r0 = (size_t)b * SEQ + qb * 128;
    __syncthreads();
    { const int l = tid >> 2, c16 = (tid & 3) * 16; float a[8], c[8];
      unpack8(*(const uint4*)(H + (r0 + l) * HS + 1792 + hh * 64 + c16), a); unpack8(*(const uint4*)(H + (r0 + l) * HS + 1792 + hh * 64 + c16 + 8), c);
      float ss = 0.f;
#pragma unroll
      for (int e = 0; e < 8; ++e) ss += a[e] * a[e] + c[e] * c[e];
      ss += __shfl_xor(ss, 1); ss += __shfl_xor(ss, 2); const float rstd = rsqrtf(ss * (1.f / 64.f) + 1e-6f) * 0.125f;
#pragma unroll
      for (int e = 0; e < 8; ++e) { a[e] *= rstd * p.od_qn_w[c16 + e]; c[e] *= rstd * p.od_qn_w[c16 + 8 + e]; }
      *(uint4*)(Qs + l * 72 + c16) = pack8(a); *(uint4*)(Qs + l * 72 + c16 + 8) = pack8(c);
      if ((tid & 3) == 0) cq[l] = FC[(size_t)bh * SEQ + qb * 128 + l]; }
    float mrow[4], lsum[4]; f32x4 O[4];
#pragma unroll
    for (int j = 0; j < 4; ++j) { mrow[j] = -1e30f; lsum[j] = 0.f; O[j] = (f32x4){0.f, 0.f, 0.f, 0.f}; }
    const int lrow = 16 * w + (lane >> 4) * 4;
    for (int kb = 0; kb <= qb; ++kb) {
        __syncthreads();
#pragma unroll
        for (int it = 0; it < 2; ++it) { const int g = tid + it * 512; { const int s = g >> 3, c8 = (g & 7) * 8; *(uint4*)(Ks + s * 72 + c8) = *(const uint4*)(KN + ((size_t)bh * SEQ + kb * 128 + s) * 64 + c8); }
            { const int e = g >> 4, s8 = (g & 15) * 8; *(uint4*)(Vts + e * 136 + s8) = *(const uint4*)(VT + ((size_t)bh * 64 + e) * SEQ + kb * 128 + s8); } }
        if (tid < 128) ck[tid] = FC[(size_t)bh * SEQ + kb * 128 + tid];
        __syncthreads();
        f32x4 S[8];
        { const bf16x8 q0 = ldfrag(Qs, 16 * w, 72, 0, lane), q1 = ldfrag(Qs, 16 * w, 72, 32, lane);
#pragma unroll
          for (int nt = 0; nt < 8; ++nt) { f32x4 z = {0.f, 0.f, 0.f, 0.f}; z = MFMA16(q0, ldfrag(Ks, nt * 16, 72, 0, lane), z); S[nt] = MFMA16(q1, ldfrag(Ks, nt * 16, 72, 32, lane), z); } }
        const bool diag = (kb == qb);
#pragma unroll
        for (int nt = 0; nt < 8; ++nt) { const int s = nt * 16 + (lane & 15); const float cks = ck[s];
#pragma unroll
            for (int j = 0; j < 4; ++j) { float v = S[nt][j] + cq[lrow + j] - cks; if (diag && s > lrow + j) v = -1e30f; S[nt][j] = v; } }
#pragma unroll
        for (int j = 0; j < 4; ++j) { float mx = S[0][j];
#pragma unroll
            for (int nt = 1; nt < 8; ++nt) mx = fmaxf(mx, S[nt][j]);
            mx = max16(mx); const float mnew = fmaxf(mrow[j], mx); const float alpha = __expf(mrow[j] - mnew); mrow[j] = mnew; float rs = 0.f;
#pragma unroll
            for (int nt = 0; nt < 8; ++nt) { const float pv = __expf(S[nt][j] - mnew); S[nt][j] = pv; rs += pv; }
            rs = red16(rs); lsum[j] = lsum[j] * alpha + rs;
#pragma unroll
            for (int n4 = 0; n4 < 4; ++n4) O[n4][j] *= alpha; }
#pragma unroll
        for (int nt = 0; nt < 8; ++nt)
#pragma unroll
            for (int j = 0; j < 4; ++j) Ps[(lrow + j) * 136 + nt * 16 + (lane & 15)] = f2bf(S[nt][j]);
        __syncthreads();
#pragma unroll
        for (int ks = 0; ks < 4; ++ks) { const bf16x8 pf = ldfrag(Ps, 16 * w, 136, ks * 32, lane);
#pragma unroll
            for (int n4 = 0; n4 < 4; ++n4) O[n4] = MFMA16(pf, ldfrag(Vts, n4 * 16, 136, ks * 32, lane), O[n4]); }
    }
#pragma unroll
    for (int n4 = 0; n4 < 4; ++n4)
#pragma unroll
        for (int j = 0; j < 4; ++j) Y[(r0 + lrow + j) * DM + 512 + hh * 64 + n4 * 16 + (lane & 15)] = f2bf(O[n4][j] / lsum[j]);
}
constexpr int RW_T = 32, RW_BUF = 43008;
struct RwRegs { unsigned short r[9], k[9], v[9], om[8], a[8]; };
DI void rwkv_unit(const Params& p, unsigned char* smem, int bh, int rg) {
    const bf16_t* H = (const bf16_t*)(p.ws + O_H); const bf16_t* LW = (const bf16_t*)(p.ws + O_LW); bf16_t* Y = (bf16_t*)(p.ws + O_XN);
    const int tid = otid(), lane = tid & 63, w = tid >> 6, b = bh >> 3, hh = bh & 7; const size_t rb = (size_t)b * SEQ;
    float* ysh = (float*)(smem + 2 * RW_BUF);
    const int NCH = SEQ / RW_T;
    __syncthreads();
    if (w < 4) {
        float S0 = 0.f, S1 = 0.f, S2 = 0.f, S3 = 0.f; const int kq = lane & 15, row = w * 4 + (lane >> 4);
        __syncthreads();
        for (int ch = 0; ch < NCH; ++ch) {
            const float* bufp = (const float*)(smem + (ch & 1) * RW_BUF); float* yo = ysh + (ch & 1) * 512;
#pragma unroll 4
            for (int tt = 0; tt < RW_T; ++tt) {
                const f32x4 r4 = *(const f32x4*)(bufp + tt * 64 + kq * 4), w4 = *(const f32x4*)(bufp + 2048 + tt * 64 + kq * 4), k4 = *(const f32x4*)(bufp + 4096 + tt * 64 + kq * 4);
                const f32x4 q4 = *(const f32x4*)(bufp + 6144 + tt * 64 + kq * 4), b4 = *(const f32x4*)(bufp + 8192 + tt * 64 + kq * 4); const float vv = bufp[10240 + tt * 16 + row];
                float d = S0 * q4[0] + S1 * q4[1] + S2 * q4[2] + S3 * q4[3]; d = dpp_red16(d); const float sa = -d;
                S0 = S0 * w4[0] + sa * b4[0] + vv * k4[0]; S1 = S1 * w4[1] + sa * b4[1] + vv * k4[1]; S2 = S2 * w4[2] + sa * b4[2] + vv * k4[2]; S3 = S3 * w4[3] + sa * b4[3] + vv * k4[3];
                float y = S0 * r4[0] + S1 * r4[1] + S2 * r4[2] + S3 * r4[3]; y = dpp_red16(y);
                if (kq == 0) yo[tt * 16 + row] = y;
            }
            __syncthreads();
        }
    } else {
        const int lw = w - 4, col = hh * 64 + lane; RwRegs ra;
        const float mur = p.od_mu[col], muk = p.od_mu[512 + col], muv = p.od_mu[1024 + col], kk_w = p.od_k_k[col], ka_w = p.od_k_a[col];
        auto issue = [&](int ch, RwRegs& rr) {
            const int tbase = ch * RW_T + lw * 8;
#pragma unroll
            for (int i = 0; i < 9; ++i) { const int t = tbase + i - 1;
                if (t >= 0) { const bf16_t* hp = H + (rb + t) * HS; rr.r[i] = hp[col]; rr.k[i] = hp[512 + col]; rr.v[i] = hp[1024 + col]; } else { rr.r[i] = 0; rr.k[i] = 0; rr.v[i] = 0; }
                if (i > 0) { const bf16_t* lp = LW + (rb + t) * 1536; rr.om[i - 1] = lp[col]; rr.a[i - 1] = lp[512 + col]; } }
        };
        auto process = [&](int ch, const RwRegs& rr) {
            float* bufp = (float*)(smem + (ch & 1) * RW_BUF);
#pragma unroll
            for (int i = 1; i < 9; ++i) { const int tt = lw * 8 + i - 1;
                const float rc = bf2f(rr.r[i]), rp = bf2f(rr.r[i - 1]), kc = bf2f(rr.k[i]), kp = bf2f(rr.k[i - 1]), vc = bf2f(rr.v[i]), vp = bf2f(rr.v[i - 1]);
                const float rl = rc + (rp - rc) * mur, kl = kc + (kp - kc) * muk, vl = vc + (vp - vc) * muv; const float a = bf2f(rr.a[i - 1]), wv = 1.f - bf2f(rr.om[i - 1]);
                const float kkr = kl * kk_w; const float nrm = sqrtf(red64(kkr * kkr)); const float kk = kkr / fmaxf(nrm, 1e-12f);
                bufp[tt * 64 + lane] = rl; bufp[2048 + tt * 64 + lane] = wv; bufp[4096 + tt * 64 + lane] = kl * (1.f + (a - 1.f) * ka_w); bufp[6144 + tt * 64 + lane] = kk; bufp[8192 + tt * 64 + lane] = kk * a;
                if ((lane >> 4) == rg) bufp[10240 + tt * 16 + (lane & 15)] = vl; }
        };
        issue(0, ra); process(0, ra); issue(1, ra);
        __syncthreads();
        for (int ch = 0; ch < NCH; ++ch) {
            if (ch + 1 < NCH) { process(ch + 1, ra); if (ch + 2 < NCH) issue(ch + 2, ra); }
            if (ch > 0) { const float* yi = ysh + ((ch - 1) & 1) * 512; const int t2 = tid - 256, tt = t2 >> 3, pr = (t2 & 7) * 2;
                *(unsigned*)(Y + (rb + (ch - 1) * RW_T + tt) * DM + hh * 64 + rg * 16 + pr) = pack2(yi[tt * 16 + pr], yi[tt * 16 + pr + 1]); }
            __syncthreads();
        }
        { const float* yi = ysh + ((NCH - 1) & 1) * 512; const int t2 = tid - 256, tt = t2 >> 3, pr = (t2 & 7) * 2;
          *(unsigned*)(Y + (rb + (NCH - 1) * RW_T + tt) * DM + hh * 64 + rg * 16 + pr) = pack2(yi[tt * 16 + pr], yi[tt * 16 + pr + 1]); }
    }
    __syncthreads();
}
DI void phase_l1_mix(const Params& p, unsigned char* smem) {
    unsigned* ctr = (unsigned*)(p.ws + O_CTL); int* sh = (int*)(smem + 90112);
    if (obid() < 64) rwkv_unit(p, smem, obid() >> 2, obid() & 3);
    for (;;) {
        __syncthreads(); if (otid() == 0) *sh = (int)atomicAdd(ctr, 1u); __syncthreads();
        const int u = *sh; if (u >= 1024) break;
        fox_unit(p, smem, u & 15, 63 - (u >> 4));
    }
}
DI void phase_rwkv_fin(const Params& p) {
    const bf16_t* H = (const bf16_t*)(p.ws + O_H); const bf16_t* LW = (const bf16_t*)(p.ws + O_LW); bf16_t* Y = (bf16_t*)(p.ws + O_XN);
    const int lane = otid() & 63, wv = otid() >> 6;
    for (int task = obid() * 8 + wv; task < TOK * 8; task += gridDim.x * 8) {
        const int r = task >> 3, hh = task & 7, t = r & (SEQ - 1), col = hh * 64 + lane; const bf16_t* hp = H + (size_t)r * HS;
        const float y = bf2f(Y[(size_t)r * DM + col]); const float mean = red64(y) * (1.f / 64.f); const float dy = y - mean; const float var = red64(dy * dy) * (1.f / 64.f);
        const float yln = dy * rsqrtf(var + 64e-5f) * p.od_ln_w[col] + p.od_ln_b[col];
        const float rc = bf2f(hp[col]), kc = bf2f(hp[512 + col]), vc = bf2f(hp[1024 + col]); float rp = 0.f, kp = 0.f, vp = 0.f;
        if (t > 0) { rp = bf2f(hp[col - HS]); kp = bf2f(hp[512 + col - HS]); vp = bf2f(hp[1024 + col - HS]); }
        const float rl = rc + (rp - rc) * p.od_mu[col], kl = kc + (kp - kc) * p.od_mu[512 + col], vl = vc + (vp - vc) * p.od_mu[1024 + col];
        const float a = bf2f(LW[(size_t)r * 1536 + 512 + col]), g = bf2f(LW[(size_t)r * 1536 + 1024 + col]);
        const float kt = kl * (1.f + (a - 1.f) * p.od_k_a[col]); const float bonus = red64(rl * kt * p.od_r_k[col]) * vl;
        Y[(size_t)r * DM + col] = f2bf((yln + bonus) * g);
    }
}
__global__ void __launch_bounds__(512, 2) fwd_megakernel(Params p) {
    extern __shared__ __attribute__((aligned(16))) unsigned char smem[];
    cg::grid_group grid = cg::this_grid();
    unsigned char* ws = p.ws;
    bf16_t* XN = (bf16_t*)(ws + O_XN); bf16_t* Hb = (bf16_t*)(ws + O_H); float* aux = (float*)(ws + O_AUX);
    const bf16_t* t_in = (const bf16_t*)(ws + O_WT_IN); const bf16_t* t_out = (const bf16_t*)(ws + O_WT_OUT); const bf16_t* t_up = (const bf16_t*)(ws + O_WT_UP);
    const bf16_t* t_dn = (const bf16_t*)(ws + O_WT_DN); const bf16_t* t_lr = (const bf16_t*)(ws + O_WT_LR);
    if (blockIdx.x == 0 && threadIdx.x == 0) *(unsigned*)(ws + O_CTL) = 0u;
#define GEMM_H(layer) { EpiH E; E.H = Hb; E.aux = aux; E.auxc = layer ? 3328 : 1280; run_gemm(smem, XN, t_in, 3584, 1024, E); }
#define GEMM_OUT(layer) { EpiRes E; E.res = layer ? p.out : p.x; E.out = p.out; run_gemm(smem, XN, t_out, 1024, 1024, E); }
#define GEMM_UP() { EpiGU E; E.G = (bf16_t*)(ws + O_G); E.U = (bf16_t*)(ws + O_U); run_gemm(smem, XN, t_up, 2 * DFF, 1024, E); }
#define GEMM_DN() { EpiRes E; E.res = p.out; E.out = p.out; run_gemm(smem, (const bf16_t*)(ws + O_U), t_dn, 1024, DFF, E); }
    phase_weights(p, smem, 0); phase_rmsnorm(p.x, p.ev_norm_w, XN); grid.sync();
    GEMM_H(0) grid.sync();
    phase_m1(p, smem); grid.sync();
    phase_m2(p); grid.sync();
    phase_m3(p, smem); grid.sync();
    GEMM_OUT(0) grid.sync();
    phase_rmsnorm(p.out, p.ffn_norm_w, XN); grid.sync();
    GEMM_UP() grid.sync();
    phase_ffn_act(p, 0); grid.sync();
    GEMM_DN() grid.sync();
    phase_weights(p, smem, 1); phase_rmsnorm(p.out, p.od_norm_w, XN); grid.sync();
    GEMM_H(1) grid.sync();
    phase_l1_prep(p, smem); grid.sync();
    { EpiLR E; E.LW = (bf16_t*)(ws + O_LW); E.w0 = p.od_w0; E.a0 = p.od_a0; run_gemm(smem, (const bf16_t*)(ws + O_AP), t_lr, 1536, 256, E); } grid.sync();
    phase_l1_mix(p, smem); grid.sync();
    phase_rwkv_fin(p); grid.sync();
    GEMM_OUT(1) grid.sync();
    phase_rmsnorm(p.out, p.ffn_norm_w + DM, XN); grid.sync();
    GEMM_UP() grid.sync();
    phase_ffn_act(p, 1); grid.sync();
    GEMM_DN()
}

extern "C" void kernel_launch(void* const* d_in, const int* in_sizes, int n_in, void* d_out, int out_size, void* d_ws, size_t ws_size, hipStream_t stream) {
    static int grid_blocks = 0;
    if (grid_blocks == 0) {
        int dev = 0, cus = 0, per_cu = 0;
        hipGetDevice(&dev); hipDeviceGetAttribute(&cus, hipDeviceAttributeMultiprocessorCount, dev);
        if (hipFuncSetAttribute((const void*)fwd_megakernel, hipFuncAttributeMaxDynamicSharedMemorySize, LDS_BYTES) != hipSuccess) fprintf(stderr, "hipFuncSetAttribute failed\n");
        hipOccupancyMaxActiveBlocksPerMultiprocessor(&per_cu, (const void*)fwd_megakernel, 512, LDS_BYTES);
        (void)hipGetLastError();
        if (per_cu < 1) fprintf(stderr, "occupancy query says %d blocks per CU\n", per_cu);
        grid_blocks = cus > 0 ? cus : 256;
        if (ws_size < WS_NEED) fprintf(stderr, "workspace too small: %zu < %zu\n", ws_size, (size_t)WS_NEED);
    }
    Params p{};
    const float** pp = (const float**)&p;
    for (int i = 0; i < 33; ++i) pp[i] = (const float*)d_in[i];
    p.out = (float*)d_out; p.ws = (unsigned char*)d_ws;
    void* args[] = {&p};
    hipError_t e = hipLaunchCooperativeKernel((const void*)fwd_megakernel, dim3(grid_blocks), dim3(512), args, LDS_BYTES, stream);
    if (e != hipSuccess) fprintf(stderr, "cooperative launch failed: %s (grid %d)\n", hipGetErrorString(e), grid_blocks);
}
```

```cpp
#include <hip/hip_runtime.h>
#include <hip/hip_cooperative_groups.h>
#include <cstdio>
#ifndef PROBE
#define PROBE 0
#endif
namespace cg = cooperative_groups;
namespace pg8 {
#define PG8_LAS __attribute__((address_space(3)))
typedef unsigned short bf16_t;
typedef short bf16x8 __attribute__((ext_vector_type(8)));
typedef float f32x4 __attribute__((ext_vector_type(4)));
typedef unsigned u32x4 __attribute__((ext_vector_type(4)));
constexpr int BM = 256, BK = 64, HALF = 128, HTB = HALF * BK * 2  , STAGE_BYTES = 8 * HTB, NXCD = 8, WGM = 8;

__host__ __device__ __forceinline__ int lds_byte(int r, int c) { const int st = (r >> 4) * 2 + (c >> 5), rr = r & 15, cc = c & 31, ob = rr * 64 + cc * 2; return st * 1024 + (ob ^ (((ob >> 9) & 1) << 5)); }
__host__ __device__ __forceinline__ void stage_rc(int b, int& R, int& C) { const int st = b / 1024, sb = b % 1024, swz = sb ^ (((sb >> 9) & 1) << 5); R = (st >> 1) * 16 + swz / 64; C = (st & 1) * 32 + (swz % 64) / 2; }
__host__ __device__ __forceinline__ int perm32(int rho) { const int n = rho >> 4, i = rho & 15; return 8 * (i >> 2) + 4 * n + (i & 3); }

struct Unit { int pm, pn; };
struct Gemm { const bf16_t* A; const bf16_t* Bt; int M, N, K; };

struct StaticOrder {
    int nM, nN, nwg, G, c;
    __host__ __device__ void init(int M, int N, int G_, int c_) { nM = M / BM; nN = N / BM; nwg = nM * nN; G = G_; c = c_; }
    __host__ __device__ bool next(int i, Unit& u) const {
        const long L = (long)i * G + c; if (L >= nwg) return false;
        int wgid = (int)L; { const int q = nwg / NXCD, r = nwg % NXCD, xcd = wgid % NXCD, off = wgid / NXCD; wgid = (xcd < r ? xcd * (q + 1) : r * (q + 1) + (xcd - r) * q) + off; }
        const int nig = WGM * nN, gid = wgid / nig, fm = gid * WGM, gsz = (nM - fm) < WGM ? (nM - fm) : WGM;
        u.pm = fm + ((wgid % nig) % gsz); u.pn = (wgid % nig) / gsz; return true;
    }
    __device__ __forceinline__ void a_ready(const Unit&) const {}
    __device__ __forceinline__ void done(const Unit&) const {}
};
__device__ __forceinline__ unsigned cvt_pk_bf16(float lo, float hi) { unsigned r; asm volatile("v_cvt_pk_bf16_f32 %0, %1, %2" : "=v"(r) : "v"(lo), "v"(hi)); return r; }

template <class Epi, class Sched, bool STAMP = false>
__device__ __forceinline__ void gemm_phase(PG8_LAS unsigned char* lds, const Gemm g, const Sched& S, const Epi& E, unsigned long long* stamps) {
    int tid_ = threadIdx.x; asm volatile("" : "+v"(tid_)); const int tid = tid_, wid = __builtin_amdgcn_readfirstlane(tid >> 6), lane = tid & 63, wr = wid >> 2, wc = wid & 3, fr = lane & 15, fq = lane >> 4;
    const int K = g.K, nt = K / BK;
    int ts_lo = 0, ts_hi = 0, nts = 0; const unsigned long long rt_entry = STAMP ? (unsigned long long)wall_clock64() : 0ull;
#define PG8_STAMP() do { if (STAMP && wid == 0 && nts < 64) { const unsigned long long _c = (unsigned long long)clock64(); \
        ts_lo = (lane == nts) ? (int)(unsigned)_c : ts_lo; ts_hi = (lane == nts) ? (int)(unsigned)(_c >> 32) : ts_hi; ++nts; } } while (0)
    PG8_STAMP();
    unsigned voffA[2], voffB[2];
#pragma unroll
    for (int i = 0; i < 2; ++i) { int R, C; stage_rc(tid * 16 + i * 8192, R, C); const int Rb = Epi::PERM ? ((R & ~31) + perm32(R & 31)) : R;
        voffA[i] = (unsigned)(R * K + C) * 2u; voffB[i] = (unsigned)(Rb * K + C) * 2u; }
    const size_t kstep = (size_t)(BK * 2);
    const size_t hstep = (size_t)HALF * K * 2;
    const size_t tstep = 2 * hstep;
    const unsigned ldsw = (unsigned)wid * 1024u;
    const int aoff = lds_byte(wr * 64 + fr, fq * 8), boff = lds_byte(wc * 32 + fr, fq * 8);
#define PG8_SA(b, h) (((b) * 2 + (h)) * HTB)
#define PG8_SB(b, h) ((4 + (b) * 2 + (h)) * HTB)
#define PG8_STAGE(bufoff, gbase, voff) do { _Pragma("unroll") for (int _i = 0; _i < 2; ++_i) \
        __builtin_amdgcn_global_load_lds((const unsigned*)((const char*)(gbase) + (voff)[_i]), (PG8_LAS unsigned*)(lds + (bufoff) + ldsw + _i * 8192), 16, 0, 0); } while (0)
#define PG8_LDA(dst, b, h) do { _Pragma("unroll") for (int m = 0; m < 4; ++m) _Pragma("unroll") for (int k = 0; k < 2; ++k) dst[m][k] = *(const PG8_LAS bf16x8*)(lds + PG8_SA(b, h) + aoff + m * 2048 + k * 1024); } while (0)
#define PG8_LDB(dst, b, h) do { _Pragma("unroll") for (int n = 0; n < 2; ++n) _Pragma("unroll") for (int k = 0; k < 2; ++k) dst[n][k] = *(const PG8_LAS bf16x8*)(lds + PG8_SB(b, h) + boff + n * 2048 + k * 1024); } while (0)
#define PG8_MMA(ai, bj, At, Bt) do { __builtin_amdgcn_s_setprio(1); _Pragma("unroll") for (int m = 0; m < 4; ++m) _Pragma("unroll") for (int n = 0; n < 2; ++n) _Pragma("unroll") for (int k = 0; k < 2; ++k) \
        acc[ai][bj][m][n] = __builtin_amdgcn_mfma_f32_16x16x32_bf16(Bt[n][k], At[m][k], acc[ai][bj][m][n], 0, 0, 0); __builtin_amdgcn_s_setprio(0); } while (0)
#define PG8_WAIT_V(n) asm volatile("s_waitcnt vmcnt(" #n ")" ::: "memory")
#define PG8_WAIT_L(n) asm volatile("s_waitcnt lgkmcnt(" #n ")" ::: "memory")
#define PG8_BAR __builtin_amdgcn_s_barrier()
#define PG8_SCHED __builtin_amdgcn_sched_barrier(0)
    Unit cur, nxt; int ui = 0;
    if (!S.next(0, cur)) return;
    f32x4 acc[2][2][4][2];
#pragma unroll
    for (int a = 0; a < 2; ++a)
#pragma unroll
        for (int b = 0; b < 2; ++b)
#pragma unroll
            for (int m = 0; m < 4; ++m)
#pragma unroll
                for (int n = 0; n < 2; ++n) acc[a][b][m][n] = (f32x4){0.f, 0.f, 0.f, 0.f};
    bf16x8 At[4][2], B0[2][2], B1[2][2];
    const char* cA = (const char*)g.A + (size_t)cur.pm * tstep; const char* cB = (const char*)g.Bt + (size_t)cur.pn * tstep;
    S.a_ready(cur);
    PG8_STAGE(PG8_SB(0, 0), cB, voffB); PG8_STAGE(PG8_SA(0, 0), cA, voffA); PG8_STAGE(PG8_SB(0, 1), cB + hstep, voffB); PG8_STAGE(PG8_SA(0, 1), cA + hstep, voffA);
    if (wr == 1) PG8_BAR;
    PG8_WAIT_V(4); PG8_BAR;
    PG8_STAGE(PG8_SB(1, 0), cB + kstep, voffB); PG8_STAGE(PG8_SA(1, 0), cA + kstep, voffA); PG8_STAGE(PG8_SB(1, 1), cB + hstep + kstep, voffB);
    PG8_WAIT_V(6); PG8_BAR;
    PG8_STAMP();
    for (;;) {
        const bool has_next = S.next(ui + 1, nxt);
        const char* nA = has_next ? (const char*)g.A + (size_t)nxt.pm * tstep : cA; const char* nB = has_next ? (const char*)g.Bt + (size_t)nxt.pn * tstep : cB;
        for (int t = 0; t < nt; t += 2) {
            const bool last = (t == nt - 2);
            const char* a1 = cA + (size_t)(t + 1) * kstep;
            const char* a2 = last ? nA : cA + (size_t)(t + 2) * kstep; const char* b2 = last ? nB : cB + (size_t)(t + 2) * kstep;
            const char* a3 = a2 + kstep; const char* b3 = b2 + kstep;
            if (last && has_next) S.a_ready(nxt);
            PG8_LDB(B0, 0, 0); PG8_SCHED; PG8_LDA(At, 0, 0); PG8_STAGE(PG8_SA(1, 1), a1 + hstep, voffA);
            PG8_WAIT_L(8); PG8_BAR; PG8_WAIT_L(0); PG8_MMA(0, 0, At, B0); PG8_BAR; PG8_SCHED;
            PG8_LDB(B1, 0, 1); PG8_STAGE(PG8_SB(0, 0), b2, voffB);
            PG8_BAR; PG8_WAIT_L(0); PG8_MMA(0, 1, At, B1); PG8_BAR;
            PG8_LDA(At, 0, 1); PG8_STAGE(PG8_SA(0, 0), a2, voffA);
            PG8_BAR; PG8_WAIT_L(0); PG8_MMA(1, 0, At, B0); PG8_BAR; PG8_SCHED;
            PG8_STAGE(PG8_SB(0, 1), b2 + hstep, voffB);
            PG8_WAIT_V(6); PG8_BAR; PG8_MMA(1, 1, At, B1); PG8_BAR;
            PG8_LDB(B0, 1, 0); PG8_SCHED; PG8_LDA(At, 1, 0); PG8_STAGE(PG8_SA(0, 1), a2 + hstep, voffA);
            PG8_WAIT_L(8); PG8_BAR; PG8_WAIT_L(0); PG8_MMA(0, 0, At, B0); PG8_BAR; PG8_SCHED;
            PG8_LDB(B1, 1, 1); PG8_STAGE(PG8_SB(1, 0), b3, voffB);
            PG8_BAR; PG8_WAIT_L(0); PG8_MMA(0, 1, At, B1); PG8_BAR;
            PG8_LDA(At, 1, 1); PG8_STAGE(PG8_SA(1, 0), a3, voffA);
            PG8_BAR; PG8_WAIT_L(0); PG8_MMA(1, 0, At, B0); PG8_BAR; PG8_SCHED;
            PG8_STAGE(PG8_SB(1, 1), b3 + hstep, voffB);
            PG8_WAIT_V(6); PG8_BAR; PG8_MMA(1, 1, At, B1); PG8_BAR;
        }
        PG8_STAMP();
        if constexpr (!Epi::AFTER_DRAIN) { E(acc, cur, wr, wc, fr, fq); S.done(cur); }
        PG8_STAMP();
        if (!has_next) break;
#pragma unroll
        for (int a = 0; a < 2; ++a)
#pragma unroll
            for (int b = 0; b < 2; ++b)
#pragma unroll
                for (int m = 0; m < 4; ++m)
#pragma unroll
                    for (int n = 0; n < 2; ++n) acc[a][b][m][n] = (f32x4){0.f, 0.f, 0.f, 0.f};
        cur = nxt; cA = nA; cB = nB; ++ui;
    }
    PG8_WAIT_V(0);
    if (wr == 0) PG8_BAR;
    PG8_BAR;
    if constexpr (Epi::AFTER_DRAIN) { E.fused(acc, cur, wr, wc, fr, fq, lds, wid, lane); S.done(cur); }
    PG8_STAMP();
    if (STAMP && wid == 0) { stamps[lane] = lane < nts ? (((unsigned long long)(unsigned)ts_hi << 32) | (unsigned)ts_lo) : 0ull;
        if (lane == 62) stamps[62] = rt_entry; if (lane == 63) stamps[63] = (unsigned long long)wall_clock64(); }
#undef PG8_STAMP
#undef PG8_SA
#undef PG8_SB
#undef PG8_STAGE
#undef PG8_LDA
#undef PG8_LDB
#undef PG8_MMA
#undef PG8_WAIT_V
#undef PG8_WAIT_L
#undef PG8_BAR
#undef PG8_SCHED
}
}

using pg8::bf16_t; using pg8::bf16x8; using pg8::f32x4; using pg8::Unit; using pg8::cvt_pk_bf16;
#define DI __device__ __forceinline__
constexpr int TOK = 16384, SEQ = 8192, DM = 1024, HS = 3336, DFF = 2816;
constexpr size_t O_CTL = 0, O_CD = 256, O_AUX = 4352, O_ROPE = 528640, O_FC = 2625792, O_WT = 3150080;
constexpr size_t O_WT_IN = O_WT, O_WT_OUT = O_WT_IN + 7340032, O_WT_UP = O_WT_OUT + 2097152, O_WT_DN = O_WT_UP + 11534336, O_WT_LR = O_WT_DN + 5767168;
constexpr size_t O_XN = O_WT + 27525120, O_R1 = O_XN + 33554432;
constexpr size_t O_H = O_R1, O_ST = O_R1 + 109314048, O_YG = O_ST + 33554432;
constexpr size_t O_G = O_R1, O_U = O_R1 + 92274688;
constexpr size_t O_LW = O_R1 + 109314048, O_KN = O_LW + 50331648, O_VT = O_KN + 16777216, O_AP = O_VT + 16777216;
constexpr size_t O_KNRM = O_AP + 8388608;
constexpr size_t O_BAR = O_KNRM + 524288;
constexpr size_t WS_NEED = O_BAR + 16384;
constexpr int LDS_BYTES = 131072 + 256;

struct Params {
    const float* x; const float* ev_norm_w; const float* ev_w_in; const float* ev_conv_w; const float* ev_conv_b; const float* ev_dt_bias; const float* ev_a_log;
    const float* ev_d; const float* ev_ssd_norm_w; const float* ev_ret_norm_w; const float* ev_w_out;
    const float* od_norm_w; const float* od_w_in; const float* od_mu; const float* od_w0; const float* od_w_up; const float* od_a0; const float* od_a_up;
    const float* od_g_up; const float* od_k_k; const float* od_k_a; const float* od_r_k; const float* od_ln_w; const float* od_ln_b;
    const float* od_qn_w; const float* od_kn_w; const float* od_f_bias; const float* od_w_out;
    const float* ffn_norm_w; const float* ffn_w_up; const float* ffn_conv_w; const float* ffn_conv_b; const float* ffn_w_down;
    float* out; unsigned char* ws;
};

DI unsigned short f2bf(float f) { unsigned u = __float_as_uint(f); u += 0x7fffu + ((u >> 16) & 1u); return (unsigned short)(u >> 16); }
DI float bf2f(unsigned short b) { return __uint_as_float(((unsigned)b) << 16); }
DI unsigned pack2(float lo, float hi) { return (unsigned)f2bf(lo) | ((unsigned)f2bf(hi) << 16); }
DI float bflo(unsigned w) { return __uint_as_float(w << 16); }
DI float bfhi(unsigned w) { return __uint_as_float(w & 0xffff0000u); }
DI void unpack8(const uint4 r, float (&o)[8]) { o[0] = bflo(r.x); o[1] = bfhi(r.x); o[2] = bflo(r.y); o[3] = bfhi(r.y); o[4] = bflo(r.z); o[5] = bfhi(r.z); o[6] = bflo(r.w); o[7] = bfhi(r.w); }
DI uint4 pack8(const float (&o)[8]) { uint4 r; r.x = pack2(o[0], o[1]); r.y = pack2(o[2], o[3]); r.z = pack2(o[4], o[5]); r.w = pack2(o[6], o[7]); return r; }
DI float silu_(float x) { return x / (1.f + __expf(-x)); }
DI float sigm_(float x) { return 1.f / (1.f + __expf(-x)); }
DI float softplus_(float x) { return fmaxf(x, 0.f) + log1pf(__expf(-fabsf(x))); }
DI bf16x8 ldfrag(const bf16_t* base, int row0, int ld, int k0, int lane) { return *(const bf16x8*)(base + (row0 + (lane & 15)) * ld + k0 + (lane >> 4) * 8); }
#define MFMA16(a, b, c) __builtin_amdgcn_mfma_f32_16x16x32_bf16((a), (b), (c), 0, 0, 0)
DI float red16(float v) { v += __shfl_xor(v, 1); v += __shfl_xor(v, 2); v += __shfl_xor(v, 4); v += __shfl_xor(v, 8); return v; }
DI float max16(float v) { v = fmaxf(v, __shfl_xor(v, 1)); v = fmaxf(v, __shfl_xor(v, 2)); v = fmaxf(v, __shfl_xor(v, 4)); v = fmaxf(v, __shfl_xor(v, 8)); return v; }
DI float red64(float v) { v += __shfl_xor(v, 32); v += __shfl_xor(v, 16); return red16(v); }
DI float dpp_red16(float x) {
    x += __builtin_bit_cast(float, __builtin_amdgcn_update_dpp(0, __builtin_bit_cast(int, x), 0xB1, 0xF, 0xF, true));
    x += __builtin_bit_cast(float, __builtin_amdgcn_update_dpp(0, __builtin_bit_cast(int, x), 0x4E, 0xF, 0xF, true));
    x += __builtin_bit_cast(float, __builtin_amdgcn_update_dpp(0, __builtin_bit_cast(int, x), 0x141, 0xF, 0xF, true));
    x += __builtin_bit_cast(float, __builtin_amdgcn_update_dpp(0, __builtin_bit_cast(int, x), 0x140, 0xF, 0xF, true));
    return x;
}

DI int otid() { int t = threadIdx.x; asm volatile("" : "+v"(t)); return t; }
DI int obid() { int b = blockIdx.x; asm volatile("" : "+s"(b)); return b; }
struct EpiH {
    static constexpr bool PERM = false, AFTER_DRAIN = false;
    bf16_t* H; float* aux; int auxc;
    DI void operator()(const f32x4 (&acc)[2][2][4][2], const Unit& u, int wr, int wc, int fr, int fq) const {
        const int row0 = u.pm * 256 + wr * 64 + fr, col0 = u.pn * 256 + wc * 32 + 4 * fq;
#pragma unroll
        for (int ai = 0; ai < 2; ++ai)
#pragma unroll
            for (int m = 0; m < 4; ++m) { const size_t r = (size_t)(row0 + ai * 128 + m * 16);
#pragma unroll
                for (int bj = 0; bj < 2; ++bj)
#pragma unroll
                    for (int n = 0; n < 2; ++n) { const int c = col0 + bj * 128 + n * 16; const f32x4 v = acc[ai][bj][m][n];
                        if (c < HS) { uint2 w; w.x = cvt_pk_bf16(v[0], v[1]); w.y = cvt_pk_bf16(v[2], v[3]); *(uint2*)(H + r * HS + c) = w;
                            if (c == auxc || c == auxc + 4) *(f32x4*)(aux + r * 8 + (c - auxc)) = v; } } }
    }
};
struct EpiRes {
    static constexpr bool PERM = false, AFTER_DRAIN = false;
    const float* res; float* out;
    DI void operator()(const f32x4 (&acc)[2][2][4][2], const Unit& u, int wr, int wc, int fr, int fq) const {
        const int row0 = u.pm * 256 + wr * 64 + fr, col0 = u.pn * 256 + wc * 32 + 4 * fq;
#pragma unroll
        for (int ai = 0; ai < 2; ++ai)
#pragma unroll
            for (int m = 0; m < 4; ++m) { const size_t r = (size_t)(row0 + ai * 128 + m * 16);
#pragma unroll
                for (int bj = 0; bj < 2; ++bj)
#pragma unroll
                    for (int n = 0; n < 2; ++n) { const int c = col0 + bj * 128 + n * 16;
                        const f32x4 rv = *(const f32x4*)(res + r * DM + c); *(f32x4*)(out + r * DM + c) = rv + acc[ai][bj][m][n]; } }
    }
};
struct EpiGU {
    static constexpr bool PERM = false, AFTER_DRAIN = false;
    bf16_t* G; bf16_t* U;
    DI void operator()(const f32x4 (&acc)[2][2][4][2], const Unit& u, int wr, int wc, int fr, int fq) const {
        const int row0 = u.pm * 256 + wr * 64 + fr, col0 = u.pn * 128 + wc * 32 + 4 * fq;
#pragma unroll
        for (int ai = 0; ai < 2; ++ai)
#pragma unroll
            for (int m = 0; m < 4; ++m) { const size_t r = (size_t)(row0 + ai * 128 + m * 16);
#pragma unroll
                for (int n = 0; n < 2; ++n) { const int c = col0 + n * 16; const f32x4 g = acc[ai][0][m][n], v = acc[ai][1][m][n];
                    uint2 w; w.x = cvt_pk_bf16(g[0], g[1]); w.y = cvt_pk_bf16(g[2], g[3]); *(uint2*)(G + r * DFF + c) = w;
                    w.x = cvt_pk_bf16(v[0], v[1]); w.y = cvt_pk_bf16(v[2], v[3]); *(uint2*)(U + r * DFF + c) = w; } }
    }
};
struct EpiLR {
    static constexpr bool PERM = false, AFTER_DRAIN = false;
    bf16_t* LW; const float* w0; const float* a0;
    DI void operator()(const f32x4 (&acc)[2][2][4][2], const Unit& u, int wr, int wc, int fr, int fq) const {
        const int row0 = u.pm * 256 + wr * 64 + fr, col0 = u.pn * 256 + wc * 32 + 4 * fq;
#pragma unroll
        for (int ai = 0; ai < 2; ++ai)
#pragma unroll
            for (int m = 0; m < 4; ++m) { const size_t r = (size_t)(row0 + ai * 128 + m * 16);
#pragma unroll
                for (int bj = 0; bj < 2; ++bj)
#pragma unroll
                    for (int n = 0; n < 2; ++n) { const int c = col0 + bj * 128 + n * 16; f32x4 v = acc[ai][bj][m][n];
                        if (c < 512) { const f32x4 b = *(const f32x4*)(w0 + c);
#pragma unroll
                            for (int j = 0; j < 4; ++j) v[j] = 1.f - __expf(-0.606531f * sigm_(b[j] + v[j])); }
                        else if (c < 1024) { const f32x4 b = *(const f32x4*)(a0 + c - 512);
#pragma unroll
                            for (int j = 0; j < 4; ++j) v[j] = sigm_(b[j] + v[j]); }
                        uint2 w; w.x = cvt_pk_bf16(v[0], v[1]); w.y = cvt_pk_bf16(v[2], v[3]); *(uint2*)(LW + r * 1536 + c) = w; } }
    }
};
template <class Epi> DI void run_gemm(unsigned char* smem, const bf16_t* A, const bf16_t* Bt, int N, int K, const Epi& E) {
    pg8::Gemm g; g.A = A; g.Bt = Bt; g.M = TOK; g.N = N; g.K = K;
    pg8::StaticOrder S; S.init(TOK, N, (int)gridDim.x, obid());
    pg8::gemm_phase<Epi, pg8::StaticOrder, false>((PG8_LAS unsigned char*)smem, g, S, E, nullptr);
}

DI void conv_tile(const float* W, int Nsrc, int K, bf16_t* Wt, int nd0, int sc0, int nvalid, int k0, float* tile) {
    const int tid = otid(), j = tid & 63, kb = tid >> 6;
#pragma unroll
    for (int i = 0; i < 8; ++i) { const int kk = kb + 8 * i; tile[kk * 65 + j] = (j < nvalid) ? W[(size_t)(k0 + kk) * Nsrc + sc0 + j] : 0.f; }
    __syncthreads();
    const int nl = tid >> 3, ks = (tid & 7) * 8;
    uint4 o;
    o.x = pack2(tile[(ks + 0) * 65 + nl], tile[(ks + 1) * 65 + nl]); o.y = pack2(tile[(ks + 2) * 65 + nl], tile[(ks + 3) * 65 + nl]);
    o.z = pack2(tile[(ks + 4) * 65 + nl], tile[(ks + 5) * 65 + nl]); o.w = pack2(tile[(ks + 6) * 65 + nl], tile[(ks + 7) * 65 + nl]);
    *(uint4*)(Wt + (size_t)(nd0 + nl) * K + k0 + ks) = o;
    __syncthreads();
}
DI void phase_weights(const Params& p, unsigned char* smem, int layer) {
    float* tile = (float*)smem;
    const float* w_in = layer ? p.od_w_in : p.ev_w_in; const float* w_out = layer ? p.od_w_out : p.ev_w_out;
    const float* w_up = p.ffn_w_up + (size_t)layer * DM * 2 * DFF; const float* w_dn = p.ffn_w_down + (size_t)layer * DFF * DM;
    bf16_t* t_in = (bf16_t*)(p.ws + O_WT_IN); bf16_t* t_out = (bf16_t*)(p.ws + O_WT_OUT); bf16_t* t_up = (bf16_t*)(p.ws + O_WT_UP); bf16_t* t_dn = (bf16_t*)(p.ws + O_WT_DN);
    for (int job = obid(); job < 3264; job += gridDim.x) {
        if (job < 896) { const int nt = job >> 4, kt = job & 15, nd0 = nt * 64; int nv = HS - nd0; nv = nv < 0 ? 0 : (nv > 64 ? 64 : nv);
            conv_tile(w_in, HS, 1024, t_in, nd0, nd0, nv, kt * 64, tile); }
        else if (job < 1152) { const int j2 = job - 896, nt = j2 >> 4, kt = j2 & 15; conv_tile(w_out, 1024, 1024, t_out, nt * 64, nt * 64, 64, kt * 64, tile); }
        else if (job < 2560) { const int j2 = job - 1152, nt = j2 >> 4, kt = j2 & 15, nd0 = nt * 64; const int pn = nd0 >> 8, bj = (nd0 >> 7) & 1, j0 = nd0 & 127;
            conv_tile(w_up, 2 * DFF, 1024, t_up, nd0, bj * DFF + 128 * pn + j0, 64, kt * 64, tile); }
        else { const int j2 = job - 2560, nt = j2 / 44, kt = j2 % 44; conv_tile(w_dn, 1024, DFF, t_dn, nt * 64, nt * 64, 64, kt * 64, tile); }
    }
    const int gtid = obid() * 512 + otid(), gsz = gridDim.x * 512;
    if (layer == 0) {
        float* rc = (float*)(p.ws + O_ROPE); float* rs = rc + SEQ * 32;
        for (int idx = gtid; idx < SEQ * 32; idx += gsz) { const int pos = idx >> 5, i = idx & 31;
            const float inv = (float)exp(-(double)i * (9.210340371976184 / 32.0)); const float ang = (float)pos * inv;
            const double a = (double)ang; const double n = rint(a * 0.15915494309189535); const double r = a - n * 6.283185307179586; const double r2 = r * r;
            double sn = 1.0 / 121645100408832000.0, cs = 1.0 / 2432902008176640000.0;
            sn = sn * r2 - 1.0 / 355687428096000.0; sn = sn * r2 + 1.0 / 1307674368000.0; sn = sn * r2 - 1.0 / 6227020800.0; sn = sn * r2 + 1.0 / 39916800.0;
            sn = sn * r2 - 1.0 / 362880.0; sn = sn * r2 + 1.0 / 5040.0; sn = sn * r2 - 1.0 / 120.0; sn = sn * r2 + 1.0 / 6.0; sn = sn * r2 * -1.0 + 1.0; sn = sn * r;
            cs = cs * r2 - 1.0 / 6402373705728000.0; cs = cs * r2 + 1.0 / 20922789888000.0; cs = cs * r2 - 1.0 / 87178291200.0; cs = cs * r2 + 1.0 / 479001600.0;
            cs = cs * r2 - 1.0 / 3628800.0; cs = cs * r2 + 1.0 / 40320.0; cs = cs * r2 - 1.0 / 720.0; cs = cs * r2 + 1.0 / 24.0; cs = cs * r2 - 0.5; cs = cs * r2 + 1.0;
            rc[idx] = (float)cs; rs[idx] = (float)sn; }
    } else {
        bf16_t* t_lr = (bf16_t*)(p.ws + O_WT_LR);
        for (int idx = gtid; idx < 1536 * 256; idx += gsz) { const int n = idx >> 8, k = idx & 255; float v = 0.f;
            if (n < 512) { if (k < 64) v = p.od_w_up[k * 512 + n]; }
            else if (n < 1024) { if (k >= 64 && k < 128) v = p.od_a_up[(k - 64) * 512 + n - 512]; }
            else { if (k >= 128) v = p.od_g_up[(k - 128) * 512 + n - 1024]; }
            t_lr[idx] = f2bf(v); }
    }
}
DI void phase_rmsnorm(const float* x, const float* w, bf16_t* xn) {
    const int lane = otid() & 63, wv = otid() >> 6;
    for (int r = obid() * 8 + wv; r < TOK; r += gridDim.x * 8) {
        const float* xr = x + (size_t)r * DM; f32x4 v[4]; float ss = 0.f;
#pragma unroll
        for (int i = 0; i < 4; ++i) { v[i] = *(const f32x4*)(xr + i * 256 + lane * 4); ss += v[i][0] * v[i][0] + v[i][1] * v[i][1] + v[i][2] * v[i][2] + v[i][3] * v[i][3]; }
        ss = red64(ss); const float rstd = rsqrtf(ss * (1.f / DM) + 1e-6f);
#pragma unroll
        for (int i = 0; i < 4; ++i) { const f32x4 ww = *(const f32x4*)(w + i * 256 + lane * 4); uint2 o; o.x = pack2(v[i][0] * rstd * ww[0], v[i][1] * rstd * ww[1]); o.y = pack2(v[i][2] * rstd * ww[2], v[i][3] * rstd * ww[3]);
            *(uint2*)(xn + (size_t)r * DM + i * 256 + lane * 4) = o; }
    }
}
DI void ssd_conv8(const Params& p, const bf16_t* H, int b, int t, int ch, float (&o)[8]) {
    float acc[8];
    { const f32x4 b0 = *(const f32x4*)(p.ev_conv_b + ch), b1 = *(const f32x4*)(p.ev_conv_b + ch + 4);
      acc[0] = b0[0]; acc[1] = b0[1]; acc[2] = b0[2]; acc[3] = b0[3]; acc[4] = b1[0]; acc[5] = b1[1]; acc[6] = b1[2]; acc[7] = b1[3]; }
#pragma unroll
    for (int k = 0; k < 4; ++k) { const int tt = t - 3 + k;
        if (tt >= 0) { float xv[8]; unpack8(*(const uint4*)(H + ((size_t)b * SEQ + tt) * HS + 512 + ch), xv);
            const f32x4 w0 = *(const f32x4*)(p.ev_conv_w + k * 768 + ch), w1 = *(const f32x4*)(p.ev_conv_w + k * 768 + ch + 4);
            acc[0] += w0[0] * xv[0]; acc[1] += w0[1] * xv[1]; acc[2] += w0[2] * xv[2]; acc[3] += w0[3] * xv[3];
            acc[4] += w1[0] * xv[4]; acc[5] += w1[1] * xv[5]; acc[6] += w1[2] * xv[6]; acc[7] += w1[3] * xv[7]; } }
#pragma unroll
    for (int e = 0; e < 8; ++e) o[e] = silu_(acc[e]);
}
DI float ret_lg(int hh) { return log1pf(-exp2f(-5.f - (float)hh)); }
DI void chunk_decay(const Params& p, int mixer, int b, int hh, int t0, float* acs, float* dts) {
    const int tid = otid(); const float* aux = (const float*)(p.ws + O_AUX);
    if (tid < 128) {
        if (mixer == 0) { const float dt = softplus_(aux[((size_t)b * SEQ + t0 + tid) * 8 + hh] + p.ev_dt_bias[hh]); dts[tid] = dt; acs[tid] = -expf(p.ev_a_log[hh]) * dt; }
        else { dts[tid] = 1.f; acs[tid] = 0.f; }
    }
    __syncthreads();
    float my = 0.f;
    if (tid < 128) { if (mixer == 0) { for (int i = 0; i <= tid; ++i) my += acs[i]; } else my = (float)(tid + 1) * ret_lg(hh); }
    __syncthreads();
    if (tid < 128) acs[tid] = my;
    __syncthreads();
}
DI void phase_m1(const Params& p, unsigned char* smem) {
    bf16_t* Kt = (bf16_t*)smem; bf16_t* Vt = (bf16_t*)(smem + 17408); float* acs = (float*)(smem + 34816); float* dts = acs + 128;
    const bf16_t* H = (const bf16_t*)(p.ws + O_H); float* ST = (float*)(p.ws + O_ST); float* CD = (float*)(p.ws + O_CD);
    const float* rc = (const float*)(p.ws + O_ROPE); const float* rs = rc + SEQ * 32;
    const int tid = otid(), lane = tid & 63, w = tid >> 6;
    for (int u = obid(); u < 2048; u += gridDim.x) {
        const int mixer = u >> 10, bh = (u >> 6) & 15, c = u & 63, b = bh >> 3, hh = bh & 7, t0 = c * 128;
        chunk_decay(p, mixer, b, hh, t0, acs, dts);
        const float aend = acs[127];
        if (mixer == 0) {
#pragma unroll
            for (int it = 0; it < 2; ++it) { const int g = tid + it * 512, s = g >> 3, c8 = (g & 7) * 8; float o[8];
                const float sc = __expf(aend - acs[s]) * dts[s];
                ssd_conv8(p, H, b, t0 + s, 512 + (hh >> 2) * 64 + c8, o);
#pragma unroll
                for (int e = 0; e < 8; ++e) Kt[(c8 + e) * 136 + s] = f2bf(o[e] * sc);
                ssd_conv8(p, H, b, t0 + s, hh * 64 + c8, o);
#pragma unroll
                for (int e = 0; e < 8; ++e) Vt[(c8 + e) * 136 + s] = f2bf(o[e]); }
            if (tid == 0) CD[bh * 64 + c] = __expf(aend);
        } else {
            { const int s = tid >> 2, i0 = (tid & 3) * 8; const size_t r = (size_t)b * SEQ + t0 + s; float k1[8], k2[8];
              unpack8(*(const uint4*)(H + r * HS + 1800 + hh * 64 + i0), k1); unpack8(*(const uint4*)(H + r * HS + 1800 + hh * 64 + 32 + i0), k2);
              const float sc = __expf(aend - acs[s]) * 0.125f;
#pragma unroll
              for (int e = 0; e < 8; ++e) { const float cs = rc[(t0 + s) * 32 + i0 + e], sn = rs[(t0 + s) * 32 + i0 + e];
                  Kt[(i0 + e) * 136 + s] = f2bf((k1[e] * cs - k2[e] * sn) * sc); Kt[(32 + i0 + e) * 136 + s] = f2bf((k1[e] * sn + k2[e] * cs) * sc); } }
#pragma unroll
            for (int it = 0; it < 2; ++it) { const int g = tid + it * 512, s = g >> 3, c8 = (g & 7) * 8; const size_t r = (size_t)b * SEQ + t0 + s; float v[8];
                unpack8(*(const uint4*)(H + r * HS + 2312 + hh * 64 + c8), v);
#pragma unroll
                for (int e = 0; e < 8; ++e) Vt[(c8 + e) * 136 + s] = (unsigned short)f2bf(v[e]); }
        }
        __syncthreads();
        { const int mt = w & 3, nt0 = (w >> 2) * 2; f32x4 a0 = {0.f, 0.f, 0.f, 0.f}, a1 = {0.f, 0.f, 0.f, 0.f};
#pragma unroll
          for (int ks = 0; ks < 4; ++ks) { const bf16x8 af = ldfrag(Kt, mt * 16, 136, ks * 32, lane);
              a0 = MFMA16(af, ldfrag(Vt, nt0 * 16, 136, ks * 32, lane), a0); a1 = MFMA16(af, ldfrag(Vt, nt0 * 16 + 16, 136, ks * 32, lane), a1); }
          float* dst = ST + (size_t)u * 4096 + mt * 16 + (lane >> 4) * 4;
          *(f32x4*)(dst + (nt0 * 16 + (lane & 15)) * 64) = a0; *(f32x4*)(dst + (nt0 * 16 + 16 + (lane & 15)) * 64) = a1; }
        __syncthreads();
    }
}
DI void phase_m2(const Params& p) {
    float* ST = (float*)(p.ws + O_ST); const float* CD = (const float*)(p.ws + O_CD);
    for (int idx = obid() * 512 + otid(); idx < 32 * 4096; idx += gridDim.x * 512) {
        const int mb = idx >> 12, e = idx & 4095, mixer = mb >> 4, bh = mb & 15; float run = 0.f;
        const float gdec = __expf(128.f * ret_lg(bh & 7));
#pragma unroll 8
        for (int c = 0; c < 64; ++c) { const size_t o = ((size_t)(mb * 64 + c)) * 4096 + e; const float v = ST[o]; ST[o] = run;
            const float dec = mixer == 0 ? CD[bh * 64 + c] : gdec; run = run * dec + v; }
    }
}
template <int MIXER> DI void m3_head(const Params& p, unsigned char* smem, int b, int c, int hh, float (&ssq)[4]) {
    bf16_t* Qs = (bf16_t*)smem; bf16_t* Ks = (bf16_t*)(smem + 18432); bf16_t* Vt = (bf16_t*)(smem + 36864); bf16_t* Rt = (bf16_t*)(smem + 54272); bf16_t* Ps = (bf16_t*)(smem + 63488);
    float* acs = (float*)(smem + 98304); float* dts = acs + 128;
    const bf16_t* H = (const bf16_t*)(p.ws + O_H); const float* ST = (const float*)(p.ws + O_ST); float* YG = (float*)(p.ws + O_YG); bf16_t* Y = (bf16_t*)(p.ws + O_XN);
    const float* rc = (const float*)(p.ws + O_ROPE); const float* rs = rc + SEQ * 32;
    const int tid = otid(), lane = tid & 63, w = tid >> 6, t0 = c * 128, bh = b * 8 + hh;
    const size_t u = (size_t)((MIXER * 16 + bh) * 64 + c);
    __syncthreads();
    chunk_decay(p, MIXER, b, hh, t0, acs, dts);
    if (MIXER == 0) {
#pragma unroll
        for (int it = 0; it < 2; ++it) { const int g = tid + it * 512, s = g >> 3, c8 = (g & 7) * 8; float o[8];
            ssd_conv8(p, H, b, t0 + s, 640 + (hh >> 2) * 64 + c8, o); *(uint4*)(Qs + s * 72 + c8) = pack8(o);
            ssd_conv8(p, H, b, t0 + s, 512 + (hh >> 2) * 64 + c8, o); *(uint4*)(Ks + s * 72 + c8) = pack8(o);
            ssd_conv8(p, H, b, t0 + s, hh * 64 + c8, o);
#pragma unroll
            for (int e = 0; e < 8; ++e) Vt[(c8 + e) * 136 + s] = f2bf(o[e]); }
    } else {
        { const int s = tid >> 2, i0 = (tid & 3) * 8; const size_t r = (size_t)b * SEQ + t0 + s; float a1[8], a2[8], o1[8], o2[8];
          unpack8(*(const uint4*)(H + r * HS + 1288 + hh * 64 + i0), a1); unpack8(*(const uint4*)(H + r * HS + 1288 + hh * 64 + 32 + i0), a2);
#pragma unroll
          for (int e = 0; e < 8; ++e) { const float cs = rc[(t0 + s) * 32 + i0 + e], sn = rs[(t0 + s) * 32 + i0 + e]; o1[e] = a1[e] * cs - a2[e] * sn; o2[e] = a1[e] * sn + a2[e] * cs; }
          *(uint4*)(Qs + s * 72 + i0) = pack8(o1); *(uint4*)(Qs + s * 72 + 32 + i0) = pack8(o2);
          unpack8(*(const uint4*)(H + r * HS + 1800 + hh * 64 + i0), a1); unpack8(*(const uint4*)(H + r * HS + 1800 + hh * 64 + 32 + i0), a2);
#pragma unroll
          for (int e = 0; e < 8; ++e) { const float cs = rc[(t0 + s) * 32 + i0 + e], sn = rs[(t0 + s) * 32 + i0 + e]; o1[e] = (a1[e] * cs - a2[e] * sn) * 0.125f; o2[e] = (a1[e] * sn + a2[e] * cs) * 0.125f; }
          *(uint4*)(Ks + s * 72 + i0) = pack8(o1); *(uint4*)(Ks + s * 72 + 32 + i0) = pack8(o2); }
#pragma unroll
        for (int it = 0; it < 2; ++it) { const int g = tid + it * 512, s = g >> 3, c8 = (g & 7) * 8; const size_t r = (size_t)b * SEQ + t0 + s;
            const uint4 raw = *(const uint4*)(H + r * HS + 2312 + hh * 64 + c8); const unsigned short* rv = (const unsigned short*)&raw;
#pragma unroll
            for (int e = 0; e < 8; ++e) Vt[(c8 + e) * 136 + s] = rv[e]; }
    }
    { const int pr = tid >> 3, n8 = (tid & 7) * 8; const float* src = ST + u * 4096 + pr * 64 + n8; const f32x4 x0 = *(const f32x4*)src, x1 = *(const f32x4*)(src + 4);
      uint4 o; o.x = pack2(x0[0], x0[1]); o.y = pack2(x0[2], x0[3]); o.z = pack2(x1[0], x1[1]); o.w = pack2(x1[2], x1[3]); *(uint4*)(Rt + pr * 72 + n8) = o; }
    __syncthreads();
    const int nks = (w >> 1) + 1;
    const int lrow = 16 * w + (lane >> 4) * 4;
    {
        const bf16x8 q0 = ldfrag(Qs, 16 * w, 72, 0, lane), q1 = ldfrag(Qs, 16 * w, 72, 32, lane);
        float al[4];
#pragma unroll
        for (int j = 0; j < 4; ++j) al[j] = acs[lrow + j];
        for (int nt = 0; nt < 2 * nks; ++nt) { f32x4 sacc = {0.f, 0.f, 0.f, 0.f};
            sacc = MFMA16(q0, ldfrag(Ks, nt * 16, 72, 0, lane), sacc); sacc = MFMA16(q1, ldfrag(Ks, nt * 16, 72, 32, lane), sacc);
            const int s = nt * 16 + (lane & 15); const float as = acs[s], ds = dts[s];
#pragma unroll
            for (int j = 0; j < 4; ++j) { const float pv = (s <= lrow + j) ? sacc[j] * __expf(al[j] - as) * ds : 0.f; Ps[(lrow + j) * 136 + s] = f2bf(pv); } }
    }
    __syncthreads();
    f32x4 yd[4], yo[4];
#pragma unroll
    for (int nt = 0; nt < 4; ++nt) { yd[nt] = (f32x4){0.f, 0.f, 0.f, 0.f}; yo[nt] = (f32x4){0.f, 0.f, 0.f, 0.f}; }
    for (int ks = 0; ks < nks; ++ks) { const bf16x8 pf = ldfrag(Ps, 16 * w, 136, ks * 32, lane);
#pragma unroll
        for (int nt = 0; nt < 4; ++nt) yd[nt] = MFMA16(pf, ldfrag(Vt, nt * 16, 136, ks * 32, lane), yd[nt]); }
#pragma unroll
    for (int ks = 0; ks < 2; ++ks) { const bf16x8 qf = ldfrag(Qs, 16 * w, 72, ks * 32, lane);
#pragma unroll
        for (int nt = 0; nt < 4; ++nt) yo[nt] = MFMA16(qf, ldfrag(Rt, nt * 16, 72, ks * 32, lane), yo[nt]); }
    float ea[4];
#pragma unroll
    for (int j = 0; j < 4; ++j) ea[j] = __expf(acs[lrow + j]);
    if (MIXER == 0) {
        const float dsk = p.ev_d[hh];
#pragma unroll
        for (int nt = 0; nt < 4; ++nt) { const int pc = nt * 16 + (lane & 15);
#pragma unroll
            for (int j = 0; j < 4; ++j) { const size_t r = (size_t)b * SEQ + t0 + lrow + j;
                const float y = yd[nt][j] + ea[j] * yo[nt][j] + dsk * bf2f(Vt[pc * 136 + lrow + j]);
                const float z = bf2f(H[r * HS + hh * 64 + pc]); const float yg = y * silu_(z); ssq[j] += yg * yg; YG[r * 512 + hh * 64 + pc] = yg; } }
    } else {
        float s2[4];
#pragma unroll
        for (int j = 0; j < 4; ++j) { float a = 0.f;
#pragma unroll
            for (int nt = 0; nt < 4; ++nt) { const float y = yd[nt][j] + ea[j] * yo[nt][j]; yd[nt][j] = y; a += y * y; }
            s2[j] = rsqrtf(red16(a) * (1.f / 64.f) + 1e-6f); }
#pragma unroll
        for (int nt = 0; nt < 4; ++nt) { const int pc = nt * 16 + (lane & 15); const float nw = p.ev_ret_norm_w[hh * 64 + pc];
#pragma unroll
            for (int j = 0; j < 4; ++j) { const size_t r = (size_t)b * SEQ + t0 + lrow + j; const float g = bf2f(H[r * HS + 2824 + hh * 64 + pc]);
                Y[r * DM + 512 + hh * 64 + pc] = f2bf(silu_(g) * yd[nt][j] * s2[j] * nw); } }
    }
}
DI void phase_m3(const Params& p, unsigned char* smem) {
    const int lane = otid() & 63, w = otid() >> 6;
    for (int u = obid(); u < 256; u += gridDim.x) {
        const int mixer = u >> 7, b = (u >> 6) & 1, c = u & 63; float ssq[4] = {0.f, 0.f, 0.f, 0.f};
        if (mixer == 0) {
            for (int hh = 0; hh < 8; ++hh) m3_head<0>(p, smem, b, c, hh, ssq);
            float* YG = (float*)(p.ws + O_YG); bf16_t* Y = (bf16_t*)(p.ws + O_XN); const int lrow = 16 * w + (lane >> 4) * 4;
            float rstd[4];
#pragma unroll
            for (int j = 0; j < 4; ++j) rstd[j] = rsqrtf(red16(ssq[j]) * (1.f / 512.f) + 1e-6f);
            for (int cc = 0; cc < 32; ++cc) { const int col = cc * 16 + (lane & 15); const float nw = p.ev_ssd_norm_w[col];
#pragma unroll
                for (int j = 0; j < 4; ++j) { const size_t r = (size_t)b * SEQ + c * 128 + lrow + j;
                    const float v = __hip_atomic_load(YG + r * 512 + col, __ATOMIC_RELAXED, __HIP_MEMORY_SCOPE_AGENT); Y[r * DM + col] = f2bf(v * rstd[j] * nw); } }
        } else {
            for (int hh = 0; hh < 8; ++hh) m3_head<1>(p, smem, b, c, hh, ssq);
        }
    }
}
DI void phase_ffn_act(const Params& p, int layer) {
    const bf16_t* G = (const bf16_t*)(p.ws + O_G); bf16_t* U = (bf16_t*)(p.ws + O_U);
    const float* cw = p.ffn_conv_w + (size_t)layer * 3 * DFF; const float* cb = p.ffn_conv_b + (size_t)layer * DFF;
    for (int idx = obid() * 512 + otid(); idx < TOK * (DFF / 8); idx += gridDim.x * 512) {
        const int r = idx / (DFF / 8), c8 = (idx % (DFF / 8)) * 8, t = r & (SEQ - 1);
        float acc[8], g[8], uv[8];
        { const f32x4 b0 = *(const f32x4*)(cb + c8), b1 = *(const f32x4*)(cb + c8 + 4); acc[0] = b0[0]; acc[1] = b0[1]; acc[2] = b0[2]; acc[3] = b0[3]; acc[4] = b1[0]; acc[5] = b1[1]; acc[6] = b1[2]; acc[7] = b1[3]; }
#pragma unroll
        for (int k = 0; k < 3; ++k) { if (t - 2 + k >= 0) { unpack8(*(const uint4*)(G + (size_t)(r - 2 + k) * DFF + c8), g);
            const f32x4 w0 = *(const f32x4*)(cw + k * DFF + c8), w1 = *(const f32x4*)(cw + k * DFF + c8 + 4);
            acc[0] += w0[0] * g[0]; acc[1] += w0[1] * g[1]; acc[2] += w0[2] * g[2]; acc[3] += w0[3] * g[3]; acc[4] += w1[0] * g[4]; acc[5] += w1[1] * g[5]; acc[6] += w1[2] * g[6]; acc[7] += w1[3] * g[7]; } }
        unpack8(*(const uint4*)(U + (size_t)r * DFF + c8), uv);
#pragma unroll
        for (int e = 0; e < 8; ++e) acc[e] = silu_(acc[e]) * uv[e];
        *(uint4*)(U + (size_t)r * DFF + c8) = pack8(acc);
    }
}
DI void phase_l1_prep(const Params& p, unsigned char* smem) {
    const bf16_t* H = (const bf16_t*)(p.ws + O_H); const float* aux = (const float*)(p.ws + O_AUX); float* FC = (float*)(p.ws + O_FC);
    bf16_t* KN = (bf16_t*)(p.ws + O_KN); bf16_t* VT = (bf16_t*)(p.ws + O_VT); bf16_t* AP = (bf16_t*)(p.ws + O_AP);
    const int tid = otid();
    for (int u = obid(); u < 16 + 1024; u += gridDim.x) {
        __syncthreads();
        if (u < 16) {
            float* tot = (float*)smem; const int bh = u, b = bh >> 3, hh = bh & 7; const float fb = p.od_f_bias[hh]; float loc[16]; float run = 0.f;
#pragma unroll
            for (int i = 0; i < 16; ++i) { const float xv = aux[((size_t)b * SEQ + tid * 16 + i) * 8 + hh] + fb; run += -softplus_(-xv); loc[i] = run; }
            tot[tid] = run; __syncthreads();
            float off = 0.f; for (int i = 0; i < tid; ++i) off += tot[i];
#pragma unroll
            for (int i = 0; i < 16; ++i) FC[(size_t)bh * SEQ + tid * 16 + i] = off + loc[i];
        } else {
            bf16_t* Vl = (bf16_t*)smem; const int v2 = u - 16, bh = v2 >> 6, blk = v2 & 63, b = bh >> 3, hh = bh & 7, t0 = blk * 128;
            { const int l = tid >> 2, c16 = (tid & 3) * 16; const size_t r = (size_t)b * SEQ + t0 + l; float a[8], c[8];
              unpack8(*(const uint4*)(H + r * HS + 2304 + hh * 64 + c16), a); unpack8(*(const uint4*)(H + r * HS + 2304 + hh * 64 + c16 + 8), c);
              float ss = 0.f;
#pragma unroll
              for (int e = 0; e < 8; ++e) ss += a[e] * a[e] + c[e] * c[e];
              ss += __shfl_xor(ss, 1); ss += __shfl_xor(ss, 2); const float rstd = rsqrtf(ss * (1.f / 64.f) + 1e-6f);
#pragma unroll
              for (int e = 0; e < 8; ++e) { a[e] *= rstd * p.od_kn_w[c16 + e]; c[e] *= rstd * p.od_kn_w[c16 + 8 + e]; }
              bf16_t* dst = KN + ((size_t)bh * SEQ + t0 + l) * 64 + c16; *(uint4*)dst = pack8(a); *(uint4*)(dst + 8) = pack8(c); }
#pragma unroll
            for (int it = 0; it < 2; ++it) { const int g = tid + it * 512, s = g >> 3, c8 = (g & 7) * 8; const size_t r = (size_t)b * SEQ + t0 + s;
                *(uint4*)(Vl + s * 72 + c8) = *(const uint4*)(H + r * HS + 2816 + hh * 64 + c8); }
            __syncthreads();
#pragma unroll
            for (int it = 0; it < 2; ++it) { const int g = tid + it * 512, e = g >> 4, s8 = (g & 15) * 8; uint4 o;
                o.x = (unsigned)Vl[(s8 + 0) * 72 + e] | ((unsigned)Vl[(s8 + 1) * 72 + e] << 16); o.y = (unsigned)Vl[(s8 + 2) * 72 + e] | ((unsigned)Vl[(s8 + 3) * 72 + e] << 16);
                o.z = (unsigned)Vl[(s8 + 4) * 72 + e] | ((unsigned)Vl[(s8 + 5) * 72 + e] << 16); o.w = (unsigned)Vl[(s8 + 6) * 72 + e] | ((unsigned)Vl[(s8 + 7) * 72 + e] << 16);
                *(uint4*)(VT + ((size_t)bh * 64 + e) * SEQ + t0 + s8) = o; }
        }
    }
    {
        float* KNRM = (float*)(p.ws + O_KNRM);
        for (int idx = obid() * 512 + tid; idx < TOK * 64; idx += gridDim.x * 512) {
            const int r = idx >> 6, c8 = (idx & 63) * 8, t = r & (SEQ - 1); float cur[8], prv[8]; float ss = 0.f;
            unpack8(*(const uint4*)(H + (size_t)r * HS + 512 + c8), cur);
            if (t > 0) unpack8(*(const uint4*)(H + (size_t)(r - 1) * HS + 512 + c8), prv); else {
#pragma unroll
                for (int e = 0; e < 8; ++e) prv[e] = 0.f; }
#pragma unroll
            for (int e = 0; e < 8; ++e) { const float v = (cur[e] + (prv[e] - cur[e]) * p.od_mu[512 + c8 + e]) * p.od_k_k[c8 + e]; ss += v * v; }
            ss += __shfl_xor(ss, 1); ss += __shfl_xor(ss, 2); ss += __shfl_xor(ss, 4);
            if ((idx & 7) == 0) KNRM[(size_t)r * 8 + (c8 >> 6)] = 1.f / fmaxf(sqrtf(ss), 1e-12f);
        }
    }
    for (int idx = obid() * 512 + tid; idx < TOK * 32; idx += gridDim.x * 512) {
        const int r = idx >> 5, j8 = (idx & 31) * 8, t = r & (SEQ - 1); float cur[8], prv[8], o[8];
        unpack8(*(const uint4*)(H + (size_t)r * HS + 1536 + j8), cur);
        if (t > 0) unpack8(*(const uint4*)(H + (size_t)(r - 1) * HS + 1536 + j8), prv); else {
#pragma unroll
            for (int e = 0; e < 8; ++e) prv[e] = 0.f; }
#pragma unroll
        for (int e = 0; e < 8; ++e) { const float v = cur[e] + (prv[e] - cur[e]) * p.od_mu[1536 + j8 + e];
            o[e] = (j8 < 64) ? tanhf(v) : ((j8 < 128) ? v : sigm_(v)); }
        *(uint4*)(AP + (size_t)r * 256 + j8) = pack8(o);
    }
}
DI void fox_unit(const Params& p, unsigned char* smem, int bh, int qb) {
    bf16_t* Qs = (bf16_t*)smem; bf16_t* Ks = (bf16_t*)(smem + 18432); bf16_t* Vts = (bf16_t*)(smem + 36864); bf16_t* Ps = (bf16_t*)(smem + 54272);
    float* cq = (float*)(smem + 89088); float* ck = (float*)(smem + 89600);
    const bf16_t* H = (const bf16_t*)(p.ws + O_H); const float* FC = (const float*)(p.ws + O_FC); const bf16_t* KN = (const bf16_t*)(p.ws + O_KN); const bf16_t* VT = (const bf16_t*)(p.ws + O_VT);
    bf16_t* Y = (bf16_t*)(p.ws + O_XN);
    const int tid = otid(), lane = tid & 63, w = tid >> 6, b = bh >> 3, hh = bh & 7; const size_t r0 = (size_t)b * SEQ + qb * 128;
    __syncthreads();
    { const int l = tid >> 2, c16 = (tid & 3) * 16; float a[8], c[8];
      unpack8(*(const uint4*)(H + (r0 + l) * HS + 1792 + hh * 64 + c16), a); unpack8(*(const uint4*)(H + (r0 + l) * HS + 1792 + hh * 64 + c16 + 8), c);
      float ss = 0.f;
#pragma unroll
      for (int e = 0; e < 8; ++e) ss += a[e] * a[e] + c[e] * c[e];
      ss += __shfl_xor(ss, 1); ss += __shfl_xor(ss, 2); const float rstd = rsqrtf(ss * (1.f / 64.f) + 1e-6f) * 0.125f;
#pragma unroll
      for (int e = 0; e < 8; ++e) { a[e] *= rstd * p.od_qn_w[c16 + e]; c[e] *= rstd * p.od_qn_w[c16 + 8 + e]; }
      *(uint4*)(Qs + l * 72 + c16) = pack8(a); *(uint4*)(Qs + l * 72 + c16 + 8) = pack8(c);
      if ((tid & 3) == 0) cq[l] = FC[(size_t)bh * SEQ + qb * 128 + l]; }
    float mrow[4], lsum[4]; f32x4 O[4];
#pragma unroll
    for (int j = 0; j < 4; ++j) { mrow[j] = -1e30f; lsum[j] = 0.f; O[j] = (f32x4){0.f, 0.f, 0.f, 0.f}; }
    const int lrow = 16 * w + (lane >> 4) * 4;
    uint4 kreg0, kreg1, vreg0, vreg1; float ckreg = 0.f;
    const int g0 = tid, g1 = tid + 512;
#define FOX_ISSUE(kb_) { \
        kreg0 = *(const uint4*)(KN + ((size_t)bh * SEQ + (kb_) * 128 + (g0 >> 3)) * 64 + (g0 & 7) * 8); \
        kreg1 = *(const uint4*)(KN + ((size_t)bh * SEQ + (kb_) * 128 + (g1 >> 3)) * 64 + (g1 & 7) * 8); \
        vreg0 = *(const uint4*)(VT + ((size_t)bh * 64 + (g0 >> 4)) * SEQ + (kb_) * 128 + (g0 & 15) * 8); \
        vreg1 = *(const uint4*)(VT + ((size_t)bh * 64 + (g1 >> 4)) * SEQ + (kb_) * 128 + (g1 & 15) * 8); \
        if (tid < 128) ckreg = FC[(size_t)bh * SEQ + (kb_) * 128 + tid]; }
    FOX_ISSUE(0)
    for (int kb = 0; kb <= qb; ++kb) {
        __syncthreads();
        *(uint4*)(Ks + (g0 >> 3) * 72 + (g0 & 7) * 8) = kreg0; *(uint4*)(Ks + (g1 >> 3) * 72 + (g1 & 7) * 8) = kreg1;
        *(uint4*)(Vts + (g0 >> 4) * 136 + (g0 & 15) * 8) = vreg0; *(uint4*)(Vts + (g1 >> 4) * 136 + (g1 & 15) * 8) = vreg1;
        if (tid < 128) ck[tid] = ckreg;
        __syncthreads();
        if (kb < qb) FOX_ISSUE(kb + 1)
        f32x4 S[8];
        { const bf16x8 q0 = ldfrag(Qs, 16 * w, 72, 0, lane), q1 = ldfrag(Qs, 16 * w, 72, 32, lane);
#pragma unroll
          for (int nt = 0; nt < 8; ++nt) { f32x4 z = {0.f, 0.f, 0.f, 0.f}; z = MFMA16(q0, ldfrag(Ks, nt * 16, 72, 0, lane), z); S[nt] = MFMA16(q1, ldfrag(Ks, nt * 16, 72, 32, lane), z); } }
        const bool diag = (kb == qb);
#pragma unroll
        for (int nt = 0; nt < 8; ++nt) { const int s = nt * 16 + (lane & 15); const float cks = ck[s];
#pragma unroll
            for (int j = 0; j < 4; ++j) { float v = S[nt][j] + cq[lrow + j] - cks; if (diag && s > lrow + j) v = -1e30f; S[nt][j] = v; } }
#pragma unroll
        for (int j = 0; j < 4; ++j) { float mx = S[0][j];
#pragma unroll
            for (int nt = 1; nt < 8; ++nt) mx = fmaxf(mx, S[nt][j]);
            mx = max16(mx); const float mnew = fmaxf(mrow[j], mx); const float alpha = __expf(mrow[j] - mnew); mrow[j] = mnew; float rs = 0.f;
#pragma unroll
            for (int nt = 0; nt < 8; ++nt) { const float pv = __expf(S[nt][j] - mnew); S[nt][j] = pv; rs += pv; }
            rs = red16(rs); lsum[j] = lsum[j] * alpha + rs;
#pragma unroll
            for (int n4 = 0; n4 < 4; ++n4) O[n4][j] *= alpha; }
#pragma unroll
        for (int nt = 0; nt < 8; ++nt)
#pragma unroll
            for (int j = 0; j < 4; ++j) Ps[(lrow + j) * 136 + nt * 16 + (lane & 15)] = f2bf(S[nt][j]);
        __syncthreads();
#pragma unroll
        for (int ks = 0; ks < 4; ++ks) { const bf16x8 pf = ldfrag(Ps, 16 * w, 136, ks * 32, lane);
#pragma unroll
            for (int n4 = 0; n4 < 4; ++n4) O[n4] = MFMA16(pf, ldfrag(Vts, n4 * 16, 136, ks * 32, lane), O[n4]); }
    }
#pragma unroll
    for (int n4 = 0; n4 < 4; ++n4)
#pragma unroll
        for (int j = 0; j < 4; ++j) Y[(r0 + lrow + j) * DM + 512 + hh * 64 + n4 * 16 + (lane & 15)] = f2bf(O[n4][j] / lsum[j]);
}
constexpr int RW_T = 32, RW_BUF = 43008;
struct RwRegs { unsigned short r[9], k[9], v[9], om[8], a[8]; float kn[8]; };
DI void rwkv_unit(const Params& p, unsigned char* smem, int bh, int rg) {
    const bf16_t* H = (const bf16_t*)(p.ws + O_H); const bf16_t* LW = (const bf16_t*)(p.ws + O_LW); bf16_t* Y = (bf16_t*)(p.ws + O_XN); const float* KNRM = (const float*)(p.ws + O_KNRM);
    const int tid = otid(), lane = tid & 63, w = tid >> 6, b = bh >> 3, hh = bh & 7; const size_t rb = (size_t)b * SEQ;
    float* ysh = (float*)(smem + 2 * RW_BUF);
    const int NCH = SEQ / RW_T;
    __syncthreads();
    if (w < 4) {
        float S0 = 0.f, S1 = 0.f, S2 = 0.f, S3 = 0.f; const int kq = lane & 15, row = w * 4 + (lane >> 4);
        __syncthreads();
        for (int ch = 0; ch < NCH; ++ch) {
            const float* bufp = (const float*)(smem + (ch & 1) * RW_BUF) + kq * 4; const float* vp = (const float*)(smem + (ch & 1) * RW_BUF) + 10240 + row; float* yo = ysh + (ch & 1) * 512 + row;
#define RW_LOAD(R, W, K, Q, B, V, tt) { R = *(const f32x4*)(bufp + (tt) * 64); W = *(const f32x4*)(bufp + 2048 + (tt) * 64); K = *(const f32x4*)(bufp + 4096 + (tt) * 64); \
                Q = *(const f32x4*)(bufp + 6144 + (tt) * 64); B = *(const f32x4*)(bufp + 8192 + (tt) * 64); V = vp[(tt) * 16]; }
#define RW_STEP(R, W, K, Q, B, V, i) { float d = S0 * Q[0] + S1 * Q[1] + S2 * Q[2] + S3 * Q[3]; d = dpp_red16(d); const float sa = -d; \
                S0 = (S0 * W[0] + V * K[0]) + sa * B[0]; S1 = (S1 * W[1] + V * K[1]) + sa * B[1]; S2 = (S2 * W[2] + V * K[2]) + sa * B[2]; S3 = (S3 * W[3] + V * K[3]) + sa * B[3]; \
                float y = S0 * R[0] + S1 * R[1] + S2 * R[2] + S3 * R[3]; y = dpp_red16(y); yacc = (kq == (i)) ? y : yacc; }
            f32x4 rA, wA, kA, qA, bA, rB, wB, kB, qB, bB; float vA, vB;
            RW_LOAD(rA, wA, kA, qA, bA, vA, 0)
            __builtin_amdgcn_sched_barrier(0);
#pragma unroll
            for (int g = 0; g < RW_T / 16; ++g) { float yacc = 0.f;
#pragma unroll
                for (int i = 0; i < 16; i += 2) { const int tt = g * 16 + i;
                    RW_LOAD(rB, wB, kB, qB, bB, vB, tt + 1)
                    RW_STEP(rA, wA, kA, qA, bA, vA, i)
                    if (tt + 2 < RW_T) RW_LOAD(rA, wA, kA, qA, bA, vA, tt + 2)
                    RW_STEP(rB, wB, kB, qB, bB, vB, i + 1)
                    __builtin_amdgcn_sched_barrier(0); }
                yo[(g * 16 + kq) * 16] = yacc; }
            __syncthreads();
        }
    } else {
        const int lw = w - 4, col = hh * 64 + lane; RwRegs ra;
        const float mur = p.od_mu[col], muk = p.od_mu[512 + col], muv = p.od_mu[1024 + col], kk_w = p.od_k_k[col], ka_w = p.od_k_a[col];
        auto issue = [&](int ch, RwRegs& rr) {
            const int tbase = ch * RW_T + lw * 8;
#pragma unroll
            for (int i = 0; i < 9; ++i) { const int t = tbase + i - 1;
                if (t >= 0) { const bf16_t* hp = H + (rb + t) * HS; rr.r[i] = hp[col]; rr.k[i] = hp[512 + col]; rr.v[i] = hp[1024 + col]; } else { rr.r[i] = 0; rr.k[i] = 0; rr.v[i] = 0; }
                if (i > 0) { const bf16_t* lp = LW + (rb + t) * 1536; rr.om[i - 1] = lp[col]; rr.a[i - 1] = lp[512 + col]; rr.kn[i - 1] = KNRM[(rb + t) * 8 + hh]; } }
        };
        auto process = [&](int ch, const RwRegs& rr) {
            float* bufp = (float*)(smem + (ch & 1) * RW_BUF);
#pragma unroll
            for (int i = 1; i < 9; ++i) { const int tt = lw * 8 + i - 1;
                const float rc = bf2f(rr.r[i]), rp = bf2f(rr.r[i - 1]), kc = bf2f(rr.k[i]), kp = bf2f(rr.k[i - 1]), vc = bf2f(rr.v[i]), vp = bf2f(rr.v[i - 1]);
                const float rl = rc + (rp - rc) * mur, kl = kc + (kp - kc) * muk, vl = vc + (vp - vc) * muv; const float a = bf2f(rr.a[i - 1]), wv = 1.f - bf2f(rr.om[i - 1]);
                const float kk = kl * kk_w * rr.kn[i - 1];
                bufp[tt * 64 + lane] = rl; bufp[2048 + tt * 64 + lane] = wv; bufp[4096 + tt * 64 + lane] = kl * (1.f + (a - 1.f) * ka_w); bufp[6144 + tt * 64 + lane] = kk; bufp[8192 + tt * 64 + lane] = kk * a;
                if ((lane >> 4) == rg) bufp[10240 + tt * 16 + (lane & 15)] = vl; }
        };
        auto touch = [&](int ch) -> unsigned {
            const int L = lw * 64 + lane; unsigned v = 0u;
            if (L < 160) { const int tok = L / 5, which = L - tok * 5; const size_t t = rb + (size_t)ch * RW_T + tok;
                const bf16_t* a = which < 3 ? H + t * HS + which * 512 + hh * 64 : LW + t * 1536 + (which - 3) * 512 + hh * 64;
                v = *(const volatile unsigned*)a; }
            return v;
        };
        unsigned pfacc = touch(1) ^ touch(2) ^ touch(3); unsigned pfA = touch(4), pfB = touch(5);
        issue(0, ra); process(0, ra); issue(1, ra);
        __syncthreads();
        for (int ch = 0; ch < NCH; ++ch) {
            pfacc ^= pfA; pfA = pfB; pfB = (ch + 6 < NCH) ? touch(ch + 6) : 0u;
            if (ch + 1 < NCH) { process(ch + 1, ra); if (ch + 2 < NCH) issue(ch + 2, ra); }
            if (ch > 0) { const float* yi = ysh + ((ch - 1) & 1) * 512; const int t2 = tid - 256, tt = t2 >> 3, pr = (t2 & 7) * 2;
                *(unsigned*)(Y + (rb + (ch - 1) * RW_T + tt) * DM + hh * 64 + rg * 16 + pr) = pack2(yi[tt * 16 + pr], yi[tt * 16 + pr + 1]); }
            __syncthreads();
        }
        pfacc ^= pfA ^ pfB; if (pfacc == 0x9e3779b9u && rg == 77) Y[0] = 0;
        { const float* yi = ysh + ((NCH - 1) & 1) * 512; const int t2 = tid - 256, tt = t2 >> 3, pr = (t2 & 7) * 2;
          *(unsigned*)(Y + (rb + (NCH - 1) * RW_T + tt) * DM + hh * 64 + rg * 16 + pr) = pack2(yi[tt * 16 + pr], yi[tt * 16 + pr + 1]); }
    }
    __syncthreads();
}
DI void phase_l1_mix(const Params& p, unsigned char* smem, int pass) {
    unsigned* ctr = (unsigned*)(p.ws + O_CTL) + pass * 4; int* sh = (int*)(smem + 90112);
    if (obid() < 64 && pass != 2) rwkv_unit(p, smem, obid() >> 2, obid() & 3);
    for (;;) {
        __syncthreads(); if (otid() == 0) *sh = (int)atomicAdd(ctr, 1u); __syncthreads();
        const int u = *sh; if (u >= 1024) break;
        fox_unit(p, smem, u & 15, 63 - (u >> 4));
    }
}
DI void phase_rwkv_fin(const Params& p) {
    const bf16_t* H = (const bf16_t*)(p.ws + O_H); const bf16_t* LW = (const bf16_t*)(p.ws + O_LW); bf16_t* Y = (bf16_t*)(p.ws + O_XN);
    const int lane = otid() & 63, wv = otid() >> 6;
    for (int task = obid() * 8 + wv; task < TOK * 8; task += gridDim.x * 8) {
        const int r = task >> 3, hh = task & 7, t = r & (SEQ - 1), col = hh * 64 + lane; const bf16_t* hp = H + (size_t)r * HS;
        const float y = bf2f(Y[(size_t)r * DM + col]); const float mean = red64(y) * (1.f / 64.f); const float dy = y - mean; const float var = red64(dy * dy) * (1.f / 64.f);
        const float yln = dy * rsqrtf(var + 64e-5f) * p.od_ln_w[col] + p.od_ln_b[col];
        const float rc = bf2f(hp[col]), kc = bf2f(hp[512 + col]), vc = bf2f(hp[1024 + col]); float rp = 0.f, kp = 0.f, vp = 0.f;
        if (t > 0) { rp = bf2f(hp[col - HS]); kp = bf2f(hp[512 + col - HS]); vp = bf2f(hp[1024 + col - HS]); }
        const float rl = rc + (rp - rc) * p.od_mu[col], kl = kc + (kp - kc) * p.od_mu[512 + col], vl = vc + (vp - vc) * p.od_mu[1024 + col];
        const float a = bf2f(LW[(size_t)r * 1536 + 512 + col]), g = bf2f(LW[(size_t)r * 1536 + 1024 + col]);
        const float kt = kl * (1.f + (a - 1.f) * p.od_k_a[col]); const float bonus = red64(rl * kt * p.od_r_k[col]) * vl;
        Y[(size_t)r * DM + col] = f2bf((yln + bonus) * g);
    }
}
#define XB_TMO      128
#define XB_XCNT(j)  (256  + 64 * (j))
#define XB_XSUB(j)  (1280 + 64 * (j))
#define XB_XGEN(j)  (2304 + 64 * (j))
#define XB_TOP      3328
#define XB_TOPGEN   3392
#define XCD_BAR_WORDS 3456
#define XB_SPIN_CAP (1u << 18)
#define LAS __attribute__((address_space(3)))

__device__ __forceinline__ unsigned xb_ld(unsigned* p)              { return __hip_atomic_load(p, __ATOMIC_RELAXED, __HIP_MEMORY_SCOPE_AGENT); }
__device__ __forceinline__ unsigned xb_add(unsigned* p, unsigned v) { return __hip_atomic_fetch_add(p, v, __ATOMIC_RELAXED, __HIP_MEMORY_SCOPE_AGENT); }
__device__ __forceinline__ unsigned xb_xcc_id() { return (unsigned)__builtin_amdgcn_s_getreg((3 << 11) | 20) & 0xFu; }
#define XB_SPIN(cond, bar) do { unsigned _sp = 0; while (cond) { __builtin_amdgcn_s_sleep(1); \
    if ((++_sp & 255u) == 0u) { if (xb_ld(&(bar)[XB_TMO])) break; if (_sp > XB_SPIN_CAP) { atomicAdd(&(bar)[XB_TMO], 1u); break; } } } } while (0)

struct XcdBarrier {
    unsigned* bar; unsigned x;
    volatile LAS unsigned* st;
};

__device__ __forceinline__ XcdBarrier xcd_barrier_post(unsigned* bar, volatile LAS unsigned* st) {
    XcdBarrier b; b.bar = bar; b.x = xb_xcc_id(); b.st = st;
    if (threadIdx.x == 0) (void)xb_add(&bar[XB_XCNT(b.x)], 1u);
    return b;
}
__device__ __forceinline__ void xcd_barrier_complete(unsigned* bar, unsigned x, unsigned& nloc, unsigned& nx) {
    const unsigned G = gridDim.x * gridDim.y * gridDim.z;
    unsigned sum, cnt, mine, sp = 0u;
    for (;;) {
        sum = 0u; cnt = 0u; mine = 0u;
#pragma unroll
        for (unsigned j = 0; j < 16; ++j) { const unsigned c = xb_ld(&bar[XB_XCNT(j)]); sum += c; cnt += (c > 0u) ? 1u : 0u; mine = (j == x) ? c : mine; }
        if (sum == G) break;
        __builtin_amdgcn_s_sleep(1);
        if ((++sp & 255u) == 0u) { if (xb_ld(&bar[XB_TMO])) break; if (sp > XB_SPIN_CAP) { atomicAdd(&bar[XB_TMO], 1u); break; } }
    }
    nloc = mine > 0u ? mine : 1u; nx = cnt > 0u ? cnt : 1u;
}

__device__ __forceinline__ void xcd_barrier(const XcdBarrier& b) {
    asm volatile("s_waitcnt vmcnt(0)" ::: "memory");
    __syncthreads();
    if (threadIdx.x == 0) {
        unsigned* bar = b.bar;
        __builtin_amdgcn_s_waitcnt(0);
        unsigned nloc = b.st[0], nx = b.st[1];
        if (nloc == 0u) { xcd_barrier_complete(bar, b.x, nloc, nx); b.st[0] = nloc; b.st[1] = nx; }
        const unsigned old = xb_add(&bar[XB_XSUB(b.x)], 1u);
        const unsigned gen = old / nloc;
        if (old + 1u == (gen + 1u) * nloc) {
            __builtin_amdgcn_fence(__ATOMIC_RELEASE, "agent");
            asm volatile("s_waitcnt vmcnt(0)" ::: "memory");
            const unsigned og = xb_add(&bar[XB_TOP], 1u);
            const unsigned tg = og / nx;
            if (og + 1u == (tg + 1u) * nx) xb_add(&bar[XB_TOPGEN], 1u);
            else XB_SPIN(xb_ld(&bar[XB_TOPGEN]) == tg, bar);
            __builtin_amdgcn_fence(__ATOMIC_ACQUIRE, "agent");
            xb_add(&bar[XB_XGEN(b.x)], 1u);
            asm volatile("s_waitcnt vmcnt(0)" ::: "memory");
        } else {
            XB_SPIN(xb_ld(&bar[XB_XGEN(b.x)]) == gen, bar);
            __builtin_amdgcn_fence(__ATOMIC_ACQUIRE, "agent");
            asm volatile("s_waitcnt vmcnt(0)" ::: "memory");
        }
    }
    __syncthreads();
}


__global__ void __launch_bounds__(512, 2) fwd_megakernel(Params p) {
    extern __shared__ __attribute__((aligned(16))) unsigned char smem[];
    cg::grid_group grid = cg::this_grid();
    unsigned char* ws = p.ws;
    bf16_t* XN = (bf16_t*)(ws + O_XN); bf16_t* Hb = (bf16_t*)(ws + O_H); float* aux = (float*)(ws + O_AUX);
    const bf16_t* t_in = (const bf16_t*)(ws + O_WT_IN); const bf16_t* t_out = (const bf16_t*)(ws + O_WT_OUT); const bf16_t* t_up = (const bf16_t*)(ws + O_WT_UP);
    const bf16_t* t_dn = (const bf16_t*)(ws + O_WT_DN); const bf16_t* t_lr = (const bf16_t*)(ws + O_WT_LR);
    if (blockIdx.x == 0 && threadIdx.x < 16) ((unsigned*)(ws + O_CTL))[threadIdx.x] = 0u;
    if (threadIdx.x == 0) *(uint4*)(smem + 131072) = make_uint4(0u, 0u, 0u, 0u);
    __syncthreads();
    const XcdBarrier xb = xcd_barrier_post((unsigned*)(ws + O_BAR), (volatile LAS unsigned*)(smem + 131072));
#define GSYNC() xcd_barrier(xb)
#define GEMM_H(layer) { EpiH E; E.H = Hb; E.aux = aux; E.auxc = layer ? 3328 : 1280; run_gemm(smem, XN, t_in, 3584, 1024, E); }
#define GEMM_OUT(layer) { EpiRes E; E.res = layer ? p.out : p.x; E.out = p.out; run_gemm(smem, XN, t_out, 1024, 1024, E); }
#define GEMM_UP() { EpiGU E; E.G = (bf16_t*)(ws + O_G); E.U = (bf16_t*)(ws + O_U); run_gemm(smem, XN, t_up, 2 * DFF, 1024, E); }
#define GEMM_DN() { EpiRes E; E.res = p.out; E.out = p.out; run_gemm(smem, (const bf16_t*)(ws + O_U), t_dn, 1024, DFF, E); }
    phase_weights(p, smem, 0); phase_rmsnorm(p.x, p.ev_norm_w, XN); grid.sync();
    GEMM_H(0) GSYNC();
#if PROBE == 2
    GEMM_H(0) GSYNC();
#endif
    phase_m1(p, smem); GSYNC();
#if PROBE == 3
    phase_m1(p, smem); GSYNC();
#endif
    phase_m2(p); GSYNC();
#if PROBE == 6
    GSYNC(); GSYNC(); GSYNC(); GSYNC(); GSYNC(); GSYNC(); GSYNC(); GSYNC(); GSYNC(); GSYNC();
#endif
#if PROBE == 7
    phase_weights(p, smem, 0); GSYNC(); phase_rmsnorm(p.x, p.ev_norm_w, XN); GSYNC(); phase_rmsnorm(p.x, p.ev_norm_w, XN); GSYNC();
#endif
    phase_m3(p, smem); GSYNC();
#if PROBE == 3
    phase_m3(p, smem); GSYNC();
#endif
    GEMM_OUT(0) GSYNC();
#if PROBE == 2
    GEMM_OUT(0) GSYNC();
#endif
    phase_rmsnorm(p.out, p.ffn_norm_w, XN); GSYNC();
    GEMM_UP() GSYNC();
#if PROBE == 2
    GEMM_UP() GSYNC();
#endif
    phase_ffn_act(p, 0); GSYNC();
    GEMM_DN() GSYNC();
    phase_weights(p, smem, 1); phase_rmsnorm(p.out, p.od_norm_w, XN); GSYNC();
    GEMM_H(1) GSYNC();
    phase_l1_prep(p, smem); GSYNC();
    { EpiLR E; E.LW = (bf16_t*)(ws + O_LW); E.w0 = p.od_w0; E.a0 = p.od_a0; run_gemm(smem, (const bf16_t*)(ws + O_AP), t_lr, 1536, 256, E); } GSYNC();
    phase_l1_mix(p, smem, 0); GSYNC();
#if PROBE == 4
    phase_l1_mix(p, smem, 1); GSYNC();
#endif
#if PROBE == 5
    phase_l1_mix(p, smem, 2); GSYNC();
#endif
    phase_rwkv_fin(p); GSYNC();
    GEMM_OUT(1) GSYNC();
    phase_rmsnorm(p.out, p.ffn_norm_w + DM, XN); GSYNC();
    GEMM_UP() GSYNC();
    phase_ffn_act(p, 1); GSYNC();
    GEMM_DN()
}

extern "C" void kernel_launch(void* const* d_in, const int* in_sizes, int n_in, void* d_out, int out_size, void* d_ws, size_t ws_size, hipStream_t stream) {
    static int grid_blocks = 0;
    if (grid_blocks == 0) {
        int dev = 0, cus = 0, per_cu = 0;
        hipGetDevice(&dev); hipDeviceGetAttribute(&cus, hipDeviceAttributeMultiprocessorCount, dev);
        if (hipFuncSetAttribute((const void*)fwd_megakernel, hipFuncAttributeMaxDynamicSharedMemorySize, LDS_BYTES) != hipSuccess) fprintf(stderr, "hipFuncSetAttribute failed\n");
        hipOccupancyMaxActiveBlocksPerMultiprocessor(&per_cu, (const void*)fwd_megakernel, 512, LDS_BYTES);
        (void)hipGetLastError();
        if (per_cu < 1) fprintf(stderr, "occupancy query says %d blocks per CU\n", per_cu);
        grid_blocks = cus > 0 ? cus : 256;
        if (ws_size < WS_NEED) fprintf(stderr, "workspace too small: %zu < %zu\n", ws_size, (size_t)WS_NEED);
    }
    Params p{};
    const float** pp = (const float**)&p;
    for (int i = 0; i < 33; ++i) pp[i] = (const float*)d_in[i];
    p.out = (float*)d_out; p.ws = (unsigned char*)d_ws;
    (void)hipMemsetAsync((char*)d_ws + O_BAR, 0, 16384, stream);
    void* args[] = {&p};
    hipError_t e = hipLaunchCooperativeKernel((const void*)fwd_megakernel, dim3(grid_blocks), dim3(512), args, LDS_BYTES, stream);
    if (e != hipSuccess) fprintf(stderr, "cooperative launch failed: %s (grid %d)\n", hipGetErrorString(e), grid_blocks);
}
```

```cpp
#include <hip/hip_runtime.h>
#include <hip/hip_cooperative_groups.h>
#include <cstdio>
#ifndef PROBE
#define PROBE 0
#endif
namespace cg = cooperative_groups;
namespace pg8 {
#define PG8_LAS __attribute__((address_space(3)))
typedef unsigned short bf16_t;
typedef short bf16x8 __attribute__((ext_vector_type(8)));
typedef float f32x4 __attribute__((ext_vector_type(4)));
typedef unsigned u32x4 __attribute__((ext_vector_type(4)));
constexpr int BM = 256, BK = 64, HALF = 128, HTB = HALF * BK * 2  , STAGE_BYTES = 8 * HTB, NXCD = 8, WGM = 8;

__host__ __device__ __forceinline__ int lds_byte(int r, int c) { const int st = (r >> 4) * 2 + (c >> 5), rr = r & 15, cc = c & 31, ob = rr * 64 + cc * 2; return st * 1024 + (ob ^ (((ob >> 9) & 1) << 5)); }
__host__ __device__ __forceinline__ void stage_rc(int b, int& R, int& C) { const int st = b / 1024, sb = b % 1024, swz = sb ^ (((sb >> 9) & 1) << 5); R = (st >> 1) * 16 + swz / 64; C = (st & 1) * 32 + (swz % 64) / 2; }
__host__ __device__ __forceinline__ int perm32(int rho) { const int n = rho >> 4, i = rho & 15; return 8 * (i >> 2) + 4 * n + (i & 3); }

struct Unit { int pm, pn; };
struct Gemm { const bf16_t* A; const bf16_t* Bt; int M, N, K; };

struct StaticOrder {
    int nM, nN, nwg, G, c;
    __host__ __device__ void init(int M, int N, int G_, int c_) { nM = M / BM; nN = N / BM; nwg = nM * nN; G = G_; c = c_; }
    __host__ __device__ bool next(int i, Unit& u) const {
        const long L = (long)i * G + c; if (L >= nwg) return false;
        int wgid = (int)L; { const int q = nwg / NXCD, r = nwg % NXCD, xcd = wgid % NXCD, off = wgid / NXCD; wgid = (xcd < r ? xcd * (q + 1) : r * (q + 1) + (xcd - r) * q) + off; }
        const int nig = WGM * nN, gid = wgid / nig, fm = gid * WGM, gsz = (nM - fm) < WGM ? (nM - fm) : WGM;
        u.pm = fm + ((wgid % nig) % gsz); u.pn = (wgid % nig) / gsz; return true;
    }
    __device__ __forceinline__ void a_ready(const Unit&) const {}
    __device__ __forceinline__ void done(const Unit&) const {}
};
__device__ __forceinline__ unsigned cvt_pk_bf16(float lo, float hi) { unsigned r; asm volatile("v_cvt_pk_bf16_f32 %0, %1, %2" : "=v"(r) : "v"(lo), "v"(hi)); return r; }

template <class Epi, class Sched, bool STAMP = false>
__device__ __forceinline__ void gemm_phase(PG8_LAS unsigned char* lds, const Gemm g, const Sched& S, const Epi& E, unsigned long long* stamps) {
    int tid_ = threadIdx.x; asm volatile("" : "+v"(tid_)); const int tid = tid_, wid = __builtin_amdgcn_readfirstlane(tid >> 6), lane = tid & 63, wr = wid >> 2, wc = wid & 3, fr = lane & 15, fq = lane >> 4;
    const int K = g.K, nt = K / BK;
    int ts_lo = 0, ts_hi = 0, nts = 0; const unsigned long long rt_entry = STAMP ? (unsigned long long)wall_clock64() : 0ull;
#define PG8_STAMP() do { if (STAMP && wid == 0 && nts < 64) { const unsigned long long _c = (unsigned long long)clock64(); \
        ts_lo = (lane == nts) ? (int)(unsigned)_c : ts_lo; ts_hi = (lane == nts) ? (int)(unsigned)(_c >> 32) : ts_hi; ++nts; } } while (0)
    PG8_STAMP();
    unsigned voffA[2], voffB[2];
#pragma unroll
    for (int i = 0; i < 2; ++i) { int R, C; stage_rc(tid * 16 + i * 8192, R, C); const int Rb = Epi::PERM ? ((R & ~31) + perm32(R & 31)) : R;
        voffA[i] = (unsigned)(R * K + C) * 2u; voffB[i] = (unsigned)(Rb * K + C) * 2u; }
    const size_t kstep = (size_t)(BK * 2);
    const size_t hstep = (size_t)HALF * K * 2;
    const size_t tstep = 2 * hstep;
    const unsigned ldsw = (unsigned)wid * 1024u;
    const int aoff = lds_byte(wr * 64 + fr, fq * 8), boff = lds_byte(wc * 32 + fr, fq * 8);
#define PG8_SA(b, h) (((b) * 2 + (h)) * HTB)
#define PG8_SB(b, h) ((4 + (b) * 2 + (h)) * HTB)
#define PG8_STAGE(bufoff, gbase, voff) do { _Pragma("unroll") for (int _i = 0; _i < 2; ++_i) \
        __builtin_amdgcn_global_load_lds((const unsigned*)((const char*)(gbase) + (voff)[_i]), (PG8_LAS unsigned*)(lds + (bufoff) + ldsw + _i * 8192), 16, 0, 0); } while (0)
#define PG8_LDA(dst, b, h) do { _Pragma("unroll") for (int m = 0; m < 4; ++m) _Pragma("unroll") for (int k = 0; k < 2; ++k) dst[m][k] = *(const PG8_LAS bf16x8*)(lds + PG8_SA(b, h) + aoff + m * 2048 + k * 1024); } while (0)
#define PG8_LDB(dst, b, h) do { _Pragma("unroll") for (int n = 0; n < 2; ++n) _Pragma("unroll") for (int k = 0; k < 2; ++k) dst[n][k] = *(const PG8_LAS bf16x8*)(lds + PG8_SB(b, h) + boff + n * 2048 + k * 1024); } while (0)
#define PG8_MMA(ai, bj, At, Bt) do { __builtin_amdgcn_s_setprio(1); _Pragma("unroll") for (int m = 0; m < 4; ++m) _Pragma("unroll") for (int n = 0; n < 2; ++n) _Pragma("unroll") for (int k = 0; k < 2; ++k) \
        acc[ai][bj][m][n] = __builtin_amdgcn_mfma_f32_16x16x32_bf16(Bt[n][k], At[m][k], acc[ai][bj][m][n], 0, 0, 0); __builtin_amdgcn_s_setprio(0); } while (0)
#define PG8_WAIT_V(n) asm volatile("s_waitcnt vmcnt(" #n ")" ::: "memory")
#define PG8_WAIT_L(n) asm volatile("s_waitcnt lgkmcnt(" #n ")" ::: "memory")
#define PG8_BAR __builtin_amdgcn_s_barrier()
#define PG8_SCHED __builtin_amdgcn_sched_barrier(0)
    Unit cur, nxt; int ui = 0;
    if (!S.next(0, cur)) return;
    f32x4 acc[2][2][4][2];
#pragma unroll
    for (int a = 0; a < 2; ++a)
#pragma unroll
        for (int b = 0; b < 2; ++b)
#pragma unroll
            for (int m = 0; m < 4; ++m)
#pragma unroll
                for (int n = 0; n < 2; ++n) acc[a][b][m][n] = (f32x4){0.f, 0.f, 0.f, 0.f};
    bf16x8 At[4][2], B0[2][2], B1[2][2];
    const char* cA = (const char*)g.A + (size_t)cur.pm * tstep; const char* cB = (const char*)g.Bt + (size_t)cur.pn * tstep;
    S.a_ready(cur);
    PG8_STAGE(PG8_SB(0, 0), cB, voffB); PG8_STAGE(PG8_SA(0, 0), cA, voffA); PG8_STAGE(PG8_SB(0, 1), cB + hstep, voffB); PG8_STAGE(PG8_SA(0, 1), cA + hstep, voffA);
    if (wr == 1) PG8_BAR;
    PG8_WAIT_V(4); PG8_BAR;
    PG8_STAGE(PG8_SB(1, 0), cB + kstep, voffB); PG8_STAGE(PG8_SA(1, 0), cA + kstep, voffA); PG8_STAGE(PG8_SB(1, 1), cB + hstep + kstep, voffB);
    PG8_WAIT_V(6); PG8_BAR;
    PG8_STAMP();
    for (;;) {
        const bool has_next = S.next(ui + 1, nxt);
        const char* nA = has_next ? (const char*)g.A + (size_t)nxt.pm * tstep : cA; const char* nB = has_next ? (const char*)g.Bt + (size_t)nxt.pn * tstep : cB;
        for (int t = 0; t < nt; t += 2) {
            const bool last = (t == nt - 2);
            const char* a1 = cA + (size_t)(t + 1) * kstep;
            const char* a2 = last ? nA : cA + (size_t)(t + 2) * kstep; const char* b2 = last ? nB : cB + (size_t)(t + 2) * kstep;
            const char* a3 = a2 + kstep; const char* b3 = b2 + kstep;
            if (last && has_next) S.a_ready(nxt);
            PG8_LDB(B0, 0, 0); PG8_SCHED; PG8_LDA(At, 0, 0); PG8_STAGE(PG8_SA(1, 1), a1 + hstep, voffA);
            PG8_WAIT_L(8); PG8_BAR; PG8_WAIT_L(0); PG8_MMA(0, 0, At, B0); PG8_BAR; PG8_SCHED;
            PG8_LDB(B1, 0, 1); PG8_STAGE(PG8_SB(0, 0), b2, voffB);
            PG8_BAR; PG8_WAIT_L(0); PG8_MMA(0, 1, At, B1); PG8_BAR;
            PG8_LDA(At, 0, 1); PG8_STAGE(PG8_SA(0, 0), a2, voffA);
            PG8_BAR; PG8_WAIT_L(0); PG8_MMA(1, 0, At, B0); PG8_BAR; PG8_SCHED;
            PG8_STAGE(PG8_SB(0, 1), b2 + hstep, voffB);
            PG8_WAIT_V(6); PG8_BAR; PG8_MMA(1, 1, At, B1); PG8_BAR;
            PG8_LDB(B0, 1, 0); PG8_SCHED; PG8_LDA(At, 1, 0); PG8_STAGE(PG8_SA(0, 1), a2 + hstep, voffA);
            PG8_WAIT_L(8); PG8_BAR; PG8_WAIT_L(0); PG8_MMA(0, 0, At, B0); PG8_BAR; PG8_SCHED;
            PG8_LDB(B1, 1, 1); PG8_STAGE(PG8_SB(1, 0), b3, voffB);
            PG8_BAR; PG8_WAIT_L(0); PG8_MMA(0, 1, At, B1); PG8_BAR;
            PG8_LDA(At, 1, 1); PG8_STAGE(PG8_SA(1, 0), a3, voffA);
            PG8_BAR; PG8_WAIT_L(0); PG8_MMA(1, 0, At, B0); PG8_BAR; PG8_SCHED;
            PG8_STAGE(PG8_SB(1, 1), b3 + hstep, voffB);
            PG8_WAIT_V(6); PG8_BAR; PG8_MMA(1, 1, At, B1); PG8_BAR;
        }
        PG8_STAMP();
        if constexpr (!Epi::AFTER_DRAIN) { E(acc, cur, wr, wc, fr, fq); S.done(cur); }
        PG8_STAMP();
        if (!has_next) break;
#pragma unroll
        for (int a = 0; a < 2; ++a)
#pragma unroll
            for (int b = 0; b < 2; ++b)
#pragma unroll
                for (int m = 0; m < 4; ++m)
#pragma unroll
                    for (int n = 0; n < 2; ++n) acc[a][b][m][n] = (f32x4){0.f, 0.f, 0.f, 0.f};
        cur = nxt; cA = nA; cB = nB; ++ui;
    }
    PG8_WAIT_V(0);
    if (wr == 0) PG8_BAR;
    PG8_BAR;
    if constexpr (Epi::AFTER_DRAIN) { E.fused(acc, cur, wr, wc, fr, fq, lds, wid, lane); S.done(cur); }
    PG8_STAMP();
    if (STAMP && wid == 0) { stamps[lane] = lane < nts ? (((unsigned long long)(unsigned)ts_hi << 32) | (unsigned)ts_lo) : 0ull;
        if (lane == 62) stamps[62] = rt_entry; if (lane == 63) stamps[63] = (unsigned long long)wall_clock64(); }
#undef PG8_STAMP
#undef PG8_SA
#undef PG8_SB
#undef PG8_STAGE
#undef PG8_LDA
#undef PG8_LDB
#undef PG8_MMA
#undef PG8_WAIT_V
#undef PG8_WAIT_L
#undef PG8_BAR
#undef PG8_SCHED
}
}

using pg8::bf16_t; using pg8::bf16x8; using pg8::f32x4; using pg8::Unit; using pg8::cvt_pk_bf16;
#define DI __device__ __forceinline__
constexpr int TOK = 16384, SEQ = 8192, DM = 1024, HS = 3336, DFF = 2816;
constexpr size_t O_CTL = 0, O_CD = 256, O_AUX = 4352, O_ROPE = 528640, O_FC = 2625792, O_WT = 3150080;
constexpr size_t O_WT_IN = O_WT, O_WT_OUT = O_WT_IN + 7340032, O_WT_UP = O_WT_OUT + 2097152, O_WT_DN = O_WT_UP + 11534336, O_WT_LR = O_WT_DN + 5767168;
constexpr size_t O_XN = O_WT + 27525120, O_R1 = O_XN + 33554432;
constexpr size_t O_H = O_R1, O_ST = O_R1 + 109314048, O_YG = O_ST + 33554432;
constexpr size_t O_G = O_R1, O_U = O_R1 + 92274688;
constexpr size_t O_LW = O_R1 + 109314048, O_KN = O_LW + 50331648, O_VT = O_KN + 16777216, O_AP = O_VT + 16777216;
constexpr size_t O_KNRM = O_AP + 8388608;
constexpr size_t O_BAR = O_KNRM + 524288;
constexpr size_t WS_NEED = O_BAR + 16384;
constexpr int LDS_BYTES = 131072 + 256;

struct Params {
    const float* x; const float* ev_norm_w; const float* ev_w_in; const float* ev_conv_w; const float* ev_conv_b; const float* ev_dt_bias; const float* ev_a_log;
    const float* ev_d; const float* ev_ssd_norm_w; const float* ev_ret_norm_w; const float* ev_w_out;
    const float* od_norm_w; const float* od_w_in; const float* od_mu; const float* od_w0; const float* od_w_up; const float* od_a0; const float* od_a_up;
    const float* od_g_up; const float* od_k_k; const float* od_k_a; const float* od_r_k; const float* od_ln_w; const float* od_ln_b;
    const float* od_qn_w; const float* od_kn_w; const float* od_f_bias; const float* od_w_out;
    const float* ffn_norm_w; const float* ffn_w_up; const float* ffn_conv_w; const float* ffn_conv_b; const float* ffn_w_down;
    float* out; unsigned char* ws;
};

DI unsigned short f2bf(float f) { unsigned u = __float_as_uint(f); u += 0x7fffu + ((u >> 16) & 1u); return (unsigned short)(u >> 16); }
DI float bf2f(unsigned short b) { return __uint_as_float(((unsigned)b) << 16); }
DI unsigned pack2(float lo, float hi) { return (unsigned)f2bf(lo) | ((unsigned)f2bf(hi) << 16); }
DI float bflo(unsigned w) { return __uint_as_float(w << 16); }
DI float bfhi(unsigned w) { return __uint_as_float(w & 0xffff0000u); }
DI void unpack8(const uint4 r, float (&o)[8]) { o[0] = bflo(r.x); o[1] = bfhi(r.x); o[2] = bflo(r.y); o[3] = bfhi(r.y); o[4] = bflo(r.z); o[5] = bfhi(r.z); o[6] = bflo(r.w); o[7] = bfhi(r.w); }
DI uint4 pack8(const float (&o)[8]) { uint4 r; r.x = pack2(o[0], o[1]); r.y = pack2(o[2], o[3]); r.z = pack2(o[4], o[5]); r.w = pack2(o[6], o[7]); return r; }
DI float silu_(float x) { return x / (1.f + __expf(-x)); }
DI float sigm_(float x) { return 1.f / (1.f + __expf(-x)); }
DI float softplus_(float x) { return fmaxf(x, 0.f) + log1pf(__expf(-fabsf(x))); }
DI bf16x8 ldfrag(const bf16_t* base, int row0, int ld, int k0, int lane) { return *(const bf16x8*)(base + (row0 + (lane & 15)) * ld + k0 + (lane >> 4) * 8); }
#define MFMA16(a, b, c) __builtin_amdgcn_mfma_f32_16x16x32_bf16((a), (b), (c), 0, 0, 0)
DI float red16(float v) { v += __shfl_xor(v, 1); v += __shfl_xor(v, 2); v += __shfl_xor(v, 4); v += __shfl_xor(v, 8); return v; }
DI float max16(float v) { v = fmaxf(v, __shfl_xor(v, 1)); v = fmaxf(v, __shfl_xor(v, 2)); v = fmaxf(v, __shfl_xor(v, 4)); v = fmaxf(v, __shfl_xor(v, 8)); return v; }
DI float red64(float v) { v += __shfl_xor(v, 32); v += __shfl_xor(v, 16); return red16(v); }
DI float dpp_red16(float x) {
    x += __builtin_bit_cast(float, __builtin_amdgcn_update_dpp(0, __builtin_bit_cast(int, x), 0xB1, 0xF, 0xF, true));
    x += __builtin_bit_cast(float, __builtin_amdgcn_update_dpp(0, __builtin_bit_cast(int, x), 0x4E, 0xF, 0xF, true));
    x += __builtin_bit_cast(float, __builtin_amdgcn_update_dpp(0, __builtin_bit_cast(int, x), 0x141, 0xF, 0xF, true));
    x += __builtin_bit_cast(float, __builtin_amdgcn_update_dpp(0, __builtin_bit_cast(int, x), 0x140, 0xF, 0xF, true));
    return x;
}

DI int otid() { int t = threadIdx.x; asm volatile("" : "+v"(t)); return t; }
DI int obid() { int b = blockIdx.x; asm volatile("" : "+s"(b)); return b; }
struct EpiH {
    static constexpr bool PERM = false, AFTER_DRAIN = false;
    bf16_t* H; float* aux; int auxc;
    DI void operator()(const f32x4 (&acc)[2][2][4][2], const Unit& u, int wr, int wc, int fr, int fq) const {
        const int row0 = u.pm * 256 + wr * 64 + fr, col0 = u.pn * 256 + wc * 32 + 4 * fq;
#pragma unroll
        for (int ai = 0; ai < 2; ++ai)
#pragma unroll
            for (int m = 0; m < 4; ++m) { const size_t r = (size_t)(row0 + ai * 128 + m * 16);
#pragma unroll
                for (int bj = 0; bj < 2; ++bj)
#pragma unroll
                    for (int n = 0; n < 2; ++n) { const int c = col0 + bj * 128 + n * 16; const f32x4 v = acc[ai][bj][m][n];
                        if (c < HS) { uint2 w; w.x = cvt_pk_bf16(v[0], v[1]); w.y = cvt_pk_bf16(v[2], v[3]); *(uint2*)(H + r * HS + c) = w;
                            if (c == auxc || c == auxc + 4) *(f32x4*)(aux + r * 8 + (c - auxc)) = v; } } }
    }
};
struct EpiRes {
    static constexpr bool PERM = false, AFTER_DRAIN = false;
    const float* res; float* out;
    DI void operator()(const f32x4 (&acc)[2][2][4][2], const Unit& u, int wr, int wc, int fr, int fq) const {
        const int row0 = u.pm * 256 + wr * 64 + fr, col0 = u.pn * 256 + wc * 32 + 4 * fq;
#pragma unroll
        for (int ai = 0; ai < 2; ++ai)
#pragma unroll
            for (int m = 0; m < 4; ++m) { const size_t r = (size_t)(row0 + ai * 128 + m * 16);
#pragma unroll
                for (int bj = 0; bj < 2; ++bj)
#pragma unroll
                    for (int n = 0; n < 2; ++n) { const int c = col0 + bj * 128 + n * 16;
                        const f32x4 rv = *(const f32x4*)(res + r * DM + c); *(f32x4*)(out + r * DM + c) = rv + acc[ai][bj][m][n]; } }
    }
};
struct EpiGU {
    static constexpr bool PERM = false, AFTER_DRAIN = false;
    bf16_t* G; bf16_t* U;
    DI void operator()(const f32x4 (&acc)[2][2][4][2], const Unit& u, int wr, int wc, int fr, int fq) const {
        const int row0 = u.pm * 256 + wr * 64 + fr, col0 = u.pn * 128 + wc * 32 + 4 * fq;
#pragma unroll
        for (int ai = 0; ai < 2; ++ai)
#pragma unroll
            for (int m = 0; m < 4; ++m) { const size_t r = (size_t)(row0 + ai * 128 + m * 16);
#pragma unroll
                for (int n = 0; n < 2; ++n) { const int c = col0 + n * 16; const f32x4 g = acc[ai][0][m][n], v = acc[ai][1][m][n];
                    uint2 w; w.x = cvt_pk_bf16(g[0], g[1]); w.y = cvt_pk_bf16(g[2], g[3]); *(uint2*)(G + r * DFF + c) = w;
                    w.x = cvt_pk_bf16(v[0], v[1]); w.y = cvt_pk_bf16(v[2], v[3]); *(uint2*)(U + r * DFF + c) = w; } }
    }
};
struct EpiLR {
    static constexpr bool PERM = false, AFTER_DRAIN = false;
    bf16_t* LW; const float* w0; const float* a0;
    DI void operator()(const f32x4 (&acc)[2][2][4][2], const Unit& u, int wr, int wc, int fr, int fq) const {
        const int row0 = u.pm * 256 + wr * 64 + fr, col0 = u.pn * 256 + wc * 32 + 4 * fq;
#pragma unroll
        for (int ai = 0; ai < 2; ++ai)
#pragma unroll
            for (int m = 0; m < 4; ++m) { const size_t r = (size_t)(row0 + ai * 128 + m * 16);
#pragma unroll
                for (int bj = 0; bj < 2; ++bj)
#pragma unroll
                    for (int n = 0; n < 2; ++n) { const int c = col0 + bj * 128 + n * 16; f32x4 v = acc[ai][bj][m][n];
                        if (c < 512) { const f32x4 b = *(const f32x4*)(w0 + c);
#pragma unroll
                            for (int j = 0; j < 4; ++j) v[j] = 1.f - __expf(-0.606531f * sigm_(b[j] + v[j])); }
                        else if (c < 1024) { const f32x4 b = *(const f32x4*)(a0 + c - 512);
#pragma unroll
                            for (int j = 0; j < 4; ++j) v[j] = sigm_(b[j] + v[j]); }
                        uint2 w; w.x = cvt_pk_bf16(v[0], v[1]); w.y = cvt_pk_bf16(v[2], v[3]); *(uint2*)(LW + r * 1536 + c) = w; } }
    }
};
template <class Epi> DI void run_gemm(unsigned char* smem, const bf16_t* A, const bf16_t* Bt, int N, int K, const Epi& E) {
    pg8::Gemm g; g.A = A; g.Bt = Bt; g.M = TOK; g.N = N; g.K = K;
    pg8::StaticOrder S; S.init(TOK, N, (int)gridDim.x, obid());
    pg8::gemm_phase<Epi, pg8::StaticOrder, false>((PG8_LAS unsigned char*)smem, g, S, E, nullptr);
}

DI void conv_tile(const float* W, int Nsrc, int K, bf16_t* Wt, int nd0, int sc0, int nvalid, int k0, float* tile) {
    const int tid = otid(), j = tid & 63, kb = tid >> 6;
#pragma unroll
    for (int i = 0; i < 8; ++i) { const int kk = kb + 8 * i; tile[kk * 65 + j] = (j < nvalid) ? W[(size_t)(k0 + kk) * Nsrc + sc0 + j] : 0.f; }
    __syncthreads();
    const int nl = tid >> 3, ks = (tid & 7) * 8;
    uint4 o;
    o.x = pack2(tile[(ks + 0) * 65 + nl], tile[(ks + 1) * 65 + nl]); o.y = pack2(tile[(ks + 2) * 65 + nl], tile[(ks + 3) * 65 + nl]);
    o.z = pack2(tile[(ks + 4) * 65 + nl], tile[(ks + 5) * 65 + nl]); o.w = pack2(tile[(ks + 6) * 65 + nl], tile[(ks + 7) * 65 + nl]);
    *(uint4*)(Wt + (size_t)(nd0 + nl) * K + k0 + ks) = o;
    __syncthreads();
}
DI void phase_weights(const Params& p, unsigned char* smem, int layer) {
    float* tile = (float*)smem;
    const float* w_in = layer ? p.od_w_in : p.ev_w_in; const float* w_out = layer ? p.od_w_out : p.ev_w_out;
    const float* w_up = p.ffn_w_up + (size_t)layer * DM * 2 * DFF; const float* w_dn = p.ffn_w_down + (size_t)layer * DFF * DM;
    bf16_t* t_in = (bf16_t*)(p.ws + O_WT_IN); bf16_t* t_out = (bf16_t*)(p.ws + O_WT_OUT); bf16_t* t_up = (bf16_t*)(p.ws + O_WT_UP); bf16_t* t_dn = (bf16_t*)(p.ws + O_WT_DN);
    for (int job = obid(); job < 3264; job += gridDim.x) {
        if (job < 896) { const int nt = job >> 4, kt = job & 15, nd0 = nt * 64; int nv = HS - nd0; nv = nv < 0 ? 0 : (nv > 64 ? 64 : nv);
            conv_tile(w_in, HS, 1024, t_in, nd0, nd0, nv, kt * 64, tile); }
        else if (job < 1152) { const int j2 = job - 896, nt = j2 >> 4, kt = j2 & 15; conv_tile(w_out, 1024, 1024, t_out, nt * 64, nt * 64, 64, kt * 64, tile); }
        else if (job < 2560) { const int j2 = job - 1152, nt = j2 >> 4, kt = j2 & 15, nd0 = nt * 64; const int pn = nd0 >> 8, bj = (nd0 >> 7) & 1, j0 = nd0 & 127;
            conv_tile(w_up, 2 * DFF, 1024, t_up, nd0, bj * DFF + 128 * pn + j0, 64, kt * 64, tile); }
        else { const int j2 = job - 2560, nt = j2 / 44, kt = j2 % 44; conv_tile(w_dn, 1024, DFF, t_dn, nt * 64, nt * 64, 64, kt * 64, tile); }
    }
    const int gtid = obid() * 512 + otid(), gsz = gridDim.x * 512;
    if (layer == 0) {
        float* rc = (float*)(p.ws + O_ROPE); float* rs = rc + SEQ * 32;
        for (int idx = gtid; idx < SEQ * 32; idx += gsz) { const int pos = idx >> 5, i = idx & 31;
            const float inv = (float)exp(-(double)i * (9.210340371976184 / 32.0)); const float ang = (float)pos * inv;
            const double a = (double)ang; const double n = rint(a * 0.15915494309189535); const double r = a - n * 6.283185307179586; const double r2 = r * r;
            double sn = 1.0 / 121645100408832000.0, cs = 1.0 / 2432902008176640000.0;
            sn = sn * r2 - 1.0 / 355687428096000.0; sn = sn * r2 + 1.0 / 1307674368000.0; sn = sn * r2 - 1.0 / 6227020800.0; sn = sn * r2 + 1.0 / 39916800.0;
            sn = sn * r2 - 1.0 / 362880.0; sn = sn * r2 + 1.0 / 5040.0; sn = sn * r2 - 1.0 / 120.0; sn = sn * r2 + 1.0 / 6.0; sn = sn * r2 * -1.0 + 1.0; sn = sn * r;
            cs = cs * r2 - 1.0 / 6402373705728000.0; cs = cs * r2 + 1.0 / 20922789888000.0; cs = cs * r2 - 1.0 / 87178291200.0; cs = cs * r2 + 1.0 / 479001600.0;
            cs = cs * r2 - 1.0 / 3628800.0; cs = cs * r2 + 1.0 / 40320.0; cs = cs * r2 - 1.0 / 720.0; cs = cs * r2 + 1.0 / 24.0; cs = cs * r2 - 0.5; cs = cs * r2 + 1.0;
            rc[idx] = (float)cs; rs[idx] = (float)sn; }
    } else {
        bf16_t* t_lr = (bf16_t*)(p.ws + O_WT_LR);
        for (int idx = gtid; idx < 1536 * 256; idx += gsz) { const int n = idx >> 8, k = idx & 255; float v = 0.f;
            if (n < 512) { if (k < 64) v = p.od_w_up[k * 512 + n]; }
            else if (n < 1024) { if (k >= 64 && k < 128) v = p.od_a_up[(k - 64) * 512 + n - 512]; }
            else { if (k >= 128) v = p.od_g_up[(k - 128) * 512 + n - 1024]; }
            t_lr[idx] = f2bf(v); }
    }
}
DI void phase_rmsnorm(const float* x, const float* w, bf16_t* xn) {
    const int lane = otid() & 63, wv = otid() >> 6;
    for (int r = obid() * 8 + wv; r < TOK; r += gridDim.x * 8) {
        const float* xr = x + (size_t)r * DM; f32x4 v[4]; float ss = 0.f;
#pragma unroll
        for (int i = 0; i < 4; ++i) { v[i] = *(const f32x4*)(xr + i * 256 + lane * 4); ss += v[i][0] * v[i][0] + v[i][1] * v[i][1] + v[i][2] * v[i][2] + v[i][3] * v[i][3]; }
        ss = red64(ss); const float rstd = rsqrtf(ss * (1.f / DM) + 1e-6f);
#pragma unroll
        for (int i = 0; i < 4; ++i) { const f32x4 ww = *(const f32x4*)(w + i * 256 + lane * 4); uint2 o; o.x = pack2(v[i][0] * rstd * ww[0], v[i][1] * rstd * ww[1]); o.y = pack2(v[i][2] * rstd * ww[2], v[i][3] * rstd * ww[3]);
            *(uint2*)(xn + (size_t)r * DM + i * 256 + lane * 4) = o; }
    }
}
DI void ssd_conv8(const Params& p, const bf16_t* H, int b, int t, int ch, float (&o)[8]) {
    const bf16_t* base = H + (size_t)b * SEQ * HS + 512 + ch;
    const int t0 = t - 3 < 0 ? 0 : t - 3, t1 = t - 2 < 0 ? 0 : t - 2, t2 = t - 1 < 0 ? 0 : t - 1;
    const uint4 r0 = *(const uint4*)(base + (size_t)t0 * HS), r1 = *(const uint4*)(base + (size_t)t1 * HS), r2 = *(const uint4*)(base + (size_t)t2 * HS), r3 = *(const uint4*)(base + (size_t)t * HS);
    const float m0 = t >= 3 ? 1.f : 0.f, m1 = t >= 2 ? 1.f : 0.f, m2 = t >= 1 ? 1.f : 0.f;
    float acc[8], xv[8];
    { const f32x4 b0 = *(const f32x4*)(p.ev_conv_b + ch), b1 = *(const f32x4*)(p.ev_conv_b + ch + 4);
      acc[0] = b0[0]; acc[1] = b0[1]; acc[2] = b0[2]; acc[3] = b0[3]; acc[4] = b1[0]; acc[5] = b1[1]; acc[6] = b1[2]; acc[7] = b1[3]; }
#define SSD_TAP(k, raw, msk) { unpack8(raw, xv); const f32x4 w0 = *(const f32x4*)(p.ev_conv_w + (k) * 768 + ch) * (msk), w1 = *(const f32x4*)(p.ev_conv_w + (k) * 768 + ch + 4) * (msk); \
        acc[0] += w0[0] * xv[0]; acc[1] += w0[1] * xv[1]; acc[2] += w0[2] * xv[2]; acc[3] += w0[3] * xv[3]; acc[4] += w1[0] * xv[4]; acc[5] += w1[1] * xv[5]; acc[6] += w1[2] * xv[6]; acc[7] += w1[3] * xv[7]; }
    SSD_TAP(0, r0, m0) SSD_TAP(1, r1, m1) SSD_TAP(2, r2, m2) SSD_TAP(3, r3, 1.f)
#pragma unroll
    for (int e = 0; e < 8; ++e) o[e] = silu_(acc[e]);
}
DI float ret_lg(int hh) { return log1pf(-exp2f(-5.f - (float)hh)); }
DI void chunk_decay(const Params& p, int mixer, int b, int hh, int t0, float* acs, float* dts) {
    const int tid = otid(), lane = tid & 63; const float* aux = (const float*)(p.ws + O_AUX);
    float v = 0.f;
    if (tid < 128) {
        if (mixer == 0) { const float dt = softplus_(aux[((size_t)b * SEQ + t0 + tid) * 8 + hh] + p.ev_dt_bias[hh]); dts[tid] = dt; v = -expf(p.ev_a_log[hh]) * dt; }
        else { dts[tid] = 1.f; v = ret_lg(hh); }
    }
#pragma unroll
    for (int off = 1; off < 64; off <<= 1) { const float t = __shfl_up(v, off); if (lane >= off) v += t; }
    if (tid == 63) acs[256] = v;
    __syncthreads();
    if (tid >= 64 && tid < 128) v += acs[256];
    if (tid < 128) acs[tid] = v;
    __syncthreads();
}
DI void phase_m1(const Params& p, unsigned char* smem) {
    bf16_t* Kt = (bf16_t*)smem; bf16_t* Vt = (bf16_t*)(smem + 17408); float* acs = (float*)(smem + 34816); float* dts = acs + 128;
    const bf16_t* H = (const bf16_t*)(p.ws + O_H); float* ST = (float*)(p.ws + O_ST); float* CD = (float*)(p.ws + O_CD);
    const float* rc = (const float*)(p.ws + O_ROPE); const float* rs = rc + SEQ * 32;
    const int tid = otid(), lane = tid & 63, w = tid >> 6;
    for (int u = obid(); u < 2048; u += gridDim.x) {
        const int mixer = u >> 10, bh = (u >> 6) & 15, c = u & 63, b = bh >> 3, hh = bh & 7, t0 = c * 128;
        chunk_decay(p, mixer, b, hh, t0, acs, dts);
        const float aend = acs[127];
        if (mixer == 0) {
#pragma unroll
            for (int it = 0; it < 2; ++it) { const int g = tid + it * 512, s = g >> 3, c8 = (g & 7) * 8; float o[8];
                const float sc = __expf(aend - acs[s]) * dts[s];
                ssd_conv8(p, H, b, t0 + s, 512 + (hh >> 2) * 64 + c8, o);
#pragma unroll
                for (int e = 0; e < 8; ++e) Kt[(c8 + e) * 136 + s] = f2bf(o[e] * sc);
                ssd_conv8(p, H, b, t0 + s, hh * 64 + c8, o);
#pragma unroll
                for (int e = 0; e < 8; ++e) Vt[(c8 + e) * 136 + s] = f2bf(o[e]); }
            if (tid == 0) CD[bh * 64 + c] = __expf(aend);
        } else {
            { const int s = tid >> 2, i0 = (tid & 3) * 8; const size_t r = (size_t)b * SEQ + t0 + s; float k1[8], k2[8];
              unpack8(*(const uint4*)(H + r * HS + 1800 + hh * 64 + i0), k1); unpack8(*(const uint4*)(H + r * HS + 1800 + hh * 64 + 32 + i0), k2);
              const float sc = __expf(aend - acs[s]) * 0.125f;
#pragma unroll
              for (int e = 0; e < 8; ++e) { const float cs = rc[(t0 + s) * 32 + i0 + e], sn = rs[(t0 + s) * 32 + i0 + e];
                  Kt[(i0 + e) * 136 + s] = f2bf((k1[e] * cs - k2[e] * sn) * sc); Kt[(32 + i0 + e) * 136 + s] = f2bf((k1[e] * sn + k2[e] * cs) * sc); } }
#pragma unroll
            for (int it = 0; it < 2; ++it) { const int g = tid + it * 512, s = g >> 3, c8 = (g & 7) * 8; const size_t r = (size_t)b * SEQ + t0 + s; float v[8];
                unpack8(*(const uint4*)(H + r * HS + 2312 + hh * 64 + c8), v);
#pragma unroll
                for (int e = 0; e < 8; ++e) Vt[(c8 + e) * 136 + s] = (unsigned short)f2bf(v[e]); }
        }
        __syncthreads();
        { const int mt = w & 3, nt0 = (w >> 2) * 2; f32x4 a0 = {0.f, 0.f, 0.f, 0.f}, a1 = {0.f, 0.f, 0.f, 0.f};
#pragma unroll
          for (int ks = 0; ks < 4; ++ks) { const bf16x8 af = ldfrag(Kt, mt * 16, 136, ks * 32, lane);
              a0 = MFMA16(af, ldfrag(Vt, nt0 * 16, 136, ks * 32, lane), a0); a1 = MFMA16(af, ldfrag(Vt, nt0 * 16 + 16, 136, ks * 32, lane), a1); }
          float* dst = ST + (size_t)u * 4096 + mt * 16 + (lane >> 4) * 4;
          *(f32x4*)(dst + (nt0 * 16 + (lane & 15)) * 64) = a0; *(f32x4*)(dst + (nt0 * 16 + 16 + (lane & 15)) * 64) = a1; }
        __syncthreads();
    }
}
DI void phase_m2(const Params& p) {
    float* ST = (float*)(p.ws + O_ST); const float* CD = (const float*)(p.ws + O_CD);
    for (int idx = obid() * 512 + otid(); idx < 32 * 4096; idx += gridDim.x * 512) {
        const int mb = idx >> 12, e = idx & 4095, mixer = mb >> 4, bh = mb & 15; float run = 0.f;
        const float gdec = __expf(128.f * ret_lg(bh & 7));
#pragma unroll 8
        for (int c = 0; c < 64; ++c) { const size_t o = ((size_t)(mb * 64 + c)) * 4096 + e; const float v = ST[o]; ST[o] = run;
            const float dec = mixer == 0 ? CD[bh * 64 + c] : gdec; run = run * dec + v; }
    }
}
template <int MIXER> DI void m3_head(const Params& p, unsigned char* smem, int b, int c, int hh, float (&ssq)[4]) {
    bf16_t* Qs = (bf16_t*)smem; bf16_t* Ks = (bf16_t*)(smem + 18432); bf16_t* Vt = (bf16_t*)(smem + 36864); bf16_t* Rt = (bf16_t*)(smem + 54272); bf16_t* Ps = (bf16_t*)(smem + 63488);
    float* acs = (float*)(smem + 98304); float* dts = acs + 128;
    const bf16_t* H = (const bf16_t*)(p.ws + O_H); const float* ST = (const float*)(p.ws + O_ST); float* YG = (float*)(p.ws + O_YG); bf16_t* Y = (bf16_t*)(p.ws + O_XN);
    const float* rc = (const float*)(p.ws + O_ROPE); const float* rs = rc + SEQ * 32;
    const int tid = otid(), lane = tid & 63, w = tid >> 6, t0 = c * 128, bh = b * 8 + hh;
    const size_t u = (size_t)((MIXER * 16 + bh) * 64 + c);
    __syncthreads();
    chunk_decay(p, MIXER, b, hh, t0, acs, dts);
    if (MIXER == 0) {
#pragma unroll
        for (int it = 0; it < 2; ++it) { const int g = tid + it * 512, s = g >> 3, c8 = (g & 7) * 8; float o[8];
            ssd_conv8(p, H, b, t0 + s, 640 + (hh >> 2) * 64 + c8, o); *(uint4*)(Qs + s * 72 + c8) = pack8(o);
            ssd_conv8(p, H, b, t0 + s, 512 + (hh >> 2) * 64 + c8, o); *(uint4*)(Ks + s * 72 + c8) = pack8(o);
            ssd_conv8(p, H, b, t0 + s, hh * 64 + c8, o);
#pragma unroll
            for (int e = 0; e < 8; ++e) Vt[(c8 + e) * 136 + s] = f2bf(o[e]); }
    } else {
        { const int s = tid >> 2, i0 = (tid & 3) * 8; const size_t r = (size_t)b * SEQ + t0 + s; float a1[8], a2[8], o1[8], o2[8];
          unpack8(*(const uint4*)(H + r * HS + 1288 + hh * 64 + i0), a1); unpack8(*(const uint4*)(H + r * HS + 1288 + hh * 64 + 32 + i0), a2);
#pragma unroll
          for (int e = 0; e < 8; ++e) { const float cs = rc[(t0 + s) * 32 + i0 + e], sn = rs[(t0 + s) * 32 + i0 + e]; o1[e] = a1[e] * cs - a2[e] * sn; o2[e] = a1[e] * sn + a2[e] * cs; }
          *(uint4*)(Qs + s * 72 + i0) = pack8(o1); *(uint4*)(Qs + s * 72 + 32 + i0) = pack8(o2);
          unpack8(*(const uint4*)(H + r * HS + 1800 + hh * 64 + i0), a1); unpack8(*(const uint4*)(H + r * HS + 1800 + hh * 64 + 32 + i0), a2);
#pragma unroll
          for (int e = 0; e < 8; ++e) { const float cs = rc[(t0 + s) * 32 + i0 + e], sn = rs[(t0 + s) * 32 + i0 + e]; o1[e] = (a1[e] * cs - a2[e] * sn) * 0.125f; o2[e] = (a1[e] * sn + a2[e] * cs) * 0.125f; }
          *(uint4*)(Ks + s * 72 + i0) = pack8(o1); *(uint4*)(Ks + s * 72 + 32 + i0) = pack8(o2); }
#pragma unroll
        for (int it = 0; it < 2; ++it) { const int g = tid + it * 512, s = g >> 3, c8 = (g & 7) * 8; const size_t r = (size_t)b * SEQ + t0 + s;
            const uint4 raw = *(const uint4*)(H + r * HS + 2312 + hh * 64 + c8); const unsigned short* rv = (const unsigned short*)&raw;
#pragma unroll
            for (int e = 0; e < 8; ++e) Vt[(c8 + e) * 136 + s] = rv[e]; }
    }
    { const int pr = tid >> 3, n8 = (tid & 7) * 8; const float* src = ST + u * 4096 + pr * 64 + n8; const f32x4 x0 = *(const f32x4*)src, x1 = *(const f32x4*)(src + 4);
      uint4 o; o.x = pack2(x0[0], x0[1]); o.y = pack2(x0[2], x0[3]); o.z = pack2(x1[0], x1[1]); o.w = pack2(x1[2], x1[3]); *(uint4*)(Rt + pr * 72 + n8) = o; }
    __syncthreads();
    const int nks = (w >> 1) + 1;
    const int lrow = 16 * w + (lane >> 4) * 4;
    {
        const bf16x8 q0 = ldfrag(Qs, 16 * w, 72, 0, lane), q1 = ldfrag(Qs, 16 * w, 72, 32, lane);
        float al[4];
#pragma unroll
        for (int j = 0; j < 4; ++j) al[j] = acs[lrow + j];
        for (int nt = 0; nt < 2 * nks; ++nt) { f32x4 sacc = {0.f, 0.f, 0.f, 0.f};
            sacc = MFMA16(q0, ldfrag(Ks, nt * 16, 72, 0, lane), sacc); sacc = MFMA16(q1, ldfrag(Ks, nt * 16, 72, 32, lane), sacc);
            const int s = nt * 16 + (lane & 15); const float as = acs[s], ds = dts[s];
#pragma unroll
            for (int j = 0; j < 4; ++j) { const float pv = (s <= lrow + j) ? sacc[j] * __expf(al[j] - as) * ds : 0.f; Ps[(lrow + j) * 136 + s] = f2bf(pv); } }
    }
    __syncthreads();
    f32x4 yd[4], yo[4];
#pragma unroll
    for (int nt = 0; nt < 4; ++nt) { yd[nt] = (f32x4){0.f, 0.f, 0.f, 0.f}; yo[nt] = (f32x4){0.f, 0.f, 0.f, 0.f}; }
    for (int ks = 0; ks < nks; ++ks) { const bf16x8 pf = ldfrag(Ps, 16 * w, 136, ks * 32, lane);
#pragma unroll
        for (int nt = 0; nt < 4; ++nt) yd[nt] = MFMA16(pf, ldfrag(Vt, nt * 16, 136, ks * 32, lane), yd[nt]); }
#pragma unroll
    for (int ks = 0; ks < 2; ++ks) { const bf16x8 qf = ldfrag(Qs, 16 * w, 72, ks * 32, lane);
#pragma unroll
        for (int nt = 0; nt < 4; ++nt) yo[nt] = MFMA16(qf, ldfrag(Rt, nt * 16, 72, ks * 32, lane), yo[nt]); }
    float ea[4];
#pragma unroll
    for (int j = 0; j < 4; ++j) ea[j] = __expf(acs[lrow + j]);
    if (MIXER == 0) {
        const float dsk = p.ev_d[hh];
#pragma unroll
        for (int nt = 0; nt < 4; ++nt) { const int pc = nt * 16 + (lane & 15);
#pragma unroll
            for (int j = 0; j < 4; ++j) { const size_t r = (size_t)b * SEQ + t0 + lrow + j;
                const float y = yd[nt][j] + ea[j] * yo[nt][j] + dsk * bf2f(Vt[pc * 136 + lrow + j]);
                const float z = bf2f(H[r * HS + hh * 64 + pc]); const float yg = y * silu_(z); ssq[j] += yg * yg; YG[r * 512 + hh * 64 + pc] = yg; } }
    } else {
        float s2[4];
#pragma unroll
        for (int j = 0; j < 4; ++j) { float a = 0.f;
#pragma unroll
            for (int nt = 0; nt < 4; ++nt) { const float y = yd[nt][j] + ea[j] * yo[nt][j]; yd[nt][j] = y; a += y * y; }
            s2[j] = rsqrtf(red16(a) * (1.f / 64.f) + 1e-6f); }
#pragma unroll
        for (int nt = 0; nt < 4; ++nt) { const int pc = nt * 16 + (lane & 15); const float nw = p.ev_ret_norm_w[hh * 64 + pc];
#pragma unroll
            for (int j = 0; j < 4; ++j) { const size_t r = (size_t)b * SEQ + t0 + lrow + j; const float g = bf2f(H[r * HS + 2824 + hh * 64 + pc]);
                Y[r * DM + 512 + hh * 64 + pc] = f2bf(silu_(g) * yd[nt][j] * s2[j] * nw); } }
    }
}
DI void phase_m3(const Params& p, unsigned char* smem) {
    const int lane = otid() & 63, w = otid() >> 6;
    for (int u = obid(); u < 256; u += gridDim.x) {
        const int mixer = u >> 7, b = (u >> 6) & 1, c = u & 63; float ssq[4] = {0.f, 0.f, 0.f, 0.f};
        if (mixer == 0) {
            for (int hh = 0; hh < 8; ++hh) m3_head<0>(p, smem, b, c, hh, ssq);
            float* YG = (float*)(p.ws + O_YG); bf16_t* Y = (bf16_t*)(p.ws + O_XN); const int lrow = 16 * w + (lane >> 4) * 4;
            float rstd[4];
#pragma unroll
            for (int j = 0; j < 4; ++j) rstd[j] = rsqrtf(red16(ssq[j]) * (1.f / 512.f) + 1e-6f);
            for (int cc = 0; cc < 32; ++cc) { const int col = cc * 16 + (lane & 15); const float nw = p.ev_ssd_norm_w[col];
#pragma unroll
                for (int j = 0; j < 4; ++j) { const size_t r = (size_t)b * SEQ + c * 128 + lrow + j;
                    const float v = __hip_atomic_load(YG + r * 512 + col, __ATOMIC_RELAXED, __HIP_MEMORY_SCOPE_AGENT); Y[r * DM + col] = f2bf(v * rstd[j] * nw); } }
        } else {
            for (int hh = 0; hh < 8; ++hh) m3_head<1>(p, smem, b, c, hh, ssq);
        }
    }
}
DI void phase_ffn_act(const Params& p, int layer) {
    const bf16_t* G = (const bf16_t*)(p.ws + O_G); bf16_t* U = (bf16_t*)(p.ws + O_U);
    const float* cw = p.ffn_conv_w + (size_t)layer * 3 * DFF; const float* cb = p.ffn_conv_b + (size_t)layer * DFF;
    for (int idx = obid() * 512 + otid(); idx < TOK * (DFF / 8); idx += gridDim.x * 512) {
        const int r = idx / (DFF / 8), c8 = (idx % (DFF / 8)) * 8, t = r & (SEQ - 1);
        float acc[8], g[8], uv[8];
        { const f32x4 b0 = *(const f32x4*)(cb + c8), b1 = *(const f32x4*)(cb + c8 + 4); acc[0] = b0[0]; acc[1] = b0[1]; acc[2] = b0[2]; acc[3] = b0[3]; acc[4] = b1[0]; acc[5] = b1[1]; acc[6] = b1[2]; acc[7] = b1[3]; }
        { const int ra = t >= 2 ? r - 2 : r, rb2 = t >= 1 ? r - 1 : r; const float ma = t >= 2 ? 1.f : 0.f, mb = t >= 1 ? 1.f : 0.f;
          const uint4 g0 = *(const uint4*)(G + (size_t)ra * DFF + c8), g1 = *(const uint4*)(G + (size_t)rb2 * DFF + c8), g2 = *(const uint4*)(G + (size_t)r * DFF + c8);
#define ACT_TAP(k, raw, msk) { unpack8(raw, g); const f32x4 w0 = *(const f32x4*)(cw + (k) * DFF + c8) * (msk), w1 = *(const f32x4*)(cw + (k) * DFF + c8 + 4) * (msk); \
            acc[0] += w0[0] * g[0]; acc[1] += w0[1] * g[1]; acc[2] += w0[2] * g[2]; acc[3] += w0[3] * g[3]; acc[4] += w1[0] * g[4]; acc[5] += w1[1] * g[5]; acc[6] += w1[2] * g[6]; acc[7] += w1[3] * g[7]; }
          ACT_TAP(0, g0, ma) ACT_TAP(1, g1, mb) ACT_TAP(2, g2, 1.f) }
        unpack8(*(const uint4*)(U + (size_t)r * DFF + c8), uv);
#pragma unroll
        for (int e = 0; e < 8; ++e) acc[e] = silu_(acc[e]) * uv[e];
        *(uint4*)(U + (size_t)r * DFF + c8) = pack8(acc);
    }
}
DI void phase_l1_prep(const Params& p, unsigned char* smem) {
    const bf16_t* H = (const bf16_t*)(p.ws + O_H); const float* aux = (const float*)(p.ws + O_AUX); float* FC = (float*)(p.ws + O_FC);
    bf16_t* KN = (bf16_t*)(p.ws + O_KN); bf16_t* VT = (bf16_t*)(p.ws + O_VT); bf16_t* AP = (bf16_t*)(p.ws + O_AP);
    const int tid = otid();
    for (int u = obid(); u < 16 + 1024; u += gridDim.x) {
        __syncthreads();
        if (u < 16) {
            float* tot = (float*)smem; const int bh = u, b = bh >> 3, hh = bh & 7; const float fb = p.od_f_bias[hh]; float loc[16]; float run = 0.f;
#pragma unroll
            for (int i = 0; i < 16; ++i) { const float xv = aux[((size_t)b * SEQ + tid * 16 + i) * 8 + hh] + fb; run += -softplus_(-xv); loc[i] = run; }
            tot[tid] = run; __syncthreads();
            float off = 0.f; for (int i = 0; i < tid; ++i) off += tot[i];
#pragma unroll
            for (int i = 0; i < 16; ++i) FC[(size_t)bh * SEQ + tid * 16 + i] = off + loc[i];
        } else {
            bf16_t* Vl = (bf16_t*)smem; const int v2 = u - 16, bh = v2 >> 6, blk = v2 & 63, b = bh >> 3, hh = bh & 7, t0 = blk * 128;
            { const int l = tid >> 2, c16 = (tid & 3) * 16; const size_t r = (size_t)b * SEQ + t0 + l; float a[8], c[8];
              unpack8(*(const uint4*)(H + r * HS + 2304 + hh * 64 + c16), a); unpack8(*(const uint4*)(H + r * HS + 2304 + hh * 64 + c16 + 8), c);
              float ss = 0.f;
#pragma unroll
              for (int e = 0; e < 8; ++e) ss += a[e] * a[e] + c[e] * c[e];
              ss += __shfl_xor(ss, 1); ss += __shfl_xor(ss, 2); const float rstd = rsqrtf(ss * (1.f / 64.f) + 1e-6f);
#pragma unroll
              for (int e = 0; e < 8; ++e) { a[e] *= rstd * p.od_kn_w[c16 + e]; c[e] *= rstd * p.od_kn_w[c16 + 8 + e]; }
              bf16_t* dst = KN + ((size_t)bh * SEQ + t0 + l) * 64 + c16; *(uint4*)dst = pack8(a); *(uint4*)(dst + 8) = pack8(c); }
#pragma unroll
            for (int it = 0; it < 2; ++it) { const int g = tid + it * 512, s = g >> 3, c8 = (g & 7) * 8; const size_t r = (size_t)b * SEQ + t0 + s;
                *(uint4*)(Vl + s * 72 + c8) = *(const uint4*)(H + r * HS + 2816 + hh * 64 + c8); }
            __syncthreads();
#pragma unroll
            for (int it = 0; it < 2; ++it) { const int g = tid + it * 512, e = g >> 4, s8 = (g & 15) * 8; uint4 o;
                o.x = (unsigned)Vl[(s8 + 0) * 72 + e] | ((unsigned)Vl[(s8 + 1) * 72 + e] << 16); o.y = (unsigned)Vl[(s8 + 2) * 72 + e] | ((unsigned)Vl[(s8 + 3) * 72 + e] << 16);
                o.z = (unsigned)Vl[(s8 + 4) * 72 + e] | ((unsigned)Vl[(s8 + 5) * 72 + e] << 16); o.w = (unsigned)Vl[(s8 + 6) * 72 + e] | ((unsigned)Vl[(s8 + 7) * 72 + e] << 16);
                *(uint4*)(VT + ((size_t)bh * 64 + e) * SEQ + t0 + s8) = o; }
        }
    }
    {
        float* KNRM = (float*)(p.ws + O_KNRM);
        for (int idx = obid() * 512 + tid; idx < TOK * 64; idx += gridDim.x * 512) {
            const int r = idx >> 6, c8 = (idx & 63) * 8, t = r & (SEQ - 1); float cur[8], prv[8]; float ss = 0.f;
            unpack8(*(const uint4*)(H + (size_t)r * HS + 512 + c8), cur);
            if (t > 0) unpack8(*(const uint4*)(H + (size_t)(r - 1) * HS + 512 + c8), prv); else {
#pragma unroll
                for (int e = 0; e < 8; ++e) prv[e] = 0.f; }
#pragma unroll
            for (int e = 0; e < 8; ++e) { const float v = (cur[e] + (prv[e] - cur[e]) * p.od_mu[512 + c8 + e]) * p.od_k_k[c8 + e]; ss += v * v; }
            ss += __shfl_xor(ss, 1); ss += __shfl_xor(ss, 2); ss += __shfl_xor(ss, 4);
            if ((idx & 7) == 0) KNRM[(size_t)r * 8 + (c8 >> 6)] = 1.f / fmaxf(sqrtf(ss), 1e-12f);
        }
    }
    for (int idx = obid() * 512 + tid; idx < TOK * 32; idx += gridDim.x * 512) {
        const int r = idx >> 5, j8 = (idx & 31) * 8, t = r & (SEQ - 1); float cur[8], prv[8], o[8];
        unpack8(*(const uint4*)(H + (size_t)r * HS + 1536 + j8), cur);
        if (t > 0) unpack8(*(const uint4*)(H + (size_t)(r - 1) * HS + 1536 + j8), prv); else {
#pragma unroll
            for (int e = 0; e < 8; ++e) prv[e] = 0.f; }
#pragma unroll
        for (int e = 0; e < 8; ++e) { const float v = cur[e] + (prv[e] - cur[e]) * p.od_mu[1536 + j8 + e];
            o[e] = (j8 < 64) ? tanhf(v) : ((j8 < 128) ? v : sigm_(v)); }
        *(uint4*)(AP + (size_t)r * 256 + j8) = pack8(o);
    }
}
DI void fox_unit(const Params& p, unsigned char* smem, int bh, int qb) {
    bf16_t* Qs = (bf16_t*)smem; bf16_t* Ks = (bf16_t*)(smem + 18432); bf16_t* Vts = (bf16_t*)(smem + 36864); float* ck = (float*)(smem + 89600);
    const bf16_t* H = (const bf16_t*)(p.ws + O_H); const float* FC = (const float*)(p.ws + O_FC); const bf16_t* KN = (const bf16_t*)(p.ws + O_KN); const bf16_t* VT = (const bf16_t*)(p.ws + O_VT);
    bf16_t* Y = (bf16_t*)(p.ws + O_XN);
    const int tid = otid(), lane = tid & 63, w = tid >> 6, b = bh >> 3, hh = bh & 7; const size_t r0 = (size_t)b * SEQ + qb * 128;
    const float LOG2E = 1.4426950408889634f;
    __syncthreads();
    { const int l = tid >> 2, c16 = (tid & 3) * 16; float a[8], c[8];
      unpack8(*(const uint4*)(H + (r0 + l) * HS + 1792 + hh * 64 + c16), a); unpack8(*(const uint4*)(H + (r0 + l) * HS + 1792 + hh * 64 + c16 + 8), c);
      float ss = 0.f;
#pragma unroll
      for (int e = 0; e < 8; ++e) ss += a[e] * a[e] + c[e] * c[e];
      ss += __shfl_xor(ss, 1); ss += __shfl_xor(ss, 2); const float rstd = rsqrtf(ss * (1.f / 64.f) + 1e-6f) * (0.125f * LOG2E);
#pragma unroll
      for (int e = 0; e < 8; ++e) { a[e] *= rstd * p.od_qn_w[c16 + e]; c[e] *= rstd * p.od_qn_w[c16 + 8 + e]; }
      *(uint4*)(Qs + l * 72 + c16) = pack8(a); *(uint4*)(Qs + l * 72 + c16 + 8) = pack8(c); }
    float mrow = -1e30f, lsum = 0.f; f32x4 O[4];
#pragma unroll
    for (int j = 0; j < 4; ++j) O[j] = (f32x4){0.f, 0.f, 0.f, 0.f};
    const int q4 = (lane >> 4) * 4, lq = 16 * w + (lane & 15);
    uint4 kreg0, kreg1, vreg0, vreg1; float ckreg = 0.f;
    const int g0 = tid, g1 = tid + 512;
#define FOX_ISSUE(kb_) { \
        kreg0 = *(const uint4*)(KN + ((size_t)bh * SEQ + (kb_) * 128 + (g0 >> 3)) * 64 + (g0 & 7) * 8); \
        kreg1 = *(const uint4*)(KN + ((size_t)bh * SEQ + (kb_) * 128 + (g1 >> 3)) * 64 + (g1 & 7) * 8); \
        vreg0 = *(const uint4*)(VT + ((size_t)bh * 64 + (g0 >> 4)) * SEQ + (kb_) * 128 + (g0 & 15) * 8); \
        vreg1 = *(const uint4*)(VT + ((size_t)bh * 64 + (g1 >> 4)) * SEQ + (kb_) * 128 + (g1 & 15) * 8); \
        if (tid < 128) ckreg = FC[(size_t)bh * SEQ + (kb_) * 128 + tid]; }
    FOX_ISSUE(0)
    for (int kb = 0; kb <= qb; ++kb) {
        __syncthreads();
        *(uint4*)(Ks + (g0 >> 3) * 72 + (g0 & 7) * 8) = kreg0; *(uint4*)(Ks + (g1 >> 3) * 72 + (g1 & 7) * 8) = kreg1;
        *(uint4*)(Vts + (g0 >> 4) * 136 + (g0 & 15) * 8) = vreg0; *(uint4*)(Vts + (g1 >> 4) * 136 + (g1 & 15) * 8) = vreg1;
        if (tid < 128) ck[tid] = ckreg * LOG2E;
        __syncthreads();
        if (kb < qb) FOX_ISSUE(kb + 1)
        f32x4 S[8];
        { const bf16x8 q0 = ldfrag(Qs, 16 * w, 72, 0, lane), q1 = ldfrag(Qs, 16 * w, 72, 32, lane);
#pragma unroll
          for (int nt = 0; nt < 8; ++nt) { f32x4 z = {0.f, 0.f, 0.f, 0.f}; z = MFMA16(ldfrag(Ks, nt * 16, 72, 0, lane), q0, z); S[nt] = MFMA16(ldfrag(Ks, nt * 16, 72, 32, lane), q1, z); } }
#pragma unroll
        for (int nt = 0; nt < 8; ++nt) S[nt] = S[nt] - *(const f32x4*)(ck + nt * 16 + q4);
        if (kb == qb) {
#pragma unroll
            for (int nt = 0; nt < 8; ++nt)
#pragma unroll
                for (int j = 0; j < 4; ++j) if (nt * 16 + q4 + j > lq) S[nt][j] = -1e30f;
        }
        float mx = S[0][0];
#pragma unroll
        for (int nt = 0; nt < 8; ++nt)
#pragma unroll
            for (int j = 0; j < 4; ++j) mx = fmaxf(mx, S[nt][j]);
        mx = fmaxf(mx, __shfl_xor(mx, 16)); mx = fmaxf(mx, __shfl_xor(mx, 32));
        const float mnew = fmaxf(mrow, mx); const float alpha = __builtin_amdgcn_exp2f(mrow - mnew); mrow = mnew;
        float rs = 0.f;
#pragma unroll
        for (int nt = 0; nt < 8; ++nt)
#pragma unroll
            for (int j = 0; j < 4; ++j) { const float pv = __builtin_amdgcn_exp2f(S[nt][j] - mnew); S[nt][j] = pv; rs += pv; }
        lsum = lsum * alpha + rs;
#pragma unroll
        for (int et = 0; et < 4; ++et) O[et] = O[et] * alpha;
#pragma unroll
        for (int ks = 0; ks < 4; ++ks) {
            uint4 pw; pw.x = cvt_pk_bf16(S[2 * ks][0], S[2 * ks][1]); pw.y = cvt_pk_bf16(S[2 * ks][2], S[2 * ks][3]); pw.z = cvt_pk_bf16(S[2 * ks + 1][0], S[2 * ks + 1][1]); pw.w = cvt_pk_bf16(S[2 * ks + 1][2], S[2 * ks + 1][3]);
            const bf16x8 pf = __builtin_bit_cast(bf16x8, pw);
#pragma unroll
            for (int et = 0; et < 4; ++et) { const bf16_t* vp = Vts + (et * 16 + (lane & 15)) * 136 + ks * 32 + q4;
                uint4 vw; const uint2 lo = *(const uint2*)vp, hi = *(const uint2*)(vp + 16); vw.x = lo.x; vw.y = lo.y; vw.z = hi.x; vw.w = hi.y;
                O[et] = MFMA16(__builtin_bit_cast(bf16x8, vw), pf, O[et]); }
        }
    }
    lsum += __shfl_xor(lsum, 16); lsum += __shfl_xor(lsum, 32);
    const float inv = 1.f / lsum;
#pragma unroll
    for (int et = 0; et < 4; ++et) { uint2 o; o.x = pack2(O[et][0] * inv, O[et][1] * inv); o.y = pack2(O[et][2] * inv, O[et][3] * inv);
        *(uint2*)(Y + (r0 + lq) * DM + 512 + hh * 64 + et * 16 + q4) = o; }
}
constexpr int RW_T = 32, RW_BUF = 43008;
struct RwRegs { unsigned short r[9], k[9], v[9], om[8], a[8]; float kn[8]; };
#define RW_BAR() do { asm volatile("s_waitcnt lgkmcnt(0)" ::: "memory"); __builtin_amdgcn_s_barrier(); asm volatile("" ::: "memory"); } while (0)
DI void rwkv_unit(const Params& p, unsigned char* smem, int bh, int rg) {
    const bf16_t* H = (const bf16_t*)(p.ws + O_H); const bf16_t* LW = (const bf16_t*)(p.ws + O_LW); bf16_t* Y = (bf16_t*)(p.ws + O_XN); const float* KNRM = (const float*)(p.ws + O_KNRM);
    const int tid = otid(), lane = tid & 63, w = tid >> 6, b = bh >> 3, hh = bh & 7; const size_t rb = (size_t)b * SEQ;
    float* ysh = (float*)(smem + 2 * RW_BUF);
    const int NCH = SEQ / RW_T;
    __syncthreads();
    if (w < 2) {
        float S0 = 0.f, S1 = 0.f, S2 = 0.f, S3 = 0.f; const int kq = lane & 15, row = w * 4 + (lane >> 4);
        RW_BAR();
        for (int ch = 0; ch < NCH; ++ch) {
            const float* bufp = (const float*)(smem + (ch & 1) * RW_BUF) + kq * 4; const float* vp = (const float*)(smem + (ch & 1) * RW_BUF) + 10240 + row; float* yo = ysh + (ch & 1) * 256 + row;
#define RW_LOAD(R, W, K, Q, B, V, tt) { R = *(const f32x4*)(bufp + (tt) * 64); W = *(const f32x4*)(bufp + 2048 + (tt) * 64); K = *(const f32x4*)(bufp + 4096 + (tt) * 64); \
                Q = *(const f32x4*)(bufp + 6144 + (tt) * 64); B = *(const f32x4*)(bufp + 8192 + (tt) * 64); V = vp[(tt) * 8]; }
#define DPPF(x, ctrl) __builtin_bit_cast(float, __builtin_amdgcn_update_dpp(0, __builtin_bit_cast(int, (x)), (ctrl), 0xF, 0xF, true))
            f32x4 prevR = {0.f, 0.f, 0.f, 0.f}; float yacc = 0.f;
            f32x4 rN, wN, kN, qN, bN; float vN;
            RW_LOAD(rN, wN, kN, qN, bN, vN, 0)
            __builtin_amdgcn_sched_barrier(0);
#pragma unroll
            for (int tt = 0; tt < RW_T; ++tt) {
                const f32x4 R = rN, W = wN, K = kN, Q = qN, B = bN; const float V = vN;
                if (tt + 1 < RW_T) RW_LOAD(rN, wN, kN, qN, bN, vN, tt + 1)
                float d = S0 * Q[0] + S1 * Q[1] + S2 * Q[2] + S3 * Q[3];
                if (tt > 0) {
                    float y = S0 * prevR[0] + S1 * prevR[1] + S2 * prevR[2] + S3 * prevR[3];
                    d += DPPF(d, 0xB1); y += DPPF(y, 0xB1); d += DPPF(d, 0x4E); y += DPPF(y, 0x4E); d += DPPF(d, 0x141); y += DPPF(y, 0x141); d += DPPF(d, 0x140); y += DPPF(y, 0x140);
                    yacc = (kq == ((tt - 1) & 15)) ? y : yacc;
                    if (tt == 16) yo[kq * 8] = yacc;
                } else d = dpp_red16(d);
                const float sa = -d;
                S0 = (S0 * W[0] + V * K[0]) + sa * B[0]; S1 = (S1 * W[1] + V * K[1]) + sa * B[1]; S2 = (S2 * W[2] + V * K[2]) + sa * B[2]; S3 = (S3 * W[3] + V * K[3]) + sa * B[3];
                prevR = R;
                if (tt & 1) __builtin_amdgcn_sched_barrier(0);
            }
            { float y = S0 * prevR[0] + S1 * prevR[1] + S2 * prevR[2] + S3 * prevR[3]; y = dpp_red16(y); yacc = (kq == 15) ? y : yacc; yo[(16 + kq) * 8] = yacc; }
            RW_BAR();
        }
    } else if (w == 4 || w == 5) {
        const unsigned* ta0; const unsigned* ta1; const unsigned* ta2; size_t st0, st1, st2;
        { int L = lane; int tok = L / 5, which = L - tok * 5; ta0 = (const unsigned*)(which < 3 ? H + (rb + tok) * HS + which * 512 + hh * 64 : LW + (rb + tok) * 1536 + (which - 3) * 512 + hh * 64); st0 = which < 3 ? (size_t)HS * 2 : (size_t)1536 * 2;
          L = lane + 64; tok = L / 5; which = L - tok * 5; ta1 = (const unsigned*)(which < 3 ? H + (rb + tok) * HS + which * 512 + hh * 64 : LW + (rb + tok) * 1536 + (which - 3) * 512 + hh * 64); st1 = which < 3 ? (size_t)HS * 2 : (size_t)1536 * 2;
          L = lane + 128 > 159 ? 159 : lane + 128; tok = L / 5; which = L - tok * 5; ta2 = (const unsigned*)(which < 3 ? H + (rb + tok) * HS + which * 512 + hh * 64 : LW + (rb + tok) * 1536 + (which - 3) * 512 + hh * 64); st2 = which < 3 ? (size_t)HS * 2 : (size_t)1536 * 2; }
        unsigned x0 = 0, x1 = 0, x2 = 0, y0 = 0, y1 = 0, y2 = 0, z0 = 0, z1 = 0, z2 = 0, pacc = 0;
        RW_BAR();
        for (int ch = 0; ch < NCH; ++ch) {
            if (w == 4) { int cc = ch + 6; cc = cc > NCH - 1 ? NCH - 1 : cc; const size_t tb = (size_t)cc * RW_T;
                pacc ^= x0 ^ x1 ^ x2; x0 = y0; x1 = y1; x2 = y2; y0 = z0; y1 = z1; y2 = z2;
                z0 = *(const unsigned*)((const char*)ta0 + tb * st0); z1 = *(const unsigned*)((const char*)ta1 + tb * st1); z2 = *(const unsigned*)((const char*)ta2 + tb * st2); }
            RW_BAR();
        }
        pacc ^= x0 ^ x1 ^ x2 ^ y0 ^ y1 ^ y2 ^ z0 ^ z1 ^ z2; if (pacc == 0x9e3779b9u && rg == 77) Y[0] = 0;
    } else {
        const int lw = (w & 1) + ((w >> 2) << 1), col = hh * 64 + lane; RwRegs ra;
        const float mur = p.od_mu[col], muk = p.od_mu[512 + col], muv = p.od_mu[1024 + col], kk_w = p.od_k_k[col], ka_w = p.od_k_a[col];
        auto issue = [&](int ch, RwRegs& rr) {
            const int tbase = ch * RW_T + lw * 8;
#pragma unroll
            for (int i = 0; i < 9; ++i) { const int t = tbase + i - 1;
                if (t >= 0) { const bf16_t* hp = H + (rb + t) * HS; rr.r[i] = hp[col]; rr.k[i] = hp[512 + col]; rr.v[i] = hp[1024 + col]; } else { rr.r[i] = 0; rr.k[i] = 0; rr.v[i] = 0; }
                if (i > 0) { const bf16_t* lp = LW + (rb + t) * 1536; rr.om[i - 1] = lp[col]; rr.a[i - 1] = lp[512 + col]; rr.kn[i - 1] = KNRM[(rb + t) * 8 + hh]; } }
        };
        auto process = [&](int ch, const RwRegs& rr) {
            float* bufp = (float*)(smem + (ch & 1) * RW_BUF);
#pragma unroll
            for (int i = 1; i < 9; ++i) { const int tt = lw * 8 + i - 1;
                const float rc = bf2f(rr.r[i]), rp = bf2f(rr.r[i - 1]), kc = bf2f(rr.k[i]), kp = bf2f(rr.k[i - 1]), vc = bf2f(rr.v[i]), vp = bf2f(rr.v[i - 1]);
                const float rl = rc + (rp - rc) * mur, kl = kc + (kp - kc) * muk, vl = vc + (vp - vc) * muv; const float a = bf2f(rr.a[i - 1]), wv = 1.f - bf2f(rr.om[i - 1]);
                const float kk = kl * kk_w * rr.kn[i - 1];
                bufp[tt * 64 + lane] = rl; bufp[2048 + tt * 64 + lane] = wv; bufp[4096 + tt * 64 + lane] = kl * (1.f + (a - 1.f) * ka_w); bufp[6144 + tt * 64 + lane] = kk; bufp[8192 + tt * 64 + lane] = kk * a;
                if ((lane >> 3) == rg) bufp[10240 + tt * 8 + (lane & 7)] = vl; }
        };
        issue(0, ra); process(0, ra); issue(1, ra);
        RW_BAR();
        for (int ch = 0; ch < NCH; ++ch) {
            if (ch + 1 < NCH) { process(ch + 1, ra); if (ch + 2 < NCH) issue(ch + 2, ra); }
            if (ch > 0 && lw < 2) { const float* yi = ysh + ((ch - 1) & 1) * 256; const int t2 = lw * 64 + lane, tt = t2 >> 2, pr = (t2 & 3) * 2;
                *(unsigned*)(Y + (rb + (ch - 1) * RW_T + tt) * DM + hh * 64 + rg * 8 + pr) = pack2(yi[tt * 8 + pr], yi[tt * 8 + pr + 1]); }
            RW_BAR();
        }
        if (lw < 2) { const float* yi = ysh + ((NCH - 1) & 1) * 256; const int t2 = lw * 64 + lane, tt = t2 >> 2, pr = (t2 & 3) * 2;
          *(unsigned*)(Y + (rb + (NCH - 1) * RW_T + tt) * DM + hh * 64 + rg * 8 + pr) = pack2(yi[tt * 8 + pr], yi[tt * 8 + pr + 1]); }
    }
    __syncthreads();
}
DI void phase_l1_mix(const Params& p, unsigned char* smem, int pass) {
    unsigned* ctr = (unsigned*)(p.ws + O_CTL) + pass * 4; int* sh = (int*)(smem + 90112);
    if (obid() < 128 && pass != 2) rwkv_unit(p, smem, obid() >> 3, obid() & 7);
    for (;;) {
        __syncthreads(); if (otid() == 0) *sh = (int)atomicAdd(ctr, 1u); __syncthreads();
        const int u = *sh; if (u >= 1024) break;
        fox_unit(p, smem, u & 15, 63 - (u >> 4));
    }
}
DI void phase_rwkv_fin(const Params& p) {
    const bf16_t* H = (const bf16_t*)(p.ws + O_H); const bf16_t* LW = (const bf16_t*)(p.ws + O_LW); bf16_t* Y = (bf16_t*)(p.ws + O_XN);
    const int lane = otid() & 63, wv = otid() >> 6;
    for (int task = obid() * 8 + wv; task < TOK * 8; task += gridDim.x * 8) {
        const int r = task >> 3, hh = task & 7, t = r & (SEQ - 1), col = hh * 64 + lane; const bf16_t* hp = H + (size_t)r * HS;
        const float y = bf2f(Y[(size_t)r * DM + col]); const float mean = red64(y) * (1.f / 64.f); const float dy = y - mean; const float var = red64(dy * dy) * (1.f / 64.f);
        const float yln = dy * rsqrtf(var + 64e-5f) * p.od_ln_w[col] + p.od_ln_b[col];
        const float rc = bf2f(hp[col]), kc = bf2f(hp[512 + col]), vc = bf2f(hp[1024 + col]); float rp = 0.f, kp = 0.f, vp = 0.f;
        if (t > 0) { rp = bf2f(hp[col - HS]); kp = bf2f(hp[512 + col - HS]); vp = bf2f(hp[1024 + col - HS]); }
        const float rl = rc + (rp - rc) * p.od_mu[col], kl = kc + (kp - kc) * p.od_mu[512 + col], vl = vc + (vp - vc) * p.od_mu[1024 + col];
        const float a = bf2f(LW[(size_t)r * 1536 + 512 + col]), g = bf2f(LW[(size_t)r * 1536 + 1024 + col]);
        const float kt = kl * (1.f + (a - 1.f) * p.od_k_a[col]); const float bonus = red64(rl * kt * p.od_r_k[col]) * vl;
        Y[(size_t)r * DM + col] = f2bf((yln + bonus) * g);
    }
}
#define XB_TMO      128
#define XB_XCNT(j)  (256  + 64 * (j))
#define XB_XSUB(j)  (1280 + 64 * (j))
#define XB_XGEN(j)  (2304 + 64 * (j))
#define XB_TOP      3328
#define XB_TOPGEN   3392
#define XCD_BAR_WORDS 3456
#define XB_SPIN_CAP (1u << 18)
#define LAS __attribute__((address_space(3)))

__device__ __forceinline__ unsigned xb_ld(unsigned* p)              { return __hip_atomic_load(p, __ATOMIC_RELAXED, __HIP_MEMORY_SCOPE_AGENT); }
__device__ __forceinline__ unsigned xb_add(unsigned* p, unsigned v) { return __hip_atomic_fetch_add(p, v, __ATOMIC_RELAXED, __HIP_MEMORY_SCOPE_AGENT); }
__device__ __forceinline__ unsigned xb_xcc_id() { return (unsigned)__builtin_amdgcn_s_getreg((3 << 11) | 20) & 0xFu; }
#define XB_SPIN(cond, bar) do { unsigned _sp = 0; while (cond) { __builtin_amdgcn_s_sleep(1); \
    if ((++_sp & 255u) == 0u) { if (xb_ld(&(bar)[XB_TMO])) break; if (_sp > XB_SPIN_CAP) { atomicAdd(&(bar)[XB_TMO], 1u); break; } } } } while (0)

struct XcdBarrier {
    unsigned* bar; unsigned x;
    volatile LAS unsigned* st;
};

__device__ __forceinline__ XcdBarrier xcd_barrier_post(unsigned* bar, volatile LAS unsigned* st) {
    XcdBarrier b; b.bar = bar; b.x = xb_xcc_id(); b.st = st;
    if (threadIdx.x == 0) (void)xb_add(&bar[XB_XCNT(b.x)], 1u);
    return b;
}
__device__ __forceinline__ void xcd_barrier_complete(unsigned* bar, unsigned x, unsigned& nloc, unsigned& nx) {
    const unsigned G = gridDim.x * gridDim.y * gridDim.z;
    unsigned sum, cnt, mine, sp = 0u;
    for (;;) {
        sum = 0u; cnt = 0u; mine = 0u;
#pragma unroll
        for (unsigned j = 0; j < 16; ++j) { const unsigned c = xb_ld(&bar[XB_XCNT(j)]); sum += c; cnt += (c > 0u) ? 1u : 0u; mine = (j == x) ? c : mine; }
        if (sum == G) break;
        __builtin_amdgcn_s_sleep(1);
        if ((++sp & 255u) == 0u) { if (xb_ld(&bar[XB_TMO])) break; if (sp > XB_SPIN_CAP) { atomicAdd(&bar[XB_TMO], 1u); break; } }
    }
    nloc = mine > 0u ? mine : 1u; nx = cnt > 0u ? cnt : 1u;
}

__device__ __forceinline__ void xcd_barrier(const XcdBarrier& b) {
    asm volatile("s_waitcnt vmcnt(0)" ::: "memory");
    __syncthreads();
    if (threadIdx.x == 0) {
        unsigned* bar = b.bar;
        __builtin_amdgcn_s_waitcnt(0);
        unsigned nloc = b.st[0], nx = b.st[1];
        if (nloc == 0u) { xcd_barrier_complete(bar, b.x, nloc, nx); b.st[0] = nloc; b.st[1] = nx; }
        const unsigned old = xb_add(&bar[XB_XSUB(b.x)], 1u);
        const unsigned gen = old / nloc;
        if (old + 1u == (gen + 1u) * nloc) {
            __builtin_amdgcn_fence(__ATOMIC_RELEASE, "agent");
            asm volatile("s_waitcnt vmcnt(0)" ::: "memory");
            const unsigned og = xb_add(&bar[XB_TOP], 1u);
            const unsigned tg = og / nx;
            if (og + 1u == (tg + 1u) * nx) xb_add(&bar[XB_TOPGEN], 1u);
            else XB_SPIN(xb_ld(&bar[XB_TOPGEN]) == tg, bar);
            __builtin_amdgcn_fence(__ATOMIC_ACQUIRE, "agent");
            xb_add(&bar[XB_XGEN(b.x)], 1u);
            asm volatile("s_waitcnt vmcnt(0)" ::: "memory");
        } else {
            XB_SPIN(xb_ld(&bar[XB_XGEN(b.x)]) == gen, bar);
            __builtin_amdgcn_fence(__ATOMIC_ACQUIRE, "agent");
            asm volatile("s_waitcnt vmcnt(0)" ::: "memory");
        }
    }
    __syncthreads();
}


__global__ void __launch_bounds__(512, 2) fwd_megakernel(Params p) {
    extern __shared__ __attribute__((aligned(16))) unsigned char smem[];
    cg::grid_group grid = cg::this_grid();
    unsigned char* ws = p.ws;
    bf16_t* XN = (bf16_t*)(ws + O_XN); bf16_t* Hb = (bf16_t*)(ws + O_H); float* aux = (float*)(ws + O_AUX);
    const bf16_t* t_in = (const bf16_t*)(ws + O_WT_IN); const bf16_t* t_out = (const bf16_t*)(ws + O_WT_OUT); const bf16_t* t_up = (const bf16_t*)(ws + O_WT_UP);
    const bf16_t* t_dn = (const bf16_t*)(ws + O_WT_DN); const bf16_t* t_lr = (const bf16_t*)(ws + O_WT_LR);
    if (blockIdx.x == 0 && threadIdx.x < 16) ((unsigned*)(ws + O_CTL))[threadIdx.x] = 0u;
    if (threadIdx.x == 0) *(uint4*)(smem + 131072) = make_uint4(0u, 0u, 0u, 0u);
    __syncthreads();
    const XcdBarrier xb = xcd_barrier_post((unsigned*)(ws + O_BAR), (volatile LAS unsigned*)(smem + 131072));
#define GSYNC() xcd_barrier(xb)
#define GEMM_H(layer) { EpiH E; E.H = Hb; E.aux = aux; E.auxc = layer ? 3328 : 1280; run_gemm(smem, XN, t_in, 3584, 1024, E); }
#define GEMM_OUT(layer) { EpiRes E; E.res = layer ? p.out : p.x; E.out = p.out; run_gemm(smem, XN, t_out, 1024, 1024, E); }
#define GEMM_UP() { EpiGU E; E.G = (bf16_t*)(ws + O_G); E.U = (bf16_t*)(ws + O_U); run_gemm(smem, XN, t_up, 2 * DFF, 1024, E); }
#define GEMM_DN() { EpiRes E; E.res = p.out; E.out = p.out; run_gemm(smem, (const bf16_t*)(ws + O_U), t_dn, 1024, DFF, E); }
    phase_weights(p, smem, 0); phase_rmsnorm(p.x, p.ev_norm_w, XN); grid.sync();
    GEMM_H(0) GSYNC();
#if PROBE == 2
    GEMM_H(0) GSYNC();
#endif
    phase_m1(p, smem); GSYNC();
#if PROBE == 3
    phase_m1(p, smem); GSYNC();
#endif
    phase_m2(p); GSYNC();
#if PROBE == 6
    GSYNC(); GSYNC(); GSYNC(); GSYNC(); GSYNC(); GSYNC(); GSYNC(); GSYNC(); GSYNC(); GSYNC();
#endif
#if PROBE == 7
    phase_weights(p, smem, 0); GSYNC(); phase_rmsnorm(p.x, p.ev_norm_w, XN); GSYNC(); phase_rmsnorm(p.x, p.ev_norm_w, XN); GSYNC();
#endif
    phase_m3(p, smem); GSYNC();
#if PROBE == 3
    phase_m3(p, smem); GSYNC();
#endif
    GEMM_OUT(0) GSYNC();
#if PROBE == 2
    GEMM_OUT(0) GSYNC();
#endif
    phase_rmsnorm(p.out, p.ffn_norm_w, XN); GSYNC();
    GEMM_UP() GSYNC();
#if PROBE == 2
    GEMM_UP() GSYNC();
#endif
    phase_ffn_act(p, 0); GSYNC();
    GEMM_DN() GSYNC();
    phase_weights(p, smem, 1); phase_rmsnorm(p.out, p.od_norm_w, XN); GSYNC();
    GEMM_H(1) GSYNC();
    phase_l1_prep(p, smem); GSYNC();
    { EpiLR E; E.LW = (bf16_t*)(ws + O_LW); E.w0 = p.od_w0; E.a0 = p.od_a0; run_gemm(smem, (const bf16_t*)(ws + O_AP), t_lr, 1536, 256, E); } GSYNC();
    phase_l1_mix(p, smem, 0); GSYNC();
#if PROBE == 4
    phase_l1_mix(p, smem, 1); GSYNC();
#endif
#if PROBE == 5
    phase_l1_mix(p, smem, 2); GSYNC();
#endif
    phase_rwkv_fin(p); GSYNC();
    GEMM_OUT(1) GSYNC();
    phase_rmsnorm(p.out, p.ffn_norm_w + DM, XN); GSYNC();
    GEMM_UP() GSYNC();
    phase_ffn_act(p, 1); GSYNC();
    GEMM_DN()
}

extern "C" void kernel_launch(void* const* d_in, const int* in_sizes, int n_in, void* d_out, int out_size, void* d_ws, size_t ws_size, hipStream_t stream) {
    static int grid_blocks = 0;
    if (grid_blocks == 0) {
        int dev = 0, cus = 0, per_cu = 0;
        hipGetDevice(&dev); hipDeviceGetAttribute(&cus, hipDeviceAttributeMultiprocessorCount, dev);
        if (hipFuncSetAttribute((const void*)fwd_megakernel, hipFuncAttributeMaxDynamicSharedMemorySize, LDS_BYTES) != hipSuccess) fprintf(stderr, "hipFuncSetAttribute failed\n");
        hipOccupancyMaxActiveBlocksPerMultiprocessor(&per_cu, (const void*)fwd_megakernel, 512, LDS_BYTES);
        (void)hipGetLastError();
        if (per_cu < 1) fprintf(stderr, "occupancy query says %d blocks per CU\n", per_cu);
        grid_blocks = cus > 0 ? cus : 256;
        if (ws_size < WS_NEED) fprintf(stderr, "workspace too small: %zu < %zu\n", ws_size, (size_t)WS_NEED);
    }
    Params p{};
    const float** pp = (const float**)&p;
    for (int i = 0; i < 33; ++i) pp[i] = (const float*)d_in[i];
    p.out = (float*)d_out; p.ws = (unsigned char*)d_ws;
    (void)hipMemsetAsync((char*)d_ws + O_BAR, 0, 16384, stream);
    void* args[] = {&p};
    hipError_t e = hipLaunchCooperativeKernel((const void*)fwd_megakernel, dim3(grid_blocks), dim3(512), args, LDS_BYTES, stream);
    if (e != hipSuccess) fprintf(stderr, "cooperative launch failed: %s (grid %d)\n", hipGetErrorString(e), grid_blocks);
}
```

```cpp
#include <hip/hip_runtime.h>
#include <hip/hip_cooperative_groups.h>
#include <cstdio>
#ifndef PROBE
#define PROBE 0
#endif
namespace cg = cooperative_groups;
namespace pg8 {
#define PG8_LAS __attribute__((address_space(3)))
typedef unsigned short bf16_t;
typedef short bf16x8 __attribute__((ext_vector_type(8)));
typedef float f32x4 __attribute__((ext_vector_type(4)));
typedef unsigned u32x4 __attribute__((ext_vector_type(4)));
constexpr int BM = 256, BK = 64, HALF = 128, HTB = HALF * BK * 2  , STAGE_BYTES = 8 * HTB, NXCD = 8, WGM = 8;

__host__ __device__ __forceinline__ int lds_byte(int r, int c) { const int st = (r >> 4) * 2 + (c >> 5), rr = r & 15, cc = c & 31, ob = rr * 64 + cc * 2; return st * 1024 + (ob ^ (((ob >> 9) & 1) << 5)); }
__host__ __device__ __forceinline__ void stage_rc(int b, int& R, int& C) { const int st = b / 1024, sb = b % 1024, swz = sb ^ (((sb >> 9) & 1) << 5); R = (st >> 1) * 16 + swz / 64; C = (st & 1) * 32 + (swz % 64) / 2; }
__host__ __device__ __forceinline__ int perm32(int rho) { const int n = rho >> 4, i = rho & 15; return 8 * (i >> 2) + 4 * n + (i & 3); }

struct Unit { int pm, pn; };
struct Gemm { const bf16_t* A; const bf16_t* Bt; int M, N, K; };

struct StaticOrder {
    int nM, nN, nwg, G, c;
    __host__ __device__ void init(int M, int N, int G_, int c_) { nM = M / BM; nN = N / BM; nwg = nM * nN; G = G_; c = c_; }
    __host__ __device__ bool next(int i, Unit& u) const {
        const long L = (long)i * G + c; if (L >= nwg) return false;
        int wgid = (int)L; { const int q = nwg / NXCD, r = nwg % NXCD, xcd = wgid % NXCD, off = wgid / NXCD; wgid = (xcd < r ? xcd * (q + 1) : r * (q + 1) + (xcd - r) * q) + off; }
        const int nig = WGM * nN, gid = wgid / nig, fm = gid * WGM, gsz = (nM - fm) < WGM ? (nM - fm) : WGM;
        u.pm = fm + ((wgid % nig) % gsz); u.pn = (wgid % nig) / gsz; return true;
    }
    __device__ __forceinline__ void a_ready(const Unit&) const {}
    __device__ __forceinline__ void done(const Unit&) const {}
};
__device__ __forceinline__ unsigned cvt_pk_bf16(float lo, float hi) { unsigned r; asm volatile("v_cvt_pk_bf16_f32 %0, %1, %2" : "=v"(r) : "v"(lo), "v"(hi)); return r; }

template <class Epi, class Sched, bool STAMP = false>
__device__ __forceinline__ void gemm_phase(PG8_LAS unsigned char* lds, const Gemm g, const Sched& S, const Epi& E, unsigned long long* stamps) {
    int tid_ = threadIdx.x; asm volatile("" : "+v"(tid_)); const int tid = tid_, wid = __builtin_amdgcn_readfirstlane(tid >> 6), lane = tid & 63, wr = wid >> 2, wc = wid & 3, fr = lane & 15, fq = lane >> 4;
    const int K = g.K, nt = K / BK;
    int ts_lo = 0, ts_hi = 0, nts = 0; const unsigned long long rt_entry = STAMP ? (unsigned long long)wall_clock64() : 0ull;
#define PG8_STAMP() do { if (STAMP && wid == 0 && nts < 64) { const unsigned long long _c = (unsigned long long)clock64(); \
        ts_lo = (lane == nts) ? (int)(unsigned)_c : ts_lo; ts_hi = (lane == nts) ? (int)(unsigned)(_c >> 32) : ts_hi; ++nts; } } while (0)
    PG8_STAMP();
    unsigned voffA[2], voffB[2];
#pragma unroll
    for (int i = 0; i < 2; ++i) { int R, C; stage_rc(tid * 16 + i * 8192, R, C); const int Rb = Epi::PERM ? ((R & ~31) + perm32(R & 31)) : R;
        voffA[i] = (unsigned)(R * K + C) * 2u; voffB[i] = (unsigned)(Rb * K + C) * 2u; }
    const size_t kstep = (size_t)(BK * 2);
    const size_t hstep = (size_t)HALF * K * 2;
    const size_t tstep = 2 * hstep;
    const unsigned ldsw = (unsigned)wid * 1024u;
    const int aoff = lds_byte(wr * 64 + fr, fq * 8), boff = lds_byte(wc * 32 + fr, fq * 8);
#define PG8_SA(b, h) (((b) * 2 + (h)) * HTB)
#define PG8_SB(b, h) ((4 + (b) * 2 + (h)) * HTB)
#define PG8_STAGE(bufoff, gbase, voff) do { _Pragma("unroll") for (int _i = 0; _i < 2; ++_i) \
        __builtin_amdgcn_global_load_lds((const unsigned*)((const char*)(gbase) + (voff)[_i]), (PG8_LAS unsigned*)(lds + (bufoff) + ldsw + _i * 8192), 16, 0, 0); } while (0)
#define PG8_LDA(dst, b, h) do { _Pragma("unroll") for (int m = 0; m < 4; ++m) _Pragma("unroll") for (int k = 0; k < 2; ++k) dst[m][k] = *(const PG8_LAS bf16x8*)(lds + PG8_SA(b, h) + aoff + m * 2048 + k * 1024); } while (0)
#define PG8_LDB(dst, b, h) do { _Pragma("unroll") for (int n = 0; n < 2; ++n) _Pragma("unroll") for (int k = 0; k < 2; ++k) dst[n][k] = *(const PG8_LAS bf16x8*)(lds + PG8_SB(b, h) + boff + n * 2048 + k * 1024); } while (0)
#define PG8_MMA(ai, bj, At, Bt) do { __builtin_amdgcn_s_setprio(1); _Pragma("unroll") for (int m = 0; m < 4; ++m) _Pragma("unroll") for (int n = 0; n < 2; ++n) _Pragma("unroll") for (int k = 0; k < 2; ++k) \
        acc[ai][bj][m][n] = __builtin_amdgcn_mfma_f32_16x16x32_bf16(Bt[n][k], At[m][k], acc[ai][bj][m][n], 0, 0, 0); __builtin_amdgcn_s_setprio(0); } while (0)
#define PG8_WAIT_V(n) asm volatile("s_waitcnt vmcnt(" #n ")" ::: "memory")
#define PG8_WAIT_L(n) asm volatile("s_waitcnt lgkmcnt(" #n ")" ::: "memory")
#define PG8_BAR __builtin_amdgcn_s_barrier()
#define PG8_SCHED __builtin_amdgcn_sched_barrier(0)
    Unit cur, nxt; int ui = 0;
    if (!S.next(0, cur)) return;
    f32x4 acc[2][2][4][2];
#pragma unroll
    for (int a = 0; a < 2; ++a)
#pragma unroll
        for (int b = 0; b < 2; ++b)
#pragma unroll
            for (int m = 0; m < 4; ++m)
#pragma unroll
                for (int n = 0; n < 2; ++n) acc[a][b][m][n] = (f32x4){0.f, 0.f, 0.f, 0.f};
    bf16x8 At[4][2], B0[2][2], B1[2][2];
    const char* cA = (const char*)g.A + (size_t)cur.pm * tstep; const char* cB = (const char*)g.Bt + (size_t)cur.pn * tstep;
    S.a_ready(cur);
    PG8_STAGE(PG8_SB(0, 0), cB, voffB); PG8_STAGE(PG8_SA(0, 0), cA, voffA); PG8_STAGE(PG8_SB(0, 1), cB + hstep, voffB); PG8_STAGE(PG8_SA(0, 1), cA + hstep, voffA);
    if (wr == 1) PG8_BAR;
    PG8_WAIT_V(4); PG8_BAR;
    PG8_STAGE(PG8_SB(1, 0), cB + kstep, voffB); PG8_STAGE(PG8_SA(1, 0), cA + kstep, voffA); PG8_STAGE(PG8_SB(1, 1), cB + hstep + kstep, voffB);
    PG8_WAIT_V(6); PG8_BAR;
    PG8_STAMP();
    for (;;) {
        const bool has_next = S.next(ui + 1, nxt);
        const char* nA = has_next ? (const char*)g.A + (size_t)nxt.pm * tstep : cA; const char* nB = has_next ? (const char*)g.Bt + (size_t)nxt.pn * tstep : cB;
        for (int t = 0; t < nt; t += 2) {
            const bool last = (t == nt - 2);
            const char* a1 = cA + (size_t)(t + 1) * kstep;
            const char* a2 = last ? nA : cA + (size_t)(t + 2) * kstep; const char* b2 = last ? nB : cB + (size_t)(t + 2) * kstep;
            const char* a3 = a2 + kstep; const char* b3 = b2 + kstep;
            if (last && has_next) S.a_ready(nxt);
            PG8_LDB(B0, 0, 0); PG8_SCHED; PG8_LDA(At, 0, 0); PG8_STAGE(PG8_SA(1, 1), a1 + hstep, voffA);
            PG8_WAIT_L(8); PG8_BAR; PG8_WAIT_L(0); PG8_MMA(0, 0, At, B0); PG8_BAR; PG8_SCHED;
            PG8_LDB(B1, 0, 1); PG8_STAGE(PG8_SB(0, 0), b2, voffB);
            PG8_BAR; PG8_WAIT_L(0); PG8_MMA(0, 1, At, B1); PG8_BAR;
            PG8_LDA(At, 0, 1); PG8_STAGE(PG8_SA(0, 0), a2, voffA);
            PG8_BAR; PG8_WAIT_L(0); PG8_MMA(1, 0, At, B0); PG8_BAR; PG8_SCHED;
            PG8_STAGE(PG8_SB(0, 1), b2 + hstep, voffB);
            PG8_WAIT_V(6); PG8_BAR; PG8_MMA(1, 1, At, B1); PG8_BAR;
            PG8_LDB(B0, 1, 0); PG8_SCHED; PG8_LDA(At, 1, 0); PG8_STAGE(PG8_SA(0, 1), a2 + hstep, voffA);
            PG8_WAIT_L(8); PG8_BAR; PG8_WAIT_L(0); PG8_MMA(0, 0, At, B0); PG8_BAR; PG8_SCHED;
            PG8_LDB(B1, 1, 1); PG8_STAGE(PG8_SB(1, 0), b3, voffB);
            PG8_BAR; PG8_WAIT_L(0); PG8_MMA(0, 1, At, B1); PG8_BAR;
            PG8_LDA(At, 1, 1); PG8_STAGE(PG8_SA(1, 0), a3, voffA);
            PG8_BAR; PG8_WAIT_L(0); PG8_MMA(1, 0, At, B0); PG8_BAR; PG8_SCHED;
            PG8_STAGE(PG8_SB(1, 1), b3 + hstep, voffB);
            PG8_WAIT_V(6); PG8_BAR; PG8_MMA(1, 1, At, B1); PG8_BAR;
        }
        PG8_STAMP();
        if constexpr (!Epi::AFTER_DRAIN) { E(acc, cur, wr, wc, fr, fq); S.done(cur); }
        PG8_STAMP();
        if (!has_next) break;
#pragma unroll
        for (int a = 0; a < 2; ++a)
#pragma unroll
            for (int b = 0; b < 2; ++b)
#pragma unroll
                for (int m = 0; m < 4; ++m)
#pragma unroll
                    for (int n = 0; n < 2; ++n) acc[a][b][m][n] = (f32x4){0.f, 0.f, 0.f, 0.f};
        cur = nxt; cA = nA; cB = nB; ++ui;
    }
    PG8_WAIT_V(0);
    if (wr == 0) PG8_BAR;
    PG8_BAR;
    if constexpr (Epi::AFTER_DRAIN) { E.fused(acc, cur, wr, wc, fr, fq, lds, wid, lane); S.done(cur); }
    PG8_STAMP();
    if (STAMP && wid == 0) { stamps[lane] = lane < nts ? (((unsigned long long)(unsigned)ts_hi << 32) | (unsigned)ts_lo) : 0ull;
        if (lane == 62) stamps[62] = rt_entry; if (lane == 63) stamps[63] = (unsigned long long)wall_clock64(); }
#undef PG8_STAMP
#undef PG8_SA
#undef PG8_SB
#undef PG8_STAGE
#undef PG8_LDA
#undef PG8_LDB
#undef PG8_MMA
#undef PG8_WAIT_V
#undef PG8_WAIT_L
#undef PG8_BAR
#undef PG8_SCHED
}
}

using pg8::bf16_t; using pg8::bf16x8; using pg8::f32x4; using pg8::Unit; using pg8::cvt_pk_bf16;
#define DI __device__ __forceinline__
constexpr int TOK = 16384, SEQ = 8192, DM = 1024, HS = 3336, DFF = 2816;
constexpr size_t O_CTL = 0, O_CD = 256, O_AUX = 4352, O_ROPE = 528640, O_FC = 2625792, O_WT = 3150080;
constexpr size_t O_WT_IN = O_WT, O_WT_OUT = O_WT_IN + 7340032, O_WT_UP = O_WT_OUT + 2097152, O_WT_DN = O_WT_UP + 11534336, O_WT_LR = O_WT_DN + 5767168;
constexpr size_t O_XN = O_WT + 27525120, O_R1 = O_XN + 33554432;
constexpr size_t O_H = O_R1, O_ST = O_R1 + 109314048, O_YG = O_ST + 33554432;
constexpr size_t O_G = O_R1, O_U = O_R1 + 92274688;
constexpr size_t O_LW = O_R1 + 109314048, O_KN = O_LW + 50331648, O_VT = O_KN + 16777216, O_AP = O_VT + 16777216;
constexpr size_t O_KNRM = O_AP + 8388608;
constexpr size_t O_BAR = O_KNRM + 524288;
constexpr size_t WS_NEED = O_BAR + 16384;
constexpr int LDS_BYTES = 131072 + 256;

struct Params {
    const float* x; const float* ev_norm_w; const float* ev_w_in; const float* ev_conv_w; const float* ev_conv_b; const float* ev_dt_bias; const float* ev_a_log;
    const float* ev_d; const float* ev_ssd_norm_w; const float* ev_ret_norm_w; const float* ev_w_out;
    const float* od_norm_w; const float* od_w_in; const float* od_mu; const float* od_w0; const float* od_w_up; const float* od_a0; const float* od_a_up;
    const float* od_g_up; const float* od_k_k; const float* od_k_a; const float* od_r_k; const float* od_ln_w; const float* od_ln_b;
    const float* od_qn_w; const float* od_kn_w; const float* od_f_bias; const float* od_w_out;
    const float* ffn_norm_w; const float* ffn_w_up; const float* ffn_conv_w; const float* ffn_conv_b; const float* ffn_w_down;
    float* out; unsigned char* ws;
};

DI unsigned short f2bf(float f) { unsigned u = __float_as_uint(f); u += 0x7fffu + ((u >> 16) & 1u); return (unsigned short)(u >> 16); }
DI float bf2f(unsigned short b) { return __uint_as_float(((unsigned)b) << 16); }
DI unsigned pack2(float lo, float hi) { return (unsigned)f2bf(lo) | ((unsigned)f2bf(hi) << 16); }
DI float bflo(unsigned w) { return __uint_as_float(w << 16); }
DI float bfhi(unsigned w) { return __uint_as_float(w & 0xffff0000u); }
DI void unpack8(const uint4 r, float (&o)[8]) { o[0] = bflo(r.x); o[1] = bfhi(r.x); o[2] = bflo(r.y); o[3] = bfhi(r.y); o[4] = bflo(r.z); o[5] = bfhi(r.z); o[6] = bflo(r.w); o[7] = bfhi(r.w); }
DI uint4 pack8(const float (&o)[8]) { uint4 r; r.x = pack2(o[0], o[1]); r.y = pack2(o[2], o[3]); r.z = pack2(o[4], o[5]); r.w = pack2(o[6], o[7]); return r; }
DI float silu_(float x) { return x / (1.f + __expf(-x)); }
DI float sigm_(float x) { return 1.f / (1.f + __expf(-x)); }
DI float softplus_(float x) { return fmaxf(x, 0.f) + log1pf(__expf(-fabsf(x))); }
DI bf16x8 ldfrag(const bf16_t* base, int row0, int ld, int k0, int lane) { return *(const bf16x8*)(base + (row0 + (lane & 15)) * ld + k0 + (lane >> 4) * 8); }
#define MFMA16(a, b, c) __builtin_amdgcn_mfma_f32_16x16x32_bf16((a), (b), (c), 0, 0, 0)
DI float red16(float v) { v += __shfl_xor(v, 1); v += __shfl_xor(v, 2); v += __shfl_xor(v, 4); v += __shfl_xor(v, 8); return v; }
DI float max16(float v) { v = fmaxf(v, __shfl_xor(v, 1)); v = fmaxf(v, __shfl_xor(v, 2)); v = fmaxf(v, __shfl_xor(v, 4)); v = fmaxf(v, __shfl_xor(v, 8)); return v; }
DI float red64(float v) { v += __shfl_xor(v, 32); v += __shfl_xor(v, 16); return red16(v); }
DI float dpp_red16(float x) {
    x += __builtin_bit_cast(float, __builtin_amdgcn_update_dpp(0, __builtin_bit_cast(int, x), 0xB1, 0xF, 0xF, true));
    x += __builtin_bit_cast(float, __builtin_amdgcn_update_dpp(0, __builtin_bit_cast(int, x), 0x4E, 0xF, 0xF, true));
    x += __builtin_bit_cast(float, __builtin_amdgcn_update_dpp(0, __builtin_bit_cast(int, x), 0x141, 0xF, 0xF, true));
    x += __builtin_bit_cast(float, __builtin_amdgcn_update_dpp(0, __builtin_bit_cast(int, x), 0x140, 0xF, 0xF, true));
    return x;
}

DI int otid() { int t = threadIdx.x; asm volatile("" : "+v"(t)); return t; }
DI int obid() { int b = blockIdx.x; asm volatile("" : "+s"(b)); return b; }
struct EpiH {
    static constexpr bool PERM = false, AFTER_DRAIN = false;
    bf16_t* H; float* aux; int auxc;
    DI void operator()(const f32x4 (&acc)[2][2][4][2], const Unit& u, int wr, int wc, int fr, int fq) const {
        const int row0 = u.pm * 256 + wr * 64 + fr, col0 = u.pn * 256 + wc * 32 + 4 * fq;
#pragma unroll
        for (int ai = 0; ai < 2; ++ai)
#pragma unroll
            for (int m = 0; m < 4; ++m) { const size_t r = (size_t)(row0 + ai * 128 + m * 16);
#pragma unroll
                for (int bj = 0; bj < 2; ++bj)
#pragma unroll
                    for (int n = 0; n < 2; ++n) { const int c = col0 + bj * 128 + n * 16; const f32x4 v = acc[ai][bj][m][n];
                        if (c < HS) { uint2 w; w.x = cvt_pk_bf16(v[0], v[1]); w.y = cvt_pk_bf16(v[2], v[3]); *(uint2*)(H + r * HS + c) = w;
                            if (c == auxc || c == auxc + 4) *(f32x4*)(aux + r * 8 + (c - auxc)) = v; } } }
    }
};
struct EpiRes {
    static constexpr bool PERM = false, AFTER_DRAIN = false;
    const float* res; float* out;
    DI void operator()(const f32x4 (&acc)[2][2][4][2], const Unit& u, int wr, int wc, int fr, int fq) const {
        const int row0 = u.pm * 256 + wr * 64 + fr, col0 = u.pn * 256 + wc * 32 + 4 * fq;
#pragma unroll
        for (int ai = 0; ai < 2; ++ai)
#pragma unroll
            for (int m = 0; m < 4; ++m) { const size_t r = (size_t)(row0 + ai * 128 + m * 16);
#pragma unroll
                for (int bj = 0; bj < 2; ++bj)
#pragma unroll
                    for (int n = 0; n < 2; ++n) { const int c = col0 + bj * 128 + n * 16;
                        const f32x4 rv = *(const f32x4*)(res + r * DM + c); *(f32x4*)(out + r * DM + c) = rv + acc[ai][bj][m][n]; } }
    }
};
struct EpiGU {
    static constexpr bool PERM = false, AFTER_DRAIN = false;
    bf16_t* G; bf16_t* U;
    DI void operator()(const f32x4 (&acc)[2][2][4][2], const Unit& u, int wr, int wc, int fr, int fq) const {
        const int row0 = u.pm * 256 + wr * 64 + fr, col0 = u.pn * 128 + wc * 32 + 4 * fq;
#pragma unroll
        for (int ai = 0; ai < 2; ++ai)
#pragma unroll
            for (int m = 0; m < 4; ++m) { const size_t r = (size_t)(row0 + ai * 128 + m * 16);
#pragma unroll
                for (int n = 0; n < 2; ++n) { const int c = col0 + n * 16; const f32x4 g = acc[ai][0][m][n], v = acc[ai][1][m][n];
                    uint2 w; w.x = cvt_pk_bf16(g[0], g[1]); w.y = cvt_pk_bf16(g[2], g[3]); *(uint2*)(G + r * DFF + c) = w;
                    w.x = cvt_pk_bf16(v[0], v[1]); w.y = cvt_pk_bf16(v[2], v[3]); *(uint2*)(U + r * DFF + c) = w; } }
    }
};
struct EpiLR {
    static constexpr bool PERM = false, AFTER_DRAIN = false;
    bf16_t* LW; const float* w0; const float* a0;
    DI void operator()(const f32x4 (&acc)[2][2][4][2], const Unit& u, int wr, int wc, int fr, int fq) const {
        const int row0 = u.pm * 256 + wr * 64 + fr, col0 = u.pn * 256 + wc * 32 + 4 * fq;
#pragma unroll
        for (int ai = 0; ai < 2; ++ai)
#pragma unroll
            for (int m = 0; m < 4; ++m) { const size_t r = (size_t)(row0 + ai * 128 + m * 16);
#pragma unroll
                for (int bj = 0; bj < 2; ++bj)
#pragma unroll
                    for (int n = 0; n < 2; ++n) { const int c = col0 + bj * 128 + n * 16; f32x4 v = acc[ai][bj][m][n];
                        if (c < 512) { const f32x4 b = *(const f32x4*)(w0 + c);
#pragma unroll
                            for (int j = 0; j < 4; ++j) v[j] = 1.f - __expf(-0.606531f * sigm_(b[j] + v[j])); }
                        else if (c < 1024) { const f32x4 b = *(const f32x4*)(a0 + c - 512);
#pragma unroll
                            for (int j = 0; j < 4; ++j) v[j] = sigm_(b[j] + v[j]); }
                        uint2 w; w.x = cvt_pk_bf16(v[0], v[1]); w.y = cvt_pk_bf16(v[2], v[3]); *(uint2*)(LW + r * 1536 + c) = w; } }
    }
};
template <class Epi> DI void run_gemm(unsigned char* smem, const bf16_t* A, const bf16_t* Bt, int N, int K, const Epi& E) {
    pg8::Gemm g; g.A = A; g.Bt = Bt; g.M = TOK; g.N = N; g.K = K;
    pg8::StaticOrder S; S.init(TOK, N, (int)gridDim.x, obid());
    pg8::gemm_phase<Epi, pg8::StaticOrder, false>((PG8_LAS unsigned char*)smem, g, S, E, nullptr);
}

DI void conv_tile4(const float* W, int Nsrc, int K, bf16_t* Wt, int nd0, int sc0, int nvalid, int k0, float* tile) {
    const int tid = otid(), j = tid & 63, kb = tid >> 6;
    float v[32];
#pragma unroll
    for (int i = 0; i < 32; ++i) { const int kk = kb + 8 * i; v[i] = (j < nvalid) ? W[(size_t)(k0 + kk) * Nsrc + sc0 + j] : 0.f; }
#pragma unroll
    for (int i = 0; i < 32; ++i) { const int kk = kb + 8 * i; tile[kk * 65 + j] = v[i]; }
    __syncthreads();
    const int nl = tid >> 3, ks = (tid & 7) * 8;
#pragma unroll
    for (int q = 0; q < 4; ++q) { const float* tq = tile + q * 64 * 65; uint4 o;
        o.x = pack2(tq[(ks + 0) * 65 + nl], tq[(ks + 1) * 65 + nl]); o.y = pack2(tq[(ks + 2) * 65 + nl], tq[(ks + 3) * 65 + nl]);
        o.z = pack2(tq[(ks + 4) * 65 + nl], tq[(ks + 5) * 65 + nl]); o.w = pack2(tq[(ks + 6) * 65 + nl], tq[(ks + 7) * 65 + nl]);
        *(uint4*)(Wt + (size_t)(nd0 + nl) * K + k0 + q * 64 + ks) = o; }
    __syncthreads();
}
DI void phase_weights(const Params& p, unsigned char* smem, int layer) {
    float* tile = (float*)smem;
    const float* w_in = layer ? p.od_w_in : p.ev_w_in; const float* w_out = layer ? p.od_w_out : p.ev_w_out;
    const float* w_up = p.ffn_w_up + (size_t)layer * DM * 2 * DFF; const float* w_dn = p.ffn_w_down + (size_t)layer * DFF * DM;
    bf16_t* t_in = (bf16_t*)(p.ws + O_WT_IN); bf16_t* t_out = (bf16_t*)(p.ws + O_WT_OUT); bf16_t* t_up = (bf16_t*)(p.ws + O_WT_UP); bf16_t* t_dn = (bf16_t*)(p.ws + O_WT_DN);
    for (int job = obid(); job < 816; job += gridDim.x) {
        if (job < 224) { const int nt = job >> 2, kt = job & 3, nd0 = nt * 64; int nv = HS - nd0; nv = nv < 0 ? 0 : (nv > 64 ? 64 : nv);
            conv_tile4(w_in, HS, 1024, t_in, nd0, nd0, nv, kt * 256, tile); }
        else if (job < 288) { const int j2 = job - 224, nt = j2 >> 2, kt = j2 & 3; conv_tile4(w_out, 1024, 1024, t_out, nt * 64, nt * 64, 64, kt * 256, tile); }
        else if (job < 640) { const int j2 = job - 288, nt = j2 >> 2, kt = j2 & 3, nd0 = nt * 64; const int pn = nd0 >> 8, bj = (nd0 >> 7) & 1, j0 = nd0 & 127;
            conv_tile4(w_up, 2 * DFF, 1024, t_up, nd0, bj * DFF + 128 * pn + j0, 64, kt * 256, tile); }
        else { const int j2 = job - 640, nt = j2 / 11, kt = j2 % 11; conv_tile4(w_dn, 1024, DFF, t_dn, nt * 64, nt * 64, 64, kt * 256, tile); }
    }
    const int gtid = obid() * 512 + otid(), gsz = gridDim.x * 512;
    if (layer == 0) {
        float* rc = (float*)(p.ws + O_ROPE); float* rs = rc + SEQ * 32;
        for (int idx = gtid; idx < SEQ * 32; idx += gsz) { const int pos = idx >> 5, i = idx & 31;
            const float inv = (float)exp(-(double)i * (9.210340371976184 / 32.0)); const float ang = (float)pos * inv;
            const double a = (double)ang; const double n = rint(a * 0.15915494309189535); const double r = a - n * 6.283185307179586; const double r2 = r * r;
            double sn = 1.0 / 121645100408832000.0, cs = 1.0 / 2432902008176640000.0;
            sn = sn * r2 - 1.0 / 355687428096000.0; sn = sn * r2 + 1.0 / 1307674368000.0; sn = sn * r2 - 1.0 / 6227020800.0; sn = sn * r2 + 1.0 / 39916800.0;
            sn = sn * r2 - 1.0 / 362880.0; sn = sn * r2 + 1.0 / 5040.0; sn = sn * r2 - 1.0 / 120.0; sn = sn * r2 + 1.0 / 6.0; sn = sn * r2 * -1.0 + 1.0; sn = sn * r;
            cs = cs * r2 - 1.0 / 6402373705728000.0; cs = cs * r2 + 1.0 / 20922789888000.0; cs = cs * r2 - 1.0 / 87178291200.0; cs = cs * r2 + 1.0 / 479001600.0;
            cs = cs * r2 - 1.0 / 3628800.0; cs = cs * r2 + 1.0 / 40320.0; cs = cs * r2 - 1.0 / 720.0; cs = cs * r2 + 1.0 / 24.0; cs = cs * r2 - 0.5; cs = cs * r2 + 1.0;
            rc[idx] = (float)cs; rs[idx] = (float)sn; }
    } else {
        bf16_t* t_lr = (bf16_t*)(p.ws + O_WT_LR);
        for (int idx = gtid; idx < 1536 * 256; idx += gsz) { const int n = idx >> 8, k = idx & 255; float v = 0.f;
            if (n < 512) { if (k < 64) v = p.od_w_up[k * 512 + n]; }
            else if (n < 1024) { if (k >= 64 && k < 128) v = p.od_a_up[(k - 64) * 512 + n - 512]; }
            else { if (k >= 128) v = p.od_g_up[(k - 128) * 512 + n - 1024]; }
            t_lr[idx] = f2bf(v); }
    }
}
DI void phase_rmsnorm(const float* x, const float* w, bf16_t* xn) {
    const int lane = otid() & 63, wv = otid() >> 6;
    for (int r = obid() * 8 + wv; r < TOK; r += gridDim.x * 8) {
        const float* xr = x + (size_t)r * DM; f32x4 v[4]; float ss = 0.f;
#pragma unroll
        for (int i = 0; i < 4; ++i) { v[i] = *(const f32x4*)(xr + i * 256 + lane * 4); ss += v[i][0] * v[i][0] + v[i][1] * v[i][1] + v[i][2] * v[i][2] + v[i][3] * v[i][3]; }
        ss = red64(ss); const float rstd = rsqrtf(ss * (1.f / DM) + 1e-6f);
#pragma unroll
        for (int i = 0; i < 4; ++i) { const f32x4 ww = *(const f32x4*)(w + i * 256 + lane * 4); uint2 o; o.x = pack2(v[i][0] * rstd * ww[0], v[i][1] * rstd * ww[1]); o.y = pack2(v[i][2] * rstd * ww[2], v[i][3] * rstd * ww[3]);
            *(uint2*)(xn + (size_t)r * DM + i * 256 + lane * 4) = o; }
    }
}
DI void ssd_conv8(const Params& p, const bf16_t* H, int b, int t, int ch, float (&o)[8]) {
    const bf16_t* base = H + (size_t)b * SEQ * HS + 512 + ch;
    const int t0 = t - 3 < 0 ? 0 : t - 3, t1 = t - 2 < 0 ? 0 : t - 2, t2 = t - 1 < 0 ? 0 : t - 1;
    const uint4 r0 = *(const uint4*)(base + (size_t)t0 * HS), r1 = *(const uint4*)(base + (size_t)t1 * HS), r2 = *(const uint4*)(base + (size_t)t2 * HS), r3 = *(const uint4*)(base + (size_t)t * HS);
    const float m0 = t >= 3 ? 1.f : 0.f, m1 = t >= 2 ? 1.f : 0.f, m2 = t >= 1 ? 1.f : 0.f;
    float acc[8], xv[8];
    { const f32x4 b0 = *(const f32x4*)(p.ev_conv_b + ch), b1 = *(const f32x4*)(p.ev_conv_b + ch + 4);
      acc[0] = b0[0]; acc[1] = b0[1]; acc[2] = b0[2]; acc[3] = b0[3]; acc[4] = b1[0]; acc[5] = b1[1]; acc[6] = b1[2]; acc[7] = b1[3]; }
#define SSD_TAP(k, raw, msk) { unpack8(raw, xv); const f32x4 w0 = *(const f32x4*)(p.ev_conv_w + (k) * 768 + ch) * (msk), w1 = *(const f32x4*)(p.ev_conv_w + (k) * 768 + ch + 4) * (msk); \
        acc[0] += w0[0] * xv[0]; acc[1] += w0[1] * xv[1]; acc[2] += w0[2] * xv[2]; acc[3] += w0[3] * xv[3]; acc[4] += w1[0] * xv[4]; acc[5] += w1[1] * xv[5]; acc[6] += w1[2] * xv[6]; acc[7] += w1[3] * xv[7]; }
    SSD_TAP(0, r0, m0) SSD_TAP(1, r1, m1) SSD_TAP(2, r2, m2) SSD_TAP(3, r3, 1.f)
#pragma unroll
    for (int e = 0; e < 8; ++e) o[e] = silu_(acc[e]);
}
DI float ret_lg(int hh) { return log1pf(-exp2f(-5.f - (float)hh)); }
DI void chunk_decay(const Params& p, int mixer, int b, int hh, int t0, float* acs, float* dts) {
    const int tid = otid(), lane = tid & 63; const float* aux = (const float*)(p.ws + O_AUX);
    float v = 0.f;
    if (tid < 128) {
        if (mixer == 0) { const float dt = softplus_(aux[((size_t)b * SEQ + t0 + tid) * 8 + hh] + p.ev_dt_bias[hh]); dts[tid] = dt; v = -expf(p.ev_a_log[hh]) * dt; }
        else { dts[tid] = 1.f; v = ret_lg(hh); }
    }
#pragma unroll
    for (int off = 1; off < 64; off <<= 1) { const float t = __shfl_up(v, off); if (lane >= off) v += t; }
    if (tid == 63) acs[256] = v;
    __syncthreads();
    if (tid >= 64 && tid < 128) v += acs[256];
    if (tid < 128) acs[tid] = v;
    __syncthreads();
}
DI void phase_m1(const Params& p, unsigned char* smem) {
    bf16_t* Kt = (bf16_t*)smem; bf16_t* Vt = (bf16_t*)(smem + 17408); float* acs = (float*)(smem + 34816); float* dts = acs + 128;
    const bf16_t* H = (const bf16_t*)(p.ws + O_H); float* ST = (float*)(p.ws + O_ST); float* CD = (float*)(p.ws + O_CD);
    const float* rc = (const float*)(p.ws + O_ROPE); const float* rs = rc + SEQ * 32;
    const int tid = otid(), lane = tid & 63, w = tid >> 6;
    for (int u = obid(); u < 2048; u += gridDim.x) {
        const int mixer = u >> 10, bh = (u >> 6) & 15, c = u & 63, b = bh >> 3, hh = bh & 7, t0 = c * 128;
        chunk_decay(p, mixer, b, hh, t0, acs, dts);
        const float aend = acs[127];
        if (mixer == 0) {
#pragma unroll
            for (int it = 0; it < 2; ++it) { const int g = tid + it * 512, s = g >> 3, c8 = (g & 7) * 8; float o[8];
                const float sc = __expf(aend - acs[s]) * dts[s];
                ssd_conv8(p, H, b, t0 + s, 512 + (hh >> 2) * 64 + c8, o);
#pragma unroll
                for (int e = 0; e < 8; ++e) Kt[(c8 + e) * 136 + s] = f2bf(o[e] * sc);
                ssd_conv8(p, H, b, t0 + s, hh * 64 + c8, o);
#pragma unroll
                for (int e = 0; e < 8; ++e) Vt[(c8 + e) * 136 + s] = f2bf(o[e]); }
            if (tid == 0) CD[bh * 64 + c] = __expf(aend);
        } else {
            { const int s = tid >> 2, i0 = (tid & 3) * 8; const size_t r = (size_t)b * SEQ + t0 + s; float k1[8], k2[8];
              unpack8(*(const uint4*)(H + r * HS + 1800 + hh * 64 + i0), k1); unpack8(*(const uint4*)(H + r * HS + 1800 + hh * 64 + 32 + i0), k2);
              const float sc = __expf(aend - acs[s]) * 0.125f;
#pragma unroll
              for (int e = 0; e < 8; ++e) { const float cs = rc[(t0 + s) * 32 + i0 + e], sn = rs[(t0 + s) * 32 + i0 + e];
                  Kt[(i0 + e) * 136 + s] = f2bf((k1[e] * cs - k2[e] * sn) * sc); Kt[(32 + i0 + e) * 136 + s] = f2bf((k1[e] * sn + k2[e] * cs) * sc); } }
#pragma unroll
            for (int it = 0; it < 2; ++it) { const int g = tid + it * 512, s = g >> 3, c8 = (g & 7) * 8; const size_t r = (size_t)b * SEQ + t0 + s; float v[8];
                unpack8(*(const uint4*)(H + r * HS + 2312 + hh * 64 + c8), v);
#pragma unroll
                for (int e = 0; e < 8; ++e) Vt[(c8 + e) * 136 + s] = (unsigned short)f2bf(v[e]); }
        }
        __syncthreads();
        { const int mt = w & 3, nt0 = (w >> 2) * 2; f32x4 a0 = {0.f, 0.f, 0.f, 0.f}, a1 = {0.f, 0.f, 0.f, 0.f};
#pragma unroll
          for (int ks = 0; ks < 4; ++ks) { const bf16x8 af = ldfrag(Kt, mt * 16, 136, ks * 32, lane);
              a0 = MFMA16(af, ldfrag(Vt, nt0 * 16, 136, ks * 32, lane), a0); a1 = MFMA16(af, ldfrag(Vt, nt0 * 16 + 16, 136, ks * 32, lane), a1); }
          float* dst = ST + (size_t)u * 4096 + mt * 16 + (lane >> 4) * 4;
          *(f32x4*)(dst + (nt0 * 16 + (lane & 15)) * 64) = a0; *(f32x4*)(dst + (nt0 * 16 + 16 + (lane & 15)) * 64) = a1; }
        __syncthreads();
    }
}
DI void phase_m2(const Params& p) {
    float* ST = (float*)(p.ws + O_ST); const float* CD = (const float*)(p.ws + O_CD);
    for (int idx = obid() * 512 + otid(); idx < 32 * 4096; idx += gridDim.x * 512) {
        const int mb = idx >> 12, e = idx & 4095, mixer = mb >> 4, bh = mb & 15; float run = 0.f;
        const float gdec = __expf(128.f * ret_lg(bh & 7));
#pragma unroll 8
        for (int c = 0; c < 64; ++c) { const size_t o = ((size_t)(mb * 64 + c)) * 4096 + e; const float v = ST[o]; ST[o] = run;
            const float dec = mixer == 0 ? CD[bh * 64 + c] : gdec; run = run * dec + v; }
    }
}
template <int MIXER> DI void m3_head(const Params& p, unsigned char* smem, int b, int c, int hh, float (&ssq)[4]) {
    bf16_t* Qs = (bf16_t*)smem; bf16_t* Ks = (bf16_t*)(smem + 18432); bf16_t* Vt = (bf16_t*)(smem + 36864); bf16_t* Rt = (bf16_t*)(smem + 54272); bf16_t* Ps = (bf16_t*)(smem + 63488);
    float* acs = (float*)(smem + 98304); float* dts = acs + 128;
    const bf16_t* H = (const bf16_t*)(p.ws + O_H); const float* ST = (const float*)(p.ws + O_ST); float* YG = (float*)(p.ws + O_YG); bf16_t* Y = (bf16_t*)(p.ws + O_XN);
    const float* rc = (const float*)(p.ws + O_ROPE); const float* rs = rc + SEQ * 32;
    const int tid = otid(), lane = tid & 63, w = tid >> 6, t0 = c * 128, bh = b * 8 + hh;
    const size_t u = (size_t)((MIXER * 16 + bh) * 64 + c);
    __syncthreads();
    chunk_decay(p, MIXER, b, hh, t0, acs, dts);
    if (MIXER == 0) {
#pragma unroll
        for (int it = 0; it < 2; ++it) { const int g = tid + it * 512, s = g >> 3, c8 = (g & 7) * 8; float o[8];
            ssd_conv8(p, H, b, t0 + s, 640 + (hh >> 2) * 64 + c8, o); *(uint4*)(Qs + s * 72 + c8) = pack8(o);
            ssd_conv8(p, H, b, t0 + s, 512 + (hh >> 2) * 64 + c8, o); *(uint4*)(Ks + s * 72 + c8) = pack8(o);
            ssd_conv8(p, H, b, t0 + s, hh * 64 + c8, o);
#pragma unroll
            for (int e = 0; e < 8; ++e) Vt[(c8 + e) * 136 + s] = f2bf(o[e]); }
    } else {
        { const int s = tid >> 2, i0 = (tid & 3) * 8; const size_t r = (size_t)b * SEQ + t0 + s; float a1[8], a2[8], o1[8], o2[8];
          unpack8(*(const uint4*)(H + r * HS + 1288 + hh * 64 + i0), a1); unpack8(*(const uint4*)(H + r * HS + 1288 + hh * 64 + 32 + i0), a2);
#pragma unroll
          for (int e = 0; e < 8; ++e) { const float cs = rc[(t0 + s) * 32 + i0 + e], sn = rs[(t0 + s) * 32 + i0 + e]; o1[e] = a1[e] * cs - a2[e] * sn; o2[e] = a1[e] * sn + a2[e] * cs; }
          *(uint4*)(Qs + s * 72 + i0) = pack8(o1); *(uint4*)(Qs + s * 72 + 32 + i0) = pack8(o2);
          unpack8(*(const uint4*)(H + r * HS + 1800 + hh * 64 + i0), a1); unpack8(*(const uint4*)(H + r * HS + 1800 + hh * 64 + 32 + i0), a2);
#pragma unroll
          for (int e = 0; e < 8; ++e) { const float cs = rc[(t0 + s) * 32 + i0 + e], sn = rs[(t0 + s) * 32 + i0 + e]; o1[e] = (a1[e] * cs - a2[e] * sn) * 0.125f; o2[e] = (a1[e] * sn + a2[e] * cs) * 0.125f; }
          *(uint4*)(Ks + s * 72 + i0) = pack8(o1); *(uint4*)(Ks + s * 72 + 32 + i0) = pack8(o2); }
#pragma unroll
        for (int it = 0; it < 2; ++it) { const int g = tid + it * 512, s = g >> 3, c8 = (g & 7) * 8; const size_t r = (size_t)b * SEQ + t0 + s;
            const uint4 raw = *(const uint4*)(H + r * HS + 2312 + hh * 64 + c8); const unsigned short* rv = (const unsigned short*)&raw;
#pragma unroll
            for (int e = 0; e < 8; ++e) Vt[(c8 + e) * 136 + s] = rv[e]; }
    }
    { const int pr = tid >> 3, n8 = (tid & 7) * 8; const float* src = ST + u * 4096 + pr * 64 + n8; const f32x4 x0 = *(const f32x4*)src, x1 = *(const f32x4*)(src + 4);
      uint4 o; o.x = pack2(x0[0], x0[1]); o.y = pack2(x0[2], x0[3]); o.z = pack2(x1[0], x1[1]); o.w = pack2(x1[2], x1[3]); *(uint4*)(Rt + pr * 72 + n8) = o; }
    __syncthreads();
    const int nks = (w >> 1) + 1;
    const int lrow = 16 * w + (lane >> 4) * 4;
    {
        const bf16x8 q0 = ldfrag(Qs, 16 * w, 72, 0, lane), q1 = ldfrag(Qs, 16 * w, 72, 32, lane);
        float al[4];
#pragma unroll
        for (int j = 0; j < 4; ++j) al[j] = acs[lrow + j];
        for (int nt = 0; nt < 2 * nks; ++nt) { f32x4 sacc = {0.f, 0.f, 0.f, 0.f};
            sacc = MFMA16(q0, ldfrag(Ks, nt * 16, 72, 0, lane), sacc); sacc = MFMA16(q1, ldfrag(Ks, nt * 16, 72, 32, lane), sacc);
            const int s = nt * 16 + (lane & 15); const float as = acs[s], ds = dts[s];
#pragma unroll
            for (int j = 0; j < 4; ++j) { const float pv = (s <= lrow + j) ? sacc[j] * __expf(al[j] - as) * ds : 0.f; Ps[(lrow + j) * 136 + s] = f2bf(pv); } }
    }
    __syncthreads();
    f32x4 yd[4], yo[4];
#pragma unroll
    for (int nt = 0; nt < 4; ++nt) { yd[nt] = (f32x4){0.f, 0.f, 0.f, 0.f}; yo[nt] = (f32x4){0.f, 0.f, 0.f, 0.f}; }
    for (int ks = 0; ks < nks; ++ks) { const bf16x8 pf = ldfrag(Ps, 16 * w, 136, ks * 32, lane);
#pragma unroll
        for (int nt = 0; nt < 4; ++nt) yd[nt] = MFMA16(pf, ldfrag(Vt, nt * 16, 136, ks * 32, lane), yd[nt]); }
#pragma unroll
    for (int ks = 0; ks < 2; ++ks) { const bf16x8 qf = ldfrag(Qs, 16 * w, 72, ks * 32, lane);
#pragma unroll
        for (int nt = 0; nt < 4; ++nt) yo[nt] = MFMA16(qf, ldfrag(Rt, nt * 16, 72, ks * 32, lane), yo[nt]); }
    float ea[4];
#pragma unroll
    for (int j = 0; j < 4; ++j) ea[j] = __expf(acs[lrow + j]);
    if (MIXER == 0) {
        const float dsk = p.ev_d[hh];
#pragma unroll
        for (int nt = 0; nt < 4; ++nt) { const int pc = nt * 16 + (lane & 15);
#pragma unroll
            for (int j = 0; j < 4; ++j) { const size_t r = (size_t)b * SEQ + t0 + lrow + j;
                const float y = yd[nt][j] + ea[j] * yo[nt][j] + dsk * bf2f(Vt[pc * 136 + lrow + j]);
                const float z = bf2f(H[r * HS + hh * 64 + pc]); const float yg = y * silu_(z); ssq[j] += yg * yg; YG[r * 512 + hh * 64 + pc] = yg; } }
    } else {
        float s2[4];
#pragma unroll
        for (int j = 0; j < 4; ++j) { float a = 0.f;
#pragma unroll
            for (int nt = 0; nt < 4; ++nt) { const float y = yd[nt][j] + ea[j] * yo[nt][j]; yd[nt][j] = y; a += y * y; }
            s2[j] = rsqrtf(red16(a) * (1.f / 64.f) + 1e-6f); }
#pragma unroll
        for (int nt = 0; nt < 4; ++nt) { const int pc = nt * 16 + (lane & 15); const float nw = p.ev_ret_norm_w[hh * 64 + pc];
#pragma unroll
            for (int j = 0; j < 4; ++j) { const size_t r = (size_t)b * SEQ + t0 + lrow + j; const float g = bf2f(H[r * HS + 2824 + hh * 64 + pc]);
                Y[r * DM + 512 + hh * 64 + pc] = f2bf(silu_(g) * yd[nt][j] * s2[j] * nw); } }
    }
}
DI void phase_m3(const Params& p, unsigned char* smem) {
    const int lane = otid() & 63, w = otid() >> 6;
    for (int u = obid(); u < 256; u += gridDim.x) {
        const int mixer = u >> 7, b = (u >> 6) & 1, c = u & 63; float ssq[4] = {0.f, 0.f, 0.f, 0.f};
        if (mixer == 0) {
            for (int hh = 0; hh < 8; ++hh) m3_head<0>(p, smem, b, c, hh, ssq);
            float* YG = (float*)(p.ws + O_YG); bf16_t* Y = (bf16_t*)(p.ws + O_XN); const int lrow = 16 * w + (lane >> 4) * 4;
            float rstd[4];
#pragma unroll
            for (int j = 0; j < 4; ++j) rstd[j] = rsqrtf(red16(ssq[j]) * (1.f / 512.f) + 1e-6f);
            for (int cc = 0; cc < 32; ++cc) { const int col = cc * 16 + (lane & 15); const float nw = p.ev_ssd_norm_w[col];
#pragma unroll
                for (int j = 0; j < 4; ++j) { const size_t r = (size_t)b * SEQ + c * 128 + lrow + j;
                    const float v = __hip_atomic_load(YG + r * 512 + col, __ATOMIC_RELAXED, __HIP_MEMORY_SCOPE_AGENT); Y[r * DM + col] = f2bf(v * rstd[j] * nw); } }
        } else {
            for (int hh = 0; hh < 8; ++hh) m3_head<1>(p, smem, b, c, hh, ssq);
        }
    }
}
DI void phase_ffn_act(const Params& p, int layer) {
    const bf16_t* G = (const bf16_t*)(p.ws + O_G); bf16_t* U = (bf16_t*)(p.ws + O_U);
    const float* cw = p.ffn_conv_w + (size_t)layer * 3 * DFF; const float* cb = p.ffn_conv_b + (size_t)layer * DFF;
    for (int idx = obid() * 512 + otid(); idx < TOK * (DFF / 8); idx += gridDim.x * 512) {
        const int r = idx / (DFF / 8), c8 = (idx % (DFF / 8)) * 8, t = r & (SEQ - 1);
        float acc[8], g[8], uv[8];
        { const f32x4 b0 = *(const f32x4*)(cb + c8), b1 = *(const f32x4*)(cb + c8 + 4); acc[0] = b0[0]; acc[1] = b0[1]; acc[2] = b0[2]; acc[3] = b0[3]; acc[4] = b1[0]; acc[5] = b1[1]; acc[6] = b1[2]; acc[7] = b1[3]; }
        { const int ra = t >= 2 ? r - 2 : r, rb2 = t >= 1 ? r - 1 : r; const float ma = t >= 2 ? 1.f : 0.f, mb = t >= 1 ? 1.f : 0.f;
          const uint4 g0 = *(const uint4*)(G + (size_t)ra * DFF + c8), g1 = *(const uint4*)(G + (size_t)rb2 * DFF + c8), g2 = *(const uint4*)(G + (size_t)r * DFF + c8);
#define ACT_TAP(k, raw, msk) { unpack8(raw, g); const f32x4 w0 = *(const f32x4*)(cw + (k) * DFF + c8) * (msk), w1 = *(const f32x4*)(cw + (k) * DFF + c8 + 4) * (msk); \
            acc[0] += w0[0] * g[0]; acc[1] += w0[1] * g[1]; acc[2] += w0[2] * g[2]; acc[3] += w0[3] * g[3]; acc[4] += w1[0] * g[4]; acc[5] += w1[1] * g[5]; acc[6] += w1[2] * g[6]; acc[7] += w1[3] * g[7]; }
          ACT_TAP(0, g0, ma) ACT_TAP(1, g1, mb) ACT_TAP(2, g2, 1.f) }
        unpack8(*(const uint4*)(U + (size_t)r * DFF + c8), uv);
#pragma unroll
        for (int e = 0; e < 8; ++e) acc[e] = silu_(acc[e]) * uv[e];
        *(uint4*)(U + (size_t)r * DFF + c8) = pack8(acc);
    }
}
DI void phase_l1_prep(const Params& p, unsigned char* smem) {
    const bf16_t* H = (const bf16_t*)(p.ws + O_H); const float* aux = (const float*)(p.ws + O_AUX); float* FC = (float*)(p.ws + O_FC);
    bf16_t* KN = (bf16_t*)(p.ws + O_KN); bf16_t* VT = (bf16_t*)(p.ws + O_VT); bf16_t* AP = (bf16_t*)(p.ws + O_AP);
    const int tid = otid();
    for (int u = obid(); u < 16 + 1024; u += gridDim.x) {
        __syncthreads();
        if (u < 16) {
            float* tot = (float*)smem; const int bh = u, b = bh >> 3, hh = bh & 7; const float fb = p.od_f_bias[hh]; float loc[16]; float run = 0.f;
#pragma unroll
            for (int i = 0; i < 16; ++i) { const float xv = aux[((size_t)b * SEQ + tid * 16 + i) * 8 + hh] + fb; run += -softplus_(-xv); loc[i] = run; }
            tot[tid] = run; __syncthreads();
            float off = 0.f; for (int i = 0; i < tid; ++i) off += tot[i];
#pragma unroll
            for (int i = 0; i < 16; ++i) FC[(size_t)bh * SEQ + tid * 16 + i] = off + loc[i];
        } else {
            bf16_t* Vl = (bf16_t*)smem; const int v2 = u - 16, bh = v2 >> 6, blk = v2 & 63, b = bh >> 3, hh = bh & 7, t0 = blk * 128;
            { const int l = tid >> 2, c16 = (tid & 3) * 16; const size_t r = (size_t)b * SEQ + t0 + l; float a[8], c[8];
              unpack8(*(const uint4*)(H + r * HS + 2304 + hh * 64 + c16), a); unpack8(*(const uint4*)(H + r * HS + 2304 + hh * 64 + c16 + 8), c);
              float ss = 0.f;
#pragma unroll
              for (int e = 0; e < 8; ++e) ss += a[e] * a[e] + c[e] * c[e];
              ss += __shfl_xor(ss, 1); ss += __shfl_xor(ss, 2); const float rstd = rsqrtf(ss * (1.f / 64.f) + 1e-6f);
#pragma unroll
              for (int e = 0; e < 8; ++e) { a[e] *= rstd * p.od_kn_w[c16 + e]; c[e] *= rstd * p.od_kn_w[c16 + 8 + e]; }
              bf16_t* dst = KN + ((size_t)bh * SEQ + t0 + l) * 64 + c16; *(uint4*)dst = pack8(a); *(uint4*)(dst + 8) = pack8(c); }
#pragma unroll
            for (int it = 0; it < 2; ++it) { const int g = tid + it * 512, s = g >> 3, c8 = (g & 7) * 8; const size_t r = (size_t)b * SEQ + t0 + s;
                *(uint4*)(Vl + s * 72 + c8) = *(const uint4*)(H + r * HS + 2816 + hh * 64 + c8); }
            __syncthreads();
#pragma unroll
            for (int it = 0; it < 2; ++it) { const int g = tid + it * 512, e = g >> 4, s8 = (g & 15) * 8; uint4 o;
                o.x = (unsigned)Vl[(s8 + 0) * 72 + e] | ((unsigned)Vl[(s8 + 1) * 72 + e] << 16); o.y = (unsigned)Vl[(s8 + 2) * 72 + e] | ((unsigned)Vl[(s8 + 3) * 72 + e] << 16);
                o.z = (unsigned)Vl[(s8 + 4) * 72 + e] | ((unsigned)Vl[(s8 + 5) * 72 + e] << 16); o.w = (unsigned)Vl[(s8 + 6) * 72 + e] | ((unsigned)Vl[(s8 + 7) * 72 + e] << 16);
                *(uint4*)(VT + ((size_t)bh * 64 + e) * SEQ + t0 + s8) = o; }
        }
    }
    {
        float* KNRM = (float*)(p.ws + O_KNRM);
        for (int idx = obid() * 512 + tid; idx < TOK * 64; idx += gridDim.x * 512) {
            const int r = idx >> 6, c8 = (idx & 63) * 8, t = r & (SEQ - 1); float cur[8], prv[8]; float ss = 0.f;
            unpack8(*(const uint4*)(H + (size_t)r * HS + 512 + c8), cur);
            if (t > 0) unpack8(*(const uint4*)(H + (size_t)(r - 1) * HS + 512 + c8), prv); else {
#pragma unroll
                for (int e = 0; e < 8; ++e) prv[e] = 0.f; }
#pragma unroll
            for (int e = 0; e < 8; ++e) { const float v = (cur[e] + (prv[e] - cur[e]) * p.od_mu[512 + c8 + e]) * p.od_k_k[c8 + e]; ss += v * v; }
            ss += __shfl_xor(ss, 1); ss += __shfl_xor(ss, 2); ss += __shfl_xor(ss, 4);
            if ((idx & 7) == 0) KNRM[(size_t)r * 8 + (c8 >> 6)] = 1.f / fmaxf(sqrtf(ss), 1e-12f);
        }
    }
    for (int idx = obid() * 512 + tid; idx < TOK * 32; idx += gridDim.x * 512) {
        const int r = idx >> 5, j8 = (idx & 31) * 8, t = r & (SEQ - 1); float cur[8], prv[8], o[8];
        unpack8(*(const uint4*)(H + (size_t)r * HS + 1536 + j8), cur);
        if (t > 0) unpack8(*(const uint4*)(H + (size_t)(r - 1) * HS + 1536 + j8), prv); else {
#pragma unroll
            for (int e = 0; e < 8; ++e) prv[e] = 0.f; }
#pragma unroll
        for (int e = 0; e < 8; ++e) { const float v = cur[e] + (prv[e] - cur[e]) * p.od_mu[1536 + j8 + e];
            o[e] = (j8 < 64) ? tanhf(v) : ((j8 < 128) ? v : sigm_(v)); }
        *(uint4*)(AP + (size_t)r * 256 + j8) = pack8(o);
    }
}
DI void fox_unit(const Params& p, unsigned char* smem, int bh, int qb) {
    bf16_t* Qs = (bf16_t*)smem; bf16_t* Ks = (bf16_t*)(smem + 18432); bf16_t* Vts = (bf16_t*)(smem + 36864); float* ck = (float*)(smem + 89600);
    const bf16_t* H = (const bf16_t*)(p.ws + O_H); const float* FC = (const float*)(p.ws + O_FC); const bf16_t* KN = (const bf16_t*)(p.ws + O_KN); const bf16_t* VT = (const bf16_t*)(p.ws + O_VT);
    bf16_t* Y = (bf16_t*)(p.ws + O_XN);
    const int tid = otid(), lane = tid & 63, w = tid >> 6, b = bh >> 3, hh = bh & 7; const size_t r0 = (size_t)b * SEQ + qb * 128;
    const float LOG2E = 1.4426950408889634f;
    __syncthreads();
    { const int l = tid >> 2, c16 = (tid & 3) * 16; float a[8], c[8];
      unpack8(*(const uint4*)(H + (r0 + l) * HS + 1792 + hh * 64 + c16), a); unpack8(*(const uint4*)(H + (r0 + l) * HS + 1792 + hh * 64 + c16 + 8), c);
      float ss = 0.f;
#pragma unroll
      for (int e = 0; e < 8; ++e) ss += a[e] * a[e] + c[e] * c[e];
      ss += __shfl_xor(ss, 1); ss += __shfl_xor(ss, 2); const float rstd = rsqrtf(ss * (1.f / 64.f) + 1e-6f) * (0.125f * LOG2E);
#pragma unroll
      for (int e = 0; e < 8; ++e) { a[e] *= rstd * p.od_qn_w[c16 + e]; c[e] *= rstd * p.od_qn_w[c16 + 8 + e]; }
      *(uint4*)(Qs + l * 72 + c16) = pack8(a); *(uint4*)(Qs + l * 72 + c16 + 8) = pack8(c); }
    float mrow = -1e30f, lsum = 0.f; f32x4 O[4];
#pragma unroll
    for (int j = 0; j < 4; ++j) O[j] = (f32x4){0.f, 0.f, 0.f, 0.f};
    const int q4 = (lane >> 4) * 4, lq = 16 * w + (lane & 15);
    uint4 kreg0, kreg1, vreg0, vreg1; float ckreg = 0.f;
    const int g0 = tid, g1 = tid + 512;
#define FOX_ISSUE(kb_) { \
        kreg0 = *(const uint4*)(KN + ((size_t)bh * SEQ + (kb_) * 128 + (g0 >> 3)) * 64 + (g0 & 7) * 8); \
        kreg1 = *(const uint4*)(KN + ((size_t)bh * SEQ + (kb_) * 128 + (g1 >> 3)) * 64 + (g1 & 7) * 8); \
        vreg0 = *(const uint4*)(VT + ((size_t)bh * 64 + (g0 >> 4)) * SEQ + (kb_) * 128 + (g0 & 15) * 8); \
        vreg1 = *(const uint4*)(VT + ((size_t)bh * 64 + (g1 >> 4)) * SEQ + (kb_) * 128 + (g1 & 15) * 8); \
        if (tid < 128) ckreg = FC[(size_t)bh * SEQ + (kb_) * 128 + tid]; }
    FOX_ISSUE(0)
    for (int kb = 0; kb <= qb; ++kb) {
        __syncthreads();
        *(uint4*)(Ks + (g0 >> 3) * 72 + (g0 & 7) * 8) = kreg0; *(uint4*)(Ks + (g1 >> 3) * 72 + (g1 & 7) * 8) = kreg1;
        *(uint4*)(Vts + (g0 >> 4) * 136 + (g0 & 15) * 8) = vreg0; *(uint4*)(Vts + (g1 >> 4) * 136 + (g1 & 15) * 8) = vreg1;
        if (tid < 128) ck[tid] = ckreg * LOG2E;
        __syncthreads();
        if (kb < qb) FOX_ISSUE(kb + 1)
        f32x4 S[8];
        { const bf16x8 q0 = ldfrag(Qs, 16 * w, 72, 0, lane), q1 = ldfrag(Qs, 16 * w, 72, 32, lane);
#pragma unroll
          for (int nt = 0; nt < 8; ++nt) { f32x4 z = {0.f, 0.f, 0.f, 0.f}; z = MFMA16(ldfrag(Ks, nt * 16, 72, 0, lane), q0, z); S[nt] = MFMA16(ldfrag(Ks, nt * 16, 72, 32, lane), q1, z); } }
#pragma unroll
        for (int nt = 0; nt < 8; ++nt) S[nt] = S[nt] - *(const f32x4*)(ck + nt * 16 + q4);
        if (kb == qb) {
#pragma unroll
            for (int nt = 0; nt < 8; ++nt)
#pragma unroll
                for (int j = 0; j < 4; ++j) if (nt * 16 + q4 + j > lq) S[nt][j] = -1e30f;
        }
        float mx = S[0][0];
#pragma unroll
        for (int nt = 0; nt < 8; ++nt)
#pragma unroll
            for (int j = 0; j < 4; ++j) mx = fmaxf(mx, S[nt][j]);
        mx = fmaxf(mx, __shfl_xor(mx, 16)); mx = fmaxf(mx, __shfl_xor(mx, 32));
        const float mnew = fmaxf(mrow, mx); const float alpha = __builtin_amdgcn_exp2f(mrow - mnew); mrow = mnew;
        float rs = 0.f;
#pragma unroll
        for (int nt = 0; nt < 8; ++nt)
#pragma unroll
            for (int j = 0; j < 4; ++j) { const float pv = __builtin_amdgcn_exp2f(S[nt][j] - mnew); S[nt][j] = pv; rs += pv; }
        lsum = lsum * alpha + rs;
#pragma unroll
        for (int et = 0; et < 4; ++et) O[et] = O[et] * alpha;
#pragma unroll
        for (int ks = 0; ks < 4; ++ks) {
            uint4 pw; pw.x = cvt_pk_bf16(S[2 * ks][0], S[2 * ks][1]); pw.y = cvt_pk_bf16(S[2 * ks][2], S[2 * ks][3]); pw.z = cvt_pk_bf16(S[2 * ks + 1][0], S[2 * ks + 1][1]); pw.w = cvt_pk_bf16(S[2 * ks + 1][2], S[2 * ks + 1][3]);
            const bf16x8 pf = __builtin_bit_cast(bf16x8, pw);
#pragma unroll
            for (int et = 0; et < 4; ++et) { const bf16_t* vp = Vts + (et * 16 + (lane & 15)) * 136 + ks * 32 + q4;
                uint4 vw; const uint2 lo = *(const uint2*)vp, hi = *(const uint2*)(vp + 16); vw.x = lo.x; vw.y = lo.y; vw.z = hi.x; vw.w = hi.y;
                O[et] = MFMA16(__builtin_bit_cast(bf16x8, vw), pf, O[et]); }
        }
    }
    lsum += __shfl_xor(lsum, 16); lsum += __shfl_xor(lsum, 32);
    const float inv = 1.f / lsum;
#pragma unroll
    for (int et = 0; et < 4; ++et) { uint2 o; o.x = pack2(O[et][0] * inv, O[et][1] * inv); o.y = pack2(O[et][2] * inv, O[et][3] * inv);
        *(uint2*)(Y + (r0 + lq) * DM + 512 + hh * 64 + et * 16 + q4) = o; }
}
constexpr int RW_T = 32, RW_BUF = 43008;
struct RwRegs { unsigned short r[9], k[9], v[9], om[8], a[8]; float kn[8]; };
#define RW_BAR() do { asm volatile("s_waitcnt lgkmcnt(0)" ::: "memory"); __builtin_amdgcn_s_barrier(); asm volatile("" ::: "memory"); } while (0)
DI void rwkv_unit(const Params& p, unsigned char* smem, int bh, int rg) {
    const bf16_t* H = (const bf16_t*)(p.ws + O_H); const bf16_t* LW = (const bf16_t*)(p.ws + O_LW); bf16_t* Y = (bf16_t*)(p.ws + O_XN); const float* KNRM = (const float*)(p.ws + O_KNRM);
    const int tid = otid(), lane = tid & 63, w = tid >> 6, b = bh >> 3, hh = bh & 7; const size_t rb = (size_t)b * SEQ;
    float* ysh = (float*)(smem + 2 * RW_BUF);
    const int NCH = SEQ / RW_T;
    __syncthreads();
    if (w < 2) {
        float S0 = 0.f, S1 = 0.f, S2 = 0.f, S3 = 0.f; const int kq = lane & 15, row = w * 4 + (lane >> 4);
        RW_BAR();
        for (int ch = 0; ch < NCH; ++ch) {
            const float* bufp = (const float*)(smem + (ch & 1) * RW_BUF) + kq * 4; const float* vp = (const float*)(smem + (ch & 1) * RW_BUF) + 10240 + row; float* yo = ysh + (ch & 1) * 256 + row;
#define RW_LOAD(R, W, K, Q, B, V, tt) { R = *(const f32x4*)(bufp + (tt) * 64); W = *(const f32x4*)(bufp + 2048 + (tt) * 64); K = *(const f32x4*)(bufp + 4096 + (tt) * 64); \
                Q = *(const f32x4*)(bufp + 6144 + (tt) * 64); B = *(const f32x4*)(bufp + 8192 + (tt) * 64); V = vp[(tt) * 8]; }
#define DPPF(x, ctrl) __builtin_bit_cast(float, __builtin_amdgcn_update_dpp(0, __builtin_bit_cast(int, (x)), (ctrl), 0xF, 0xF, true))
            f32x4 prevR = {0.f, 0.f, 0.f, 0.f}; float yacc = 0.f;
            f32x4 rN, wN, kN, qN, bN; float vN;
            RW_LOAD(rN, wN, kN, qN, bN, vN, 0)
            __builtin_amdgcn_sched_barrier(0);
#pragma unroll
            for (int tt = 0; tt < RW_T; ++tt) {
                const f32x4 R = rN, W = wN, K = kN, Q = qN, B = bN; const float V = vN;
                if (tt + 1 < RW_T) RW_LOAD(rN, wN, kN, qN, bN, vN, tt + 1)
                float d = S0 * Q[0] + S1 * Q[1] + S2 * Q[2] + S3 * Q[3];
                if (tt > 0) {
                    float y = S0 * prevR[0] + S1 * prevR[1] + S2 * prevR[2] + S3 * prevR[3];
                    d += DPPF(d, 0xB1); y += DPPF(y, 0xB1); d += DPPF(d, 0x4E); y += DPPF(y, 0x4E); d += DPPF(d, 0x141); y += DPPF(y, 0x141); d += DPPF(d, 0x140); y += DPPF(y, 0x140);
                    yacc = (kq == ((tt - 1) & 15)) ? y : yacc;
                    if (tt == 16) yo[kq * 8] = yacc;
                } else d = dpp_red16(d);
                const float sa = -d;
                S0 = (S0 * W[0] + V * K[0]) + sa * B[0]; S1 = (S1 * W[1] + V * K[1]) + sa * B[1]; S2 = (S2 * W[2] + V * K[2]) + sa * B[2]; S3 = (S3 * W[3] + V * K[3]) + sa * B[3];
                prevR = R;
                if (tt & 1) __builtin_amdgcn_sched_barrier(0);
            }
            { float y = S0 * prevR[0] + S1 * prevR[1] + S2 * prevR[2] + S3 * prevR[3]; y = dpp_red16(y); yacc = (kq == 15) ? y : yacc; yo[(16 + kq) * 8] = yacc; }
            RW_BAR();
        }
    } else if (w == 4 || w == 5) {
        const unsigned* ta0; const unsigned* ta1; const unsigned* ta2; size_t st0, st1, st2;
        { int L = lane; int tok = L / 5, which = L - tok * 5; ta0 = (const unsigned*)(which < 3 ? H + (rb + tok) * HS + which * 512 + hh * 64 : LW + (rb + tok) * 1536 + (which - 3) * 512 + hh * 64); st0 = which < 3 ? (size_t)HS * 2 : (size_t)1536 * 2;
          L = lane + 64; tok = L / 5; which = L - tok * 5; ta1 = (const unsigned*)(which < 3 ? H + (rb + tok) * HS + which * 512 + hh * 64 : LW + (rb + tok) * 1536 + (which - 3) * 512 + hh * 64); st1 = which < 3 ? (size_t)HS * 2 : (size_t)1536 * 2;
          L = lane + 128 > 159 ? 159 : lane + 128; tok = L / 5; which = L - tok * 5; ta2 = (const unsigned*)(which < 3 ? H + (rb + tok) * HS + which * 512 + hh * 64 : LW + (rb + tok) * 1536 + (which - 3) * 512 + hh * 64); st2 = which < 3 ? (size_t)HS * 2 : (size_t)1536 * 2; }
        unsigned x0 = 0, x1 = 0, x2 = 0, y0 = 0, y1 = 0, y2 = 0, z0 = 0, z1 = 0, z2 = 0, pacc = 0;
        RW_BAR();
        for (int ch = 0; ch < NCH; ++ch) {
            if (w == 4) { int cc = ch + 6; cc = cc > NCH - 1 ? NCH - 1 : cc; const size_t tb = (size_t)cc * RW_T;
                pacc ^= x0 ^ x1 ^ x2; x0 = y0; x1 = y1; x2 = y2; y0 = z0; y1 = z1; y2 = z2;
                z0 = *(const unsigned*)((const char*)ta0 + tb * st0); z1 = *(const unsigned*)((const char*)ta1 + tb * st1); z2 = *(const unsigned*)((const char*)ta2 + tb * st2); }
            RW_BAR();
        }
        pacc ^= x0 ^ x1 ^ x2 ^ y0 ^ y1 ^ y2 ^ z0 ^ z1 ^ z2; if (pacc == 0x9e3779b9u && rg == 77) Y[0] = 0;
    } else {
        const int lw = (w & 1) + ((w >> 2) << 1), col = hh * 64 + lane; RwRegs ra;
        const float mur = p.od_mu[col], muk = p.od_mu[512 + col], muv = p.od_mu[1024 + col], kk_w = p.od_k_k[col], ka_w = p.od_k_a[col];
        auto issue = [&](int ch, RwRegs& rr) {
            const int tbase = ch * RW_T + lw * 8;
#pragma unroll
            for (int i = 0; i < 9; ++i) { const int t = tbase + i - 1;
                if (t >= 0) { const bf16_t* hp = H + (rb + t) * HS; rr.r[i] = hp[col]; rr.k[i] = hp[512 + col]; rr.v[i] = hp[1024 + col]; } else { rr.r[i] = 0; rr.k[i] = 0; rr.v[i] = 0; }
                if (i > 0) { const bf16_t* lp = LW + (rb + t) * 1536; rr.om[i - 1] = lp[col]; rr.a[i - 1] = lp[512 + col]; rr.kn[i - 1] = KNRM[(rb + t) * 8 + hh]; } }
        };
        auto process = [&](int ch, const RwRegs& rr) {
            float* bufp = (float*)(smem + (ch & 1) * RW_BUF);
#pragma unroll
            for (int i = 1; i < 9; ++i) { const int tt = lw * 8 + i - 1;
                const float rc = bf2f(rr.r[i]), rp = bf2f(rr.r[i - 1]), kc = bf2f(rr.k[i]), kp = bf2f(rr.k[i - 1]), vc = bf2f(rr.v[i]), vp = bf2f(rr.v[i - 1]);
                const float rl = rc + (rp - rc) * mur, kl = kc + (kp - kc) * muk, vl = vc + (vp - vc) * muv; const float a = bf2f(rr.a[i - 1]), wv = 1.f - bf2f(rr.om[i - 1]);
                const float kk = kl * kk_w * rr.kn[i - 1];
                bufp[tt * 64 + lane] = rl; bufp[2048 + tt * 64 + lane] = wv; bufp[4096 + tt * 64 + lane] = kl * (1.f + (a - 1.f) * ka_w); bufp[6144 + tt * 64 + lane] = kk; bufp[8192 + tt * 64 + lane] = kk * a;
                if ((lane >> 3) == rg) bufp[10240 + tt * 8 + (lane & 7)] = vl; }
        };
        issue(0, ra); process(0, ra); issue(1, ra);
        RW_BAR();
        for (int ch = 0; ch < NCH; ++ch) {
            if (ch + 1 < NCH) { process(ch + 1, ra); if (ch + 2 < NCH) issue(ch + 2, ra); }
            if (ch > 0 && lw < 2) { const float* yi = ysh + ((ch - 1) & 1) * 256; const int t2 = lw * 64 + lane, tt = t2 >> 2, pr = (t2 & 3) * 2;
                *(unsigned*)(Y + (rb + (ch - 1) * RW_T + tt) * DM + hh * 64 + rg * 8 + pr) = pack2(yi[tt * 8 + pr], yi[tt * 8 + pr + 1]); }
            RW_BAR();
        }
        if (lw < 2) { const float* yi = ysh + ((NCH - 1) & 1) * 256; const int t2 = lw * 64 + lane, tt = t2 >> 2, pr = (t2 & 3) * 2;
          *(unsigned*)(Y + (rb + (NCH - 1) * RW_T + tt) * DM + hh * 64 + rg * 8 + pr) = pack2(yi[tt * 8 + pr], yi[tt * 8 + pr + 1]); }
    }
    __syncthreads();
}
DI void phase_l1_mix(const Params& p, unsigned char* smem, int pass) {
    unsigned* ctr = (unsigned*)(p.ws + O_CTL) + pass * 4; int* sh = (int*)(smem + 90112);
    if (obid() < 128 && pass != 2) rwkv_unit(p, smem, obid() >> 3, obid() & 7);
    for (;;) {
        __syncthreads(); if (otid() == 0) *sh = (int)atomicAdd(ctr, 1u); __syncthreads();
        const int u = *sh; if (u >= 1024) break;
        fox_unit(p, smem, u & 15, 63 - (u >> 4));
    }
}
DI void phase_rwkv_fin(const Params& p) {
    const bf16_t* H = (const bf16_t*)(p.ws + O_H); const bf16_t* LW = (const bf16_t*)(p.ws + O_LW); bf16_t* Y = (bf16_t*)(p.ws + O_XN);
    const int lane = otid() & 63, wv = otid() >> 6;
    for (int task = obid() * 8 + wv; task < TOK * 8; task += gridDim.x * 8) {
        const int r = task >> 3, hh = task & 7, t = r & (SEQ - 1), col = hh * 64 + lane; const bf16_t* hp = H + (size_t)r * HS;
        const float y = bf2f(Y[(size_t)r * DM + col]); const float mean = red64(y) * (1.f / 64.f); const float dy = y - mean; const float var = red64(dy * dy) * (1.f / 64.f);
        const float yln = dy * rsqrtf(var + 64e-5f) * p.od_ln_w[col] + p.od_ln_b[col];
        const float rc = bf2f(hp[col]), kc = bf2f(hp[512 + col]), vc = bf2f(hp[1024 + col]); float rp = 0.f, kp = 0.f, vp = 0.f;
        if (t > 0) { rp = bf2f(hp[col - HS]); kp = bf2f(hp[512 + col - HS]); vp = bf2f(hp[1024 + col - HS]); }
        const float rl = rc + (rp - rc) * p.od_mu[col], kl = kc + (kp - kc) * p.od_mu[512 + col], vl = vc + (vp - vc) * p.od_mu[1024 + col];
        const float a = bf2f(LW[(size_t)r * 1536 + 512 + col]), g = bf2f(LW[(size_t)r * 1536 + 1024 + col]);
        const float kt = kl * (1.f + (a - 1.f) * p.od_k_a[col]); const float bonus = red64(rl * kt * p.od_r_k[col]) * vl;
        Y[(size_t)r * DM + col] = f2bf((yln + bonus) * g);
    }
}
#define XB_TMO      128
#define XB_XCNT(j)  (256  + 64 * (j))
#define XB_XSUB(j)  (1280 + 64 * (j))
#define XB_XGEN(j)  (2304 + 64 * (j))
#define XB_TOP      3328
#define XB_TOPGEN   3392
#define XCD_BAR_WORDS 3456
#define XB_SPIN_CAP (1u << 18)
#define LAS __attribute__((address_space(3)))

__device__ __forceinline__ unsigned xb_ld(unsigned* p)              { return __hip_atomic_load(p, __ATOMIC_RELAXED, __HIP_MEMORY_SCOPE_AGENT); }
__device__ __forceinline__ unsigned xb_add(unsigned* p, unsigned v) { return __hip_atomic_fetch_add(p, v, __ATOMIC_RELAXED, __HIP_MEMORY_SCOPE_AGENT); }
__device__ __forceinline__ unsigned xb_xcc_id() { return (unsigned)__builtin_amdgcn_s_getreg((3 << 11) | 20) & 0xFu; }
#define XB_SPIN(cond, bar) do { unsigned _sp = 0; while (cond) { __builtin_amdgcn_s_sleep(1); \
    if ((++_sp & 255u) == 0u) { if (xb_ld(&(bar)[XB_TMO])) break; if (_sp > XB_SPIN_CAP) { atomicAdd(&(bar)[XB_TMO], 1u); break; } } } } while (0)

struct XcdBarrier {
    unsigned* bar; unsigned x;
    volatile LAS unsigned* st;
};

__device__ __forceinline__ XcdBarrier xcd_barrier_post(unsigned* bar, volatile LAS unsigned* st) {
    XcdBarrier b; b.bar = bar; b.x = xb_xcc_id(); b.st = st;
    if (threadIdx.x == 0) (void)xb_add(&bar[XB_XCNT(b.x)], 1u);
    return b;
}
__device__ __forceinline__ void xcd_barrier_complete(unsigned* bar, unsigned x, unsigned& nloc, unsigned& nx) {
    const unsigned G = gridDim.x * gridDim.y * gridDim.z;
    unsigned sum, cnt, mine, sp = 0u;
    for (;;) {
        sum = 0u; cnt = 0u; mine = 0u;
#pragma unroll
        for (unsigned j = 0; j < 16; ++j) { const unsigned c = xb_ld(&bar[XB_XCNT(j)]); sum += c; cnt += (c > 0u) ? 1u : 0u; mine = (j == x) ? c : mine; }
        if (sum == G) break;
        __builtin_amdgcn_s_sleep(1);
        if ((++sp & 255u) == 0u) { if (xb_ld(&bar[XB_TMO])) break; if (sp > XB_SPIN_CAP) { atomicAdd(&bar[XB_TMO], 1u); break; } }
    }
    nloc = mine > 0u ? mine : 1u; nx = cnt > 0u ? cnt : 1u;
}

__device__ __forceinline__ void xcd_barrier(const XcdBarrier& b) {
    asm volatile("s_waitcnt vmcnt(0)" ::: "memory");
    __syncthreads();
    if (threadIdx.x == 0) {
        unsigned* bar = b.bar;
        __builtin_amdgcn_s_waitcnt(0);
        unsigned nloc = b.st[0], nx = b.st[1];
        if (nloc == 0u) { xcd_barrier_complete(bar, b.x, nloc, nx); b.st[0] = nloc; b.st[1] = nx; }
        const unsigned old = xb_add(&bar[XB_XSUB(b.x)], 1u);
        const unsigned gen = old / nloc;
        if (old + 1u == (gen + 1u) * nloc) {
            __builtin_amdgcn_fence(__ATOMIC_RELEASE, "agent");
            asm volatile("s_waitcnt vmcnt(0)" ::: "memory");
            const unsigned og = xb_add(&bar[XB_TOP], 1u);
            const unsigned tg = og / nx;
            if (og + 1u == (tg + 1u) * nx) xb_add(&bar[XB_TOPGEN], 1u);
            else XB_SPIN(xb_ld(&bar[XB_TOPGEN]) == tg, bar);
            __builtin_amdgcn_fence(__ATOMIC_ACQUIRE, "agent");
            xb_add(&bar[XB_XGEN(b.x)], 1u);
            asm volatile("s_waitcnt vmcnt(0)" ::: "memory");
        } else {
            XB_SPIN(xb_ld(&bar[XB_XGEN(b.x)]) == gen, bar);
            __builtin_amdgcn_fence(__ATOMIC_ACQUIRE, "agent");
            asm volatile("s_waitcnt vmcnt(0)" ::: "memory");
        }
    }
    __syncthreads();
}


__global__ void __launch_bounds__(512, 2) fwd_megakernel(Params p) {
    extern __shared__ __attribute__((aligned(16))) unsigned char smem[];
    cg::grid_group grid = cg::this_grid();
    unsigned char* ws = p.ws;
    bf16_t* XN = (bf16_t*)(ws + O_XN); bf16_t* Hb = (bf16_t*)(ws + O_H); float* aux = (float*)(ws + O_AUX);
    const bf16_t* t_in = (const bf16_t*)(ws + O_WT_IN); const bf16_t* t_out = (const bf16_t*)(ws + O_WT_OUT); const bf16_t* t_up = (const bf16_t*)(ws + O_WT_UP);
    const bf16_t* t_dn = (const bf16_t*)(ws + O_WT_DN); const bf16_t* t_lr = (const bf16_t*)(ws + O_WT_LR);
    if (blockIdx.x == 0 && threadIdx.x < 16) ((unsigned*)(ws + O_CTL))[threadIdx.x] = 0u;
    if (threadIdx.x == 0) *(uint4*)(smem + 131072) = make_uint4(0u, 0u, 0u, 0u);
    __syncthreads();
    const XcdBarrier xb = xcd_barrier_post((unsigned*)(ws + O_BAR), (volatile LAS unsigned*)(smem + 131072));
#define GSYNC() xcd_barrier(xb)
#define GEMM_H(layer) { EpiH E; E.H = Hb; E.aux = aux; E.auxc = layer ? 3328 : 1280; run_gemm(smem, XN, t_in, 3584, 1024, E); }
#define GEMM_OUT(layer) { EpiRes E; E.res = layer ? p.out : p.x; E.out = p.out; run_gemm(smem, XN, t_out, 1024, 1024, E); }
#define GEMM_UP() { EpiGU E; E.G = (bf16_t*)(ws + O_G); E.U = (bf16_t*)(ws + O_U); run_gemm(smem, XN, t_up, 2 * DFF, 1024, E); }
#define GEMM_DN() { EpiRes E; E.res = p.out; E.out = p.out; run_gemm(smem, (const bf16_t*)(ws + O_U), t_dn, 1024, DFF, E); }
    phase_weights(p, smem, 0); phase_rmsnorm(p.x, p.ev_norm_w, XN); grid.sync();
    GEMM_H(0) GSYNC();
#if PROBE == 2
    GEMM_H(0) GSYNC();
#endif
    phase_m1(p, smem); GSYNC();
#if PROBE == 3
    phase_m1(p, smem); GSYNC();
#endif
    phase_m2(p); GSYNC();
#if PROBE == 6
    GSYNC(); GSYNC(); GSYNC(); GSYNC(); GSYNC(); GSYNC(); GSYNC(); GSYNC(); GSYNC(); GSYNC();
#endif
#if PROBE == 7
    phase_weights(p, smem, 0); GSYNC(); phase_rmsnorm(p.x, p.ev_norm_w, XN); GSYNC(); phase_rmsnorm(p.x, p.ev_norm_w, XN); GSYNC();
#endif
    phase_m3(p, smem); GSYNC();
#if PROBE == 3
    phase_m3(p, smem); GSYNC();
#endif
    GEMM_OUT(0) GSYNC();
#if PROBE == 2
    GEMM_OUT(0) GSYNC();
#endif
    phase_rmsnorm(p.out, p.ffn_norm_w, XN); GSYNC();
    GEMM_UP() GSYNC();
#if PROBE == 2
    GEMM_UP() GSYNC();
#endif
    phase_ffn_act(p, 0); GSYNC();
    GEMM_DN() GSYNC();
    phase_weights(p, smem, 1); phase_rmsnorm(p.out, p.od_norm_w, XN); GSYNC();
    GEMM_H(1) GSYNC();
    phase_l1_prep(p, smem); GSYNC();
    { EpiLR E; E.LW = (bf16_t*)(ws + O_LW); E.w0 = p.od_w0; E.a0 = p.od_a0; run_gemm(smem, (const bf16_t*)(ws + O_AP), t_lr, 1536, 256, E); } GSYNC();
    phase_l1_mix(p, smem, 0); GSYNC();
#if PROBE == 4
    phase_l1_mix(p, smem, 1); GSYNC();
#endif
#if PROBE == 5
    phase_l1_mix(p, smem, 2); GSYNC();
#endif
    phase_rwkv_fin(p); GSYNC();
    GEMM_OUT(1) GSYNC();
    phase_rmsnorm(p.out, p.ffn_norm_w + DM, XN); GSYNC();
    GEMM_UP() GSYNC();
    phase_ffn_act(p, 1); GSYNC();
    GEMM_DN()
}

extern "C" void kernel_launch(void* const* d_in, const int* in_sizes, int n_in, void* d_out, int out_size, void* d_ws, size_t ws_size, hipStream_t stream) {
    static int grid_blocks = 0;
    if (grid_blocks == 0) {
        int dev = 0, cus = 0, per_cu = 0;
        hipGetDevice(&dev); hipDeviceGetAttribute(&cus, hipDeviceAttributeMultiprocessorCount, dev);
        if (hipFuncSetAttribute((const void*)fwd_megakernel, hipFuncAttributeMaxDynamicSharedMemorySize, LDS_BYTES) != hipSuccess) fprintf(stderr, "hipFuncSetAttribute failed\n");
        hipOccupancyMaxActiveBlocksPerMultiprocessor(&per_cu, (const void*)fwd_megakernel, 512, LDS_BYTES);
        (void)hipGetLastError();
        if (per_cu < 1) fprintf(stderr, "occupancy query says %d blocks per CU\n", per_cu);
        grid_blocks = cus > 0 ? cus : 256;
        if (ws_size < WS_NEED) fprintf(stderr, "workspace too small: %zu < %zu\n", ws_size, (size_t)WS_NEED);
    }
    Params p{};
    const float** pp = (const float**)&p;
    for (int i = 0; i < 33; ++i) pp[i] = (const float*)d_in[i];
    p.out = (float*)d_out; p.ws = (unsigned char*)d_ws;
    (void)hipMemsetAsync((char*)d_ws + O_BAR, 0, 16384, stream);
    void* args[] = {&p};
    hipError_t e = hipLaunchCooperativeKernel((const void*)fwd_megakernel, dim3(grid_blocks), dim3(512), args, LDS_BYTES, stream);
    if (e != hipSuccess) fprintf(stderr, "cooperative launch failed: %s (grid %d)\n", hipGetErrorString(e), grid_blocks);
}
```

```cpp
#include <hip/hip_runtime.h>
#include <hip/hip_cooperative_groups.h>
#include <cstdio>
#ifndef PROBE
#define PROBE 0
#endif
namespace cg = cooperative_groups;
namespace pg8 {
#define PG8_LAS __attribute__((address_space(3)))
typedef unsigned short bf16_t;
typedef short bf16x8 __attribute__((ext_vector_type(8)));
typedef float f32x4 __attribute__((ext_vector_type(4)));
typedef unsigned u32x4 __attribute__((ext_vector_type(4)));
constexpr int BM = 256, BK = 64, HALF = 128, HTB = HALF * BK * 2  , STAGE_BYTES = 8 * HTB, NXCD = 8, WGM = 8;

__host__ __device__ __forceinline__ int lds_byte(int r, int c) { const int st = (r >> 4) * 2 + (c >> 5), rr = r & 15, cc = c & 31, ob = rr * 64 + cc * 2; return st * 1024 + (ob ^ (((ob >> 9) & 1) << 5)); }
__host__ __device__ __forceinline__ void stage_rc(int b, int& R, int& C) { const int st = b / 1024, sb = b % 1024, swz = sb ^ (((sb >> 9) & 1) << 5); R = (st >> 1) * 16 + swz / 64; C = (st & 1) * 32 + (swz % 64) / 2; }
__host__ __device__ __forceinline__ int perm32(int rho) { const int n = rho >> 4, i = rho & 15; return 8 * (i >> 2) + 4 * n + (i & 3); }

struct Unit { int pm, pn; };
struct Gemm { const bf16_t* A; const bf16_t* Bt; int M, N, K; };

struct StaticOrder {
    int nM, nN, nwg, G, c;
    __host__ __device__ void init(int M, int N, int G_, int c_) { nM = M / BM; nN = N / BM; nwg = nM * nN; G = G_; c = c_; }
    __host__ __device__ bool next(int i, Unit& u) const {
        const long L = (long)i * G + c; if (L >= nwg) return false;
        int wgid = (int)L; { const int q = nwg / NXCD, r = nwg % NXCD, xcd = wgid % NXCD, off = wgid / NXCD; wgid = (xcd < r ? xcd * (q + 1) : r * (q + 1) + (xcd - r) * q) + off; }
        const int nig = WGM * nN, gid = wgid / nig, fm = gid * WGM, gsz = (nM - fm) < WGM ? (nM - fm) : WGM;
        u.pm = fm + ((wgid % nig) % gsz); u.pn = (wgid % nig) / gsz; return true;
    }
    __device__ __forceinline__ void a_ready(const Unit&) const {}
    __device__ __forceinline__ void done(const Unit&) const {}
};
__device__ __forceinline__ unsigned cvt_pk_bf16(float lo, float hi) { unsigned r; asm volatile("v_cvt_pk_bf16_f32 %0, %1, %2" : "=v"(r) : "v"(lo), "v"(hi)); return r; }

template <class Epi, class Sched, bool STAMP = false>
__device__ __forceinline__ void gemm_phase(PG8_LAS unsigned char* lds, const Gemm g, const Sched& S, const Epi& E, unsigned long long* stamps) {
    int tid_ = threadIdx.x; asm volatile("" : "+v"(tid_)); const int tid = tid_, wid = __builtin_amdgcn_readfirstlane(tid >> 6), lane = tid & 63, wr = wid >> 2, wc = wid & 3, fr = lane & 15, fq = lane >> 4;
    const int K = g.K, nt = K / BK;
    int ts_lo = 0, ts_hi = 0, nts = 0; const unsigned long long rt_entry = STAMP ? (unsigned long long)wall_clock64() : 0ull;
#define PG8_STAMP() do { if (STAMP && wid == 0 && nts < 64) { const unsigned long long _c = (unsigned long long)clock64(); \
        ts_lo = (lane == nts) ? (int)(unsigned)_c : ts_lo; ts_hi = (lane == nts) ? (int)(unsigned)(_c >> 32) : ts_hi; ++nts; } } while (0)
    PG8_STAMP();
    unsigned voffA[2], voffB[2];
#pragma unroll
    for (int i = 0; i < 2; ++i) { int R, C; stage_rc(tid * 16 + i * 8192, R, C); const int Rb = Epi::PERM ? ((R & ~31) + perm32(R & 31)) : R;
        voffA[i] = (unsigned)(R * K + C) * 2u; voffB[i] = (unsigned)(Rb * K + C) * 2u; }
    const size_t kstep = (size_t)(BK * 2);
    const size_t hstep = (size_t)HALF * K * 2;
    const size_t tstep = 2 * hstep;
    const unsigned ldsw = (unsigned)wid * 1024u;
    const int aoff = lds_byte(wr * 64 + fr, fq * 8), boff = lds_byte(wc * 32 + fr, fq * 8);
#define PG8_SA(b, h) (((b) * 2 + (h)) * HTB)
#define PG8_SB(b, h) ((4 + (b) * 2 + (h)) * HTB)
#define PG8_STAGE(bufoff, gbase, voff) do { _Pragma("unroll") for (int _i = 0; _i < 2; ++_i) \
        __builtin_amdgcn_global_load_lds((const unsigned*)((const char*)(gbase) + (voff)[_i]), (PG8_LAS unsigned*)(lds + (bufoff) + ldsw + _i * 8192), 16, 0, 0); } while (0)
#define PG8_LDA(dst, b, h) do { _Pragma("unroll") for (int m = 0; m < 4; ++m) _Pragma("unroll") for (int k = 0; k < 2; ++k) dst[m][k] = *(const PG8_LAS bf16x8*)(lds + PG8_SA(b, h) + aoff + m * 2048 + k * 1024); } while (0)
#define PG8_LDB(dst, b, h) do { _Pragma("unroll") for (int n = 0; n < 2; ++n) _Pragma("unroll") for (int k = 0; k < 2; ++k) dst[n][k] = *(const PG8_LAS bf16x8*)(lds + PG8_SB(b, h) + boff + n * 2048 + k * 1024); } while (0)
#define PG8_MMA(ai, bj, At, Bt) do { __builtin_amdgcn_s_setprio(1); _Pragma("unroll") for (int m = 0; m < 4; ++m) _Pragma("unroll") for (int n = 0; n < 2; ++n) _Pragma("unroll") for (int k = 0; k < 2; ++k) \
        acc[ai][bj][m][n] = __builtin_amdgcn_mfma_f32_16x16x32_bf16(Bt[n][k], At[m][k], acc[ai][bj][m][n], 0, 0, 0); __builtin_amdgcn_s_setprio(0); } while (0)
#define PG8_WAIT_V(n) asm volatile("s_waitcnt vmcnt(" #n ")" ::: "memory")
#define PG8_WAIT_L(n) asm volatile("s_waitcnt lgkmcnt(" #n ")" ::: "memory")
#define PG8_BAR __builtin_amdgcn_s_barrier()
#define PG8_SCHED __builtin_amdgcn_sched_barrier(0)
    Unit cur, nxt; int ui = 0;
    if (!S.next(0, cur)) return;
    f32x4 acc[2][2][4][2];
#pragma unroll
    for (int a = 0; a < 2; ++a)
#pragma unroll
        for (int b = 0; b < 2; ++b)
#pragma unroll
            for (int m = 0; m < 4; ++m)
#pragma unroll
                for (int n = 0; n < 2; ++n) acc[a][b][m][n] = (f32x4){0.f, 0.f, 0.f, 0.f};
    bf16x8 At[4][2], B0[2][2], B1[2][2];
    const char* cA = (const char*)g.A + (size_t)cur.pm * tstep; const char* cB = (const char*)g.Bt + (size_t)cur.pn * tstep;
    S.a_ready(cur);
    PG8_STAGE(PG8_SB(0, 0), cB, voffB); PG8_STAGE(PG8_SA(0, 0), cA, voffA); PG8_STAGE(PG8_SB(0, 1), cB + hstep, voffB); PG8_STAGE(PG8_SA(0, 1), cA + hstep, voffA);
    if (wr == 1) PG8_BAR;
    PG8_WAIT_V(4); PG8_BAR;
    PG8_STAGE(PG8_SB(1, 0), cB + kstep, voffB); PG8_STAGE(PG8_SA(1, 0), cA + kstep, voffA); PG8_STAGE(PG8_SB(1, 1), cB + hstep + kstep, voffB);
    PG8_WAIT_V(6); PG8_BAR;
    PG8_STAMP();
    for (;;) {
        const bool has_next = S.next(ui + 1, nxt);
        const char* nA = has_next ? (const char*)g.A + (size_t)nxt.pm * tstep : cA; const char* nB = has_next ? (const char*)g.Bt + (size_t)nxt.pn * tstep : cB;
        for (int t = 0; t < nt; t += 2) {
            const bool last = (t == nt - 2);
            const char* a1 = cA + (size_t)(t + 1) * kstep;
            const char* a2 = last ? nA : cA + (size_t)(t + 2) * kstep; const char* b2 = last ? nB : cB + (size_t)(t + 2) * kstep;
            const char* a3 = a2 + kstep; const char* b3 = b2 + kstep;
            if (last && has_next) S.a_ready(nxt);
            PG8_LDB(B0, 0, 0); PG8_SCHED; PG8_LDA(At, 0, 0); PG8_STAGE(PG8_SA(1, 1), a1 + hstep, voffA);
            PG8_WAIT_L(8); PG8_BAR; PG8_WAIT_L(0); PG8_MMA(0, 0, At, B0); PG8_BAR; PG8_SCHED;
            PG8_LDB(B1, 0, 1); PG8_STAGE(PG8_SB(0, 0), b2, voffB);
            PG8_BAR; PG8_WAIT_L(0); PG8_MMA(0, 1, At, B1); PG8_BAR;
            PG8_LDA(At, 0, 1); PG8_STAGE(PG8_SA(0, 0), a2, voffA);
            PG8_BAR; PG8_WAIT_L(0); PG8_MMA(1, 0, At, B0); PG8_BAR; PG8_SCHED;
            PG8_STAGE(PG8_SB(0, 1), b2 + hstep, voffB);
            PG8_WAIT_V(6); PG8_BAR; PG8_MMA(1, 1, At, B1); PG8_BAR;
            PG8_LDB(B0, 1, 0); PG8_SCHED; PG8_LDA(At, 1, 0); PG8_STAGE(PG8_SA(0, 1), a2 + hstep, voffA);
            PG8_WAIT_L(8); PG8_BAR; PG8_WAIT_L(0); PG8_MMA(0, 0, At, B0); PG8_BAR; PG8_SCHED;
            PG8_LDB(B1, 1, 1); PG8_STAGE(PG8_SB(1, 0), b3, voffB);
            PG8_BAR; PG8_WAIT_L(0); PG8_MMA(0, 1, At, B1); PG8_BAR;
            PG8_LDA(At, 1, 1); PG8_STAGE(PG8_SA(1, 0), a3, voffA);
            PG8_BAR; PG8_WAIT_L(0); PG8_MMA(1, 0, At, B0); PG8_BAR; PG8_SCHED;
            PG8_STAGE(PG8_SB(1, 1), b3 + hstep, voffB);
            PG8_WAIT_V(6); PG8_BAR; PG8_MMA(1, 1, At, B1); PG8_BAR;
        }
        PG8_STAMP();
        if constexpr (!Epi::AFTER_DRAIN) { E(acc, cur, wr, wc, fr, fq); S.done(cur); }
        PG8_STAMP();
        if (!has_next) break;
#pragma unroll
        for (int a = 0; a < 2; ++a)
#pragma unroll
            for (int b = 0; b < 2; ++b)
#pragma unroll
                for (int m = 0; m < 4; ++m)
#pragma unroll
                    for (int n = 0; n < 2; ++n) acc[a][b][m][n] = (f32x4){0.f, 0.f, 0.f, 0.f};
        cur = nxt; cA = nA; cB = nB; ++ui;
    }
    PG8_WAIT_V(0);
    if (wr == 0) PG8_BAR;
    PG8_BAR;
    if constexpr (Epi::AFTER_DRAIN) { E.fused(acc, cur, wr, wc, fr, fq, lds, wid, lane); S.done(cur); }
    PG8_STAMP();
    if (STAMP && wid == 0) { stamps[lane] = lane < nts ? (((unsigned long long)(unsigned)ts_hi << 32) | (unsigned)ts_lo) : 0ull;
        if (lane == 62) stamps[62] = rt_entry; if (lane == 63) stamps[63] = (unsigned long long)wall_clock64(); }
#undef PG8_STAMP
#undef PG8_SA
#undef PG8_SB
#undef PG8_STAGE
#undef PG8_LDA
#undef PG8_LDB
#undef PG8_MMA
#undef PG8_WAIT_V
#undef PG8_WAIT_L
#undef PG8_BAR
#undef PG8_SCHED
}
}

using pg8::bf16_t; using pg8::bf16x8; using pg8::f32x4; using pg8::Unit; using pg8::cvt_pk_bf16;
#define DI __device__ __forceinline__
constexpr int TOK = 16384, SEQ = 8192, DM = 1024, HS = 3336, DFF = 2816;
constexpr size_t O_CTL = 0, O_CD = 256, O_AUX = 4352, O_ROPE = 528640, O_FC = 2625792, O_WT = 3150080;
constexpr size_t O_WT_IN = O_WT, O_WT_OUT = O_WT_IN + 7340032, O_WT_UP = O_WT_OUT + 2097152, O_WT_DN = O_WT_UP + 11534336, O_WT_LR = O_WT_DN + 5767168;
constexpr size_t O_XN = O_WT + 27525120, O_R1 = O_XN + 33554432;
constexpr size_t O_H = O_R1, O_ST = O_R1 + 109314048, O_YG = O_ST + 33554432;
constexpr size_t O_G = O_R1, O_U = O_R1 + 92274688;
constexpr size_t O_LW = O_R1 + 109314048, O_KN = O_LW + 50331648, O_VT = O_KN + 16777216, O_AP = O_VT + 16777216;
constexpr size_t O_KNRM = O_AP + 8388608;
constexpr size_t O_BAR = O_KNRM + 524288;
constexpr size_t WS_NEED = O_BAR + 16384;
constexpr int LDS_BYTES = 131072 + 256;

struct Params {
    const float* x; const float* ev_norm_w; const float* ev_w_in; const float* ev_conv_w; const float* ev_conv_b; const float* ev_dt_bias; const float* ev_a_log;
    const float* ev_d; const float* ev_ssd_norm_w; const float* ev_ret_norm_w; const float* ev_w_out;
    const float* od_norm_w; const float* od_w_in; const float* od_mu; const float* od_w0; const float* od_w_up; const float* od_a0; const float* od_a_up;
    const float* od_g_up; const float* od_k_k; const float* od_k_a; const float* od_r_k; const float* od_ln_w; const float* od_ln_b;
    const float* od_qn_w; const float* od_kn_w; const float* od_f_bias; const float* od_w_out;
    const float* ffn_norm_w; const float* ffn_w_up; const float* ffn_conv_w; const float* ffn_conv_b; const float* ffn_w_down;
    float* out; unsigned char* ws;
};

DI unsigned cvtpk(float lo, float hi) { unsigned r; asm("v_cvt_pk_bf16_f32 %0, %1, %2" : "=v"(r) : "v"(lo), "v"(hi)); return r; }
DI unsigned short f2bf(float f) { return (unsigned short)(cvtpk(f, f) & 0xffffu); }
DI float bf2f(unsigned short b) { return __uint_as_float(((unsigned)b) << 16); }
DI unsigned pack2(float lo, float hi) { return cvtpk(lo, hi); }
DI float bflo(unsigned w) { return __uint_as_float(w << 16); }
DI float bfhi(unsigned w) { return __uint_as_float(w & 0xffff0000u); }
DI void unpack8(const uint4 r, float (&o)[8]) { o[0] = bflo(r.x); o[1] = bfhi(r.x); o[2] = bflo(r.y); o[3] = bfhi(r.y); o[4] = bflo(r.z); o[5] = bfhi(r.z); o[6] = bflo(r.w); o[7] = bfhi(r.w); }
DI uint4 pack8(const float (&o)[8]) { uint4 r; r.x = pack2(o[0], o[1]); r.y = pack2(o[2], o[3]); r.z = pack2(o[4], o[5]); r.w = pack2(o[6], o[7]); return r; }
DI float silu_(float x) { return x * __builtin_amdgcn_rcpf(1.f + __expf(-x)); }
DI float sigm_(float x) { return __builtin_amdgcn_rcpf(1.f + __expf(-x)); }
DI float softplus_(float x) { return fmaxf(x, 0.f) + log1pf(__expf(-fabsf(x))); }
DI bf16x8 ldfrag(const bf16_t* base, int row0, int ld, int k0, int lane) { return *(const bf16x8*)(base + (row0 + (lane & 15)) * ld + k0 + (lane >> 4) * 8); }
#define MFMA16(a, b, c) __builtin_amdgcn_mfma_f32_16x16x32_bf16((a), (b), (c), 0, 0, 0)
DI float red16(float v) { v += __shfl_xor(v, 1); v += __shfl_xor(v, 2); v += __shfl_xor(v, 4); v += __shfl_xor(v, 8); return v; }
DI float max16(float v) { v = fmaxf(v, __shfl_xor(v, 1)); v = fmaxf(v, __shfl_xor(v, 2)); v = fmaxf(v, __shfl_xor(v, 4)); v = fmaxf(v, __shfl_xor(v, 8)); return v; }
DI float red64(float v) { v += __shfl_xor(v, 32); v += __shfl_xor(v, 16); return red16(v); }
DI float dpp_red16(float x) {
    x += __builtin_bit_cast(float, __builtin_amdgcn_update_dpp(0, __builtin_bit_cast(int, x), 0xB1, 0xF, 0xF, true));
    x += __builtin_bit_cast(float, __builtin_amdgcn_update_dpp(0, __builtin_bit_cast(int, x), 0x4E, 0xF, 0xF, true));
    x += __builtin_bit_cast(float, __builtin_amdgcn_update_dpp(0, __builtin_bit_cast(int, x), 0x141, 0xF, 0xF, true));
    x += __builtin_bit_cast(float, __builtin_amdgcn_update_dpp(0, __builtin_bit_cast(int, x), 0x140, 0xF, 0xF, true));
    return x;
}

DI int otid() { int t = threadIdx.x; asm volatile("" : "+v"(t)); return t; }
DI int obid() { int b = blockIdx.x; asm volatile("" : "+s"(b)); return b; }
struct EpiH {
    static constexpr bool PERM = false, AFTER_DRAIN = false;
    bf16_t* H; float* aux; int auxc;
    DI void operator()(const f32x4 (&acc)[2][2][4][2], const Unit& u, int wr, int wc, int fr, int fq) const {
        const int row0 = u.pm * 256 + wr * 64 + fr, col0 = u.pn * 256 + wc * 32 + 4 * fq;
#pragma unroll
        for (int ai = 0; ai < 2; ++ai)
#pragma unroll
            for (int m = 0; m < 4; ++m) { const size_t r = (size_t)(row0 + ai * 128 + m * 16);
#pragma unroll
                for (int bj = 0; bj < 2; ++bj)
#pragma unroll
                    for (int n = 0; n < 2; ++n) { const int c = col0 + bj * 128 + n * 16; const f32x4 v = acc[ai][bj][m][n];
                        if (c < HS) { uint2 w; w.x = cvt_pk_bf16(v[0], v[1]); w.y = cvt_pk_bf16(v[2], v[3]); *(uint2*)(H + r * HS + c) = w;
                            if (c == auxc || c == auxc + 4) *(f32x4*)(aux + r * 8 + (c - auxc)) = v; } } }
    }
};
struct EpiRes {
    static constexpr bool PERM = false, AFTER_DRAIN = false;
    const float* res; float* out;
    DI void operator()(const f32x4 (&acc)[2][2][4][2], const Unit& u, int wr, int wc, int fr, int fq) const {
        const int row0 = u.pm * 256 + wr * 64 + fr, col0 = u.pn * 256 + wc * 32 + 4 * fq;
#pragma unroll
        for (int ai = 0; ai < 2; ++ai)
#pragma unroll
            for (int m = 0; m < 4; ++m) { const size_t r = (size_t)(row0 + ai * 128 + m * 16);
#pragma unroll
                for (int bj = 0; bj < 2; ++bj)
#pragma unroll
                    for (int n = 0; n < 2; ++n) { const int c = col0 + bj * 128 + n * 16;
                        const f32x4 rv = *(const f32x4*)(res + r * DM + c); *(f32x4*)(out + r * DM + c) = rv + acc[ai][bj][m][n]; } }
    }
};
struct EpiGU {
    static constexpr bool PERM = false, AFTER_DRAIN = false;
    bf16_t* G; bf16_t* U;
    DI void operator()(const f32x4 (&acc)[2][2][4][2], const Unit& u, int wr, int wc, int fr, int fq) const {
        const int row0 = u.pm * 256 + wr * 64 + fr, col0 = u.pn * 128 + wc * 32 + 4 * fq;
#pragma unroll
        for (int ai = 0; ai < 2; ++ai)
#pragma unroll
            for (int m = 0; m < 4; ++m) { const size_t r = (size_t)(row0 + ai * 128 + m * 16);
#pragma unroll
                for (int n = 0; n < 2; ++n) { const int c = col0 + n * 16; const f32x4 g = acc[ai][0][m][n], v = acc[ai][1][m][n];
                    uint2 w; w.x = cvt_pk_bf16(g[0], g[1]); w.y = cvt_pk_bf16(g[2], g[3]); *(uint2*)(G + r * DFF + c) = w;
                    w.x = cvt_pk_bf16(v[0], v[1]); w.y = cvt_pk_bf16(v[2], v[3]); *(uint2*)(U + r * DFF + c) = w; } }
    }
};
struct EpiLR {
    static constexpr bool PERM = false, AFTER_DRAIN = false;
    bf16_t* LW; const float* w0; const float* a0;
    DI void operator()(const f32x4 (&acc)[2][2][4][2], const Unit& u, int wr, int wc, int fr, int fq) const {
        const int row0 = u.pm * 256 + wr * 64 + fr, col0 = u.pn * 256 + wc * 32 + 4 * fq;
#pragma unroll
        for (int ai = 0; ai < 2; ++ai)
#pragma unroll
            for (int m = 0; m < 4; ++m) { const size_t r = (size_t)(row0 + ai * 128 + m * 16);
#pragma unroll
                for (int bj = 0; bj < 2; ++bj)
#pragma unroll
                    for (int n = 0; n < 2; ++n) { const int c = col0 + bj * 128 + n * 16; f32x4 v = acc[ai][bj][m][n];
                        if (c < 512) { const f32x4 b = *(const f32x4*)(w0 + c);
#pragma unroll
                            for (int j = 0; j < 4; ++j) v[j] = 1.f - __expf(-0.606531f * sigm_(b[j] + v[j])); }
                        else if (c < 1024) { const f32x4 b = *(const f32x4*)(a0 + c - 512);
#pragma unroll
                            for (int j = 0; j < 4; ++j) v[j] = sigm_(b[j] + v[j]); }
                        uint2 w; w.x = cvt_pk_bf16(v[0], v[1]); w.y = cvt_pk_bf16(v[2], v[3]); *(uint2*)(LW + r * 1536 + c) = w; } }
    }
};
template <class Epi> DI void run_gemm(unsigned char* smem, const bf16_t* A, const bf16_t* Bt, int N, int K, const Epi& E) {
    pg8::Gemm g; g.A = A; g.Bt = Bt; g.M = TOK; g.N = N; g.K = K;
    pg8::StaticOrder S; S.init(TOK, N, (int)gridDim.x, obid());
    pg8::gemm_phase<Epi, pg8::StaticOrder, false>((PG8_LAS unsigned char*)smem, g, S, E, nullptr);
}

DI void conv_tile4(const float* W, int Nsrc, int K, bf16_t* Wt, int nd0, int sc0, int nvalid, int k0, float* tile) {
    const int tid = otid(), j = tid & 63, kb = tid >> 6;
    float v[32];
#pragma unroll
    for (int i = 0; i < 32; ++i) { const int kk = kb + 8 * i; v[i] = (j < nvalid) ? W[(size_t)(k0 + kk) * Nsrc + sc0 + j] : 0.f; }
#pragma unroll
    for (int i = 0; i < 32; ++i) { const int kk = kb + 8 * i; tile[kk * 65 + j] = v[i]; }
    __syncthreads();
    const int nl = tid >> 3, ks = (tid & 7) * 8;
#pragma unroll
    for (int q = 0; q < 4; ++q) { const float* tq = tile + q * 64 * 65; uint4 o;
        o.x = pack2(tq[(ks + 0) * 65 + nl], tq[(ks + 1) * 65 + nl]); o.y = pack2(tq[(ks + 2) * 65 + nl], tq[(ks + 3) * 65 + nl]);
        o.z = pack2(tq[(ks + 4) * 65 + nl], tq[(ks + 5) * 65 + nl]); o.w = pack2(tq[(ks + 6) * 65 + nl], tq[(ks + 7) * 65 + nl]);
        *(uint4*)(Wt + (size_t)(nd0 + nl) * K + k0 + q * 64 + ks) = o; }
    __syncthreads();
}
DI void phase_weights(const Params& p, unsigned char* smem, int layer, int part) {
    float* tile = (float*)smem;
    const float* w_in = layer ? p.od_w_in : p.ev_w_in; const float* w_out = layer ? p.od_w_out : p.ev_w_out;
    const float* w_up = p.ffn_w_up + (size_t)layer * DM * 2 * DFF; const float* w_dn = p.ffn_w_down + (size_t)layer * DFF * DM;
    bf16_t* t_in = (bf16_t*)(p.ws + O_WT_IN); bf16_t* t_out = (bf16_t*)(p.ws + O_WT_OUT); bf16_t* t_up = (bf16_t*)(p.ws + O_WT_UP); bf16_t* t_dn = (bf16_t*)(p.ws + O_WT_DN);
    if (part == 0) {
        for (int job = obid(); job < 288; job += gridDim.x) {
            if (job < 224) { const int nt = job >> 2, kt = job & 3, nd0 = nt * 64; int nv = HS - nd0; nv = nv < 0 ? 0 : (nv > 64 ? 64 : nv);
                conv_tile4(w_in, HS, 1024, t_in, nd0, nd0, nv, kt * 256, tile); }
            else { const int j2 = job - 224, nt = j2 >> 2, kt = j2 & 3; conv_tile4(w_out, 1024, 1024, t_out, nt * 64, nt * 64, 64, kt * 256, tile); }
        }
    } else {
        const int nb = (int)gridDim.x - 128, lb = obid() - 128;
        if (lb < 0) return;
        if (part == 1) { for (int job = lb; job < 352; job += nb) { const int nt = job >> 2, kt = job & 3, nd0 = nt * 64; const int pn = nd0 >> 8, bj = (nd0 >> 7) & 1, j0 = nd0 & 127;
                conv_tile4(w_up, 2 * DFF, 1024, t_up, nd0, bj * DFF + 128 * pn + j0, 64, kt * 256, tile); } }
        else { for (int job = lb; job < 176; job += nb) { const int nt = job / 11, kt = job % 11; conv_tile4(w_dn, 1024, DFF, t_dn, nt * 64, nt * 64, 64, kt * 256, tile); } }
        return;
    }
    const int gtid = obid() * 512 + otid(), gsz = gridDim.x * 512;
    if (layer == 0) {
        float* rc = (float*)(p.ws + O_ROPE); float* rs = rc + SEQ * 32;
        for (int idx = gtid; idx < SEQ * 32; idx += gsz) { const int pos = idx >> 5, i = idx & 31;
            const float inv = (float)exp(-(double)i * (9.210340371976184 / 32.0)); const float ang = (float)pos * inv;
            const double a = (double)ang; const double n = rint(a * 0.15915494309189535); const double r = a - n * 6.283185307179586; const double r2 = r * r;
            double sn = 1.0 / 121645100408832000.0, cs = 1.0 / 2432902008176640000.0;
            sn = sn * r2 - 1.0 / 355687428096000.0; sn = sn * r2 + 1.0 / 1307674368000.0; sn = sn * r2 - 1.0 / 6227020800.0; sn = sn * r2 + 1.0 / 39916800.0;
            sn = sn * r2 - 1.0 / 362880.0; sn = sn * r2 + 1.0 / 5040.0; sn = sn * r2 - 1.0 / 120.0; sn = sn * r2 + 1.0 / 6.0; sn = sn * r2 * -1.0 + 1.0; sn = sn * r;
            cs = cs * r2 - 1.0 / 6402373705728000.0; cs = cs * r2 + 1.0 / 20922789888000.0; cs = cs * r2 - 1.0 / 87178291200.0; cs = cs * r2 + 1.0 / 479001600.0;
            cs = cs * r2 - 1.0 / 3628800.0; cs = cs * r2 + 1.0 / 40320.0; cs = cs * r2 - 1.0 / 720.0; cs = cs * r2 + 1.0 / 24.0; cs = cs * r2 - 0.5; cs = cs * r2 + 1.0;
            rc[idx] = (float)cs; rs[idx] = (float)sn; }
    } else {
        bf16_t* t_lr = (bf16_t*)(p.ws + O_WT_LR);
        for (int idx = gtid; idx < 1536 * 256; idx += gsz) { const int n = idx >> 8, k = idx & 255; float v = 0.f;
            if (n < 512) { if (k < 64) v = p.od_w_up[k * 512 + n]; }
            else if (n < 1024) { if (k >= 64 && k < 128) v = p.od_a_up[(k - 64) * 512 + n - 512]; }
            else { if (k >= 128) v = p.od_g_up[(k - 128) * 512 + n - 1024]; }
            t_lr[idx] = f2bf(v); }
    }
}
DI void phase_rmsnorm(const float* x, const float* w, bf16_t* xn) {
    const int lane = otid() & 63, wv = otid() >> 6;
    for (int r = obid() * 8 + wv; r < TOK; r += gridDim.x * 8) {
        const float* xr = x + (size_t)r * DM; f32x4 v[4]; float ss = 0.f;
#pragma unroll
        for (int i = 0; i < 4; ++i) { v[i] = *(const f32x4*)(xr + i * 256 + lane * 4); ss += v[i][0] * v[i][0] + v[i][1] * v[i][1] + v[i][2] * v[i][2] + v[i][3] * v[i][3]; }
        ss = red64(ss); const float rstd = rsqrtf(ss * (1.f / DM) + 1e-6f);
#pragma unroll
        for (int i = 0; i < 4; ++i) { const f32x4 ww = *(const f32x4*)(w + i * 256 + lane * 4); uint2 o; o.x = pack2(v[i][0] * rstd * ww[0], v[i][1] * rstd * ww[1]); o.y = pack2(v[i][2] * rstd * ww[2], v[i][3] * rstd * ww[3]);
            *(uint2*)(xn + (size_t)r * DM + i * 256 + lane * 4) = o; }
    }
}
DI void ssd_conv8(const Params& p, const bf16_t* H, int b, int t, int ch, float (&o)[8]) {
    const bf16_t* base = H + (size_t)b * SEQ * HS + 512 + ch;
    const int t0 = t - 3 < 0 ? 0 : t - 3, t1 = t - 2 < 0 ? 0 : t - 2, t2 = t - 1 < 0 ? 0 : t - 1;
    const uint4 r0 = *(const uint4*)(base + (size_t)t0 * HS), r1 = *(const uint4*)(base + (size_t)t1 * HS), r2 = *(const uint4*)(base + (size_t)t2 * HS), r3 = *(const uint4*)(base + (size_t)t * HS);
    const float m0 = t >= 3 ? 1.f : 0.f, m1 = t >= 2 ? 1.f : 0.f, m2 = t >= 1 ? 1.f : 0.f;
    float acc[8], xv[8];
    { const f32x4 b0 = *(const f32x4*)(p.ev_conv_b + ch), b1 = *(const f32x4*)(p.ev_conv_b + ch + 4);
      acc[0] = b0[0]; acc[1] = b0[1]; acc[2] = b0[2]; acc[3] = b0[3]; acc[4] = b1[0]; acc[5] = b1[1]; acc[6] = b1[2]; acc[7] = b1[3]; }
#define SSD_TAP(k, raw, msk) { unpack8(raw, xv); const f32x4 w0 = *(const f32x4*)(p.ev_conv_w + (k) * 768 + ch) * (msk), w1 = *(const f32x4*)(p.ev_conv_w + (k) * 768 + ch + 4) * (msk); \
        acc[0] += w0[0] * xv[0]; acc[1] += w0[1] * xv[1]; acc[2] += w0[2] * xv[2]; acc[3] += w0[3] * xv[3]; acc[4] += w1[0] * xv[4]; acc[5] += w1[1] * xv[5]; acc[6] += w1[2] * xv[6]; acc[7] += w1[3] * xv[7]; }
    SSD_TAP(0, r0, m0) SSD_TAP(1, r1, m1) SSD_TAP(2, r2, m2) SSD_TAP(3, r3, 1.f)
#pragma unroll
    for (int e = 0; e < 8; ++e) o[e] = silu_(acc[e]);
}
DI float ret_lg(int hh) { return log1pf(-exp2f(-5.f - (float)hh)); }
DI void chunk_decay(const Params& p, int mixer, int b, int hh, int t0, float* acs, float* dts) {
    const int tid = otid(), lane = tid & 63; const float* aux = (const float*)(p.ws + O_AUX);
    float v = 0.f;
    if (tid < 128) {
        if (mixer == 0) { const float dt = softplus_(aux[((size_t)b * SEQ + t0 + tid) * 8 + hh] + p.ev_dt_bias[hh]); dts[tid] = dt; v = -expf(p.ev_a_log[hh]) * dt; }
        else { dts[tid] = 1.f; v = ret_lg(hh); }
    }
#pragma unroll
    for (int off = 1; off < 64; off <<= 1) { const float t = __shfl_up(v, off); if (lane >= off) v += t; }
    if (tid == 63) acs[256] = v;
    __syncthreads();
    if (tid >= 64 && tid < 128) v += acs[256];
    if (tid < 128) acs[tid] = v;
    __syncthreads();
}
DI void phase_m1(const Params& p, unsigned char* smem) {
    bf16_t* Kt = (bf16_t*)smem; bf16_t* Vt = (bf16_t*)(smem + 17408); float* acs = (float*)(smem + 34816); float* dts = acs + 128;
    const bf16_t* H = (const bf16_t*)(p.ws + O_H); float* ST = (float*)(p.ws + O_ST); float* CD = (float*)(p.ws + O_CD);
    const float* rc = (const float*)(p.ws + O_ROPE); const float* rs = rc + SEQ * 32;
    const int tid = otid(), lane = tid & 63, w = tid >> 6;
    for (int u = obid(); u < 2048; u += gridDim.x) {
        const int mixer = u >> 10, bh = (u >> 6) & 15, c = u & 63, b = bh >> 3, hh = bh & 7, t0 = c * 128;
        chunk_decay(p, mixer, b, hh, t0, acs, dts);
        const float aend = acs[127];
        if (mixer == 0) {
#pragma unroll
            for (int it = 0; it < 2; ++it) { const int g = tid + it * 512, s = g >> 3, c8 = (g & 7) * 8; float o[8];
                const float sc = __expf(aend - acs[s]) * dts[s];
                ssd_conv8(p, H, b, t0 + s, 512 + (hh >> 2) * 64 + c8, o);
#pragma unroll
                for (int e = 0; e < 8; ++e) Kt[(c8 + e) * 136 + s] = f2bf(o[e] * sc);
                ssd_conv8(p, H, b, t0 + s, hh * 64 + c8, o);
#pragma unroll
                for (int e = 0; e < 8; ++e) Vt[(c8 + e) * 136 + s] = f2bf(o[e]); }
            if (tid == 0) CD[bh * 64 + c] = __expf(aend);
        } else {
            { const int s = tid >> 2, i0 = (tid & 3) * 8; const size_t r = (size_t)b * SEQ + t0 + s; float k1[8], k2[8];
              unpack8(*(const uint4*)(H + r * HS + 1800 + hh * 64 + i0), k1); unpack8(*(const uint4*)(H + r * HS + 1800 + hh * 64 + 32 + i0), k2);
              const float sc = __expf(aend - acs[s]) * 0.125f;
#pragma unroll
              for (int e = 0; e < 8; ++e) { const float cs = rc[(t0 + s) * 32 + i0 + e], sn = rs[(t0 + s) * 32 + i0 + e];
                  Kt[(i0 + e) * 136 + s] = f2bf((k1[e] * cs - k2[e] * sn) * sc); Kt[(32 + i0 + e) * 136 + s] = f2bf((k1[e] * sn + k2[e] * cs) * sc); } }
#pragma unroll
            for (int it = 0; it < 2; ++it) { const int g = tid + it * 512, s = g >> 3, c8 = (g & 7) * 8; const size_t r = (size_t)b * SEQ + t0 + s; float v[8];
                unpack8(*(const uint4*)(H + r * HS + 2312 + hh * 64 + c8), v);
#pragma unroll
                for (int e = 0; e < 8; ++e) Vt[(c8 + e) * 136 + s] = (unsigned short)f2bf(v[e]); }
        }
        __syncthreads();
        { const int mt = w & 3, nt0 = (w >> 2) * 2; f32x4 a0 = {0.f, 0.f, 0.f, 0.f}, a1 = {0.f, 0.f, 0.f, 0.f};
#pragma unroll
          for (int ks = 0; ks < 4; ++ks) { const bf16x8 af = ldfrag(Kt, mt * 16, 136, ks * 32, lane);
              a0 = MFMA16(af, ldfrag(Vt, nt0 * 16, 136, ks * 32, lane), a0); a1 = MFMA16(af, ldfrag(Vt, nt0 * 16 + 16, 136, ks * 32, lane), a1); }
          float* dst = ST + (size_t)u * 4096 + mt * 16 + (lane >> 4) * 4;
          *(f32x4*)(dst + (nt0 * 16 + (lane & 15)) * 64) = a0; *(f32x4*)(dst + (nt0 * 16 + 16 + (lane & 15)) * 64) = a1; }
        __syncthreads();
    }
}
DI void phase_m2(const Params& p) {
    float* ST = (float*)(p.ws + O_ST); const float* CD = (const float*)(p.ws + O_CD);
    for (int idx = obid() * 512 + otid(); idx < 32 * 4096; idx += gridDim.x * 512) {
        const int mb = idx >> 12, e = idx & 4095, mixer = mb >> 4, bh = mb & 15; float run = 0.f;
        const float gdec = __expf(128.f * ret_lg(bh & 7));
#pragma unroll 8
        for (int c = 0; c < 64; ++c) { const size_t o = ((size_t)(mb * 64 + c)) * 4096 + e; const float v = ST[o]; ST[o] = run;
            const float dec = mixer == 0 ? CD[bh * 64 + c] : gdec; run = run * dec + v; }
    }
}
template <int MIXER> DI void m3_head(const Params& p, unsigned char* smem, int b, int c, int hh, float (&ssq)[4]) {
    bf16_t* Qs = (bf16_t*)smem; bf16_t* Ks = (bf16_t*)(smem + 18432); bf16_t* Vt = (bf16_t*)(smem + 36864); bf16_t* Rt = (bf16_t*)(smem + 54272); bf16_t* Ps = (bf16_t*)(smem + 63488);
    float* acs = (float*)(smem + 98304); float* dts = acs + 128;
    const bf16_t* H = (const bf16_t*)(p.ws + O_H); const float* ST = (const float*)(p.ws + O_ST); float* YG = (float*)(p.ws + O_YG); bf16_t* Y = (bf16_t*)(p.ws + O_XN);
    const float* rc = (const float*)(p.ws + O_ROPE); const float* rs = rc + SEQ * 32;
    const int tid = otid(), lane = tid & 63, w = tid >> 6, t0 = c * 128, bh = b * 8 + hh;
    const size_t u = (size_t)((MIXER * 16 + bh) * 64 + c);
    __syncthreads();
    chunk_decay(p, MIXER, b, hh, t0, acs, dts);
    if (MIXER == 0) {
#pragma unroll
        for (int it = 0; it < 2; ++it) { const int g = tid + it * 512, s = g >> 3, c8 = (g & 7) * 8; float o[8];
            ssd_conv8(p, H, b, t0 + s, 640 + (hh >> 2) * 64 + c8, o); *(uint4*)(Qs + s * 72 + c8) = pack8(o);
            ssd_conv8(p, H, b, t0 + s, 512 + (hh >> 2) * 64 + c8, o); *(uint4*)(Ks + s * 72 + c8) = pack8(o);
            ssd_conv8(p, H, b, t0 + s, hh * 64 + c8, o);
#pragma unroll
            for (int e = 0; e < 8; ++e) Vt[(c8 + e) * 136 + s] = f2bf(o[e]); }
    } else {
        { const int s = tid >> 2, i0 = (tid & 3) * 8; const size_t r = (size_t)b * SEQ + t0 + s; float a1[8], a2[8], o1[8], o2[8];
          unpack8(*(const uint4*)(H + r * HS + 1288 + hh * 64 + i0), a1); unpack8(*(const uint4*)(H + r * HS + 1288 + hh * 64 + 32 + i0), a2);
#pragma unroll
          for (int e = 0; e < 8; ++e) { const float cs = rc[(t0 + s) * 32 + i0 + e], sn = rs[(t0 + s) * 32 + i0 + e]; o1[e] = a1[e] * cs - a2[e] * sn; o2[e] = a1[e] * sn + a2[e] * cs; }
          *(uint4*)(Qs + s * 72 + i0) = pack8(o1); *(uint4*)(Qs + s * 72 + 32 + i0) = pack8(o2);
          unpack8(*(const uint4*)(H + r * HS + 1800 + hh * 64 + i0), a1); unpack8(*(const uint4*)(H + r * HS + 1800 + hh * 64 + 32 + i0), a2);
#pragma unroll
          for (int e = 0; e < 8; ++e) { const float cs = rc[(t0 + s) * 32 + i0 + e], sn = rs[(t0 + s) * 32 + i0 + e]; o1[e] = (a1[e] * cs - a2[e] * sn) * 0.125f; o2[e] = (a1[e] * sn + a2[e] * cs) * 0.125f; }
          *(uint4*)(Ks + s * 72 + i0) = pack8(o1); *(uint4*)(Ks + s * 72 + 32 + i0) = pack8(o2); }
#pragma unroll
        for (int it = 0; it < 2; ++it) { const int g = tid + it * 512, s = g >> 3, c8 = (g & 7) * 8; const size_t r = (size_t)b * SEQ + t0 + s;
            const uint4 raw = *(const uint4*)(H + r * HS + 2312 + hh * 64 + c8); const unsigned short* rv = (const unsigned short*)&raw;
#pragma unroll
            for (int e = 0; e < 8; ++e) Vt[(c8 + e) * 136 + s] = rv[e]; }
    }
    { const int pr = tid >> 3, n8 = (tid & 7) * 8; const float* src = ST + u * 4096 + pr * 64 + n8; const f32x4 x0 = *(const f32x4*)src, x1 = *(const f32x4*)(src + 4);
      uint4 o; o.x = pack2(x0[0], x0[1]); o.y = pack2(x0[2], x0[3]); o.z = pack2(x1[0], x1[1]); o.w = pack2(x1[2], x1[3]); *(uint4*)(Rt + pr * 72 + n8) = o; }
    __syncthreads();
    const int nks = (w >> 1) + 1;
    const int lrow = 16 * w + (lane >> 4) * 4;
    {
        const bf16x8 q0 = ldfrag(Qs, 16 * w, 72, 0, lane), q1 = ldfrag(Qs, 16 * w, 72, 32, lane);
        float al[4];
#pragma unroll
        for (int j = 0; j < 4; ++j) al[j] = acs[lrow + j];
        for (int nt = 0; nt < 2 * nks; ++nt) { f32x4 sacc = {0.f, 0.f, 0.f, 0.f};
            sacc = MFMA16(q0, ldfrag(Ks, nt * 16, 72, 0, lane), sacc); sacc = MFMA16(q1, ldfrag(Ks, nt * 16, 72, 32, lane), sacc);
            const int s = nt * 16 + (lane & 15); const float as = acs[s], ds = dts[s];
#pragma unroll
            for (int j = 0; j < 4; ++j) { const float pv = (s <= lrow + j) ? sacc[j] * __expf(al[j] - as) * ds : 0.f; Ps[(lrow + j) * 136 + s] = f2bf(pv); } }
    }
    __syncthreads();
    f32x4 yd[4], yo[4];
#pragma unroll
    for (int nt = 0; nt < 4; ++nt) { yd[nt] = (f32x4){0.f, 0.f, 0.f, 0.f}; yo[nt] = (f32x4){0.f, 0.f, 0.f, 0.f}; }
    for (int ks = 0; ks < nks; ++ks) { const bf16x8 pf = ldfrag(Ps, 16 * w, 136, ks * 32, lane);
#pragma unroll
        for (int nt = 0; nt < 4; ++nt) yd[nt] = MFMA16(pf, ldfrag(Vt, nt * 16, 136, ks * 32, lane), yd[nt]); }
#pragma unroll
    for (int ks = 0; ks < 2; ++ks) { const bf16x8 qf = ldfrag(Qs, 16 * w, 72, ks * 32, lane);
#pragma unroll
        for (int nt = 0; nt < 4; ++nt) yo[nt] = MFMA16(qf, ldfrag(Rt, nt * 16, 72, ks * 32, lane), yo[nt]); }
    float ea[4];
#pragma unroll
    for (int j = 0; j < 4; ++j) ea[j] = __expf(acs[lrow + j]);
    if (MIXER == 0) {
        const float dsk = p.ev_d[hh];
#pragma unroll
        for (int nt = 0; nt < 4; ++nt) { const int pc = nt * 16 + (lane & 15);
#pragma unroll
            for (int j = 0; j < 4; ++j) { const size_t r = (size_t)b * SEQ + t0 + lrow + j;
                const float y = yd[nt][j] + ea[j] * yo[nt][j] + dsk * bf2f(Vt[pc * 136 + lrow + j]);
                const float z = bf2f(H[r * HS + hh * 64 + pc]); const float yg = y * silu_(z); ssq[j] += yg * yg; YG[r * 512 + hh * 64 + pc] = yg; } }
    } else {
        float s2[4];
#pragma unroll
        for (int j = 0; j < 4; ++j) { float a = 0.f;
#pragma unroll
            for (int nt = 0; nt < 4; ++nt) { const float y = yd[nt][j] + ea[j] * yo[nt][j]; yd[nt][j] = y; a += y * y; }
            s2[j] = rsqrtf(red16(a) * (1.f / 64.f) + 1e-6f); }
#pragma unroll
        for (int nt = 0; nt < 4; ++nt) { const int pc = nt * 16 + (lane & 15); const float nw = p.ev_ret_norm_w[hh * 64 + pc];
#pragma unroll
            for (int j = 0; j < 4; ++j) { const size_t r = (size_t)b * SEQ + t0 + lrow + j; const float g = bf2f(H[r * HS + 2824 + hh * 64 + pc]);
                Y[r * DM + 512 + hh * 64 + pc] = f2bf(silu_(g) * yd[nt][j] * s2[j] * nw); } }
    }
}
DI void phase_m3(const Params& p, unsigned char* smem) {
    const int lane = otid() & 63, w = otid() >> 6;
    for (int u = obid(); u < 256; u += gridDim.x) {
        const int mixer = u >> 7, b = (u >> 6) & 1, c = u & 63; float ssq[4] = {0.f, 0.f, 0.f, 0.f};
        if (mixer == 0) {
            for (int hh = 0; hh < 8; ++hh) m3_head<0>(p, smem, b, c, hh, ssq);
            float* YG = (float*)(p.ws + O_YG); bf16_t* Y = (bf16_t*)(p.ws + O_XN); const int lrow = 16 * w + (lane >> 4) * 4;
            float rstd[4];
#pragma unroll
            for (int j = 0; j < 4; ++j) rstd[j] = rsqrtf(red16(ssq[j]) * (1.f / 512.f) + 1e-6f);
            for (int cc = 0; cc < 32; ++cc) { const int col = cc * 16 + (lane & 15); const float nw = p.ev_ssd_norm_w[col];
#pragma unroll
                for (int j = 0; j < 4; ++j) { const size_t r = (size_t)b * SEQ + c * 128 + lrow + j;
                    const float v = __hip_atomic_load(YG + r * 512 + col, __ATOMIC_RELAXED, __HIP_MEMORY_SCOPE_AGENT); Y[r * DM + col] = f2bf(v * rstd[j] * nw); } }
        } else {
            for (int hh = 0; hh < 8; ++hh) m3_head<1>(p, smem, b, c, hh, ssq);
        }
    }
}
DI void phase_ffn_act(const Params& p, int layer) {
    const bf16_t* G = (const bf16_t*)(p.ws + O_G); bf16_t* U = (bf16_t*)(p.ws + O_U);
    const float* cw = p.ffn_conv_w + (size_t)layer * 3 * DFF; const float* cb = p.ffn_conv_b + (size_t)layer * DFF;
    for (int idx = obid() * 512 + otid(); idx < TOK * (DFF / 8); idx += gridDim.x * 512) {
        const int r = idx / (DFF / 8), c8 = (idx % (DFF / 8)) * 8, t = r & (SEQ - 1);
        float acc[8], g[8], uv[8];
        { const f32x4 b0 = *(const f32x4*)(cb + c8), b1 = *(const f32x4*)(cb + c8 + 4); acc[0] = b0[0]; acc[1] = b0[1]; acc[2] = b0[2]; acc[3] = b0[3]; acc[4] = b1[0]; acc[5] = b1[1]; acc[6] = b1[2]; acc[7] = b1[3]; }
        { const int ra = t >= 2 ? r - 2 : r, rb2 = t >= 1 ? r - 1 : r; const float ma = t >= 2 ? 1.f : 0.f, mb = t >= 1 ? 1.f : 0.f;
          const uint4 g0 = *(const uint4*)(G + (size_t)ra * DFF + c8), g1 = *(const uint4*)(G + (size_t)rb2 * DFF + c8), g2 = *(const uint4*)(G + (size_t)r * DFF + c8);
#define ACT_TAP(k, raw, msk) { unpack8(raw, g); const f32x4 w0 = *(const f32x4*)(cw + (k) * DFF + c8) * (msk), w1 = *(const f32x4*)(cw + (k) * DFF + c8 + 4) * (msk); \
            acc[0] += w0[0] * g[0]; acc[1] += w0[1] * g[1]; acc[2] += w0[2] * g[2]; acc[3] += w0[3] * g[3]; acc[4] += w1[0] * g[4]; acc[5] += w1[1] * g[5]; acc[6] += w1[2] * g[6]; acc[7] += w1[3] * g[7]; }
          ACT_TAP(0, g0, ma) ACT_TAP(1, g1, mb) ACT_TAP(2, g2, 1.f) }
        unpack8(*(const uint4*)(U + (size_t)r * DFF + c8), uv);
#pragma unroll
        for (int e = 0; e < 8; ++e) acc[e] = silu_(acc[e]) * uv[e];
        *(uint4*)(U + (size_t)r * DFF + c8) = pack8(acc);
    }
}
DI void phase_l1_prep(const Params& p, unsigned char* smem) {
    const bf16_t* H = (const bf16_t*)(p.ws + O_H); const float* aux = (const float*)(p.ws + O_AUX); float* FC = (float*)(p.ws + O_FC);
    bf16_t* KN = (bf16_t*)(p.ws + O_KN); bf16_t* VT = (bf16_t*)(p.ws + O_VT); bf16_t* AP = (bf16_t*)(p.ws + O_AP);
    const int tid = otid();
    for (int u = obid(); u < 16 + 1024; u += gridDim.x) {
        __syncthreads();
        if (u < 16) {
            float* tot = (float*)smem; const int bh = u, b = bh >> 3, hh = bh & 7; const float fb = p.od_f_bias[hh]; float loc[16]; float run = 0.f;
#pragma unroll
            for (int i = 0; i < 16; ++i) { const float xv = aux[((size_t)b * SEQ + tid * 16 + i) * 8 + hh] + fb; run += -softplus_(-xv); loc[i] = run; }
            tot[tid] = run; __syncthreads();
            float off = 0.f; for (int i = 0; i < tid; ++i) off += tot[i];
#pragma unroll
            for (int i = 0; i < 16; ++i) FC[(size_t)bh * SEQ + tid * 16 + i] = off + loc[i];
        } else {
            bf16_t* Vl = (bf16_t*)smem; const int v2 = u - 16, bh = v2 >> 6, blk = v2 & 63, b = bh >> 3, hh = bh & 7, t0 = blk * 128;
            { const int l = tid >> 2, c16 = (tid & 3) * 16; const size_t r = (size_t)b * SEQ + t0 + l; float a[8], c[8];
              unpack8(*(const uint4*)(H + r * HS + 2304 + hh * 64 + c16), a); unpack8(*(const uint4*)(H + r * HS + 2304 + hh * 64 + c16 + 8), c);
              float ss = 0.f;
#pragma unroll
              for (int e = 0; e < 8; ++e) ss += a[e] * a[e] + c[e] * c[e];
              ss += __shfl_xor(ss, 1); ss += __shfl_xor(ss, 2); const float rstd = rsqrtf(ss * (1.f / 64.f) + 1e-6f);
#pragma unroll
              for (int e = 0; e < 8; ++e) { a[e] *= rstd * p.od_kn_w[c16 + e]; c[e] *= rstd * p.od_kn_w[c16 + 8 + e]; }
              bf16_t* dst = KN + ((size_t)bh * SEQ + t0 + l) * 64 + c16; *(uint4*)dst = pack8(a); *(uint4*)(dst + 8) = pack8(c); }
#pragma unroll
            for (int it = 0; it < 2; ++it) { const int g = tid + it * 512, s = g >> 3, c8 = (g & 7) * 8; const size_t r = (size_t)b * SEQ + t0 + s;
                *(uint4*)(Vl + s * 72 + c8) = *(const uint4*)(H + r * HS + 2816 + hh * 64 + c8); }
            __syncthreads();
#pragma unroll
            for (int it = 0; it < 2; ++it) { const int g = tid + it * 512, e = g >> 4, s8 = (g & 15) * 8; uint4 o;
                o.x = (unsigned)Vl[(s8 + 0) * 72 + e] | ((unsigned)Vl[(s8 + 1) * 72 + e] << 16); o.y = (unsigned)Vl[(s8 + 2) * 72 + e] | ((unsigned)Vl[(s8 + 3) * 72 + e] << 16);
                o.z = (unsigned)Vl[(s8 + 4) * 72 + e] | ((unsigned)Vl[(s8 + 5) * 72 + e] << 16); o.w = (unsigned)Vl[(s8 + 6) * 72 + e] | ((unsigned)Vl[(s8 + 7) * 72 + e] << 16);
                *(uint4*)(VT + ((size_t)bh * 64 + e) * SEQ + t0 + s8) = o; }
        }
    }
    {
        float* KNRM = (float*)(p.ws + O_KNRM);
        for (int idx = obid() * 512 + tid; idx < TOK * 64; idx += gridDim.x * 512) {
            const int r = idx >> 6, c8 = (idx & 63) * 8, t = r & (SEQ - 1); float cur[8], prv[8]; float ss = 0.f;
            unpack8(*(const uint4*)(H + (size_t)r * HS + 512 + c8), cur);
            if (t > 0) unpack8(*(const uint4*)(H + (size_t)(r - 1) * HS + 512 + c8), prv); else {
#pragma unroll
                for (int e = 0; e < 8; ++e) prv[e] = 0.f; }
#pragma unroll
            for (int e = 0; e < 8; ++e) { const float v = (cur[e] + (prv[e] - cur[e]) * p.od_mu[512 + c8 + e]) * p.od_k_k[c8 + e]; ss += v * v; }
            ss += __shfl_xor(ss, 1); ss += __shfl_xor(ss, 2); ss += __shfl_xor(ss, 4);
            if ((idx & 7) == 0) KNRM[(size_t)r * 8 + (c8 >> 6)] = 1.f / fmaxf(sqrtf(ss), 1e-12f);
        }
    }
    for (int idx = obid() * 512 + tid; idx < TOK * 32; idx += gridDim.x * 512) {
        const int r = idx >> 5, j8 = (idx & 31) * 8, t = r & (SEQ - 1); float cur[8], prv[8], o[8];
        unpack8(*(const uint4*)(H + (size_t)r * HS + 1536 + j8), cur);
        if (t > 0) unpack8(*(const uint4*)(H + (size_t)(r - 1) * HS + 1536 + j8), prv); else {
#pragma unroll
            for (int e = 0; e < 8; ++e) prv[e] = 0.f; }
#pragma unroll
        for (int e = 0; e < 8; ++e) { const float v = cur[e] + (prv[e] - cur[e]) * p.od_mu[1536 + j8 + e];
            o[e] = (j8 < 64) ? tanhf(v) : ((j8 < 128) ? v : sigm_(v)); }
        *(uint4*)(AP + (size_t)r * 256 + j8) = pack8(o);
    }
}
DI void fox_unit(const Params& p, unsigned char* smem, int bh, int qb) {
    bf16_t* Qs = (bf16_t*)smem; bf16_t* Ks = (bf16_t*)(smem + 18432); bf16_t* Vts = (bf16_t*)(smem + 36864); float* ck = (float*)(smem + 89600);
    const bf16_t* H = (const bf16_t*)(p.ws + O_H); const float* FC = (const float*)(p.ws + O_FC); const bf16_t* KN = (const bf16_t*)(p.ws + O_KN); const bf16_t* VT = (const bf16_t*)(p.ws + O_VT);
    bf16_t* Y = (bf16_t*)(p.ws + O_XN);
    const int tid = otid(), lane = tid & 63, w = tid >> 6, b = bh >> 3, hh = bh & 7; const size_t r0 = (size_t)b * SEQ + qb * 128;
    const float LOG2E = 1.4426950408889634f;
    __syncthreads();
    { const int l = tid >> 2, c16 = (tid & 3) * 16; float a[8], c[8];
      unpack8(*(const uint4*)(H + (r0 + l) * HS + 1792 + hh * 64 + c16), a); unpack8(*(const uint4*)(H + (r0 + l) * HS + 1792 + hh * 64 + c16 + 8), c);
      float ss = 0.f;
#pragma unroll
      for (int e = 0; e < 8; ++e) ss += a[e] * a[e] + c[e] * c[e];
      ss += __shfl_xor(ss, 1); ss += __shfl_xor(ss, 2); const float rstd = rsqrtf(ss * (1.f / 64.f) + 1e-6f) * (0.125f * LOG2E);
#pragma unroll
      for (int e = 0; e < 8; ++e) { a[e] *= rstd * p.od_qn_w[c16 + e]; c[e] *= rstd * p.od_qn_w[c16 + 8 + e]; }
      *(uint4*)(Qs + l * 72 + c16) = pack8(a); *(uint4*)(Qs + l * 72 + c16 + 8) = pack8(c); }
    float mrow = -1e30f, lsum = 0.f; f32x4 O[4];
#pragma unroll
    for (int j = 0; j < 4; ++j) O[j] = (f32x4){0.f, 0.f, 0.f, 0.f};
    const int q4 = (lane >> 4) * 4, lq = 16 * w + (lane & 15);
    uint4 kreg0, kreg1, vreg0, vreg1; float ckreg = 0.f;
    const int g0 = tid, g1 = tid + 512;
#define FOX_ISSUE(kb_) { \
        kreg0 = *(const uint4*)(KN + ((size_t)bh * SEQ + (kb_) * 128 + (g0 >> 3)) * 64 + (g0 & 7) * 8); \
        kreg1 = *(const uint4*)(KN + ((size_t)bh * SEQ + (kb_) * 128 + (g1 >> 3)) * 64 + (g1 & 7) * 8); \
        vreg0 = *(const uint4*)(VT + ((size_t)bh * 64 + (g0 >> 4)) * SEQ + (kb_) * 128 + (g0 & 15) * 8); \
        vreg1 = *(const uint4*)(VT + ((size_t)bh * 64 + (g1 >> 4)) * SEQ + (kb_) * 128 + (g1 & 15) * 8); \
        if (tid < 128) ckreg = FC[(size_t)bh * SEQ + (kb_) * 128 + tid]; }
    FOX_ISSUE(0)
    for (int kb = 0; kb <= qb; ++kb) {
        __syncthreads();
        *(uint4*)(Ks + (g0 >> 3) * 72 + (g0 & 7) * 8) = kreg0; *(uint4*)(Ks + (g1 >> 3) * 72 + (g1 & 7) * 8) = kreg1;
        *(uint4*)(Vts + (g0 >> 4) * 136 + (g0 & 15) * 8) = vreg0; *(uint4*)(Vts + (g1 >> 4) * 136 + (g1 & 15) * 8) = vreg1;
        if (tid < 128) ck[tid] = -ckreg * LOG2E;
        __syncthreads();
        if (kb < qb) FOX_ISSUE(kb + 1)
        f32x4 S[8];
        { const bf16x8 q0 = ldfrag(Qs, 16 * w, 72, 0, lane), q1 = ldfrag(Qs, 16 * w, 72, 32, lane);
#pragma unroll
          for (int nt = 0; nt < 8; ++nt) { f32x4 z = *(const f32x4*)(ck + nt * 16 + q4); z = MFMA16(ldfrag(Ks, nt * 16, 72, 0, lane), q0, z); S[nt] = MFMA16(ldfrag(Ks, nt * 16, 72, 32, lane), q1, z); } }
        if (kb == qb) {
#pragma unroll
            for (int nt = 0; nt < 8; ++nt)
#pragma unroll
                for (int j = 0; j < 4; ++j) if (nt * 16 + q4 + j > lq) S[nt][j] = -1e30f;
        }
        float mx = S[0][0];
#pragma unroll
        for (int nt = 0; nt < 8; ++nt)
#pragma unroll
            for (int j = 0; j < 4; ++j) mx = fmaxf(mx, S[nt][j]);
        mx = fmaxf(mx, __shfl_xor(mx, 16)); mx = fmaxf(mx, __shfl_xor(mx, 32));
        const float mnew = fmaxf(mrow, mx); const float alpha = __builtin_amdgcn_exp2f(mrow - mnew); mrow = mnew;
        float rs = 0.f;
#pragma unroll
        for (int nt = 0; nt < 8; ++nt)
#pragma unroll
            for (int j = 0; j < 4; ++j) { const float pv = __builtin_amdgcn_exp2f(S[nt][j] - mnew); S[nt][j] = pv; rs += pv; }
        lsum = lsum * alpha + rs;
#pragma unroll
        for (int et = 0; et < 4; ++et) O[et] = O[et] * alpha;
#pragma unroll
        for (int ks = 0; ks < 4; ++ks) {
            uint4 pw; pw.x = cvt_pk_bf16(S[2 * ks][0], S[2 * ks][1]); pw.y = cvt_pk_bf16(S[2 * ks][2], S[2 * ks][3]); pw.z = cvt_pk_bf16(S[2 * ks + 1][0], S[2 * ks + 1][1]); pw.w = cvt_pk_bf16(S[2 * ks + 1][2], S[2 * ks + 1][3]);
            const bf16x8 pf = __builtin_bit_cast(bf16x8, pw);
#pragma unroll
            for (int et = 0; et < 4; ++et) { const bf16_t* vp = Vts + (et * 16 + (lane & 15)) * 136 + ks * 32 + q4;
                uint4 vw; const uint2 lo = *(const uint2*)vp, hi = *(const uint2*)(vp + 16); vw.x = lo.x; vw.y = lo.y; vw.z = hi.x; vw.w = hi.y;
                O[et] = MFMA16(__builtin_bit_cast(bf16x8, vw), pf, O[et]); }
        }
    }
    lsum += __shfl_xor(lsum, 16); lsum += __shfl_xor(lsum, 32);
    const float inv = 1.f / lsum;
#pragma unroll
    for (int et = 0; et < 4; ++et) { uint2 o; o.x = pack2(O[et][0] * inv, O[et][1] * inv); o.y = pack2(O[et][2] * inv, O[et][3] * inv);
        *(uint2*)(Y + (r0 + lq) * DM + 512 + hh * 64 + et * 16 + q4) = o; }
}
constexpr int RW_T = 32, RW_BUF = 43008;
struct RwRegs { unsigned short r[9], k[9], v[9], om[8], a[8]; float kn[8]; };
#define RW_BAR() do { asm volatile("s_waitcnt lgkmcnt(0)" ::: "memory"); __builtin_amdgcn_s_barrier(); asm volatile("" ::: "memory"); } while (0)
DI void rwkv_unit(const Params& p, unsigned char* smem, int bh, int rg) {
    const bf16_t* H = (const bf16_t*)(p.ws + O_H); const bf16_t* LW = (const bf16_t*)(p.ws + O_LW); bf16_t* Y = (bf16_t*)(p.ws + O_XN); const float* KNRM = (const float*)(p.ws + O_KNRM);
    const int tid = otid(), lane = tid & 63, w = tid >> 6, b = bh >> 3, hh = bh & 7; const size_t rb = (size_t)b * SEQ;
    float* ysh = (float*)(smem + 2 * RW_BUF);
    const int NCH = SEQ / RW_T;
    __syncthreads();
    if (w < 2) {
        float S0 = 0.f, S1 = 0.f, S2 = 0.f, S3 = 0.f; const int kq = lane & 15, row = w * 4 + (lane >> 4);
        RW_BAR();
        for (int ch = 0; ch < NCH; ++ch) {
            const float* bufp = (const float*)(smem + (ch & 1) * RW_BUF) + kq * 4; const float* vp = (const float*)(smem + (ch & 1) * RW_BUF) + 10240 + row; float* yo = ysh + (ch & 1) * 256 + row;
#define RW_LOAD(R, W, K, Q, B, V, tt) { R = *(const f32x4*)(bufp + (tt) * 64); W = *(const f32x4*)(bufp + 2048 + (tt) * 64); K = *(const f32x4*)(bufp + 4096 + (tt) * 64); \
                Q = *(const f32x4*)(bufp + 6144 + (tt) * 64); B = *(const f32x4*)(bufp + 8192 + (tt) * 64); V = vp[(tt) * 8]; }
#define DPPF(x, ctrl) __builtin_bit_cast(float, __builtin_amdgcn_update_dpp(0, __builtin_bit_cast(int, (x)), (ctrl), 0xF, 0xF, true))
            f32x4 prevR = {0.f, 0.f, 0.f, 0.f}; float yacc = 0.f;
            f32x4 rN, wN, kN, qN, bN; float vN;
            RW_LOAD(rN, wN, kN, qN, bN, vN, 0)
            __builtin_amdgcn_sched_barrier(0);
#pragma unroll
            for (int tt = 0; tt < RW_T; ++tt) {
                const f32x4 R = rN, W = wN, K = kN, Q = qN, B = bN; const float V = vN;
                if (tt + 1 < RW_T) RW_LOAD(rN, wN, kN, qN, bN, vN, tt + 1)
                float d = S0 * Q[0] + S1 * Q[1] + S2 * Q[2] + S3 * Q[3];
                if (tt > 0) {
                    float y = S0 * prevR[0] + S1 * prevR[1] + S2 * prevR[2] + S3 * prevR[3];
                    d += DPPF(d, 0xB1); y += DPPF(y, 0xB1); d += DPPF(d, 0x4E); y += DPPF(y, 0x4E); d += DPPF(d, 0x141); y += DPPF(y, 0x141); d += DPPF(d, 0x140); y += DPPF(y, 0x140);
                    yacc = (kq == ((tt - 1) & 15)) ? y : yacc;
                    if (tt == 16) yo[kq * 8] = yacc;
                } else d = dpp_red16(d);
                const float sa = -d;
                S0 = (S0 * W[0] + V * K[0]) + sa * B[0]; S1 = (S1 * W[1] + V * K[1]) + sa * B[1]; S2 = (S2 * W[2] + V * K[2]) + sa * B[2]; S3 = (S3 * W[3] + V * K[3]) + sa * B[3];
                prevR = R;
                if (tt & 1) __builtin_amdgcn_sched_barrier(0);
            }
            { float y = S0 * prevR[0] + S1 * prevR[1] + S2 * prevR[2] + S3 * prevR[3]; y = dpp_red16(y); yacc = (kq == 15) ? y : yacc; yo[(16 + kq) * 8] = yacc; }
            RW_BAR();
        }
    } else if (w == 4 || w == 5) {
        const unsigned* ta0; const unsigned* ta1; const unsigned* ta2; size_t st0, st1, st2;
        { int L = lane; int tok = L / 5, which = L - tok * 5; ta0 = (const unsigned*)(which < 3 ? H + (rb + tok) * HS + which * 512 + hh * 64 : LW + (rb + tok) * 1536 + (which - 3) * 512 + hh * 64); st0 = which < 3 ? (size_t)HS * 2 : (size_t)1536 * 2;
          L = lane + 64; tok = L / 5; which = L - tok * 5; ta1 = (const unsigned*)(which < 3 ? H + (rb + tok) * HS + which * 512 + hh * 64 : LW + (rb + tok) * 1536 + (which - 3) * 512 + hh * 64); st1 = which < 3 ? (size_t)HS * 2 : (size_t)1536 * 2;
          L = lane + 128 > 159 ? 159 : lane + 128; tok = L / 5; which = L - tok * 5; ta2 = (const unsigned*)(which < 3 ? H + (rb + tok) * HS + which * 512 + hh * 64 : LW + (rb + tok) * 1536 + (which - 3) * 512 + hh * 64); st2 = which < 3 ? (size_t)HS * 2 : (size_t)1536 * 2; }
        unsigned x0 = 0, x1 = 0, x2 = 0, y0 = 0, y1 = 0, y2 = 0, z0 = 0, z1 = 0, z2 = 0, pacc = 0;
        RW_BAR();
        for (int ch = 0; ch < NCH; ++ch) {
            if (w == 4) { int cc = ch + 6; cc = cc > NCH - 1 ? NCH - 1 : cc; const size_t tb = (size_t)cc * RW_T;
                pacc ^= x0 ^ x1 ^ x2; x0 = y0; x1 = y1; x2 = y2; y0 = z0; y1 = z1; y2 = z2;
                z0 = *(const unsigned*)((const char*)ta0 + tb * st0); z1 = *(const unsigned*)((const char*)ta1 + tb * st1); z2 = *(const unsigned*)((const char*)ta2 + tb * st2); }
            RW_BAR();
        }
        pacc ^= x0 ^ x1 ^ x2 ^ y0 ^ y1 ^ y2 ^ z0 ^ z1 ^ z2; if (pacc == 0x9e3779b9u && rg == 77) Y[0] = 0;
    } else {
        const int lw = (w & 1) + ((w >> 2) << 1), col = hh * 64 + lane; RwRegs ra;
        const float mur = p.od_mu[col], muk = p.od_mu[512 + col], muv = p.od_mu[1024 + col], kk_w = p.od_k_k[col], ka_w = p.od_k_a[col];
        auto issue = [&](int ch, RwRegs& rr) {
            const int tbase = ch * RW_T + lw * 8;
#pragma unroll
            for (int i = 0; i < 9; ++i) { const int t = tbase + i - 1;
                if (t >= 0) { const bf16_t* hp = H + (rb + t) * HS; rr.r[i] = hp[col]; rr.k[i] = hp[512 + col]; rr.v[i] = hp[1024 + col]; } else { rr.r[i] = 0; rr.k[i] = 0; rr.v[i] = 0; }
                if (i > 0) { const bf16_t* lp = LW + (rb + t) * 1536; rr.om[i - 1] = lp[col]; rr.a[i - 1] = lp[512 + col]; rr.kn[i - 1] = KNRM[(rb + t) * 8 + hh]; } }
        };
        auto process = [&](int ch, const RwRegs& rr) {
            float* bufp = (float*)(smem + (ch & 1) * RW_BUF);
#pragma unroll
            for (int i = 1; i < 9; ++i) { const int tt = lw * 8 + i - 1;
                const float rc = bf2f(rr.r[i]), rp = bf2f(rr.r[i - 1]), kc = bf2f(rr.k[i]), kp = bf2f(rr.k[i - 1]), vc = bf2f(rr.v[i]), vp = bf2f(rr.v[i - 1]);
                const float rl = rc + (rp - rc) * mur, kl = kc + (kp - kc) * muk, vl = vc + (vp - vc) * muv; const float a = bf2f(rr.a[i - 1]), wv = 1.f - bf2f(rr.om[i - 1]);
                const float kk = kl * kk_w * rr.kn[i - 1];
                bufp[tt * 64 + lane] = rl; bufp[2048 + tt * 64 + lane] = wv; bufp[4096 + tt * 64 + lane] = kl * (1.f + (a - 1.f) * ka_w); bufp[6144 + tt * 64 + lane] = kk; bufp[8192 + tt * 64 + lane] = kk * a;
                if ((lane >> 3) == rg) bufp[10240 + tt * 8 + (lane & 7)] = vl; }
        };
        issue(0, ra); process(0, ra); issue(1, ra);
        RW_BAR();
        for (int ch = 0; ch < NCH; ++ch) {
            if (ch + 1 < NCH) { process(ch + 1, ra); if (ch + 2 < NCH) issue(ch + 2, ra); }
            if (ch > 0 && lw < 2) { const float* yi = ysh + ((ch - 1) & 1) * 256; const int t2 = lw * 64 + lane, tt = t2 >> 2, pr = (t2 & 3) * 2;
                *(unsigned*)(Y + (rb + (ch - 1) * RW_T + tt) * DM + hh * 64 + rg * 8 + pr) = pack2(yi[tt * 8 + pr], yi[tt * 8 + pr + 1]); }
            RW_BAR();
        }
        if (lw < 2) { const float* yi = ysh + ((NCH - 1) & 1) * 256; const int t2 = lw * 64 + lane, tt = t2 >> 2, pr = (t2 & 3) * 2;
          *(unsigned*)(Y + (rb + (NCH - 1) * RW_T + tt) * DM + hh * 64 + rg * 8 + pr) = pack2(yi[tt * 8 + pr], yi[tt * 8 + pr + 1]); }
    }
    __syncthreads();
}
DI void phase_l1_mix(const Params& p, unsigned char* smem, int pass) {
    unsigned* ctr = (unsigned*)(p.ws + O_CTL) + pass * 4; int* sh = (int*)(smem + 90112);
    if (obid() < 128 && pass != 2) rwkv_unit(p, smem, obid() >> 3, obid() & 7);
    for (;;) {
        __syncthreads(); if (otid() == 0) *sh = (int)atomicAdd(ctr, 1u); __syncthreads();
        const int u = *sh; if (u >= 1024) break;
        fox_unit(p, smem, u & 15, 63 - (u >> 4));
    }
}
DI void phase_rwkv_fin(const Params& p) {
    const bf16_t* H = (const bf16_t*)(p.ws + O_H); const bf16_t* LW = (const bf16_t*)(p.ws + O_LW); bf16_t* Y = (bf16_t*)(p.ws + O_XN);
    const int lane = otid() & 63, wv = otid() >> 6;
    for (int task = obid() * 8 + wv; task < TOK * 8; task += gridDim.x * 8) {
        const int r = task >> 3, hh = task & 7, t = r & (SEQ - 1), col = hh * 64 + lane; const bf16_t* hp = H + (size_t)r * HS;
        const float y = bf2f(Y[(size_t)r * DM + col]); const float mean = red64(y) * (1.f / 64.f); const float dy = y - mean; const float var = red64(dy * dy) * (1.f / 64.f);
        const float yln = dy * rsqrtf(var + 64e-5f) * p.od_ln_w[col] + p.od_ln_b[col];
        const float rc = bf2f(hp[col]), kc = bf2f(hp[512 + col]), vc = bf2f(hp[1024 + col]); float rp = 0.f, kp = 0.f, vp = 0.f;
        if (t > 0) { rp = bf2f(hp[col - HS]); kp = bf2f(hp[512 + col - HS]); vp = bf2f(hp[1024 + col - HS]); }
        const float rl = rc + (rp - rc) * p.od_mu[col], kl = kc + (kp - kc) * p.od_mu[512 + col], vl = vc + (vp - vc) * p.od_mu[1024 + col];
        const float a = bf2f(LW[(size_t)r * 1536 + 512 + col]), g = bf2f(LW[(size_t)r * 1536 + 1024 + col]);
        const float kt = kl * (1.f + (a - 1.f) * p.od_k_a[col]); const float bonus = red64(rl * kt * p.od_r_k[col]) * vl;
        Y[(size_t)r * DM + col] = f2bf((yln + bonus) * g);
    }
}
#define XB_TMO      128
#define XB_XCNT(j)  (256  + 64 * (j))
#define XB_XSUB(j)  (1280 + 64 * (j))
#define XB_XGEN(j)  (2304 + 64 * (j))
#define XB_TOP      3328
#define XB_TOPGEN   3392
#define XCD_BAR_WORDS 3456
#define XB_SPIN_CAP (1u << 18)
#define LAS __attribute__((address_space(3)))

__device__ __forceinline__ unsigned xb_ld(unsigned* p)              { return __hip_atomic_load(p, __ATOMIC_RELAXED, __HIP_MEMORY_SCOPE_AGENT); }
__device__ __forceinline__ unsigned xb_add(unsigned* p, unsigned v) { return __hip_atomic_fetch_add(p, v, __ATOMIC_RELAXED, __HIP_MEMORY_SCOPE_AGENT); }
__device__ __forceinline__ unsigned xb_xcc_id() { return (unsigned)__builtin_amdgcn_s_getreg((3 << 11) | 20) & 0xFu; }
#define XB_SPIN(cond, bar) do { unsigned _sp = 0; while (cond) { __builtin_amdgcn_s_sleep(1); \
    if ((++_sp & 255u) == 0u) { if (xb_ld(&(bar)[XB_TMO])) break; if (_sp > XB_SPIN_CAP) { atomicAdd(&(bar)[XB_TMO], 1u); break; } } } } while (0)

struct XcdBarrier {
    unsigned* bar; unsigned x;
    volatile LAS unsigned* st;
};

__device__ __forceinline__ XcdBarrier xcd_barrier_post(unsigned* bar, volatile LAS unsigned* st) {
    XcdBarrier b; b.bar = bar; b.x = xb_xcc_id(); b.st = st;
    if (threadIdx.x == 0) (void)xb_add(&bar[XB_XCNT(b.x)], 1u);
    return b;
}
__device__ __forceinline__ void xcd_barrier_complete(unsigned* bar, unsigned x, unsigned& nloc, unsigned& nx) {
    const unsigned G = gridDim.x * gridDim.y * gridDim.z;
    unsigned sum, cnt, mine, sp = 0u;
    for (;;) {
        sum = 0u; cnt = 0u; mine = 0u;
#pragma unroll
        for (unsigned j = 0; j < 16; ++j) { const unsigned c = xb_ld(&bar[XB_XCNT(j)]); sum += c; cnt += (c > 0u) ? 1u : 0u; mine = (j == x) ? c : mine; }
        if (sum == G) break;
        __builtin_amdgcn_s_sleep(1);
        if ((++sp & 255u) == 0u) { if (xb_ld(&bar[XB_TMO])) break; if (sp > XB_SPIN_CAP) { atomicAdd(&bar[XB_TMO], 1u); break; } }
    }
    nloc = mine > 0u ? mine : 1u; nx = cnt > 0u ? cnt : 1u;
}

__device__ __forceinline__ void xcd_barrier(const XcdBarrier& b) {
    asm volatile("s_waitcnt vmcnt(0)" ::: "memory");
    __syncthreads();
    if (threadIdx.x == 0) {
        unsigned* bar = b.bar;
        __builtin_amdgcn_s_waitcnt(0);
        unsigned nloc = b.st[0], nx = b.st[1];
        if (nloc == 0u) { xcd_barrier_complete(bar, b.x, nloc, nx); b.st[0] = nloc; b.st[1] = nx; }
        const unsigned old = xb_add(&bar[XB_XSUB(b.x)], 1u);
        const unsigned gen = old / nloc;
        if (old + 1u == (gen + 1u) * nloc) {
            __builtin_amdgcn_fence(__ATOMIC_RELEASE, "agent");
            asm volatile("s_waitcnt vmcnt(0)" ::: "memory");
            const unsigned og = xb_add(&bar[XB_TOP], 1u);
            const unsigned tg = og / nx;
            if (og + 1u == (tg + 1u) * nx) xb_add(&bar[XB_TOPGEN], 1u);
            else XB_SPIN(xb_ld(&bar[XB_TOPGEN]) == tg, bar);
            __builtin_amdgcn_fence(__ATOMIC_ACQUIRE, "agent");
            xb_add(&bar[XB_XGEN(b.x)], 1u);
            asm volatile("s_waitcnt vmcnt(0)" ::: "memory");
        } else {
            XB_SPIN(xb_ld(&bar[XB_XGEN(b.x)]) == gen, bar);
            __builtin_amdgcn_fence(__ATOMIC_ACQUIRE, "agent");
            asm volatile("s_waitcnt vmcnt(0)" ::: "memory");
        }
    }
    __syncthreads();
}


__global__ void __launch_bounds__(512, 2) fwd_megakernel(Params p) {
    extern __shared__ __attribute__((aligned(16))) unsigned char smem[];
    cg::grid_group grid = cg::this_grid();
    unsigned char* ws = p.ws;
    bf16_t* XN = (bf16_t*)(ws + O_XN); bf16_t* Hb = (bf16_t*)(ws + O_H); float* aux = (float*)(ws + O_AUX);
    const bf16_t* t_in = (const bf16_t*)(ws + O_WT_IN); const bf16_t* t_out = (const bf16_t*)(ws + O_WT_OUT); const bf16_t* t_up = (const bf16_t*)(ws + O_WT_UP);
    const bf16_t* t_dn = (const bf16_t*)(ws + O_WT_DN); const bf16_t* t_lr = (const bf16_t*)(ws + O_WT_LR);
    if (blockIdx.x == 0 && threadIdx.x < 16) ((unsigned*)(ws + O_CTL))[threadIdx.x] = 0u;
    if (threadIdx.x == 0) *(uint4*)(smem + 131072) = make_uint4(0u, 0u, 0u, 0u);
    __syncthreads();
    const XcdBarrier xb = xcd_barrier_post((unsigned*)(ws + O_BAR), (volatile LAS unsigned*)(smem + 131072));
#define GSYNC() xcd_barrier(xb)
#define GEMM_H(layer) { EpiH E; E.H = Hb; E.aux = aux; E.auxc = layer ? 3328 : 1280; run_gemm(smem, XN, t_in, 3584, 1024, E); }
#define GEMM_OUT(layer) { EpiRes E; E.res = layer ? p.out : p.x; E.out = p.out; run_gemm(smem, XN, t_out, 1024, 1024, E); }
#define GEMM_UP() { EpiGU E; E.G = (bf16_t*)(ws + O_G); E.U = (bf16_t*)(ws + O_U); run_gemm(smem, XN, t_up, 2 * DFF, 1024, E); }
#define GEMM_DN() { EpiRes E; E.res = p.out; E.out = p.out; run_gemm(smem, (const bf16_t*)(ws + O_U), t_dn, 1024, DFF, E); }
    phase_weights(p, smem, 0, 0); phase_rmsnorm(p.x, p.ev_norm_w, XN);
    if (p.ws == nullptr) grid.sync();
    GSYNC();
    GEMM_H(0) phase_weights(p, smem, 0, 1); GSYNC();
#if PROBE == 2
    GEMM_H(0) GSYNC();
#endif
    phase_m1(p, smem); GSYNC();
#if PROBE == 3
    phase_m1(p, smem); GSYNC();
#endif
    phase_m2(p); GSYNC();
#if PROBE == 6
    GSYNC(); GSYNC(); GSYNC(); GSYNC(); GSYNC(); GSYNC(); GSYNC(); GSYNC(); GSYNC(); GSYNC();
#endif
#if PROBE == 7
    phase_weights(p, smem, 0, 0); GSYNC(); phase_rmsnorm(p.x, p.ev_norm_w, XN); GSYNC(); phase_rmsnorm(p.x, p.ev_norm_w, XN); GSYNC();
#endif
    phase_m3(p, smem); GSYNC();
#if PROBE == 3
    phase_m3(p, smem); GSYNC();
#endif
    GEMM_OUT(0) GSYNC();
#if PROBE == 2
    GEMM_OUT(0) GSYNC();
#endif
    phase_rmsnorm(p.out, p.ffn_norm_w, XN); GSYNC();
    GEMM_UP() phase_weights(p, smem, 0, 2); GSYNC();
#if PROBE == 2
    GEMM_UP() GSYNC();
#endif
    phase_ffn_act(p, 0); GSYNC();
    GEMM_DN() GSYNC();
    phase_weights(p, smem, 1, 0); phase_rmsnorm(p.out, p.od_norm_w, XN); GSYNC();
    GEMM_H(1) phase_weights(p, smem, 1, 1); GSYNC();
    phase_l1_prep(p, smem); GSYNC();
    { EpiLR E; E.LW = (bf16_t*)(ws + O_LW); E.w0 = p.od_w0; E.a0 = p.od_a0; run_gemm(smem, (const bf16_t*)(ws + O_AP), t_lr, 1536, 256, E); } GSYNC();
    phase_l1_mix(p, smem, 0); GSYNC();
#if PROBE == 4
    phase_l1_mix(p, smem, 1); GSYNC();
#endif
#if PROBE == 5
    phase_l1_mix(p, smem, 2); GSYNC();
#endif
    phase_rwkv_fin(p); GSYNC();
    GEMM_OUT(1) GSYNC();
    phase_rmsnorm(p.out, p.ffn_norm_w + DM, XN); GSYNC();
    GEMM_UP() phase_weights(p, smem, 1, 2); GSYNC();
    phase_ffn_act(p, 1); GSYNC();
    GEMM_DN()
}

extern "C" void kernel_launch(void* const* d_in, const int* in_sizes, int n_in, void* d_out, int out_size, void* d_ws, size_t ws_size, hipStream_t stream) {
    static int grid_blocks = 0;
    if (grid_blocks == 0) {
        int dev = 0, cus = 0, per_cu = 0;
        hipGetDevice(&dev); hipDeviceGetAttribute(&cus, hipDeviceAttributeMultiprocessorCount, dev);
        if (hipFuncSetAttribute((const void*)fwd_megakernel, hipFuncAttributeMaxDynamicSharedMemorySize, LDS_BYTES) != hipSuccess) fprintf(stderr, "hipFuncSetAttribute failed\n");
        hipOccupancyMaxActiveBlocksPerMultiprocessor(&per_cu, (const void*)fwd_megakernel, 512, LDS_BYTES);
        (void)hipGetLastError();
        if (per_cu < 1) fprintf(stderr, "occupancy query says %d blocks per CU\n", per_cu);
        grid_blocks = cus > 0 ? cus : 256;
        if (ws_size < WS_NEED) fprintf(stderr, "workspace too small: %zu < %zu\n", ws_size, (size_t)WS_NEED);
    }
    Params p{};
    const float** pp = (const float**)&p;
    for (int i = 0; i < 33; ++i) pp[i] = (const float*)d_in[i];
    p.out = (float*)d_out; p.ws = (unsigned char*)d_ws;
    (void)hipMemsetAsync((char*)d_ws + O_BAR, 0, 16384, stream);
    void* args[] = {&p};
    hipError_t e = hipLaunchCooperativeKernel((const void*)fwd_megakernel, dim3(grid_blocks), dim3(512), args, LDS_BYTES, stream);
    if (e != hipSuccess) fprintf(stderr, "cooperative launch failed: %s (grid %d)\n", hipGetErrorString(e), grid_blocks);
}
```

```cpp
#include <hip/hip_runtime.h>
#include <hip/hip_cooperative_groups.h>
#include <cstdio>
#ifndef PROBE
#define PROBE 0
#endif
namespace cg = cooperative_groups;
namespace pg8 {
#define PG8_LAS __attribute__((address_space(3)))
typedef unsigned short bf16_t;
typedef short bf16x8 __attribute__((ext_vector_type(8)));
typedef float f32x4 __attribute__((ext_vector_type(4)));
typedef unsigned u32x4 __attribute__((ext_vector_type(4)));
constexpr int BM = 256, BK = 64, HALF = 128, HTB = HALF * BK * 2  , STAGE_BYTES = 8 * HTB, NXCD = 8, WGM = 8;

__host__ __device__ __forceinline__ int lds_byte(int r, int c) { const int st = (r >> 4) * 2 + (c >> 5), rr = r & 15, cc = c & 31, ob = rr * 64 + cc * 2; return st * 1024 + (ob ^ (((ob >> 9) & 1) << 5)); }
__host__ __device__ __forceinline__ void stage_rc(int b, int& R, int& C) { const int st = b / 1024, sb = b % 1024, swz = sb ^ (((sb >> 9) & 1) << 5); R = (st >> 1) * 16 + swz / 64; C = (st & 1) * 32 + (swz % 64) / 2; }
__host__ __device__ __forceinline__ int perm32(int rho) { const int n = rho >> 4, i = rho & 15; return 8 * (i >> 2) + 4 * n + (i & 3); }

struct Unit { int pm, pn; };
struct Gemm { const bf16_t* A; const bf16_t* Bt; int M, N, K; };

struct StaticOrder {
    int nM, nN, nwg, G, c;
    __host__ __device__ void init(int M, int N, int G_, int c_) { nM = M / BM; nN = N / BM; nwg = nM * nN; G = G_; c = c_; }
    __host__ __device__ bool next(int i, Unit& u) const {
        const long L = (long)i * G + c; if (L >= nwg) return false;
        int wgid = (int)L; { const int q = nwg / NXCD, r = nwg % NXCD, xcd = wgid % NXCD, off = wgid / NXCD; wgid = (xcd < r ? xcd * (q + 1) : r * (q + 1) + (xcd - r) * q) + off; }
        const int nig = WGM * nN, gid = wgid / nig, fm = gid * WGM, gsz = (nM - fm) < WGM ? (nM - fm) : WGM;
        u.pm = fm + ((wgid % nig) % gsz); u.pn = (wgid % nig) / gsz; return true;
    }
    __device__ __forceinline__ void a_ready(const Unit&) const {}
    __device__ __forceinline__ void done(const Unit&) const {}
};
__device__ __forceinline__ unsigned cvt_pk_bf16(float lo, float hi) { unsigned r; asm volatile("v_cvt_pk_bf16_f32 %0, %1, %2" : "=v"(r) : "v"(lo), "v"(hi)); return r; }

template <class Epi, class Sched, bool STAMP = false>
__device__ __forceinline__ void gemm_phase(PG8_LAS unsigned char* lds, const Gemm g, const Sched& S, const Epi& E, unsigned long long* stamps) {
    int tid_ = threadIdx.x; asm volatile("" : "+v"(tid_)); const int tid = tid_, wid = __builtin_amdgcn_readfirstlane(tid >> 6), lane = tid & 63, wr = wid >> 2, wc = wid & 3, fr = lane & 15, fq = lane >> 4;
    const int K = g.K, nt = K / BK;
    int ts_lo = 0, ts_hi = 0, nts = 0; const unsigned long long rt_entry = STAMP ? (unsigned long long)wall_clock64() : 0ull;
#define PG8_STAMP() do { if (STAMP && wid == 0 && nts < 64) { const unsigned long long _c = (unsigned long long)clock64(); \
        ts_lo = (lane == nts) ? (int)(unsigned)_c : ts_lo; ts_hi = (lane == nts) ? (int)(unsigned)(_c >> 32) : ts_hi; ++nts; } } while (0)
    PG8_STAMP();
    unsigned voffA[2], voffB[2];
#pragma unroll
    for (int i = 0; i < 2; ++i) { int R, C; stage_rc(tid * 16 + i * 8192, R, C); const int Rb = Epi::PERM ? ((R & ~31) + perm32(R & 31)) : R;
        voffA[i] = (unsigned)(R * K + C) * 2u; voffB[i] = (unsigned)(Rb * K + C) * 2u; }
    const size_t kstep = (size_t)(BK * 2);
    const size_t hstep = (size_t)HALF * K * 2;
    const size_t tstep = 2 * hstep;
    const unsigned ldsw = (unsigned)wid * 1024u;
    const int aoff = lds_byte(wr * 64 + fr, fq * 8), boff = lds_byte(wc * 32 + fr, fq * 8);
#define PG8_SA(b, h) (((b) * 2 + (h)) * HTB)
#define PG8_SB(b, h) ((4 + (b) * 2 + (h)) * HTB)
#define PG8_STAGE(bufoff, gbase, voff) do { _Pragma("unroll") for (int _i = 0; _i < 2; ++_i) \
        __builtin_amdgcn_global_load_lds((const unsigned*)((const char*)(gbase) + (voff)[_i]), (PG8_LAS unsigned*)(lds + (bufoff) + ldsw + _i * 8192), 16, 0, 0); } while (0)
#define PG8_LDA(dst, b, h) do { _Pragma("unroll") for (int m = 0; m < 4; ++m) _Pragma("unroll") for (int k = 0; k < 2; ++k) dst[m][k] = *(const PG8_LAS bf16x8*)(lds + PG8_SA(b, h) + aoff + m * 2048 + k * 1024); } while (0)
#define PG8_LDB(dst, b, h) do { _Pragma("unroll") for (int n = 0; n < 2; ++n) _Pragma("unroll") for (int k = 0; k < 2; ++k) dst[n][k] = *(const PG8_LAS bf16x8*)(lds + PG8_SB(b, h) + boff + n * 2048 + k * 1024); } while (0)
#define PG8_MMA(ai, bj, At, Bt) do { __builtin_amdgcn_s_setprio(1); _Pragma("unroll") for (int m = 0; m < 4; ++m) _Pragma("unroll") for (int n = 0; n < 2; ++n) _Pragma("unroll") for (int k = 0; k < 2; ++k) \
        acc[ai][bj][m][n] = __builtin_amdgcn_mfma_f32_16x16x32_bf16(Bt[n][k], At[m][k], acc[ai][bj][m][n], 0, 0, 0); __builtin_amdgcn_s_setprio(0); } while (0)
#define PG8_WAIT_V(n) asm volatile("s_waitcnt vmcnt(" #n ")" ::: "memory")
#define PG8_WAIT_L(n) asm volatile("s_waitcnt lgkmcnt(" #n ")" ::: "memory")
#define PG8_BAR __builtin_amdgcn_s_barrier()
#define PG8_SCHED __builtin_amdgcn_sched_barrier(0)
    Unit cur, nxt; int ui = 0;
    if (!S.next(0, cur)) return;
    f32x4 acc[2][2][4][2];
#pragma unroll
    for (int a = 0; a < 2; ++a)
#pragma unroll
        for (int b = 0; b < 2; ++b)
#pragma unroll
            for (int m = 0; m < 4; ++m)
#pragma unroll
                for (int n = 0; n < 2; ++n) acc[a][b][m][n] = (f32x4){0.f, 0.f, 0.f, 0.f};
    bf16x8 At[4][2], B0[2][2], B1[2][2];
    const char* cA = (const char*)g.A + (size_t)cur.pm * tstep; const char* cB = (const char*)g.Bt + (size_t)cur.pn * tstep;
    S.a_ready(cur);
    PG8_STAGE(PG8_SB(0, 0), cB, voffB); PG8_STAGE(PG8_SA(0, 0), cA, voffA); PG8_STAGE(PG8_SB(0, 1), cB + hstep, voffB); PG8_STAGE(PG8_SA(0, 1), cA + hstep, voffA);
    if (wr == 1) PG8_BAR;
    PG8_WAIT_V(4); PG8_BAR;
    PG8_STAGE(PG8_SB(1, 0), cB + kstep, voffB); PG8_STAGE(PG8_SA(1, 0), cA + kstep, voffA); PG8_STAGE(PG8_SB(1, 1), cB + hstep + kstep, voffB);
    PG8_WAIT_V(6); PG8_BAR;
    PG8_STAMP();
    for (;;) {
        const bool has_next = S.next(ui + 1, nxt);
        const char* nA = has_next ? (const char*)g.A + (size_t)nxt.pm * tstep : cA; const char* nB = has_next ? (const char*)g.Bt + (size_t)nxt.pn * tstep : cB;
        for (int t = 0; t < nt; t += 2) {
            const bool last = (t == nt - 2);
            const char* a1 = cA + (size_t)(t + 1) * kstep;
            const char* a2 = last ? nA : cA + (size_t)(t + 2) * kstep; const char* b2 = last ? nB : cB + (size_t)(t + 2) * kstep;
            const char* a3 = a2 + kstep; const char* b3 = b2 + kstep;
            if (last && has_next) S.a_ready(nxt);
            PG8_LDB(B0, 0, 0); PG8_SCHED; PG8_LDA(At, 0, 0); PG8_STAGE(PG8_SA(1, 1), a1 + hstep, voffA);
            PG8_WAIT_L(8); PG8_BAR; PG8_WAIT_L(0); PG8_MMA(0, 0, At, B0); PG8_BAR; PG8_SCHED;
            PG8_LDB(B1, 0, 1); PG8_STAGE(PG8_SB(0, 0), b2, voffB);
            PG8_BAR; PG8_WAIT_L(0); PG8_MMA(0, 1, At, B1); PG8_BAR;
            PG8_LDA(At, 0, 1); PG8_STAGE(PG8_SA(0, 0), a2, voffA);
            PG8_BAR; PG8_WAIT_L(0); PG8_MMA(1, 0, At, B0); PG8_BAR; PG8_SCHED;
            PG8_STAGE(PG8_SB(0, 1), b2 + hstep, voffB);
            PG8_WAIT_V(6); PG8_BAR; PG8_MMA(1, 1, At, B1); PG8_BAR;
            PG8_LDB(B0, 1, 0); PG8_SCHED; PG8_LDA(At, 1, 0); PG8_STAGE(PG8_SA(0, 1), a2 + hstep, voffA);
            PG8_WAIT_L(8); PG8_BAR; PG8_WAIT_L(0); PG8_MMA(0, 0, At, B0); PG8_BAR; PG8_SCHED;
            PG8_LDB(B1, 1, 1); PG8_STAGE(PG8_SB(1, 0), b3, voffB);
            PG8_BAR; PG8_WAIT_L(0); PG8_MMA(0, 1, At, B1); PG8_BAR;
            PG8_LDA(At, 1, 1); PG8_STAGE(PG8_SA(1, 0), a3, voffA);
            PG8_BAR; PG8_WAIT_L(0); PG8_MMA(1, 0, At, B0); PG8_BAR; PG8_SCHED;
            PG8_STAGE(PG8_SB(1, 1), b3 + hstep, voffB);
            PG8_WAIT_V(6); PG8_BAR; PG8_MMA(1, 1, At, B1); PG8_BAR;
        }
        PG8_STAMP();
        if constexpr (!Epi::AFTER_DRAIN) { E(acc, cur, wr, wc, fr, fq); S.done(cur); }
        PG8_STAMP();
        if (!has_next) break;
#pragma unroll
        for (int a = 0; a < 2; ++a)
#pragma unroll
            for (int b = 0; b < 2; ++b)
#pragma unroll
                for (int m = 0; m < 4; ++m)
#pragma unroll
                    for (int n = 0; n < 2; ++n) acc[a][b][m][n] = (f32x4){0.f, 0.f, 0.f, 0.f};
        cur = nxt; cA = nA; cB = nB; ++ui;
    }
    PG8_WAIT_V(0);
    if (wr == 0) PG8_BAR;
    PG8_BAR;
    if constexpr (Epi::AFTER_DRAIN) { E.fused(acc, cur, wr, wc, fr, fq, lds, wid, lane); S.done(cur); }
    PG8_STAMP();
    if (STAMP && wid == 0) { stamps[lane] = lane < nts ? (((unsigned long long)(unsigned)ts_hi << 32) | (unsigned)ts_lo) : 0ull;
        if (lane == 62) stamps[62] = rt_entry; if (lane == 63) stamps[63] = (unsigned long long)wall_clock64(); }
#undef PG8_STAMP
#undef PG8_SA
#undef PG8_SB
#undef PG8_STAGE
#undef PG8_LDA
#undef PG8_LDB
#undef PG8_MMA
#undef PG8_WAIT_V
#undef PG8_WAIT_L
#undef PG8_BAR
#undef PG8_SCHED
}
}

using pg8::bf16_t; using pg8::bf16x8; using pg8::f32x4; using pg8::Unit; using pg8::cvt_pk_bf16;
#define DI __device__ __forceinline__
constexpr int TOK = 16384, SEQ = 8192, DM = 1024, HS = 3336, DFF = 2816;
constexpr size_t O_CTL = 0, O_CD = 256, O_AUX = 4352, O_ROPE = 528640, O_FC = 2625792, O_WT = 3150080;
constexpr size_t O_WT_IN = O_WT, O_WT_OUT = O_WT_IN + 7340032, O_WT_UP = O_WT_OUT + 2097152, O_WT_DN = O_WT_UP + 11534336, O_WT_LR = O_WT_DN + 5767168;
constexpr size_t O_XN = O_WT + 27525120, O_R1 = O_XN + 33554432;
constexpr size_t O_H = O_R1, O_ST = O_R1 + 109314048, O_YG = O_ST + 33554432;
constexpr size_t O_G = O_R1, O_U = O_R1 + 92274688;
constexpr size_t O_LW = O_R1 + 109314048, O_KN = O_LW + 50331648, O_VT = O_KN + 16777216, O_AP = O_VT + 16777216;
constexpr size_t O_KNRM = O_AP + 8388608;
constexpr size_t O_BAR = O_KNRM + 524288;
constexpr size_t WS_NEED = O_BAR + 16384;
constexpr int LDS_BYTES = 131072 + 256;

struct Params {
    const float* x; const float* ev_norm_w; const float* ev_w_in; const float* ev_conv_w; const float* ev_conv_b; const float* ev_dt_bias; const float* ev_a_log;
    const float* ev_d; const float* ev_ssd_norm_w; const float* ev_ret_norm_w; const float* ev_w_out;
    const float* od_norm_w; const float* od_w_in; const float* od_mu; const float* od_w0; const float* od_w_up; const float* od_a0; const float* od_a_up;
    const float* od_g_up; const float* od_k_k; const float* od_k_a; const float* od_r_k; const float* od_ln_w; const float* od_ln_b;
    const float* od_qn_w; const float* od_kn_w; const float* od_f_bias; const float* od_w_out;
    const float* ffn_norm_w; const float* ffn_w_up; const float* ffn_conv_w; const float* ffn_conv_b; const float* ffn_w_down;
    float* out; unsigned char* ws;
};

DI unsigned cvtpk(float lo, float hi) { unsigned r; asm("v_cvt_pk_bf16_f32 %0, %1, %2" : "=v"(r) : "v"(lo), "v"(hi)); return r; }
DI unsigned short f2bf(float f) { return (unsigned short)(cvtpk(f, f) & 0xffffu); }
DI float bf2f(unsigned short b) { return __uint_as_float(((unsigned)b) << 16); }
DI unsigned pack2(float lo, float hi) { return cvtpk(lo, hi); }
DI float bflo(unsigned w) { return __uint_as_float(w << 16); }
DI float bfhi(unsigned w) { return __uint_as_float(w & 0xffff0000u); }
DI void unpack8(const uint4 r, float (&o)[8]) { o[0] = bflo(r.x); o[1] = bfhi(r.x); o[2] = bflo(r.y); o[3] = bfhi(r.y); o[4] = bflo(r.z); o[5] = bfhi(r.z); o[6] = bflo(r.w); o[7] = bfhi(r.w); }
DI uint4 pack8(const float (&o)[8]) { uint4 r; r.x = pack2(o[0], o[1]); r.y = pack2(o[2], o[3]); r.z = pack2(o[4], o[5]); r.w = pack2(o[6], o[7]); return r; }
DI float silu_(float x) { return x * __builtin_amdgcn_rcpf(1.f + __expf(-x)); }
DI float sigm_(float x) { return __builtin_amdgcn_rcpf(1.f + __expf(-x)); }
DI float softplus_(float x) { return fmaxf(x, 0.f) + log1pf(__expf(-fabsf(x))); }
DI bf16x8 ldfrag(const bf16_t* base, int row0, int ld, int k0, int lane) { return *(const bf16x8*)(base + (row0 + (lane & 15)) * ld + k0 + (lane >> 4) * 8); }
#define MFMA16(a, b, c) __builtin_amdgcn_mfma_f32_16x16x32_bf16((a), (b), (c), 0, 0, 0)
DI float red16(float v) { v += __shfl_xor(v, 1); v += __shfl_xor(v, 2); v += __shfl_xor(v, 4); v += __shfl_xor(v, 8); return v; }
DI float max16(float v) { v = fmaxf(v, __shfl_xor(v, 1)); v = fmaxf(v, __shfl_xor(v, 2)); v = fmaxf(v, __shfl_xor(v, 4)); v = fmaxf(v, __shfl_xor(v, 8)); return v; }
DI float red64(float v) { v += __shfl_xor(v, 32); v += __shfl_xor(v, 16); return red16(v); }
DI float dpp_red16(float x) {
    x += __builtin_bit_cast(float, __builtin_amdgcn_update_dpp(0, __builtin_bit_cast(int, x), 0xB1, 0xF, 0xF, true));
    x += __builtin_bit_cast(float, __builtin_amdgcn_update_dpp(0, __builtin_bit_cast(int, x), 0x4E, 0xF, 0xF, true));
    x += __builtin_bit_cast(float, __builtin_amdgcn_update_dpp(0, __builtin_bit_cast(int, x), 0x141, 0xF, 0xF, true));
    x += __builtin_bit_cast(float, __builtin_amdgcn_update_dpp(0, __builtin_bit_cast(int, x), 0x140, 0xF, 0xF, true));
    return x;
}

DI int otid() { int t = threadIdx.x; asm volatile("" : "+v"(t)); return t; }
DI int obid() { int b = blockIdx.x; asm volatile("" : "+s"(b)); return b; }
struct EpiH {
    static constexpr bool PERM = false, AFTER_DRAIN = false;
    bf16_t* H; float* aux; int auxc;
    DI void operator()(const f32x4 (&acc)[2][2][4][2], const Unit& u, int wr, int wc, int fr, int fq) const {
        const int row0 = u.pm * 256 + wr * 64 + fr, col0 = u.pn * 256 + wc * 32 + 4 * fq;
#pragma unroll
        for (int ai = 0; ai < 2; ++ai)
#pragma unroll
            for (int m = 0; m < 4; ++m) { const size_t r = (size_t)(row0 + ai * 128 + m * 16);
#pragma unroll
                for (int bj = 0; bj < 2; ++bj)
#pragma unroll
                    for (int n = 0; n < 2; ++n) { const int c = col0 + bj * 128 + n * 16; const f32x4 v = acc[ai][bj][m][n];
                        if (c < HS) { uint2 w; w.x = cvt_pk_bf16(v[0], v[1]); w.y = cvt_pk_bf16(v[2], v[3]); *(uint2*)(H + r * HS + c) = w;
                            if (c == auxc || c == auxc + 4) *(f32x4*)(aux + r * 8 + (c - auxc)) = v; } } }
    }
};
struct EpiRes {
    static constexpr bool PERM = false, AFTER_DRAIN = false;
    const float* res; float* out;
    DI void operator()(const f32x4 (&acc)[2][2][4][2], const Unit& u, int wr, int wc, int fr, int fq) const {
        const int row0 = u.pm * 256 + wr * 64 + fr, col0 = u.pn * 256 + wc * 32 + 4 * fq;
#pragma unroll
        for (int ai = 0; ai < 2; ++ai)
#pragma unroll
            for (int m = 0; m < 4; ++m) { const size_t r = (size_t)(row0 + ai * 128 + m * 16);
#pragma unroll
                for (int bj = 0; bj < 2; ++bj)
#pragma unroll
                    for (int n = 0; n < 2; ++n) { const int c = col0 + bj * 128 + n * 16;
                        const f32x4 rv = *(const f32x4*)(res + r * DM + c); *(f32x4*)(out + r * DM + c) = rv + acc[ai][bj][m][n]; } }
    }
};
DI float gu_ror1(float x) { float r; asm volatile("s_nop 1\n\tv_mov_b32_dpp %0, %1 row_ror:1 row_mask:0xf bank_mask:0xf bound_ctrl:1" : "=v"(r) : "v"(x)); return r; }
DI float gu_ror2(float x) { float r; asm volatile("s_nop 1\n\tv_mov_b32_dpp %0, %1 row_ror:2 row_mask:0xf bank_mask:0xf bound_ctrl:1" : "=v"(r) : "v"(x)); return r; }
struct EpiGU {
    static constexpr bool PERM = false, AFTER_DRAIN = false;
    bf16_t* GC; bf16_t* U; const float* cw; const float* cb;
    DI void operator()(const f32x4 (&acc)[2][2][4][2], const Unit& u, int wr, int wc, int fr, int fq) const {
        const int row0 = u.pm * 256 + wr * 64 + fr, col0 = u.pn * 128 + wc * 32 + 4 * fq;
#define GU_ROR(x, n) gu_ror##n(x)
#pragma unroll
        for (int n = 0; n < 2; ++n) { const int c = col0 + n * 16;
            const f32x4 w0 = *(const f32x4*)(cw + c), w1 = *(const f32x4*)(cw + DFF + c), w2 = *(const f32x4*)(cw + 2 * DFF + c), bb = *(const f32x4*)(cb + c);
#pragma unroll
            for (int ai = 0; ai < 2; ++ai)
#pragma unroll
                for (int m = 0; m < 4; ++m) { const size_t r = (size_t)(row0 + ai * 128 + m * 16); const size_t slab = r >> 6;
                    const f32x4 g = acc[ai][0][m][n], v = acc[ai][1][m][n]; const f32x4 gp = acc[ai][0][m > 0 ? m - 1 : 0][n];
                    f32x4 o;
#pragma unroll
                    for (int j = 0; j < 4; ++j) { const float p1 = GU_ROR(g[j], 1), q1 = GU_ROR(gp[j], 1), p2 = GU_ROR(g[j], 2), q2 = GU_ROR(gp[j], 2);
                        const float g1 = fr == 0 ? q1 : p1, g2 = fr < 2 ? q2 : p2;
                        const float a = bb[j] + w0[j] * g2 + w1[j] * g1 + w2[j] * g[j]; o[j] = silu_(a) * v[j]; }
                    const bool defer = (m == 0) && (fr < 2);
                    uint2 w;
                    w.x = cvt_pk_bf16(defer ? v[0] : o[0], defer ? v[1] : o[1]); w.y = cvt_pk_bf16(defer ? v[2] : o[2], defer ? v[3] : o[3]);
                    *(uint2*)(U + r * DFF + c) = w;
                    if (defer || (m == 3 && fr >= 14)) { const int slot = defer ? 2 + fr : fr - 14; uint2 gw; gw.x = cvt_pk_bf16(g[0], g[1]); gw.y = cvt_pk_bf16(g[2], g[3]);
                        *(uint2*)(GC + (slab * 4 + slot) * DFF + c) = gw; } }
        }
#undef GU_ROR
    }
};
struct EpiLR {
    static constexpr bool PERM = false, AFTER_DRAIN = false;
    bf16_t* LW; const float* w0; const float* a0;
    DI void operator()(const f32x4 (&acc)[2][2][4][2], const Unit& u, int wr, int wc, int fr, int fq) const {
        const int row0 = u.pm * 256 + wr * 64 + fr, col0 = u.pn * 256 + wc * 32 + 4 * fq;
#pragma unroll
        for (int ai = 0; ai < 2; ++ai)
#pragma unroll
            for (int m = 0; m < 4; ++m) { const size_t r = (size_t)(row0 + ai * 128 + m * 16);
#pragma unroll
                for (int bj = 0; bj < 2; ++bj)
#pragma unroll
                    for (int n = 0; n < 2; ++n) { const int c = col0 + bj * 128 + n * 16; f32x4 v = acc[ai][bj][m][n];
                        if (c < 512) { const f32x4 b = *(const f32x4*)(w0 + c);
#pragma unroll
                            for (int j = 0; j < 4; ++j) v[j] = 1.f - __expf(-0.606531f * sigm_(b[j] + v[j])); }
                        else if (c < 1024) { const f32x4 b = *(const f32x4*)(a0 + c - 512);
#pragma unroll
                            for (int j = 0; j < 4; ++j) v[j] = sigm_(b[j] + v[j]); }
                        uint2 w; w.x = cvt_pk_bf16(v[0], v[1]); w.y = cvt_pk_bf16(v[2], v[3]); *(uint2*)(LW + r * 1536 + c) = w; } }
    }
};
template <class Epi> DI void run_gemm(unsigned char* smem, const bf16_t* A, const bf16_t* Bt, int N, int K, const Epi& E) {
    pg8::Gemm g; g.A = A; g.Bt = Bt; g.M = TOK; g.N = N; g.K = K;
    pg8::StaticOrder S; S.init(TOK, N, (int)gridDim.x, obid());
    pg8::gemm_phase<Epi, pg8::StaticOrder, false>((PG8_LAS unsigned char*)smem, g, S, E, nullptr);
}

DI void conv_tile4(const float* W, int Nsrc, int K, bf16_t* Wt, int nd0, int sc0, int nvalid, int k0, float* tile) {
    const int tid = otid(), j = tid & 63, kb = tid >> 6;
    float v[32];
#pragma unroll
    for (int i = 0; i < 32; ++i) { const int kk = kb + 8 * i; v[i] = (j < nvalid) ? W[(size_t)(k0 + kk) * Nsrc + sc0 + j] : 0.f; }
#pragma unroll
    for (int i = 0; i < 32; ++i) { const int kk = kb + 8 * i; tile[kk * 65 + j] = v[i]; }
    __syncthreads();
    const int nl = tid >> 3, ks = (tid & 7) * 8;
#pragma unroll
    for (int q = 0; q < 4; ++q) { const float* tq = tile + q * 64 * 65; uint4 o;
        o.x = pack2(tq[(ks + 0) * 65 + nl], tq[(ks + 1) * 65 + nl]); o.y = pack2(tq[(ks + 2) * 65 + nl], tq[(ks + 3) * 65 + nl]);
        o.z = pack2(tq[(ks + 4) * 65 + nl], tq[(ks + 5) * 65 + nl]); o.w = pack2(tq[(ks + 6) * 65 + nl], tq[(ks + 7) * 65 + nl]);
        *(uint4*)(Wt + (size_t)(nd0 + nl) * K + k0 + q * 64 + ks) = o; }
    __syncthreads();
}
DI void phase_weights(const Params& p, unsigned char* smem, int layer, int part) {
    float* tile = (float*)smem;
    const float* w_in = layer ? p.od_w_in : p.ev_w_in; const float* w_out = layer ? p.od_w_out : p.ev_w_out;
    const float* w_up = p.ffn_w_up + (size_t)layer * DM * 2 * DFF; const float* w_dn = p.ffn_w_down + (size_t)layer * DFF * DM;
    bf16_t* t_in = (bf16_t*)(p.ws + O_WT_IN); bf16_t* t_out = (bf16_t*)(p.ws + O_WT_OUT); bf16_t* t_up = (bf16_t*)(p.ws + O_WT_UP); bf16_t* t_dn = (bf16_t*)(p.ws + O_WT_DN);
    if (part == 0) {
        for (int job = obid(); job < 288; job += gridDim.x) {
            if (job < 224) { const int nt = job >> 2, kt = job & 3, nd0 = nt * 64; int nv = HS - nd0; nv = nv < 0 ? 0 : (nv > 64 ? 64 : nv);
                conv_tile4(w_in, HS, 1024, t_in, nd0, nd0, nv, kt * 256, tile); }
            else { const int j2 = job - 224, nt = j2 >> 2, kt = j2 & 3; conv_tile4(w_out, 1024, 1024, t_out, nt * 64, nt * 64, 64, kt * 256, tile); }
        }
    } else {
        const int nb = (int)gridDim.x - 128, lb = obid() - 128;
        if (lb < 0) return;
        if (part == 1) { for (int job = lb; job < 352; job += nb) { const int nt = job >> 2, kt = job & 3, nd0 = nt * 64; const int pn = nd0 >> 8, bj = (nd0 >> 7) & 1, j0 = nd0 & 127;
                conv_tile4(w_up, 2 * DFF, 1024, t_up, nd0, bj * DFF + 128 * pn + j0, 64, kt * 256, tile); } }
        else { for (int job = lb; job < 176; job += nb) { const int nt = job / 11, kt = job % 11; conv_tile4(w_dn, 1024, DFF, t_dn, nt * 64, nt * 64, 64, kt * 256, tile); } }
        return;
    }
    const int gtid = obid() * 512 + otid(), gsz = gridDim.x * 512;
    if (layer == 0) {
        float* rc = (float*)(p.ws + O_ROPE); float* rs = rc + SEQ * 32;
        for (int idx = gtid; idx < SEQ * 32; idx += gsz) { const int pos = idx >> 5, i = idx & 31;
            const float inv = (float)exp(-(double)i * (9.210340371976184 / 32.0)); const float ang = (float)pos * inv;
            const double a = (double)ang; const double n = rint(a * 0.15915494309189535); const double r = a - n * 6.283185307179586; const double r2 = r * r;
            double sn = 1.0 / 121645100408832000.0, cs = 1.0 / 2432902008176640000.0;
            sn = sn * r2 - 1.0 / 355687428096000.0; sn = sn * r2 + 1.0 / 1307674368000.0; sn = sn * r2 - 1.0 / 6227020800.0; sn = sn * r2 + 1.0 / 39916800.0;
            sn = sn * r2 - 1.0 / 362880.0; sn = sn * r2 + 1.0 / 5040.0; sn = sn * r2 - 1.0 / 120.0; sn = sn * r2 + 1.0 / 6.0; sn = sn * r2 * -1.0 + 1.0; sn = sn * r;
            cs = cs * r2 - 1.0 / 6402373705728000.0; cs = cs * r2 + 1.0 / 20922789888000.0; cs = cs * r2 - 1.0 / 87178291200.0; cs = cs * r2 + 1.0 / 479001600.0;
            cs = cs * r2 - 1.0 / 3628800.0; cs = cs * r2 + 1.0 / 40320.0; cs = cs * r2 - 1.0 / 720.0; cs = cs * r2 + 1.0 / 24.0; cs = cs * r2 - 0.5; cs = cs * r2 + 1.0;
            rc[idx] = (float)cs; rs[idx] = (float)sn; }
    } else {
        bf16_t* t_lr = (bf16_t*)(p.ws + O_WT_LR);
        for (int idx = gtid; idx < 1536 * 256; idx += gsz) { const int n = idx >> 8, k = idx & 255; float v = 0.f;
            if (n < 512) { if (k < 64) v = p.od_w_up[k * 512 + n]; }
            else if (n < 1024) { if (k >= 64 && k < 128) v = p.od_a_up[(k - 64) * 512 + n - 512]; }
            else { if (k >= 128) v = p.od_g_up[(k - 128) * 512 + n - 1024]; }
            t_lr[idx] = f2bf(v); }
    }
}
DI void phase_rmsnorm(const float* x, const float* w, bf16_t* xn) {
    const int lane = otid() & 63, wv = otid() >> 6;
    for (int r = obid() * 8 + wv; r < TOK; r += gridDim.x * 8) {
        const float* xr = x + (size_t)r * DM; f32x4 v[4]; float ss = 0.f;
#pragma unroll
        for (int i = 0; i < 4; ++i) { v[i] = *(const f32x4*)(xr + i * 256 + lane * 4); ss += v[i][0] * v[i][0] + v[i][1] * v[i][1] + v[i][2] * v[i][2] + v[i][3] * v[i][3]; }
        ss = red64(ss); const float rstd = rsqrtf(ss * (1.f / DM) + 1e-6f);
#pragma unroll
        for (int i = 0; i < 4; ++i) { const f32x4 ww = *(const f32x4*)(w + i * 256 + lane * 4); uint2 o; o.x = pack2(v[i][0] * rstd * ww[0], v[i][1] * rstd * ww[1]); o.y = pack2(v[i][2] * rstd * ww[2], v[i][3] * rstd * ww[3]);
            *(uint2*)(xn + (size_t)r * DM + i * 256 + lane * 4) = o; }
    }
}
DI void ssd_conv8(const Params& p, const bf16_t* H, int b, int t, int ch, float (&o)[8]) {
    const bf16_t* base = H + (size_t)b * SEQ * HS + 512 + ch;
    const int t0 = t - 3 < 0 ? 0 : t - 3, t1 = t - 2 < 0 ? 0 : t - 2, t2 = t - 1 < 0 ? 0 : t - 1;
    const uint4 r0 = *(const uint4*)(base + (size_t)t0 * HS), r1 = *(const uint4*)(base + (size_t)t1 * HS), r2 = *(const uint4*)(base + (size_t)t2 * HS), r3 = *(const uint4*)(base + (size_t)t * HS);
    const float m0 = t >= 3 ? 1.f : 0.f, m1 = t >= 2 ? 1.f : 0.f, m2 = t >= 1 ? 1.f : 0.f;
    float acc[8], xv[8];
    { const f32x4 b0 = *(const f32x4*)(p.ev_conv_b + ch), b1 = *(const f32x4*)(p.ev_conv_b + ch + 4);
      acc[0] = b0[0]; acc[1] = b0[1]; acc[2] = b0[2]; acc[3] = b0[3]; acc[4] = b1[0]; acc[5] = b1[1]; acc[6] = b1[2]; acc[7] = b1[3]; }
#define SSD_TAP(k, raw, msk) { unpack8(raw, xv); const f32x4 w0 = *(const f32x4*)(p.ev_conv_w + (k) * 768 + ch) * (msk), w1 = *(const f32x4*)(p.ev_conv_w + (k) * 768 + ch + 4) * (msk); \
        acc[0] += w0[0] * xv[0]; acc[1] += w0[1] * xv[1]; acc[2] += w0[2] * xv[2]; acc[3] += w0[3] * xv[3]; acc[4] += w1[0] * xv[4]; acc[5] += w1[1] * xv[5]; acc[6] += w1[2] * xv[6]; acc[7] += w1[3] * xv[7]; }
    SSD_TAP(0, r0, m0) SSD_TAP(1, r1, m1) SSD_TAP(2, r2, m2) SSD_TAP(3, r3, 1.f)
#pragma unroll
    for (int e = 0; e < 8; ++e) o[e] = silu_(acc[e]);
}
DI float ret_lg(int hh) { return log1pf(-exp2f(-5.f - (float)hh)); }
DI void chunk_decay(const Params& p, int mixer, int b, int hh, int t0, float* acs, float* dts) {
    const int tid = otid(), lane = tid & 63; const float* aux = (const float*)(p.ws + O_AUX);
    float v = 0.f;
    if (tid < 128) {
        if (mixer == 0) { const float dt = softplus_(aux[((size_t)b * SEQ + t0 + tid) * 8 + hh] + p.ev_dt_bias[hh]); dts[tid] = dt; v = -expf(p.ev_a_log[hh]) * dt; }
        else { dts[tid] = 1.f; v = ret_lg(hh); }
    }
#pragma unroll
    for (int off = 1; off < 64; off <<= 1) { const float t = __shfl_up(v, off); if (lane >= off) v += t; }
    if (tid == 63) acs[256] = v;
    __syncthreads();
    if (tid >= 64 && tid < 128) v += acs[256];
    if (tid < 128) acs[tid] = v;
    __syncthreads();
}
DI void phase_m1(const Params& p, unsigned char* smem) {
    bf16_t* Kt = (bf16_t*)smem; bf16_t* Vt = (bf16_t*)(smem + 17408); float* acs = (float*)(smem + 34816); float* dts = acs + 128;
    const bf16_t* H = (const bf16_t*)(p.ws + O_H); float* ST = (float*)(p.ws + O_ST); float* CD = (float*)(p.ws + O_CD);
    const float* rc = (const float*)(p.ws + O_ROPE); const float* rs = rc + SEQ * 32;
    const int tid = otid(), lane = tid & 63, w = tid >> 6;
    for (int u = obid(); u < 2048; u += gridDim.x) {
        const int mixer = u >> 10, bh = (u >> 6) & 15, c = u & 63, b = bh >> 3, hh = bh & 7, t0 = c * 128;
        chunk_decay(p, mixer, b, hh, t0, acs, dts);
        const float aend = acs[127];
        if (mixer == 0) {
#pragma unroll
            for (int it = 0; it < 2; ++it) { const int g = tid + it * 512, s = g >> 3, c8 = (g & 7) * 8; float o[8];
                const float sc = __expf(aend - acs[s]) * dts[s];
                ssd_conv8(p, H, b, t0 + s, 512 + (hh >> 2) * 64 + c8, o);
#pragma unroll
                for (int e = 0; e < 8; ++e) Kt[(c8 + e) * 136 + s] = f2bf(o[e] * sc);
                ssd_conv8(p, H, b, t0 + s, hh * 64 + c8, o);
#pragma unroll
                for (int e = 0; e < 8; ++e) Vt[(c8 + e) * 136 + s] = f2bf(o[e]); }
            if (tid == 0) CD[bh * 64 + c] = __expf(aend);
        } else {
            { const int s = tid >> 2, i0 = (tid & 3) * 8; const size_t r = (size_t)b * SEQ + t0 + s; float k1[8], k2[8];
              unpack8(*(const uint4*)(H + r * HS + 1800 + hh * 64 + i0), k1); unpack8(*(const uint4*)(H + r * HS + 1800 + hh * 64 + 32 + i0), k2);
              const float sc = __expf(aend - acs[s]) * 0.125f;
#pragma unroll
              for (int e = 0; e < 8; ++e) { const float cs = rc[(t0 + s) * 32 + i0 + e], sn = rs[(t0 + s) * 32 + i0 + e];
                  Kt[(i0 + e) * 136 + s] = f2bf((k1[e] * cs - k2[e] * sn) * sc); Kt[(32 + i0 + e) * 136 + s] = f2bf((k1[e] * sn + k2[e] * cs) * sc); } }
#pragma unroll
            for (int it = 0; it < 2; ++it) { const int g = tid + it * 512, s = g >> 3, c8 = (g & 7) * 8; const size_t r = (size_t)b * SEQ + t0 + s; float v[8];
                unpack8(*(const uint4*)(H + r * HS + 2312 + hh * 64 + c8), v);
#pragma unroll
                for (int e = 0; e < 8; ++e) Vt[(c8 + e) * 136 + s] = (unsigned short)f2bf(v[e]); }
        }
        __syncthreads();
        { const int mt = w & 3, nt0 = (w >> 2) * 2; f32x4 a0 = {0.f, 0.f, 0.f, 0.f}, a1 = {0.f, 0.f, 0.f, 0.f};
#pragma unroll
          for (int ks = 0; ks < 4; ++ks) { const bf16x8 af = ldfrag(Kt, mt * 16, 136, ks * 32, lane);
              a0 = MFMA16(af, ldfrag(Vt, nt0 * 16, 136, ks * 32, lane), a0); a1 = MFMA16(af, ldfrag(Vt, nt0 * 16 + 16, 136, ks * 32, lane), a1); }
          float* dst = ST + (size_t)u * 4096 + mt * 16 + (lane >> 4) * 4;
          *(f32x4*)(dst + (nt0 * 16 + (lane & 15)) * 64) = a0; *(f32x4*)(dst + (nt0 * 16 + 16 + (lane & 15)) * 64) = a1; }
        __syncthreads();
    }
}
DI void phase_m2(const Params& p) {
    float* ST = (float*)(p.ws + O_ST); const float* CD = (const float*)(p.ws + O_CD);
    for (int idx = obid() * 512 + otid(); idx < 32 * 4096; idx += gridDim.x * 512) {
        const int mb = idx >> 12, e = idx & 4095, mixer = mb >> 4, bh = mb & 15; float run = 0.f;
        const float gdec = __expf(128.f * ret_lg(bh & 7));
#pragma unroll 8
        for (int c = 0; c < 64; ++c) { const size_t o = ((size_t)(mb * 64 + c)) * 4096 + e; const float v = ST[o]; ST[o] = run;
            const float dec = mixer == 0 ? CD[bh * 64 + c] : gdec; run = run * dec + v; }
    }
}
template <int MIXER> DI void m3_head(const Params& p, unsigned char* smem, int b, int c, int hh, float (&ssq)[4]) {
    bf16_t* Qs = (bf16_t*)smem; bf16_t* Ks = (bf16_t*)(smem + 18432); bf16_t* Vt = (bf16_t*)(smem + 36864); bf16_t* Rt = (bf16_t*)(smem + 54272); bf16_t* Ps = (bf16_t*)(smem + 63488);
    float* acs = (float*)(smem + 98304); float* dts = acs + 128;
    const bf16_t* H = (const bf16_t*)(p.ws + O_H); const float* ST = (const float*)(p.ws + O_ST); float* YG = (float*)(p.ws + O_YG); bf16_t* Y = (bf16_t*)(p.ws + O_XN);
    const float* rc = (const float*)(p.ws + O_ROPE); const float* rs = rc + SEQ * 32;
    const int tid = otid(), lane = tid & 63, w = tid >> 6, t0 = c * 128, bh = b * 8 + hh;
    const size_t u = (size_t)((MIXER * 16 + bh) * 64 + c);
    __syncthreads();
    chunk_decay(p, MIXER, b, hh, t0, acs, dts);
    if (MIXER == 0) {
#pragma unroll
        for (int it = 0; it < 2; ++it) { const int g = tid + it * 512, s = g >> 3, c8 = (g & 7) * 8; float o[8];
            ssd_conv8(p, H, b, t0 + s, 640 + (hh >> 2) * 64 + c8, o); *(uint4*)(Qs + s * 72 + c8) = pack8(o);
            ssd_conv8(p, H, b, t0 + s, 512 + (hh >> 2) * 64 + c8, o); *(uint4*)(Ks + s * 72 + c8) = pack8(o);
            ssd_conv8(p, H, b, t0 + s, hh * 64 + c8, o);
#pragma unroll
            for (int e = 0; e < 8; ++e) Vt[(c8 + e) * 136 + s] = f2bf(o[e]); }
    } else {
        { const int s = tid >> 2, i0 = (tid & 3) * 8; const size_t r = (size_t)b * SEQ + t0 + s; float a1[8], a2[8], o1[8], o2[8];
          unpack8(*(const uint4*)(H + r * HS + 1288 + hh * 64 + i0), a1); unpack8(*(const uint4*)(H + r * HS + 1288 + hh * 64 + 32 + i0), a2);
#pragma unroll
          for (int e = 0; e < 8; ++e) { const float cs = rc[(t0 + s) * 32 + i0 + e], sn = rs[(t0 + s) * 32 + i0 + e]; o1[e] = a1[e] * cs - a2[e] * sn; o2[e] = a1[e] * sn + a2[e] * cs; }
          *(uint4*)(Qs + s * 72 + i0) = pack8(o1); *(uint4*)(Qs + s * 72 + 32 + i0) = pack8(o2);
          unpack8(*(const uint4*)(H + r * HS + 1800 + hh * 64 + i0), a1); unpack8(*(const uint4*)(H + r * HS + 1800 + hh * 64 + 32 + i0), a2);
#pragma unroll
          for (int e = 0; e < 8; ++e) { const float cs = rc[(t0 + s) * 32 + i0 + e], sn = rs[(t0 + s) * 32 + i0 + e]; o1[e] = (a1[e] * cs - a2[e] * sn) * 0.125f; o2[e] = (a1[e] * sn + a2[e] * cs) * 0.125f; }
          *(uint4*)(Ks + s * 72 + i0) = pack8(o1); *(uint4*)(Ks + s * 72 + 32 + i0) = pack8(o2); }
#pragma unroll
        for (int it = 0; it < 2; ++it) { const int g = tid + it * 512, s = g >> 3, c8 = (g & 7) * 8; const size_t r = (size_t)b * SEQ + t0 + s;
            const uint4 raw = *(const uint4*)(H + r * HS + 2312 + hh * 64 + c8); const unsigned short* rv = (const unsigned short*)&raw;
#pragma unroll
            for (int e = 0; e < 8; ++e) Vt[(c8 + e) * 136 + s] = rv[e]; }
    }
    { const int pr = tid >> 3, n8 = (tid & 7) * 8; const float* src = ST + u * 4096 + pr * 64 + n8; const f32x4 x0 = *(const f32x4*)src, x1 = *(const f32x4*)(src + 4);
      uint4 o; o.x = pack2(x0[0], x0[1]); o.y = pack2(x0[2], x0[3]); o.z = pack2(x1[0], x1[1]); o.w = pack2(x1[2], x1[3]); *(uint4*)(Rt + pr * 72 + n8) = o; }
    __syncthreads();
    const int nks = (w >> 1) + 1;
    const int lrow = 16 * w + (lane >> 4) * 4;
    {
        const bf16x8 q0 = ldfrag(Qs, 16 * w, 72, 0, lane), q1 = ldfrag(Qs, 16 * w, 72, 32, lane);
        float al[4];
#pragma unroll
        for (int j = 0; j < 4; ++j) al[j] = acs[lrow + j];
        for (int nt = 0; nt < 2 * nks; ++nt) { f32x4 sacc = {0.f, 0.f, 0.f, 0.f};
            sacc = MFMA16(q0, ldfrag(Ks, nt * 16, 72, 0, lane), sacc); sacc = MFMA16(q1, ldfrag(Ks, nt * 16, 72, 32, lane), sacc);
            const int s = nt * 16 + (lane & 15); const float as = acs[s], ds = dts[s];
#pragma unroll
            for (int j = 0; j < 4; ++j) { const float pv = (s <= lrow + j) ? sacc[j] * __expf(al[j] - as) * ds : 0.f; Ps[(lrow + j) * 136 + s] = f2bf(pv); } }
    }
    __syncthreads();
    f32x4 yd[4], yo[4];
#pragma unroll
    for (int nt = 0; nt < 4; ++nt) { yd[nt] = (f32x4){0.f, 0.f, 0.f, 0.f}; yo[nt] = (f32x4){0.f, 0.f, 0.f, 0.f}; }
    for (int ks = 0; ks < nks; ++ks) { const bf16x8 pf = ldfrag(Ps, 16 * w, 136, ks * 32, lane);
#pragma unroll
        for (int nt = 0; nt < 4; ++nt) yd[nt] = MFMA16(pf, ldfrag(Vt, nt * 16, 136, ks * 32, lane), yd[nt]); }
#pragma unroll
    for (int ks = 0; ks < 2; ++ks) { const bf16x8 qf = ldfrag(Qs, 16 * w, 72, ks * 32, lane);
#pragma unroll
        for (int nt = 0; nt < 4; ++nt) yo[nt] = MFMA16(qf, ldfrag(Rt, nt * 16, 72, ks * 32, lane), yo[nt]); }
    float ea[4];
#pragma unroll
    for (int j = 0; j < 4; ++j) ea[j] = __expf(acs[lrow + j]);
    if (MIXER == 0) {
        const float dsk = p.ev_d[hh];
#pragma unroll
        for (int nt = 0; nt < 4; ++nt) { const int pc = nt * 16 + (lane & 15);
#pragma unroll
            for (int j = 0; j < 4; ++j) { const size_t r = (size_t)b * SEQ + t0 + lrow + j;
                const float y = yd[nt][j] + ea[j] * yo[nt][j] + dsk * bf2f(Vt[pc * 136 + lrow + j]);
                const float z = bf2f(H[r * HS + hh * 64 + pc]); const float yg = y * silu_(z); ssq[j] += yg * yg; YG[r * 512 + hh * 64 + pc] = yg; } }
    } else {
        float s2[4];
#pragma unroll
        for (int j = 0; j < 4; ++j) { float a = 0.f;
#pragma unroll
            for (int nt = 0; nt < 4; ++nt) { const float y = yd[nt][j] + ea[j] * yo[nt][j]; yd[nt][j] = y; a += y * y; }
            s2[j] = rsqrtf(red16(a) * (1.f / 64.f) + 1e-6f); }
#pragma unroll
        for (int nt = 0; nt < 4; ++nt) { const int pc = nt * 16 + (lane & 15); const float nw = p.ev_ret_norm_w[hh * 64 + pc];
#pragma unroll
            for (int j = 0; j < 4; ++j) { const size_t r = (size_t)b * SEQ + t0 + lrow + j; const float g = bf2f(H[r * HS + 2824 + hh * 64 + pc]);
                Y[r * DM + 512 + hh * 64 + pc] = f2bf(silu_(g) * yd[nt][j] * s2[j] * nw); } }
    }
}
DI void phase_m3(const Params& p, unsigned char* smem) {
    const int lane = otid() & 63, w = otid() >> 6;
    for (int u = obid(); u < 256; u += gridDim.x) {
        const int mixer = u >> 7, b = (u >> 6) & 1, c = u & 63; float ssq[4] = {0.f, 0.f, 0.f, 0.f};
        if (mixer == 0) {
            for (int hh = 0; hh < 8; ++hh) m3_head<0>(p, smem, b, c, hh, ssq);
            float* YG = (float*)(p.ws + O_YG); bf16_t* Y = (bf16_t*)(p.ws + O_XN); const int lrow = 16 * w + (lane >> 4) * 4;
            float rstd[4];
#pragma unroll
            for (int j = 0; j < 4; ++j) rstd[j] = rsqrtf(red16(ssq[j]) * (1.f / 512.f) + 1e-6f);
            for (int cc = 0; cc < 32; ++cc) { const int col = cc * 16 + (lane & 15); const float nw = p.ev_ssd_norm_w[col];
#pragma unroll
                for (int j = 0; j < 4; ++j) { const size_t r = (size_t)b * SEQ + c * 128 + lrow + j;
                    const float v = __hip_atomic_load(YG + r * 512 + col, __ATOMIC_RELAXED, __HIP_MEMORY_SCOPE_AGENT); Y[r * DM + col] = f2bf(v * rstd[j] * nw); } }
        } else {
            for (int hh = 0; hh < 8; ++hh) m3_head<1>(p, smem, b, c, hh, ssq);
        }
    }
}
DI void phase_ffn_fix(const Params& p, int layer) {
    const bf16_t* GC = (const bf16_t*)(p.ws + O_G); bf16_t* U = (bf16_t*)(p.ws + O_U);
    const float* cw = p.ffn_conv_w + (size_t)layer * 3 * DFF; const float* cb = p.ffn_conv_b + (size_t)layer * DFF;
    for (int idx = obid() * 512 + otid(); idx < 256 * 2 * (DFF / 8); idx += gridDim.x * 512) {
        const int c8 = (idx % (DFF / 8)) * 8, ri = idx / (DFF / 8), k = ri >> 1, i = ri & 1, r = k * 64 + i, t = r & (SEQ - 1);
        const int kp = k > 0 ? k - 1 : 0;
        const bf16_t* s0 = GC + ((size_t)kp * 4 + (i == 0 ? 0 : 1)) * DFF + c8;
        const bf16_t* s1 = i == 0 ? GC + ((size_t)kp * 4 + 1) * DFF + c8 : GC + ((size_t)k * 4 + 2) * DFF + c8;
        const bf16_t* s2 = GC + ((size_t)k * 4 + 2 + i) * DFF + c8;
        const float m0 = (t - 2 >= 0) ? 1.f : 0.f, m1 = (t - 1 >= 0) ? 1.f : 0.f;
        const uint4 r0 = *(const uint4*)s0, r1 = *(const uint4*)s1, r2 = *(const uint4*)s2, ru = *(const uint4*)(U + (size_t)r * DFF + c8);
        float acc[8], g[8], uv[8];
        { const f32x4 b0 = *(const f32x4*)(cb + c8), b1 = *(const f32x4*)(cb + c8 + 4); acc[0] = b0[0]; acc[1] = b0[1]; acc[2] = b0[2]; acc[3] = b0[3]; acc[4] = b1[0]; acc[5] = b1[1]; acc[6] = b1[2]; acc[7] = b1[3]; }
#define FIX_TAP(kk, raw, msk) { unpack8(raw, g); const f32x4 w0 = *(const f32x4*)(cw + (kk) * DFF + c8) * (msk), w1 = *(const f32x4*)(cw + (kk) * DFF + c8 + 4) * (msk); \
            acc[0] += w0[0] * g[0]; acc[1] += w0[1] * g[1]; acc[2] += w0[2] * g[2]; acc[3] += w0[3] * g[3]; acc[4] += w1[0] * g[4]; acc[5] += w1[1] * g[5]; acc[6] += w1[2] * g[6]; acc[7] += w1[3] * g[7]; }
        FIX_TAP(0, r0, m0) FIX_TAP(1, r1, m1) FIX_TAP(2, r2, 1.f)
        unpack8(ru, uv);
#pragma unroll
        for (int e2 = 0; e2 < 8; ++e2) acc[e2] = silu_(acc[e2]) * uv[e2];
        *(uint4*)(U + (size_t)r * DFF + c8) = pack8(acc);
    }
}
DI void phase_l1_prep(const Params& p, unsigned char* smem) {
    const bf16_t* H = (const bf16_t*)(p.ws + O_H); const float* aux = (const float*)(p.ws + O_AUX); float* FC = (float*)(p.ws + O_FC);
    bf16_t* KN = (bf16_t*)(p.ws + O_KN); bf16_t* VT = (bf16_t*)(p.ws + O_VT); bf16_t* AP = (bf16_t*)(p.ws + O_AP);
    const int tid = otid();
    for (int u = obid(); u < 16 + 1024; u += gridDim.x) {
        __syncthreads();
        if (u < 16) {
            float* tot = (float*)smem; const int bh = u, b = bh >> 3, hh = bh & 7; const float fb = p.od_f_bias[hh]; float loc[16]; float run = 0.f;
#pragma unroll
            for (int i = 0; i < 16; ++i) { const float xv = aux[((size_t)b * SEQ + tid * 16 + i) * 8 + hh] + fb; run += -softplus_(-xv); loc[i] = run; }
            tot[tid] = run; __syncthreads();
            float off = 0.f; for (int i = 0; i < tid; ++i) off += tot[i];
#pragma unroll
            for (int i = 0; i < 16; ++i) FC[(size_t)bh * SEQ + tid * 16 + i] = off + loc[i];
        } else {
            bf16_t* Vl = (bf16_t*)smem; const int v2 = u - 16, bh = v2 >> 6, blk = v2 & 63, b = bh >> 3, hh = bh & 7, t0 = blk * 128;
            { const int l = tid >> 2, c16 = (tid & 3) * 16; const size_t r = (size_t)b * SEQ + t0 + l; float a[8], c[8];
              unpack8(*(const uint4*)(H + r * HS + 2304 + hh * 64 + c16), a); unpack8(*(const uint4*)(H + r * HS + 2304 + hh * 64 + c16 + 8), c);
              float ss = 0.f;
#pragma unroll
              for (int e = 0; e < 8; ++e) ss += a[e] * a[e] + c[e] * c[e];
              ss += __shfl_xor(ss, 1); ss += __shfl_xor(ss, 2); const float rstd = rsqrtf(ss * (1.f / 64.f) + 1e-6f);
#pragma unroll
              for (int e = 0; e < 8; ++e) { a[e] *= rstd * p.od_kn_w[c16 + e]; c[e] *= rstd * p.od_kn_w[c16 + 8 + e]; }
              bf16_t* dst = KN + ((size_t)bh * SEQ + t0 + l) * 64 + c16; *(uint4*)dst = pack8(a); *(uint4*)(dst + 8) = pack8(c); }
#pragma unroll
            for (int it = 0; it < 2; ++it) { const int g = tid + it * 512, s = g >> 3, c8 = (g & 7) * 8; const size_t r = (size_t)b * SEQ + t0 + s;
                *(uint4*)(Vl + s * 72 + c8) = *(const uint4*)(H + r * HS + 2816 + hh * 64 + c8); }
            __syncthreads();
#pragma unroll
            for (int it = 0; it < 2; ++it) { const int g = tid + it * 512, e = g >> 4, s8 = (g & 15) * 8; uint4 o;
                o.x = (unsigned)Vl[(s8 + 0) * 72 + e] | ((unsigned)Vl[(s8 + 1) * 72 + e] << 16); o.y = (unsigned)Vl[(s8 + 2) * 72 + e] | ((unsigned)Vl[(s8 + 3) * 72 + e] << 16);
                o.z = (unsigned)Vl[(s8 + 4) * 72 + e] | ((unsigned)Vl[(s8 + 5) * 72 + e] << 16); o.w = (unsigned)Vl[(s8 + 6) * 72 + e] | ((unsigned)Vl[(s8 + 7) * 72 + e] << 16);
                *(uint4*)(VT + ((size_t)bh * 64 + e) * SEQ + t0 + s8) = o; }
        }
    }
    {
        float* KNRM = (float*)(p.ws + O_KNRM);
        for (int idx = obid() * 512 + tid; idx < TOK * 64; idx += gridDim.x * 512) {
            const int r = idx >> 6, c8 = (idx & 63) * 8, t = r & (SEQ - 1); float cur[8], prv[8]; float ss = 0.f;
            unpack8(*(const uint4*)(H + (size_t)r * HS + 512 + c8), cur);
            if (t > 0) unpack8(*(const uint4*)(H + (size_t)(r - 1) * HS + 512 + c8), prv); else {
#pragma unroll
                for (int e = 0; e < 8; ++e) prv[e] = 0.f; }
#pragma unroll
            for (int e = 0; e < 8; ++e) { const float v = (cur[e] + (prv[e] - cur[e]) * p.od_mu[512 + c8 + e]) * p.od_k_k[c8 + e]; ss += v * v; }
            ss += __shfl_xor(ss, 1); ss += __shfl_xor(ss, 2); ss += __shfl_xor(ss, 4);
            if ((idx & 7) == 0) KNRM[(size_t)r * 8 + (c8 >> 6)] = 1.f / fmaxf(sqrtf(ss), 1e-12f);
        }
    }
    for (int idx = obid() * 512 + tid; idx < TOK * 32; idx += gridDim.x * 512) {
        const int r = idx >> 5, j8 = (idx & 31) * 8, t = r & (SEQ - 1); float cur[8], prv[8], o[8];
        unpack8(*(const uint4*)(H + (size_t)r * HS + 1536 + j8), cur);
        if (t > 0) unpack8(*(const uint4*)(H + (size_t)(r - 1) * HS + 1536 + j8), prv); else {
#pragma unroll
            for (int e = 0; e < 8; ++e) prv[e] = 0.f; }
#pragma unroll
        for (int e = 0; e < 8; ++e) { const float v = cur[e] + (prv[e] - cur[e]) * p.od_mu[1536 + j8 + e];
            o[e] = (j8 < 64) ? tanhf(v) : ((j8 < 128) ? v : sigm_(v)); }
        *(uint4*)(AP + (size_t)r * 256 + j8) = pack8(o);
    }
}
DI void fox_unit(const Params& p, unsigned char* smem, int bh, int qb) {
    bf16_t* Qs = (bf16_t*)smem; bf16_t* Ks = (bf16_t*)(smem + 18432); bf16_t* Vts = (bf16_t*)(smem + 36864); float* ck = (float*)(smem + 89600);
    const bf16_t* H = (const bf16_t*)(p.ws + O_H); const float* FC = (const float*)(p.ws + O_FC); const bf16_t* KN = (const bf16_t*)(p.ws + O_KN); const bf16_t* VT = (const bf16_t*)(p.ws + O_VT);
    bf16_t* Y = (bf16_t*)(p.ws + O_XN);
    const int tid = otid(), lane = tid & 63, w = tid >> 6, b = bh >> 3, hh = bh & 7; const size_t r0 = (size_t)b * SEQ + qb * 128;
    const float LOG2E = 1.4426950408889634f;
    __syncthreads();
    { const int l = tid >> 2, c16 = (tid & 3) * 16; float a[8], c[8];
      unpack8(*(const uint4*)(H + (r0 + l) * HS + 1792 + hh * 64 + c16), a); unpack8(*(const uint4*)(H + (r0 + l) * HS + 1792 + hh * 64 + c16 + 8), c);
      float ss = 0.f;
#pragma unroll
      for (int e = 0; e < 8; ++e) ss += a[e] * a[e] + c[e] * c[e];
      ss += __shfl_xor(ss, 1); ss += __shfl_xor(ss, 2); const float rstd = rsqrtf(ss * (1.f / 64.f) + 1e-6f) * (0.125f * LOG2E);
#pragma unroll
      for (int e = 0; e < 8; ++e) { a[e] *= rstd * p.od_qn_w[c16 + e]; c[e] *= rstd * p.od_qn_w[c16 + 8 + e]; }
      *(uint4*)(Qs + l * 72 + c16) = pack8(a); *(uint4*)(Qs + l * 72 + c16 + 8) = pack8(c); }
    float mrow = -1e30f, lsum = 0.f; f32x4 O[4];
#pragma unroll
    for (int j = 0; j < 4; ++j) O[j] = (f32x4){0.f, 0.f, 0.f, 0.f};
    const int q4 = (lane >> 4) * 4, lq = 16 * w + (lane & 15);
    uint4 kreg0, kreg1, vreg0, vreg1; float ckreg = 0.f;
    const int g0 = tid, g1 = tid + 512;
#define FOX_ISSUE(kb_) { \
        kreg0 = *(const uint4*)(KN + ((size_t)bh * SEQ + (kb_) * 128 + (g0 >> 3)) * 64 + (g0 & 7) * 8); \
        kreg1 = *(const uint4*)(KN + ((size_t)bh * SEQ + (kb_) * 128 + (g1 >> 3)) * 64 + (g1 & 7) * 8); \
        vreg0 = *(const uint4*)(VT + ((size_t)bh * 64 + (g0 >> 4)) * SEQ + (kb_) * 128 + (g0 & 15) * 8); \
        vreg1 = *(const uint4*)(VT + ((size_t)bh * 64 + (g1 >> 4)) * SEQ + (kb_) * 128 + (g1 & 15) * 8); \
        if (tid < 128) ckreg = FC[(size_t)bh * SEQ + (kb_) * 128 + tid]; }
    FOX_ISSUE(0)
    for (int kb = 0; kb <= qb; ++kb) {
        __syncthreads();
        *(uint4*)(Ks + (g0 >> 3) * 72 + (g0 & 7) * 8) = kreg0; *(uint4*)(Ks + (g1 >> 3) * 72 + (g1 & 7) * 8) = kreg1;
        *(uint4*)(Vts + (g0 >> 4) * 136 + (g0 & 15) * 8) = vreg0; *(uint4*)(Vts + (g1 >> 4) * 136 + (g1 & 15) * 8) = vreg1;
        if (tid < 128) ck[tid] = -ckreg * LOG2E;
        __syncthreads();
        if (kb < qb) FOX_ISSUE(kb + 1)
        f32x4 S[8];
        { const bf16x8 q0 = ldfrag(Qs, 16 * w, 72, 0, lane), q1 = ldfrag(Qs, 16 * w, 72, 32, lane);
#pragma unroll
          for (int nt = 0; nt < 8; ++nt) { f32x4 z = *(const f32x4*)(ck + nt * 16 + q4); z = MFMA16(ldfrag(Ks, nt * 16, 72, 0, lane), q0, z); S[nt] = MFMA16(ldfrag(Ks, nt * 16, 72, 32, lane), q1, z); } }
        if (kb == qb) {
#pragma unroll
            for (int nt = 0; nt < 8; ++nt)
#pragma unroll
                for (int j = 0; j < 4; ++j) if (nt * 16 + q4 + j > lq) S[nt][j] = -1e30f;
        }
        float mx = S[0][0];
#pragma unroll
        for (int nt = 0; nt < 8; ++nt)
#pragma unroll
            for (int j = 0; j < 4; ++j) mx = fmaxf(mx, S[nt][j]);
        mx = fmaxf(mx, __shfl_xor(mx, 16)); mx = fmaxf(mx, __shfl_xor(mx, 32));
        const float mnew = fmaxf(mrow, mx); const float alpha = __builtin_amdgcn_exp2f(mrow - mnew); mrow = mnew;
        float rs = 0.f;
#pragma unroll
        for (int nt = 0; nt < 8; ++nt)
#pragma unroll
            for (int j = 0; j < 4; ++j) { const float pv = __builtin_amdgcn_exp2f(S[nt][j] - mnew); S[nt][j] = pv; rs += pv; }
        lsum = lsum * alpha + rs;
#pragma unroll
        for (int et = 0; et < 4; ++et) O[et] = O[et] * alpha;
#pragma unroll
        for (int ks = 0; ks < 4; ++ks) {
            uint4 pw; pw.x = cvt_pk_bf16(S[2 * ks][0], S[2 * ks][1]); pw.y = cvt_pk_bf16(S[2 * ks][2], S[2 * ks][3]); pw.z = cvt_pk_bf16(S[2 * ks + 1][0], S[2 * ks + 1][1]); pw.w = cvt_pk_bf16(S[2 * ks + 1][2], S[2 * ks + 1][3]);
            const bf16x8 pf = __builtin_bit_cast(bf16x8, pw);
#pragma unroll
            for (int et = 0; et < 4; ++et) { const bf16_t* vp = Vts + (et * 16 + (lane & 15)) * 136 + ks * 32 + q4;
                uint4 vw; const uint2 lo = *(const uint2*)vp, hi = *(const uint2*)(vp + 16); vw.x = lo.x; vw.y = lo.y; vw.z = hi.x; vw.w = hi.y;
                O[et] = MFMA16(__builtin_bit_cast(bf16x8, vw), pf, O[et]); }
        }
    }
    lsum += __shfl_xor(lsum, 16); lsum += __shfl_xor(lsum, 32);
    const float inv = 1.f / lsum;
#pragma unroll
    for (int et = 0; et < 4; ++et) { uint2 o; o.x = pack2(O[et][0] * inv, O[et][1] * inv); o.y = pack2(O[et][2] * inv, O[et][3] * inv);
        *(uint2*)(Y + (r0 + lq) * DM + 512 + hh * 64 + et * 16 + q4) = o; }
}
constexpr int RW_T = 32, RW_BUF = 43008;
struct RwRegs { unsigned short r[9], k[9], v[9], om[8], a[8]; float kn[8]; };
#define RW_BAR() do { asm volatile("s_waitcnt lgkmcnt(0)" ::: "memory"); __builtin_amdgcn_s_barrier(); asm volatile("" ::: "memory"); } while (0)
DI void rwkv_unit(const Params& p, unsigned char* smem, int bh, int rg) {
    const bf16_t* H = (const bf16_t*)(p.ws + O_H); const bf16_t* LW = (const bf16_t*)(p.ws + O_LW); bf16_t* Y = (bf16_t*)(p.ws + O_XN); const float* KNRM = (const float*)(p.ws + O_KNRM);
    const int tid = otid(), lane = tid & 63, w = tid >> 6, b = bh >> 3, hh = bh & 7; const size_t rb = (size_t)b * SEQ;
    float* ysh = (float*)(smem + 2 * RW_BUF);
    const int NCH = SEQ / RW_T;
    __syncthreads();
    if (w < 2) {
        float S0 = 0.f, S1 = 0.f, S2 = 0.f, S3 = 0.f; const int kq = lane & 15, row = w * 4 + (lane >> 4);
        RW_BAR();
        for (int ch = 0; ch < NCH; ++ch) {
            const float* bufp = (const float*)(smem + (ch & 1) * RW_BUF) + kq * 4; const float* vp = (const float*)(smem + (ch & 1) * RW_BUF) + 10240 + row; float* yo = ysh + (ch & 1) * 256 + row;
#define RW_LOAD(R, W, K, Q, B, V, tt) { R = *(const f32x4*)(bufp + (tt) * 64); W = *(const f32x4*)(bufp + 2048 + (tt) * 64); K = *(const f32x4*)(bufp + 4096 + (tt) * 64); \
                Q = *(const f32x4*)(bufp + 6144 + (tt) * 64); B = *(const f32x4*)(bufp + 8192 + (tt) * 64); V = vp[(tt) * 8]; }
#define DPPF(x, ctrl) __builtin_bit_cast(float, __builtin_amdgcn_update_dpp(0, __builtin_bit_cast(int, (x)), (ctrl), 0xF, 0xF, true))
            f32x4 prevR = {0.f, 0.f, 0.f, 0.f}; float yacc = 0.f;
            f32x4 rN, wN, kN, qN, bN; float vN;
            RW_LOAD(rN, wN, kN, qN, bN, vN, 0)
            __builtin_amdgcn_sched_barrier(0);
#pragma unroll
            for (int tt = 0; tt < RW_T; ++tt) {
                const f32x4 R = rN, W = wN, K = kN, Q = qN, B = bN; const float V = vN;
                if (tt + 1 < RW_T) RW_LOAD(rN, wN, kN, qN, bN, vN, tt + 1)
                float d = S0 * Q[0] + S1 * Q[1] + S2 * Q[2] + S3 * Q[3];
                if (tt > 0) {
                    float y = S0 * prevR[0] + S1 * prevR[1] + S2 * prevR[2] + S3 * prevR[3];
                    d += DPPF(d, 0xB1); y += DPPF(y, 0xB1); d += DPPF(d, 0x4E); y += DPPF(y, 0x4E); d += DPPF(d, 0x141); y += DPPF(y, 0x141); d += DPPF(d, 0x140); y += DPPF(y, 0x140);
                    yacc = (kq == ((tt - 1) & 15)) ? y : yacc;
                    if (tt == 16) yo[kq * 8] = yacc;
                } else d = dpp_red16(d);
                const float sa = -d;
                S0 = (S0 * W[0] + V * K[0]) + sa * B[0]; S1 = (S1 * W[1] + V * K[1]) + sa * B[1]; S2 = (S2 * W[2] + V * K[2]) + sa * B[2]; S3 = (S3 * W[3] + V * K[3]) + sa * B[3];
                prevR = R;
                if (tt & 1) __builtin_amdgcn_sched_barrier(0);
            }
            { float y = S0 * prevR[0] + S1 * prevR[1] + S2 * prevR[2] + S3 * prevR[3]; y = dpp_red16(y); yacc = (kq == 15) ? y : yacc; yo[(16 + kq) * 8] = yacc; }
            RW_BAR();
        }
    } else if (w == 4 || w == 5) {
        const unsigned* ta0; const unsigned* ta1; const unsigned* ta2; size_t st0, st1, st2;
        { int L = lane; int tok = L / 5, which = L - tok * 5; ta0 = (const unsigned*)(which < 3 ? H + (rb + tok) * HS + which * 512 + hh * 64 : LW + (rb + tok) * 1536 + (which - 3) * 512 + hh * 64); st0 = which < 3 ? (size_t)HS * 2 : (size_t)1536 * 2;
          L = lane + 64; tok = L / 5; which = L - tok * 5; ta1 = (const unsigned*)(which < 3 ? H + (rb + tok) * HS + which * 512 + hh * 64 : LW + (rb + tok) * 1536 + (which - 3) * 512 + hh * 64); st1 = which < 3 ? (size_t)HS * 2 : (size_t)1536 * 2;
          L = lane + 128 > 159 ? 159 : lane + 128; tok = L / 5; which = L - tok * 5; ta2 = (const unsigned*)(which < 3 ? H + (rb + tok) * HS + which * 512 + hh * 64 : LW + (rb + tok) * 1536 + (which - 3) * 512 + hh * 64); st2 = which < 3 ? (size_t)HS * 2 : (size_t)1536 * 2; }
        unsigned x0 = 0, x1 = 0, x2 = 0, y0 = 0, y1 = 0, y2 = 0, z0 = 0, z1 = 0, z2 = 0, pacc = 0;
        RW_BAR();
        for (int ch = 0; ch < NCH; ++ch) {
            if (w == 4) { int cc = ch + 6; cc = cc > NCH - 1 ? NCH - 1 : cc; const size_t tb = (size_t)cc * RW_T;
                pacc ^= x0 ^ x1 ^ x2; x0 = y0; x1 = y1; x2 = y2; y0 = z0; y1 = z1; y2 = z2;
                z0 = *(const unsigned*)((const char*)ta0 + tb * st0); z1 = *(const unsigned*)((const char*)ta1 + tb * st1); z2 = *(const unsigned*)((const char*)ta2 + tb * st2); }
            RW_BAR();
        }
        pacc ^= x0 ^ x1 ^ x2 ^ y0 ^ y1 ^ y2 ^ z0 ^ z1 ^ z2; if (pacc == 0x9e3779b9u && rg == 77) Y[0] = 0;
    } else {
        const int lw = (w & 1) + ((w >> 2) << 1), col = hh * 64 + lane; RwRegs ra;
        const float mur = p.od_mu[col], muk = p.od_mu[512 + col], muv = p.od_mu[1024 + col], kk_w = p.od_k_k[col], ka_w = p.od_k_a[col];
        auto issue = [&](int ch, RwRegs& rr) {
            const int tbase = ch * RW_T + lw * 8;
#pragma unroll
            for (int i = 0; i < 9; ++i) { const int t = tbase + i - 1;
                if (t >= 0) { const bf16_t* hp = H + (rb + t) * HS; rr.r[i] = hp[col]; rr.k[i] = hp[512 + col]; rr.v[i] = hp[1024 + col]; } else { rr.r[i] = 0; rr.k[i] = 0; rr.v[i] = 0; }
                if (i > 0) { const bf16_t* lp = LW + (rb + t) * 1536; rr.om[i - 1] = lp[col]; rr.a[i - 1] = lp[512 + col]; rr.kn[i - 1] = KNRM[(rb + t) * 8 + hh]; } }
        };
        auto process = [&](int ch, const RwRegs& rr) {
            float* bufp = (float*)(smem + (ch & 1) * RW_BUF);
#pragma unroll
            for (int i = 1; i < 9; ++i) { const int tt = lw * 8 + i - 1;
                const float rc = bf2f(rr.r[i]), rp = bf2f(rr.r[i - 1]), kc = bf2f(rr.k[i]), kp = bf2f(rr.k[i - 1]), vc = bf2f(rr.v[i]), vp = bf2f(rr.v[i - 1]);
                const float rl = rc + (rp - rc) * mur, kl = kc + (kp - kc) * muk, vl = vc + (vp - vc) * muv; const float a = bf2f(rr.a[i - 1]), wv = 1.f - bf2f(rr.om[i - 1]);
                const float kk = kl * kk_w * rr.kn[i - 1];
                bufp[tt * 64 + lane] = rl; bufp[2048 + tt * 64 + lane] = wv; bufp[4096 + tt * 64 + lane] = kl * (1.f + (a - 1.f) * ka_w); bufp[6144 + tt * 64 + lane] = kk; bufp[8192 + tt * 64 + lane] = kk * a;
                if ((lane >> 3) == rg) bufp[10240 + tt * 8 + (lane & 7)] = vl; }
        };
        issue(0, ra); process(0, ra); issue(1, ra);
        RW_BAR();
        for (int ch = 0; ch < NCH; ++ch) {
            if (ch + 1 < NCH) { process(ch + 1, ra); if (ch + 2 < NCH) issue(ch + 2, ra); }
            if (ch > 0 && lw < 2) { const float* yi = ysh + ((ch - 1) & 1) * 256; const int t2 = lw * 64 + lane, tt = t2 >> 2, pr = (t2 & 3) * 2;
                *(unsigned*)(Y + (rb + (ch - 1) * RW_T + tt) * DM + hh * 64 + rg * 8 + pr) = pack2(yi[tt * 8 + pr], yi[tt * 8 + pr + 1]); }
            RW_BAR();
        }
        if (lw < 2) { const float* yi = ysh + ((NCH - 1) & 1) * 256; const int t2 = lw * 64 + lane, tt = t2 >> 2, pr = (t2 & 3) * 2;
          *(unsigned*)(Y + (rb + (NCH - 1) * RW_T + tt) * DM + hh * 64 + rg * 8 + pr) = pack2(yi[tt * 8 + pr], yi[tt * 8 + pr + 1]); }
    }
    __syncthreads();
}
DI void phase_l1_mix(const Params& p, unsigned char* smem, int pass) {
    unsigned* ctr = (unsigned*)(p.ws + O_CTL) + pass * 4; int* sh = (int*)(smem + 90112);
    if (obid() < 128 && pass != 2) rwkv_unit(p, smem, obid() >> 3, obid() & 7);
    for (;;) {
        __syncthreads(); if (otid() == 0) *sh = (int)atomicAdd(ctr, 1u); __syncthreads();
        const int u = *sh; if (u >= 1024) break;
        fox_unit(p, smem, u & 15, 63 - (u >> 4));
    }
}
DI void phase_rwkv_fin(const Params& p) {
    const bf16_t* H = (const bf16_t*)(p.ws + O_H); const bf16_t* LW = (const bf16_t*)(p.ws + O_LW); bf16_t* Y = (bf16_t*)(p.ws + O_XN);
    const int lane = otid() & 63, wv = otid() >> 6;
    for (int task = obid() * 8 + wv; task < TOK * 8; task += gridDim.x * 8) {
        const int r = task >> 3, hh = task & 7, t = r & (SEQ - 1), col = hh * 64 + lane; const bf16_t* hp = H + (size_t)r * HS;
        const float y = bf2f(Y[(size_t)r * DM + col]); const float mean = red64(y) * (1.f / 64.f); const float dy = y - mean; const float var = red64(dy * dy) * (1.f / 64.f);
        const float yln = dy * rsqrtf(var + 64e-5f) * p.od_ln_w[col] + p.od_ln_b[col];
        const float rc = bf2f(hp[col]), kc = bf2f(hp[512 + col]), vc = bf2f(hp[1024 + col]); float rp = 0.f, kp = 0.f, vp = 0.f;
        if (t > 0) { rp = bf2f(hp[col - HS]); kp = bf2f(hp[512 + col - HS]); vp = bf2f(hp[1024 + col - HS]); }
        const float rl = rc + (rp - rc) * p.od_mu[col], kl = kc + (kp - kc) * p.od_mu[512 + col], vl = vc + (vp - vc) * p.od_mu[1024 + col];
        const float a = bf2f(LW[(size_t)r * 1536 + 512 + col]), g = bf2f(LW[(size_t)r * 1536 + 1024 + col]);
        const float kt = kl * (1.f + (a - 1.f) * p.od_k_a[col]); const float bonus = red64(rl * kt * p.od_r_k[col]) * vl;
        Y[(size_t)r * DM + col] = f2bf((yln + bonus) * g);
    }
}
#define XB_TMO      128
#define XB_XCNT(j)  (256  + 64 * (j))
#define XB_XSUB(j)  (1280 + 64 * (j))
#define XB_XGEN(j)  (2304 + 64 * (j))
#define XB_TOP      3328
#define XB_TOPGEN   3392
#define XCD_BAR_WORDS 3456
#define XB_SPIN_CAP (1u << 18)
#define LAS __attribute__((address_space(3)))

__device__ __forceinline__ unsigned xb_ld(unsigned* p)              { return __hip_atomic_load(p, __ATOMIC_RELAXED, __HIP_MEMORY_SCOPE_AGENT); }
__device__ __forceinline__ unsigned xb_add(unsigned* p, unsigned v) { return __hip_atomic_fetch_add(p, v, __ATOMIC_RELAXED, __HIP_MEMORY_SCOPE_AGENT); }
__device__ __forceinline__ unsigned xb_xcc_id() { return (unsigned)__builtin_amdgcn_s_getreg((3 << 11) | 20) & 0xFu; }
#define XB_SPIN(cond, bar) do { unsigned _sp = 0; while (cond) { __builtin_amdgcn_s_sleep(1); \
    if ((++_sp & 255u) == 0u) { if (xb_ld(&(bar)[XB_TMO])) break; if (_sp > XB_SPIN_CAP) { atomicAdd(&(bar)[XB_TMO], 1u); break; } } } } while (0)

struct XcdBarrier {
    unsigned* bar; unsigned x;
    volatile LAS unsigned* st;
};

__device__ __forceinline__ XcdBarrier xcd_barrier_post(unsigned* bar, volatile LAS unsigned* st) {
    XcdBarrier b; b.bar = bar; b.x = xb_xcc_id(); b.st = st;
    if (threadIdx.x == 0) (void)xb_add(&bar[XB_XCNT(b.x)], 1u);
    return b;
}
__device__ __forceinline__ void xcd_barrier_complete(unsigned* bar, unsigned x, unsigned& nloc, unsigned& nx) {
    const unsigned G = gridDim.x * gridDim.y * gridDim.z;
    unsigned sum, cnt, mine, sp = 0u;
    for (;;) {
        sum = 0u; cnt = 0u; mine = 0u;
#pragma unroll
        for (unsigned j = 0; j < 16; ++j) { const unsigned c = xb_ld(&bar[XB_XCNT(j)]); sum += c; cnt += (c > 0u) ? 1u : 0u; mine = (j == x) ? c : mine; }
        if (sum == G) break;
        __builtin_amdgcn_s_sleep(1);
        if ((++sp & 255u) == 0u) { if (xb_ld(&bar[XB_TMO])) break; if (sp > XB_SPIN_CAP) { atomicAdd(&bar[XB_TMO], 1u); break; } }
    }
    nloc = mine > 0u ? mine : 1u; nx = cnt > 0u ? cnt : 1u;
}

__device__ __forceinline__ void xcd_barrier(const XcdBarrier& b) {
    asm volatile("s_waitcnt vmcnt(0)" ::: "memory");
    __syncthreads();
    if (threadIdx.x == 0) {
        unsigned* bar = b.bar;
        __builtin_amdgcn_s_waitcnt(0);
        unsigned nloc = b.st[0], nx = b.st[1];
        if (nloc == 0u) { xcd_barrier_complete(bar, b.x, nloc, nx); b.st[0] = nloc; b.st[1] = nx; }
        const unsigned old = xb_add(&bar[XB_XSUB(b.x)], 1u);
        const unsigned gen = old / nloc;
        if (old + 1u == (gen + 1u) * nloc) {
            __builtin_amdgcn_fence(__ATOMIC_RELEASE, "agent");
            asm volatile("s_waitcnt vmcnt(0)" ::: "memory");
            const unsigned og = xb_add(&bar[XB_TOP], 1u);
            const unsigned tg = og / nx;
            if (og + 1u == (tg + 1u) * nx) xb_add(&bar[XB_TOPGEN], 1u);
            else XB_SPIN(xb_ld(&bar[XB_TOPGEN]) == tg, bar);
            __builtin_amdgcn_fence(__ATOMIC_ACQUIRE, "agent");
            xb_add(&bar[XB_XGEN(b.x)], 1u);
            asm volatile("s_waitcnt vmcnt(0)" ::: "memory");
        } else {
            XB_SPIN(xb_ld(&bar[XB_XGEN(b.x)]) == gen, bar);
            __builtin_amdgcn_fence(__ATOMIC_ACQUIRE, "agent");
            asm volatile("s_waitcnt vmcnt(0)" ::: "memory");
        }
    }
    __syncthreads();
}


__global__ void __launch_bounds__(512, 2) fwd_megakernel(Params p) {
    extern __shared__ __attribute__((aligned(16))) unsigned char smem[];
    cg::grid_group grid = cg::this_grid();
    unsigned char* ws = p.ws;
    bf16_t* XN = (bf16_t*)(ws + O_XN); bf16_t* Hb = (bf16_t*)(ws + O_H); float* aux = (float*)(ws + O_AUX);
    const bf16_t* t_in = (const bf16_t*)(ws + O_WT_IN); const bf16_t* t_out = (const bf16_t*)(ws + O_WT_OUT); const bf16_t* t_up = (const bf16_t*)(ws + O_WT_UP);
    const bf16_t* t_dn = (const bf16_t*)(ws + O_WT_DN); const bf16_t* t_lr = (const bf16_t*)(ws + O_WT_LR);
    if (blockIdx.x == 0 && threadIdx.x < 16) ((unsigned*)(ws + O_CTL))[threadIdx.x] = 0u;
    if (threadIdx.x == 0) *(uint4*)(smem + 131072) = make_uint4(0u, 0u, 0u, 0u);
    __syncthreads();
    const XcdBarrier xb = xcd_barrier_post((unsigned*)(ws + O_BAR), (volatile LAS unsigned*)(smem + 131072));
#define GSYNC() xcd_barrier(xb)
#define GEMM_H(layer) { EpiH E; E.H = Hb; E.aux = aux; E.auxc = layer ? 3328 : 1280; run_gemm(smem, XN, t_in, 3584, 1024, E); }
#define GEMM_OUT(layer) { EpiRes E; E.res = layer ? p.out : p.x; E.out = p.out; run_gemm(smem, XN, t_out, 1024, 1024, E); }
#define GEMM_UP(layer) { EpiGU E; E.GC = (bf16_t*)(ws + O_G); E.U = (bf16_t*)(ws + O_U); E.cw = p.ffn_conv_w + (size_t)(layer) * 3 * DFF; E.cb = p.ffn_conv_b + (size_t)(layer) * DFF; run_gemm(smem, XN, t_up, 2 * DFF, 1024, E); }
#define GEMM_DN() { EpiRes E; E.res = p.out; E.out = p.out; run_gemm(smem, (const bf16_t*)(ws + O_U), t_dn, 1024, DFF, E); }
    phase_weights(p, smem, 0, 0); phase_rmsnorm(p.x, p.ev_norm_w, XN);
    if (p.ws == nullptr) grid.sync();
    GSYNC();
    GEMM_H(0) phase_weights(p, smem, 0, 1); GSYNC();
#if PROBE == 2
    GEMM_H(0) GSYNC();
#endif
    phase_m1(p, smem); GSYNC();
#if PROBE == 3
    phase_m1(p, smem); GSYNC();
#endif
    phase_m2(p); GSYNC();
#if PROBE == 6
    GSYNC(); GSYNC(); GSYNC(); GSYNC(); GSYNC(); GSYNC(); GSYNC(); GSYNC(); GSYNC(); GSYNC();
#endif
#if PROBE == 7
    phase_weights(p, smem, 0, 0); GSYNC(); phase_rmsnorm(p.x, p.ev_norm_w, XN); GSYNC(); phase_rmsnorm(p.x, p.ev_norm_w, XN); GSYNC();
#endif
    phase_m3(p, smem); GSYNC();
#if PROBE == 3
    phase_m3(p, smem); GSYNC();
#endif
    GEMM_OUT(0) GSYNC();
#if PROBE == 2
    GEMM_OUT(0) GSYNC();
#endif
    phase_rmsnorm(p.out, p.ffn_norm_w, XN); GSYNC();
    GEMM_UP(0) phase_weights(p, smem, 0, 2); GSYNC();
    phase_ffn_fix(p, 0); GSYNC();
    GEMM_DN() GSYNC();
    phase_weights(p, smem, 1, 0); phase_rmsnorm(p.out, p.od_norm_w, XN); GSYNC();
    GEMM_H(1) phase_weights(p, smem, 1, 1); GSYNC();
    phase_l1_prep(p, smem); GSYNC();
    { EpiLR E; E.LW = (bf16_t*)(ws + O_LW); E.w0 = p.od_w0; E.a0 = p.od_a0; run_gemm(smem, (const bf16_t*)(ws + O_AP), t_lr, 1536, 256, E); } GSYNC();
    phase_l1_mix(p, smem, 0); GSYNC();
#if PROBE == 4
    phase_l1_mix(p, smem, 1); GSYNC();
#endif
#if PROBE == 5
    phase_l1_mix(p, smem, 2); GSYNC();
#endif
    phase_rwkv_fin(p); GSYNC();
    GEMM_OUT(1) GSYNC();
    phase_rmsnorm(p.out, p.ffn_norm_w + DM, XN); GSYNC();
    GEMM_UP(1) phase_weights(p, smem, 1, 2); GSYNC();
    phase_ffn_fix(p, 1); GSYNC();
    GEMM_DN()
}

extern "C" void kernel_launch(void* const* d_in, const int* in_sizes, int n_in, void* d_out, int out_size, void* d_ws, size_t ws_size, hipStream_t stream) {
    static int grid_blocks = 0;
    if (grid_blocks == 0) {
        int dev = 0, cus = 0, per_cu = 0;
        hipGetDevice(&dev); hipDeviceGetAttribute(&cus, hipDeviceAttributeMultiprocessorCount, dev);
        if (hipFuncSetAttribute((const void*)fwd_megakernel, hipFuncAttributeMaxDynamicSharedMemorySize, LDS_BYTES) != hipSuccess) fprintf(stderr, "hipFuncSetAttribute failed\n");
        hipOccupancyMaxActiveBlocksPerMultiprocessor(&per_cu, (const void*)fwd_megakernel, 512, LDS_BYTES);
        (void)hipGetLastError();
        if (per_cu < 1) fprintf(stderr, "occupancy query says %d blocks per CU\n", per_cu);
        grid_blocks = cus > 0 ? cus : 256;
        if (ws_size < WS_NEED) fprintf(stderr, "workspace too small: %zu < %zu\n", ws_size, (size_t)WS_NEED);
    }
    Params p{};
    const float** pp = (const float**)&p;
    for (int i = 0; i < 33; ++i) pp[i] = (const float*)d_in[i];
    p.out = (float*)d_out; p.ws = (unsigned char*)d_ws;
    (void)hipMemsetAsync((char*)d_ws + O_BAR, 0, 16384, stream);
    void* args[] = {&p};
    hipError_t e = hipLaunchCooperativeKernel((const void*)fwd_megakernel, dim3(grid_blocks), dim3(512), args, LDS_BYTES, stream);
    if (e != hipSuccess) fprintf(stderr, "cooperative launch failed: %s (grid %d)\n", hipGetErrorString(e), grid_blocks);
}
```

```cpp
#include <hip/hip_runtime.h>
#include <hip/hip_cooperative_groups.h>
#include <cstdio>
#ifndef PROBE
#define PROBE 0
#endif
namespace cg = cooperative_groups;
namespace pg8 {
#define PG8_LAS __attribute__((address_space(3)))
typedef unsigned short bf16_t;
typedef short bf16x8 __attribute__((ext_vector_type(8)));
typedef float f32x4 __attribute__((ext_vector_type(4)));
typedef unsigned u32x4 __attribute__((ext_vector_type(4)));
constexpr int BM = 256, BK = 64, HALF = 128, HTB = HALF * BK * 2  , STAGE_BYTES = 8 * HTB, NXCD = 8, WGM = 8;

__host__ __device__ __forceinline__ int lds_byte(int r, int c) { const int st = (r >> 4) * 2 + (c >> 5), rr = r & 15, cc = c & 31, ob = rr * 64 + cc * 2; return st * 1024 + (ob ^ (((ob >> 9) & 1) << 5)); }
__host__ __device__ __forceinline__ void stage_rc(int b, int& R, int& C) { const int st = b / 1024, sb = b % 1024, swz = sb ^ (((sb >> 9) & 1) << 5); R = (st >> 1) * 16 + swz / 64; C = (st & 1) * 32 + (swz % 64) / 2; }
__host__ __device__ __forceinline__ int perm32(int rho) { const int n = rho >> 4, i = rho & 15; return 8 * (i >> 2) + 4 * n + (i & 3); }

struct Unit { int pm, pn; };
struct Gemm { const bf16_t* A; const bf16_t* Bt; int M, N, K; };

struct StaticOrder {
    int nM, nN, nwg, G, c;
    __host__ __device__ void init(int M, int N, int G_, int c_) { nM = M / BM; nN = N / BM; nwg = nM * nN; G = G_; c = c_; }
    __host__ __device__ bool next(int i, Unit& u) const {
        const long L = (long)i * G + c; if (L >= nwg) return false;
        int wgid = (int)L; { const int q = nwg / NXCD, r = nwg % NXCD, xcd = wgid % NXCD, off = wgid / NXCD; wgid = (xcd < r ? xcd * (q + 1) : r * (q + 1) + (xcd - r) * q) + off; }
        const int nig = WGM * nN, gid = wgid / nig, fm = gid * WGM, gsz = (nM - fm) < WGM ? (nM - fm) : WGM;
        u.pm = fm + ((wgid % nig) % gsz); u.pn = (wgid % nig) / gsz; return true;
    }
    __device__ __forceinline__ void a_ready(const Unit&) const {}
    __device__ __forceinline__ void done(const Unit&) const {}
};
__device__ __forceinline__ unsigned cvt_pk_bf16(float lo, float hi) { unsigned r; asm volatile("v_cvt_pk_bf16_f32 %0, %1, %2" : "=v"(r) : "v"(lo), "v"(hi)); return r; }

template <class Epi, class Sched, bool STAMP = false>
__device__ __forceinline__ void gemm_phase(PG8_LAS unsigned char* lds, const Gemm g, const Sched& S, const Epi& E, unsigned long long* stamps) {
    int tid_ = threadIdx.x; asm volatile("" : "+v"(tid_)); const int tid = tid_, wid = __builtin_amdgcn_readfirstlane(tid >> 6), lane = tid & 63, wr = wid >> 2, wc = wid & 3, fr = lane & 15, fq = lane >> 4;
    const int K = g.K, nt = K / BK;
    int ts_lo = 0, ts_hi = 0, nts = 0; const unsigned long long rt_entry = STAMP ? (unsigned long long)wall_clock64() : 0ull;
#define PG8_STAMP() do { if (STAMP && wid == 0 && nts < 64) { const unsigned long long _c = (unsigned long long)clock64(); \
        ts_lo = (lane == nts) ? (int)(unsigned)_c : ts_lo; ts_hi = (lane == nts) ? (int)(unsigned)(_c >> 32) : ts_hi; ++nts; } } while (0)
    PG8_STAMP();
    unsigned voffA[2], voffB[2];
#pragma unroll
    for (int i = 0; i < 2; ++i) { int R, C; stage_rc(tid * 16 + i * 8192, R, C); const int Rb = Epi::PERM ? ((R & ~31) + perm32(R & 31)) : R;
        voffA[i] = (unsigned)(R * K + C) * 2u; voffB[i] = (unsigned)(Rb * K + C) * 2u; }
    const size_t kstep = (size_t)(BK * 2);
    const size_t hstep = (size_t)HALF * K * 2;
    const size_t tstep = 2 * hstep;
    const unsigned ldsw = (unsigned)wid * 1024u;
    const int aoff = lds_byte(wr * 64 + fr, fq * 8), boff = lds_byte(wc * 32 + fr, fq * 8);
#define PG8_SA(b, h) (((b) * 2 + (h)) * HTB)
#define PG8_SB(b, h) ((4 + (b) * 2 + (h)) * HTB)
#define PG8_STAGE(bufoff, gbase, voff) do { _Pragma("unroll") for (int _i = 0; _i < 2; ++_i) \
        __builtin_amdgcn_global_load_lds((const unsigned*)((const char*)(gbase) + (voff)[_i]), (PG8_LAS unsigned*)(lds + (bufoff) + ldsw + _i * 8192), 16, 0, 0); } while (0)
#define PG8_LDA(dst, b, h) do { _Pragma("unroll") for (int m = 0; m < 4; ++m) _Pragma("unroll") for (int k = 0; k < 2; ++k) dst[m][k] = *(const PG8_LAS bf16x8*)(lds + PG8_SA(b, h) + aoff + m * 2048 + k * 1024); } while (0)
#define PG8_LDB(dst, b, h) do { _Pragma("unroll") for (int n = 0; n < 2; ++n) _Pragma("unroll") for (int k = 0; k < 2; ++k) dst[n][k] = *(const PG8_LAS bf16x8*)(lds + PG8_SB(b, h) + boff + n * 2048 + k * 1024); } while (0)
#define PG8_MMA(ai, bj, At, Bt) do { __builtin_amdgcn_s_setprio(1); _Pragma("unroll") for (int m = 0; m < 4; ++m) _Pragma("unroll") for (int n = 0; n < 2; ++n) _Pragma("unroll") for (int k = 0; k < 2; ++k) \
        acc[ai][bj][m][n] = __builtin_amdgcn_mfma_f32_16x16x32_bf16(Bt[n][k], At[m][k], acc[ai][bj][m][n], 0, 0, 0); __builtin_amdgcn_s_setprio(0); } while (0)
#define PG8_WAIT_V(n) asm volatile("s_waitcnt vmcnt(" #n ")" ::: "memory")
#define PG8_WAIT_L(n) asm volatile("s_waitcnt lgkmcnt(" #n ")" ::: "memory")
#define PG8_BAR __builtin_amdgcn_s_barrier()
#define PG8_SCHED __builtin_amdgcn_sched_barrier(0)
    Unit cur, nxt; int ui = 0;
    if (!S.next(0, cur)) return;
    f32x4 acc[2][2][4][2];
#pragma unroll
    for (int a = 0; a < 2; ++a)
#pragma unroll
        for (int b = 0; b < 2; ++b)
#pragma unroll
            for (int m = 0; m < 4; ++m)
#pragma unroll
                for (int n = 0; n < 2; ++n) acc[a][b][m][n] = (f32x4){0.f, 0.f, 0.f, 0.f};
    bf16x8 At[4][2], B0[2][2], B1[2][2];
    const char* cA = (const char*)g.A + (size_t)cur.pm * tstep; const char* cB = (const char*)g.Bt + (size_t)cur.pn * tstep;
    S.a_ready(cur);
    PG8_STAGE(PG8_SB(0, 0), cB, voffB); PG8_STAGE(PG8_SA(0, 0), cA, voffA); PG8_STAGE(PG8_SB(0, 1), cB + hstep, voffB); PG8_STAGE(PG8_SA(0, 1), cA + hstep, voffA);
    if (wr == 1) PG8_BAR;
    PG8_WAIT_V(4); PG8_BAR;
    PG8_STAGE(PG8_SB(1, 0), cB + kstep, voffB); PG8_STAGE(PG8_SA(1, 0), cA + kstep, voffA); PG8_STAGE(PG8_SB(1, 1), cB + hstep + kstep, voffB);
    PG8_WAIT_V(6); PG8_BAR;
    PG8_STAMP();
    for (;;) {
        const bool has_next = S.next(ui + 1, nxt);
        const char* nA = has_next ? (const char*)g.A + (size_t)nxt.pm * tstep : cA; const char* nB = has_next ? (const char*)g.Bt + (size_t)nxt.pn * tstep : cB;
        for (int t = 0; t < nt; t += 2) {
            const bool last = (t == nt - 2);
            const char* a1 = cA + (size_t)(t + 1) * kstep;
            const char* a2 = last ? nA : cA + (size_t)(t + 2) * kstep; const char* b2 = last ? nB : cB + (size_t)(t + 2) * kstep;
            const char* a3 = a2 + kstep; const char* b3 = b2 + kstep;
            if (last && has_next) S.a_ready(nxt);
            PG8_LDB(B0, 0, 0); PG8_SCHED; PG8_LDA(At, 0, 0); PG8_STAGE(PG8_SA(1, 1), a1 + hstep, voffA);
            PG8_WAIT_L(8); PG8_BAR; PG8_WAIT_L(0); PG8_MMA(0, 0, At, B0); PG8_BAR; PG8_SCHED;
            PG8_LDB(B1, 0, 1); PG8_STAGE(PG8_SB(0, 0), b2, voffB);
            PG8_BAR; PG8_WAIT_L(0); PG8_MMA(0, 1, At, B1); PG8_BAR;
            PG8_LDA(At, 0, 1); PG8_STAGE(PG8_SA(0, 0), a2, voffA);
            PG8_BAR; PG8_WAIT_L(0); PG8_MMA(1, 0, At, B0); PG8_BAR; PG8_SCHED;
            PG8_STAGE(PG8_SB(0, 1), b2 + hstep, voffB);
            PG8_WAIT_V(6); PG8_BAR; PG8_MMA(1, 1, At, B1); PG8_BAR;
            PG8_LDB(B0, 1, 0); PG8_SCHED; PG8_LDA(At, 1, 0); PG8_STAGE(PG8_SA(0, 1), a2 + hstep, voffA);
            PG8_WAIT_L(8); PG8_BAR; PG8_WAIT_L(0); PG8_MMA(0, 0, At, B0); PG8_BAR; PG8_SCHED;
            PG8_LDB(B1, 1, 1); PG8_STAGE(PG8_SB(1, 0), b3, voffB);
            PG8_BAR; PG8_WAIT_L(0); PG8_MMA(0, 1, At, B1); PG8_BAR;
            PG8_LDA(At, 1, 1); PG8_STAGE(PG8_SA(1, 0), a3, voffA);
            PG8_BAR; PG8_WAIT_L(0); PG8_MMA(1, 0, At, B0); PG8_BAR; PG8_SCHED;
            PG8_STAGE(PG8_SB(1, 1), b3 + hstep, voffB);
            PG8_WAIT_V(6); PG8_BAR; PG8_MMA(1, 1, At, B1); PG8_BAR;
        }
        PG8_STAMP();
        if constexpr (!Epi::AFTER_DRAIN) { E(acc, cur, wr, wc, fr, fq); S.done(cur); }
        PG8_STAMP();
        if (!has_next) break;
#pragma unroll
        for (int a = 0; a < 2; ++a)
#pragma unroll
            for (int b = 0; b < 2; ++b)
#pragma unroll
                for (int m = 0; m < 4; ++m)
#pragma unroll
                    for (int n = 0; n < 2; ++n) acc[a][b][m][n] = (f32x4){0.f, 0.f, 0.f, 0.f};
        cur = nxt; cA = nA; cB = nB; ++ui;
    }
    PG8_WAIT_V(0);
    if (wr == 0) PG8_BAR;
    PG8_BAR;
    if constexpr (Epi::AFTER_DRAIN) { E.fused(acc, cur, wr, wc, fr, fq, lds, wid, lane); S.done(cur); }
    PG8_STAMP();
    if (STAMP && wid == 0) { stamps[lane] = lane < nts ? (((unsigned long long)(unsigned)ts_hi << 32) | (unsigned)ts_lo) : 0ull;
        if (lane == 62) stamps[62] = rt_entry; if (lane == 63) stamps[63] = (unsigned long long)wall_clock64(); }
#undef PG8_STAMP
#undef PG8_SA
#undef PG8_SB
#undef PG8_STAGE
#undef PG8_LDA
#undef PG8_LDB
#undef PG8_MMA
#undef PG8_WAIT_V
#undef PG8_WAIT_L
#undef PG8_BAR
#undef PG8_SCHED
}
}

using pg8::bf16_t; using pg8::bf16x8; using pg8::f32x4; using pg8::Unit; using pg8::cvt_pk_bf16;
#define DI __device__ __forceinline__
constexpr int TOK = 16384, SEQ = 8192, DM = 1024, HS = 3336, DFF = 2816;
constexpr size_t O_CTL = 0, O_CD = 256, O_AUX = 4352, O_ROPE = 528640, O_FC = 2625792, O_WT = 3150080;
constexpr size_t O_WT_IN = O_WT, O_WT_OUT = O_WT_IN + 7340032, O_WT_UP = O_WT_OUT + 2097152, O_WT_DN = O_WT_UP + 11534336, O_WT_LR = O_WT_DN + 5767168;
constexpr size_t O_XN = O_WT + 27525120, O_R1 = O_XN + 33554432;
constexpr size_t O_H = O_R1, O_ST = O_R1 + 109314048, O_YG = O_ST + 33554432;
constexpr size_t O_G = O_R1, O_U = O_R1 + 92274688;
constexpr size_t O_LW = O_R1 + 109314048, O_KN = O_LW + 50331648, O_VT = O_KN + 16777216, O_AP = O_VT + 16777216;
constexpr size_t O_KNRM = O_AP + 8388608;
constexpr size_t O_BAR = O_KNRM + 524288;
constexpr size_t WS_NEED = O_BAR + 16384;
constexpr int LDS_BYTES = 131072 + 256;

struct Params {
    const float* x; const float* ev_norm_w; const float* ev_w_in; const float* ev_conv_w; const float* ev_conv_b; const float* ev_dt_bias; const float* ev_a_log;
    const float* ev_d; const float* ev_ssd_norm_w; const float* ev_ret_norm_w; const float* ev_w_out;
    const float* od_norm_w; const float* od_w_in; const float* od_mu; const float* od_w0; const float* od_w_up; const float* od_a0; const float* od_a_up;
    const float* od_g_up; const float* od_k_k; const float* od_k_a; const float* od_r_k; const float* od_ln_w; const float* od_ln_b;
    const float* od_qn_w; const float* od_kn_w; const float* od_f_bias; const float* od_w_out;
    const float* ffn_norm_w; const float* ffn_w_up; const float* ffn_conv_w; const float* ffn_conv_b; const float* ffn_w_down;
    float* out; unsigned char* ws;
};

DI unsigned cvtpk(float lo, float hi) { unsigned r; asm("v_cvt_pk_bf16_f32 %0, %1, %2" : "=v"(r) : "v"(lo), "v"(hi)); return r; }
DI unsigned short f2bf(float f) { return (unsigned short)(cvtpk(f, f) & 0xffffu); }
DI float bf2f(unsigned short b) { return __uint_as_float(((unsigned)b) << 16); }
DI unsigned pack2(float lo, float hi) { return cvtpk(lo, hi); }
DI float bflo(unsigned w) { return __uint_as_float(w << 16); }
DI float bfhi(unsigned w) { return __uint_as_float(w & 0xffff0000u); }
DI void unpack8(const uint4 r, float (&o)[8]) { o[0] = bflo(r.x); o[1] = bfhi(r.x); o[2] = bflo(r.y); o[3] = bfhi(r.y); o[4] = bflo(r.z); o[5] = bfhi(r.z); o[6] = bflo(r.w); o[7] = bfhi(r.w); }
DI uint4 pack8(const float (&o)[8]) { uint4 r; r.x = pack2(o[0], o[1]); r.y = pack2(o[2], o[3]); r.z = pack2(o[4], o[5]); r.w = pack2(o[6], o[7]); return r; }
DI float silu_(float x) { return x * __builtin_amdgcn_rcpf(1.f + __expf(-x)); }
DI float sigm_(float x) { return __builtin_amdgcn_rcpf(1.f + __expf(-x)); }
DI float softplus_(float x) { return fmaxf(x, 0.f) + log1pf(__expf(-fabsf(x))); }
DI bf16x8 ldfrag(const bf16_t* base, int row0, int ld, int k0, int lane) { return *(const bf16x8*)(base + (row0 + (lane & 15)) * ld + k0 + (lane >> 4) * 8); }
#define MFMA16(a, b, c) __builtin_amdgcn_mfma_f32_16x16x32_bf16((a), (b), (c), 0, 0, 0)
DI float red16(float v) { v += __shfl_xor(v, 1); v += __shfl_xor(v, 2); v += __shfl_xor(v, 4); v += __shfl_xor(v, 8); return v; }
DI float max16(float v) { v = fmaxf(v, __shfl_xor(v, 1)); v = fmaxf(v, __shfl_xor(v, 2)); v = fmaxf(v, __shfl_xor(v, 4)); v = fmaxf(v, __shfl_xor(v, 8)); return v; }
DI float red64(float v) { v += __shfl_xor(v, 32); v += __shfl_xor(v, 16); return red16(v); }
DI float dpp_red16(float x) {
    x += __builtin_bit_cast(float, __builtin_amdgcn_update_dpp(0, __builtin_bit_cast(int, x), 0xB1, 0xF, 0xF, true));
    x += __builtin_bit_cast(float, __builtin_amdgcn_update_dpp(0, __builtin_bit_cast(int, x), 0x4E, 0xF, 0xF, true));
    x += __builtin_bit_cast(float, __builtin_amdgcn_update_dpp(0, __builtin_bit_cast(int, x), 0x141, 0xF, 0xF, true));
    x += __builtin_bit_cast(float, __builtin_amdgcn_update_dpp(0, __builtin_bit_cast(int, x), 0x140, 0xF, 0xF, true));
    return x;
}

DI int otid() { int t = threadIdx.x; asm volatile("" : "+v"(t)); return t; }
DI int obid() { int b = blockIdx.x; asm volatile("" : "+s"(b)); return b; }
struct EpiH {
    static constexpr bool PERM = false, AFTER_DRAIN = false;
    bf16_t* H; float* aux; int auxc;
    DI void operator()(const f32x4 (&acc)[2][2][4][2], const Unit& u, int wr, int wc, int fr, int fq) const {
        const int row0 = u.pm * 256 + wr * 64 + fr, col0 = u.pn * 256 + wc * 32 + 4 * fq;
#pragma unroll
        for (int ai = 0; ai < 2; ++ai)
#pragma unroll
            for (int m = 0; m < 4; ++m) { const size_t r = (size_t)(row0 + ai * 128 + m * 16);
#pragma unroll
                for (int bj = 0; bj < 2; ++bj)
#pragma unroll
                    for (int n = 0; n < 2; ++n) { const int c = col0 + bj * 128 + n * 16; const f32x4 v = acc[ai][bj][m][n];
                        if (c < HS) { uint2 w; w.x = cvt_pk_bf16(v[0], v[1]); w.y = cvt_pk_bf16(v[2], v[3]); *(uint2*)(H + r * HS + c) = w;
                            if (c == auxc || c == auxc + 4) *(f32x4*)(aux + r * 8 + (c - auxc)) = v; } } }
    }
};
struct EpiRes {
    static constexpr bool PERM = false, AFTER_DRAIN = false;
    const float* res; float* out;
    DI void operator()(const f32x4 (&acc)[2][2][4][2], const Unit& u, int wr, int wc, int fr, int fq) const {
        const int row0 = u.pm * 256 + wr * 64 + fr, col0 = u.pn * 256 + wc * 32 + 4 * fq;
#pragma unroll
        for (int ai = 0; ai < 2; ++ai)
#pragma unroll
            for (int m = 0; m < 4; ++m) { const size_t r = (size_t)(row0 + ai * 128 + m * 16);
#pragma unroll
                for (int bj = 0; bj < 2; ++bj)
#pragma unroll
                    for (int n = 0; n < 2; ++n) { const int c = col0 + bj * 128 + n * 16;
                        const f32x4 rv = *(const f32x4*)(res + r * DM + c); *(f32x4*)(out + r * DM + c) = rv + acc[ai][bj][m][n]; } }
    }
};
DI float gu_ror1(float x) { float r; asm volatile("s_nop 1\n\tv_mov_b32_dpp %0, %1 row_ror:1 row_mask:0xf bank_mask:0xf bound_ctrl:1" : "=v"(r) : "v"(x)); return r; }
DI float gu_ror2(float x) { float r; asm volatile("s_nop 1\n\tv_mov_b32_dpp %0, %1 row_ror:2 row_mask:0xf bank_mask:0xf bound_ctrl:1" : "=v"(r) : "v"(x)); return r; }
struct EpiGU {
    static constexpr bool PERM = false, AFTER_DRAIN = false;
    bf16_t* GC; bf16_t* U; const float* cw; const float* cb;
    DI void operator()(const f32x4 (&acc)[2][2][4][2], const Unit& u, int wr, int wc, int fr, int fq) const {
        const int row0 = u.pm * 256 + wr * 64 + fr, col0 = u.pn * 128 + wc * 32 + 4 * fq;
#define GU_ROR(x, n) gu_ror##n(x)
#pragma unroll
        for (int n = 0; n < 2; ++n) { const int c = col0 + n * 16;
            const f32x4 w0 = *(const f32x4*)(cw + c), w1 = *(const f32x4*)(cw + DFF + c), w2 = *(const f32x4*)(cw + 2 * DFF + c), bb = *(const f32x4*)(cb + c);
#pragma unroll
            for (int ai = 0; ai < 2; ++ai)
#pragma unroll
                for (int m = 0; m < 4; ++m) { const size_t r = (size_t)(row0 + ai * 128 + m * 16); const size_t slab = r >> 6;
                    const f32x4 g = acc[ai][0][m][n], v = acc[ai][1][m][n]; const f32x4 gp = acc[ai][0][m > 0 ? m - 1 : 0][n];
                    f32x4 o;
#pragma unroll
                    for (int j = 0; j < 4; ++j) { const float p1 = GU_ROR(g[j], 1), q1 = GU_ROR(gp[j], 1), p2 = GU_ROR(g[j], 2), q2 = GU_ROR(gp[j], 2);
                        const float g1 = fr == 0 ? q1 : p1, g2 = fr < 2 ? q2 : p2;
                        const float a = bb[j] + w0[j] * g2 + w1[j] * g1 + w2[j] * g[j]; o[j] = silu_(a) * v[j]; }
                    const bool defer = (m == 0) && (fr < 2);
                    uint2 w;
                    w.x = cvt_pk_bf16(defer ? v[0] : o[0], defer ? v[1] : o[1]); w.y = cvt_pk_bf16(defer ? v[2] : o[2], defer ? v[3] : o[3]);
                    *(uint2*)(U + r * DFF + c) = w;
                    if (defer || (m == 3 && fr >= 14)) { const int slot = defer ? 2 + fr : fr - 14; uint2 gw; gw.x = cvt_pk_bf16(g[0], g[1]); gw.y = cvt_pk_bf16(g[2], g[3]);
                        *(uint2*)(GC + (slab * 4 + slot) * DFF + c) = gw; } }
        }
#undef GU_ROR
    }
};
struct EpiLR {
    static constexpr bool PERM = false, AFTER_DRAIN = false;
    bf16_t* LW; const float* w0; const float* a0;
    DI void operator()(const f32x4 (&acc)[2][2][4][2], const Unit& u, int wr, int wc, int fr, int fq) const {
        const int row0 = u.pm * 256 + wr * 64 + fr, col0 = u.pn * 256 + wc * 32 + 4 * fq;
#pragma unroll
        for (int ai = 0; ai < 2; ++ai)
#pragma unroll
            for (int m = 0; m < 4; ++m) { const size_t r = (size_t)(row0 + ai * 128 + m * 16);
#pragma unroll
                for (int bj = 0; bj < 2; ++bj)
#pragma unroll
                    for (int n = 0; n < 2; ++n) { const int c = col0 + bj * 128 + n * 16; f32x4 v = acc[ai][bj][m][n];
                        if (c < 512) { const f32x4 b = *(const f32x4*)(w0 + c);
#pragma unroll
                            for (int j = 0; j < 4; ++j) v[j] = 1.f - __expf(-0.606531f * sigm_(b[j] + v[j])); }
                        else if (c < 1024) { const f32x4 b = *(const f32x4*)(a0 + c - 512);
#pragma unroll
                            for (int j = 0; j < 4; ++j) v[j] = sigm_(b[j] + v[j]); }
                        uint2 w; w.x = cvt_pk_bf16(v[0], v[1]); w.y = cvt_pk_bf16(v[2], v[3]); *(uint2*)(LW + r * 1536 + c) = w; } }
    }
};
template <class Epi> DI void run_gemm(unsigned char* smem, const bf16_t* A, const bf16_t* Bt, int N, int K, const Epi& E) {
    pg8::Gemm g; g.A = A; g.Bt = Bt; g.M = TOK; g.N = N; g.K = K;
    pg8::StaticOrder S; S.init(TOK, N, (int)gridDim.x, obid());
    pg8::gemm_phase<Epi, pg8::StaticOrder, false>((PG8_LAS unsigned char*)smem, g, S, E, nullptr);
}

DI void conv_tile4(const float* W, int Nsrc, int K, bf16_t* Wt, int nd0, int sc0, int nvalid, int k0, float* tile) {
    const int tid = otid(), j = tid & 63, kb = tid >> 6;
    float v[32];
#pragma unroll
    for (int i = 0; i < 32; ++i) { const int kk = kb + 8 * i; v[i] = (j < nvalid) ? W[(size_t)(k0 + kk) * Nsrc + sc0 + j] : 0.f; }
#pragma unroll
    for (int i = 0; i < 32; ++i) { const int kk = kb + 8 * i; tile[kk * 65 + j] = v[i]; }
    __syncthreads();
    const int nl = tid >> 3, ks = (tid & 7) * 8;
#pragma unroll
    for (int q = 0; q < 4; ++q) { const float* tq = tile + q * 64 * 65; uint4 o;
        o.x = pack2(tq[(ks + 0) * 65 + nl], tq[(ks + 1) * 65 + nl]); o.y = pack2(tq[(ks + 2) * 65 + nl], tq[(ks + 3) * 65 + nl]);
        o.z = pack2(tq[(ks + 4) * 65 + nl], tq[(ks + 5) * 65 + nl]); o.w = pack2(tq[(ks + 6) * 65 + nl], tq[(ks + 7) * 65 + nl]);
        *(uint4*)(Wt + (size_t)(nd0 + nl) * K + k0 + q * 64 + ks) = o; }
    __syncthreads();
}
DI void phase_weights(const Params& p, unsigned char* smem, int layer, int part, int b0 = 0) {
    float* tile = (float*)smem;
    const float* w_in = layer ? p.od_w_in : p.ev_w_in; const float* w_out = layer ? p.od_w_out : p.ev_w_out;
    const float* w_up = p.ffn_w_up + (size_t)layer * DM * 2 * DFF; const float* w_dn = p.ffn_w_down + (size_t)layer * DFF * DM;
    bf16_t* t_in = (bf16_t*)(p.ws + O_WT_IN); bf16_t* t_out = (bf16_t*)(p.ws + O_WT_OUT); bf16_t* t_up = (bf16_t*)(p.ws + O_WT_UP); bf16_t* t_dn = (bf16_t*)(p.ws + O_WT_DN);
    if (part == 0) {
        if (obid() < b0) return;
        for (int job = obid() - b0; job < 288; job += (int)gridDim.x - b0) {
            if (job < 224) { const int nt = job >> 2, kt = job & 3, nd0 = nt * 64; int nv = HS - nd0; nv = nv < 0 ? 0 : (nv > 64 ? 64 : nv);
                conv_tile4(w_in, HS, 1024, t_in, nd0, nd0, nv, kt * 256, tile); }
            else { const int j2 = job - 224, nt = j2 >> 2, kt = j2 & 3; conv_tile4(w_out, 1024, 1024, t_out, nt * 64, nt * 64, 64, kt * 256, tile); }
        }
    } else {
        const int nb = (int)gridDim.x - 128, lb = obid() - 128;
        if (lb < 0) return;
        if (part == 1) { for (int job = lb; job < 352; job += nb) { const int nt = job >> 2, kt = job & 3, nd0 = nt * 64; const int pn = nd0 >> 8, bj = (nd0 >> 7) & 1, j0 = nd0 & 127;
                conv_tile4(w_up, 2 * DFF, 1024, t_up, nd0, bj * DFF + 128 * pn + j0, 64, kt * 256, tile); } }
        else { for (int job = lb; job < 176; job += nb) { const int nt = job / 11, kt = job % 11; conv_tile4(w_dn, 1024, DFF, t_dn, nt * 64, nt * 64, 64, kt * 256, tile); } }
        return;
    }
    const int gtid = (obid() - b0) * 512 + otid(), gsz = ((int)gridDim.x - b0) * 512;
    if (layer == 0) {
        float* rc = (float*)(p.ws + O_ROPE); float* rs = rc + SEQ * 32;
        for (int idx = gtid; idx < SEQ * 32; idx += gsz) { const int pos = idx >> 5, i = idx & 31;
            const float inv = (float)exp(-(double)i * (9.210340371976184 / 32.0)); const float ang = (float)pos * inv;
            const double a = (double)ang; const double n = rint(a * 0.15915494309189535); const double r = a - n * 6.283185307179586; const double r2 = r * r;
            double sn = 1.0 / 121645100408832000.0, cs = 1.0 / 2432902008176640000.0;
            sn = sn * r2 - 1.0 / 355687428096000.0; sn = sn * r2 + 1.0 / 1307674368000.0; sn = sn * r2 - 1.0 / 6227020800.0; sn = sn * r2 + 1.0 / 39916800.0;
            sn = sn * r2 - 1.0 / 362880.0; sn = sn * r2 + 1.0 / 5040.0; sn = sn * r2 - 1.0 / 120.0; sn = sn * r2 + 1.0 / 6.0; sn = sn * r2 * -1.0 + 1.0; sn = sn * r;
            cs = cs * r2 - 1.0 / 6402373705728000.0; cs = cs * r2 + 1.0 / 20922789888000.0; cs = cs * r2 - 1.0 / 87178291200.0; cs = cs * r2 + 1.0 / 479001600.0;
            cs = cs * r2 - 1.0 / 3628800.0; cs = cs * r2 + 1.0 / 40320.0; cs = cs * r2 - 1.0 / 720.0; cs = cs * r2 + 1.0 / 24.0; cs = cs * r2 - 0.5; cs = cs * r2 + 1.0;
            rc[idx] = (float)cs; rs[idx] = (float)sn; }
    } else {
        bf16_t* t_lr = (bf16_t*)(p.ws + O_WT_LR);
        for (int idx = gtid; idx < 1536 * 256; idx += gsz) { const int n = idx >> 8, k = idx & 255; float v = 0.f;
            if (n < 512) { if (k < 64) v = p.od_w_up[k * 512 + n]; }
            else if (n < 1024) { if (k >= 64 && k < 128) v = p.od_a_up[(k - 64) * 512 + n - 512]; }
            else { if (k >= 128) v = p.od_g_up[(k - 128) * 512 + n - 1024]; }
            t_lr[idx] = f2bf(v); }
    }
}
DI void phase_rmsnorm(const float* x, const float* w, bf16_t* xn) {
    const int lane = otid() & 63, wv = otid() >> 6;
    f32x4 ww[4];
#pragma unroll
    for (int i = 0; i < 4; ++i) ww[i] = *(const f32x4*)(w + i * 256 + lane * 4);
    for (int r0 = (obid() * 8 + wv) * 4; r0 < TOK; r0 += gridDim.x * 8 * 4) {
        f32x4 v[4][4];
#pragma unroll
        for (int q = 0; q < 4; ++q)
#pragma unroll
            for (int i = 0; i < 4; ++i) v[q][i] = *(const f32x4*)(x + (size_t)(r0 + q) * DM + i * 256 + lane * 4);
#pragma unroll
        for (int q = 0; q < 4; ++q) { float ss = 0.f;
#pragma unroll
            for (int i = 0; i < 4; ++i) ss += v[q][i][0] * v[q][i][0] + v[q][i][1] * v[q][i][1] + v[q][i][2] * v[q][i][2] + v[q][i][3] * v[q][i][3];
            ss = red64(ss); const float rstd = rsqrtf(ss * (1.f / DM) + 1e-6f);
#pragma unroll
            for (int i = 0; i < 4; ++i) { uint2 o; o.x = pack2(v[q][i][0] * rstd * ww[i][0], v[q][i][1] * rstd * ww[i][1]); o.y = pack2(v[q][i][2] * rstd * ww[i][2], v[q][i][3] * rstd * ww[i][3]);
                *(uint2*)(xn + (size_t)(r0 + q) * DM + i * 256 + lane * 4) = o; } }
    }
}
DI void ssd_conv8(const Params& p, const bf16_t* H, int b, int t, int ch, float (&o)[8]) {
    const bf16_t* base = H + (size_t)b * SEQ * HS + 512 + ch;
    const int t0 = t - 3 < 0 ? 0 : t - 3, t1 = t - 2 < 0 ? 0 : t - 2, t2 = t - 1 < 0 ? 0 : t - 1;
    const uint4 r0 = *(const uint4*)(base + (size_t)t0 * HS), r1 = *(const uint4*)(base + (size_t)t1 * HS), r2 = *(const uint4*)(base + (size_t)t2 * HS), r3 = *(const uint4*)(base + (size_t)t * HS);
    const float m0 = t >= 3 ? 1.f : 0.f, m1 = t >= 2 ? 1.f : 0.f, m2 = t >= 1 ? 1.f : 0.f;
    float acc[8], xv[8];
    { const f32x4 b0 = *(const f32x4*)(p.ev_conv_b + ch), b1 = *(const f32x4*)(p.ev_conv_b + ch + 4);
      acc[0] = b0[0]; acc[1] = b0[1]; acc[2] = b0[2]; acc[3] = b0[3]; acc[4] = b1[0]; acc[5] = b1[1]; acc[6] = b1[2]; acc[7] = b1[3]; }
#define SSD_TAP(k, raw, msk) { unpack8(raw, xv); const f32x4 w0 = *(const f32x4*)(p.ev_conv_w + (k) * 768 + ch) * (msk), w1 = *(const f32x4*)(p.ev_conv_w + (k) * 768 + ch + 4) * (msk); \
        acc[0] += w0[0] * xv[0]; acc[1] += w0[1] * xv[1]; acc[2] += w0[2] * xv[2]; acc[3] += w0[3] * xv[3]; acc[4] += w1[0] * xv[4]; acc[5] += w1[1] * xv[5]; acc[6] += w1[2] * xv[6]; acc[7] += w1[3] * xv[7]; }
    SSD_TAP(0, r0, m0) SSD_TAP(1, r1, m1) SSD_TAP(2, r2, m2) SSD_TAP(3, r3, 1.f)
#pragma unroll
    for (int e = 0; e < 8; ++e) o[e] = silu_(acc[e]);
}
DI float ret_lg(int hh) { return log1pf(-exp2f(-5.f - (float)hh)); }
DI void chunk_decay(const Params& p, int mixer, int b, int hh, int t0, float* acs, float* dts) {
    const int tid = otid(), lane = tid & 63; const float* aux = (const float*)(p.ws + O_AUX);
    float v = 0.f;
    if (tid < 128) {
        if (mixer == 0) { const float dt = softplus_(aux[((size_t)b * SEQ + t0 + tid) * 8 + hh] + p.ev_dt_bias[hh]); dts[tid] = dt; v = -expf(p.ev_a_log[hh]) * dt; }
        else { dts[tid] = 1.f; v = ret_lg(hh); }
    }
#pragma unroll
    for (int off = 1; off < 64; off <<= 1) { const float t = __shfl_up(v, off); if (lane >= off) v += t; }
    if (tid == 63) acs[256] = v;
    __syncthreads();
    if (tid >= 64 && tid < 128) v += acs[256];
    if (tid < 128) acs[tid] = v;
    __syncthreads();
}
DI void phase_m1(const Params& p, unsigned char* smem) {
    bf16_t* Kt = (bf16_t*)smem; bf16_t* Vt = (bf16_t*)(smem + 17408); float* acs = (float*)(smem + 34816); float* dts = acs + 128;
    const bf16_t* H = (const bf16_t*)(p.ws + O_H); float* ST = (float*)(p.ws + O_ST); float* CD = (float*)(p.ws + O_CD);
    const float* rc = (const float*)(p.ws + O_ROPE); const float* rs = rc + SEQ * 32;
    const int tid = otid(), lane = tid & 63, w = tid >> 6;
    for (int u = obid(); u < 2048; u += gridDim.x) {
        const int mixer = u >> 10, bh = (u >> 6) & 15, c = u & 63, b = bh >> 3, hh = bh & 7, t0 = c * 128;
        chunk_decay(p, mixer, b, hh, t0, acs, dts);
        const float aend = acs[127];
        if (mixer == 0) {
#pragma unroll
            for (int it = 0; it < 2; ++it) { const int g = tid + it * 512, s = g >> 3, c8 = (g & 7) * 8; float o[8];
                const float sc = __expf(aend - acs[s]) * dts[s];
                ssd_conv8(p, H, b, t0 + s, 512 + (hh >> 2) * 64 + c8, o);
#pragma unroll
                for (int e = 0; e < 8; ++e) Kt[(c8 + e) * 136 + s] = f2bf(o[e] * sc);
                ssd_conv8(p, H, b, t0 + s, hh * 64 + c8, o);
#pragma unroll
                for (int e = 0; e < 8; ++e) Vt[(c8 + e) * 136 + s] = f2bf(o[e]); }
            if (tid == 0) CD[bh * 64 + c] = __expf(aend);
        } else {
            { const int s = tid >> 2, i0 = (tid & 3) * 8; const size_t r = (size_t)b * SEQ + t0 + s; float k1[8], k2[8];
              unpack8(*(const uint4*)(H + r * HS + 1800 + hh * 64 + i0), k1); unpack8(*(const uint4*)(H + r * HS + 1800 + hh * 64 + 32 + i0), k2);
              const float sc = __expf(aend - acs[s]) * 0.125f;
#pragma unroll
              for (int e = 0; e < 8; ++e) { const float cs = rc[(t0 + s) * 32 + i0 + e], sn = rs[(t0 + s) * 32 + i0 + e];
                  Kt[(i0 + e) * 136 + s] = f2bf((k1[e] * cs - k2[e] * sn) * sc); Kt[(32 + i0 + e) * 136 + s] = f2bf((k1[e] * sn + k2[e] * cs) * sc); } }
#pragma unroll
            for (int it = 0; it < 2; ++it) { const int g = tid + it * 512, s = g >> 3, c8 = (g & 7) * 8; const size_t r = (size_t)b * SEQ + t0 + s; float v[8];
                unpack8(*(const uint4*)(H + r * HS + 2312 + hh * 64 + c8), v);
#pragma unroll
                for (int e = 0; e < 8; ++e) Vt[(c8 + e) * 136 + s] = (unsigned short)f2bf(v[e]); }
        }
        __syncthreads();
        { const int mt = w & 3, nt0 = (w >> 2) * 2; f32x4 a0 = {0.f, 0.f, 0.f, 0.f}, a1 = {0.f, 0.f, 0.f, 0.f};
#pragma unroll
          for (int ks = 0; ks < 4; ++ks) { const bf16x8 af = ldfrag(Kt, mt * 16, 136, ks * 32, lane);
              a0 = MFMA16(af, ldfrag(Vt, nt0 * 16, 136, ks * 32, lane), a0); a1 = MFMA16(af, ldfrag(Vt, nt0 * 16 + 16, 136, ks * 32, lane), a1); }
          float* dst = ST + (size_t)u * 4096 + mt * 16 + (lane >> 4) * 4;
          *(f32x4*)(dst + (nt0 * 16 + (lane & 15)) * 64) = a0; *(f32x4*)(dst + (nt0 * 16 + 16 + (lane & 15)) * 64) = a1; }
        __syncthreads();
    }
}
DI void phase_m2(const Params& p) {
    float* ST = (float*)(p.ws + O_ST); const float* CD = (const float*)(p.ws + O_CD);
    for (int idx = obid() * 512 + otid(); idx < 32 * 4096; idx += gridDim.x * 512) {
        const int mb = idx >> 12, e = idx & 4095, mixer = mb >> 4, bh = mb & 15; float run = 0.f;
        const float gdec = __expf(128.f * ret_lg(bh & 7));
#pragma unroll 8
        for (int c = 0; c < 64; ++c) { const size_t o = ((size_t)(mb * 64 + c)) * 4096 + e; const float v = ST[o]; ST[o] = run;
            const float dec = mixer == 0 ? CD[bh * 64 + c] : gdec; run = run * dec + v; }
    }
}
template <int MIXER> DI void m3_head(const Params& p, unsigned char* smem, int b, int c, int hh, float (&ssq)[4]) {
    bf16_t* Qs = (bf16_t*)smem; bf16_t* Ks = (bf16_t*)(smem + 18432); bf16_t* Vt = (bf16_t*)(smem + 36864); bf16_t* Rt = (bf16_t*)(smem + 54272); bf16_t* Ps = (bf16_t*)(smem + 63488);
    float* acs = (float*)(smem + 98304); float* dts = acs + 128;
    const bf16_t* H = (const bf16_t*)(p.ws + O_H); const float* ST = (const float*)(p.ws + O_ST); float* YG = (float*)(p.ws + O_YG); bf16_t* Y = (bf16_t*)(p.ws + O_XN);
    const float* rc = (const float*)(p.ws + O_ROPE); const float* rs = rc + SEQ * 32;
    const int tid = otid(), lane = tid & 63, w = tid >> 6, t0 = c * 128, bh = b * 8 + hh;
    const size_t u = (size_t)((MIXER * 16 + bh) * 64 + c);
    __syncthreads();
    chunk_decay(p, MIXER, b, hh, t0, acs, dts);
    if (MIXER == 0) {
#pragma unroll
        for (int it = 0; it < 2; ++it) { const int g = tid + it * 512, s = g >> 3, c8 = (g & 7) * 8; float o[8];
            if ((hh & 3) == 0) {
                ssd_conv8(p, H, b, t0 + s, 640 + (hh >> 2) * 64 + c8, o); *(uint4*)(Qs + s * 72 + c8) = pack8(o);
                ssd_conv8(p, H, b, t0 + s, 512 + (hh >> 2) * 64 + c8, o); *(uint4*)(Ks + s * 72 + c8) = pack8(o); }
            ssd_conv8(p, H, b, t0 + s, hh * 64 + c8, o);
#pragma unroll
            for (int e = 0; e < 8; ++e) Vt[(c8 + e) * 136 + s] = f2bf(o[e]); }
    } else {
        { const int s = tid >> 2, i0 = (tid & 3) * 8; const size_t r = (size_t)b * SEQ + t0 + s; float a1[8], a2[8], o1[8], o2[8];
          unpack8(*(const uint4*)(H + r * HS + 1288 + hh * 64 + i0), a1); unpack8(*(const uint4*)(H + r * HS + 1288 + hh * 64 + 32 + i0), a2);
#pragma unroll
          for (int e = 0; e < 8; ++e) { const float cs = rc[(t0 + s) * 32 + i0 + e], sn = rs[(t0 + s) * 32 + i0 + e]; o1[e] = a1[e] * cs - a2[e] * sn; o2[e] = a1[e] * sn + a2[e] * cs; }
          *(uint4*)(Qs + s * 72 + i0) = pack8(o1); *(uint4*)(Qs + s * 72 + 32 + i0) = pack8(o2);
          unpack8(*(const uint4*)(H + r * HS + 1800 + hh * 64 + i0), a1); unpack8(*(const uint4*)(H + r * HS + 1800 + hh * 64 + 32 + i0), a2);
#pragma unroll
          for (int e = 0; e < 8; ++e) { const float cs = rc[(t0 + s) * 32 + i0 + e], sn = rs[(t0 + s) * 32 + i0 + e]; o1[e] = (a1[e] * cs - a2[e] * sn) * 0.125f; o2[e] = (a1[e] * sn + a2[e] * cs) * 0.125f; }
          *(uint4*)(Ks + s * 72 + i0) = pack8(o1); *(uint4*)(Ks + s * 72 + 32 + i0) = pack8(o2); }
#pragma unroll
        for (int it = 0; it < 2; ++it) { const int g = tid + it * 512, s = g >> 3, c8 = (g & 7) * 8; const size_t r = (size_t)b * SEQ + t0 + s;
            const uint4 raw = *(const uint4*)(H + r * HS + 2312 + hh * 64 + c8); const unsigned short* rv = (const unsigned short*)&raw;
#pragma unroll
            for (int e = 0; e < 8; ++e) Vt[(c8 + e) * 136 + s] = rv[e]; }
    }
    { const int pr = tid >> 3, n8 = (tid & 7) * 8; const float* src = ST + u * 4096 + pr * 64 + n8; const f32x4 x0 = *(const f32x4*)src, x1 = *(const f32x4*)(src + 4);
      uint4 o; o.x = pack2(x0[0], x0[1]); o.y = pack2(x0[2], x0[3]); o.z = pack2(x1[0], x1[1]); o.w = pack2(x1[2], x1[3]); *(uint4*)(Rt + pr * 72 + n8) = o; }
    __syncthreads();
    const int nks = (w >> 1) + 1;
    const int lrow = 16 * w + (lane >> 4) * 4;
    unsigned short gate[4][4];
#pragma unroll
    for (int nt = 0; nt < 4; ++nt)
#pragma unroll
        for (int j = 0; j < 4; ++j) gate[nt][j] = H[((size_t)b * SEQ + t0 + lrow + j) * HS + (MIXER == 0 ? 0 : 2824) + hh * 64 + nt * 16 + (lane & 15)];
    {
        const bf16x8 q0 = ldfrag(Qs, 16 * w, 72, 0, lane), q1 = ldfrag(Qs, 16 * w, 72, 32, lane);
        float al[4];
#pragma unroll
        for (int j = 0; j < 4; ++j) al[j] = acs[lrow + j];
        for (int nt = 0; nt < 2 * nks; ++nt) { f32x4 sacc = {0.f, 0.f, 0.f, 0.f};
            sacc = MFMA16(q0, ldfrag(Ks, nt * 16, 72, 0, lane), sacc); sacc = MFMA16(q1, ldfrag(Ks, nt * 16, 72, 32, lane), sacc);
            const int s = nt * 16 + (lane & 15); const float as = acs[s], ds = dts[s];
#pragma unroll
            for (int j = 0; j < 4; ++j) { const float pv = (s <= lrow + j) ? sacc[j] * __expf(al[j] - as) * ds : 0.f; Ps[(lrow + j) * 136 + s] = f2bf(pv); } }
    }
    __syncthreads();
    f32x4 yd[4], yo[4];
#pragma unroll
    for (int nt = 0; nt < 4; ++nt) { yd[nt] = (f32x4){0.f, 0.f, 0.f, 0.f}; yo[nt] = (f32x4){0.f, 0.f, 0.f, 0.f}; }
    for (int ks = 0; ks < nks; ++ks) { const bf16x8 pf = ldfrag(Ps, 16 * w, 136, ks * 32, lane);
#pragma unroll
        for (int nt = 0; nt < 4; ++nt) yd[nt] = MFMA16(pf, ldfrag(Vt, nt * 16, 136, ks * 32, lane), yd[nt]); }
#pragma unroll
    for (int ks = 0; ks < 2; ++ks) { const bf16x8 qf = ldfrag(Qs, 16 * w, 72, ks * 32, lane);
#pragma unroll
        for (int nt = 0; nt < 4; ++nt) yo[nt] = MFMA16(qf, ldfrag(Rt, nt * 16, 72, ks * 32, lane), yo[nt]); }
    float ea[4];
#pragma unroll
    for (int j = 0; j < 4; ++j) ea[j] = __expf(acs[lrow + j]);
    if (MIXER == 0) {
        const float dsk = p.ev_d[hh];
#pragma unroll
        for (int nt = 0; nt < 4; ++nt) { const int pc = nt * 16 + (lane & 15);
#pragma unroll
            for (int j = 0; j < 4; ++j) { const size_t r = (size_t)b * SEQ + t0 + lrow + j;
                const float y = yd[nt][j] + ea[j] * yo[nt][j] + dsk * bf2f(Vt[pc * 136 + lrow + j]);
                const float z = bf2f(gate[nt][j]); const float yg = y * silu_(z); ssq[j] += yg * yg; YG[r * 512 + hh * 64 + pc] = yg; } }
    } else {
        float s2[4];
#pragma unroll
        for (int j = 0; j < 4; ++j) { float a = 0.f;
#pragma unroll
            for (int nt = 0; nt < 4; ++nt) { const float y = yd[nt][j] + ea[j] * yo[nt][j]; yd[nt][j] = y; a += y * y; }
            s2[j] = rsqrtf(red16(a) * (1.f / 64.f) + 1e-6f); }
#pragma unroll
        for (int nt = 0; nt < 4; ++nt) { const int pc = nt * 16 + (lane & 15); const float nw = p.ev_ret_norm_w[hh * 64 + pc];
#pragma unroll
            for (int j = 0; j < 4; ++j) { const size_t r = (size_t)b * SEQ + t0 + lrow + j; const float g = bf2f(gate[nt][j]);
                Y[r * DM + 512 + hh * 64 + pc] = f2bf(silu_(g) * yd[nt][j] * s2[j] * nw); } }
    }
}
DI void phase_m3(const Params& p, unsigned char* smem) {
    const int lane = otid() & 63, w = otid() >> 6;
    for (int u = obid(); u < 256; u += gridDim.x) {
        const int mixer = u >> 7, b = (u >> 6) & 1, c = u & 63; float ssq[4] = {0.f, 0.f, 0.f, 0.f};
        if (mixer == 0) {
            for (int hh = 0; hh < 8; ++hh) m3_head<0>(p, smem, b, c, hh, ssq);
            float* YG = (float*)(p.ws + O_YG); bf16_t* Y = (bf16_t*)(p.ws + O_XN); const int lrow = 16 * w + (lane >> 4) * 4;
            float rstd[4];
#pragma unroll
            for (int j = 0; j < 4; ++j) rstd[j] = rsqrtf(red16(ssq[j]) * (1.f / 512.f) + 1e-6f);
            for (int cc = 0; cc < 32; ++cc) { const int col = cc * 16 + (lane & 15); const float nw = p.ev_ssd_norm_w[col];
#pragma unroll
                for (int j = 0; j < 4; ++j) { const size_t r = (size_t)b * SEQ + c * 128 + lrow + j;
                    const float v = __hip_atomic_load(YG + r * 512 + col, __ATOMIC_RELAXED, __HIP_MEMORY_SCOPE_AGENT); Y[r * DM + col] = f2bf(v * rstd[j] * nw); } }
        } else {
            for (int hh = 0; hh < 8; ++hh) m3_head<1>(p, smem, b, c, hh, ssq);
        }
    }
}
DI void phase_ffn_fix(const Params& p, int layer) {
    const bf16_t* GC = (const bf16_t*)(p.ws + O_G); bf16_t* U = (bf16_t*)(p.ws + O_U);
    const float* cw = p.ffn_conv_w + (size_t)layer * 3 * DFF; const float* cb = p.ffn_conv_b + (size_t)layer * DFF;
    for (int idx = obid() * 512 + otid(); idx < 256 * 2 * (DFF / 8); idx += gridDim.x * 512) {
        const int c8 = (idx % (DFF / 8)) * 8, ri = idx / (DFF / 8), k = ri >> 1, i = ri & 1, r = k * 64 + i, t = r & (SEQ - 1);
        const int kp = k > 0 ? k - 1 : 0;
        const bf16_t* s0 = GC + ((size_t)kp * 4 + (i == 0 ? 0 : 1)) * DFF + c8;
        const bf16_t* s1 = i == 0 ? GC + ((size_t)kp * 4 + 1) * DFF + c8 : GC + ((size_t)k * 4 + 2) * DFF + c8;
        const bf16_t* s2 = GC + ((size_t)k * 4 + 2 + i) * DFF + c8;
        const float m0 = (t - 2 >= 0) ? 1.f : 0.f, m1 = (t - 1 >= 0) ? 1.f : 0.f;
        const uint4 r0 = *(const uint4*)s0, r1 = *(const uint4*)s1, r2 = *(const uint4*)s2, ru = *(const uint4*)(U + (size_t)r * DFF + c8);
        float acc[8], g[8], uv[8];
        { const f32x4 b0 = *(const f32x4*)(cb + c8), b1 = *(const f32x4*)(cb + c8 + 4); acc[0] = b0[0]; acc[1] = b0[1]; acc[2] = b0[2]; acc[3] = b0[3]; acc[4] = b1[0]; acc[5] = b1[1]; acc[6] = b1[2]; acc[7] = b1[3]; }
#define FIX_TAP(kk, raw, msk) { unpack8(raw, g); const f32x4 w0 = *(const f32x4*)(cw + (kk) * DFF + c8) * (msk), w1 = *(const f32x4*)(cw + (kk) * DFF + c8 + 4) * (msk); \
            acc[0] += w0[0] * g[0]; acc[1] += w0[1] * g[1]; acc[2] += w0[2] * g[2]; acc[3] += w0[3] * g[3]; acc[4] += w1[0] * g[4]; acc[5] += w1[1] * g[5]; acc[6] += w1[2] * g[6]; acc[7] += w1[3] * g[7]; }
        FIX_TAP(0, r0, m0) FIX_TAP(1, r1, m1) FIX_TAP(2, r2, 1.f)
        unpack8(ru, uv);
#pragma unroll
        for (int e2 = 0; e2 < 8; ++e2) acc[e2] = silu_(acc[e2]) * uv[e2];
        *(uint4*)(U + (size_t)r * DFF + c8) = pack8(acc);
    }
}
DI void phase_l1_prep(const Params& p, unsigned char* smem) {
    const bf16_t* H = (const bf16_t*)(p.ws + O_H); const float* aux = (const float*)(p.ws + O_AUX); float* FC = (float*)(p.ws + O_FC);
    bf16_t* KN = (bf16_t*)(p.ws + O_KN); bf16_t* VT = (bf16_t*)(p.ws + O_VT); bf16_t* AP = (bf16_t*)(p.ws + O_AP);
    const int tid = otid();
    for (int u = obid(); u < 16 + 1024; u += gridDim.x) {
        __syncthreads();
        if (u < 16) {
            float* tot = (float*)smem; const int bh = u, b = bh >> 3, hh = bh & 7; const float fb = p.od_f_bias[hh]; float loc[16]; float run = 0.f;
#pragma unroll
            for (int i = 0; i < 16; ++i) { const float xv = aux[((size_t)b * SEQ + tid * 16 + i) * 8 + hh] + fb; run += -softplus_(-xv); loc[i] = run; }
            tot[tid] = run; __syncthreads();
            float off = 0.f; for (int i = 0; i < tid; ++i) off += tot[i];
#pragma unroll
            for (int i = 0; i < 16; ++i) FC[(size_t)bh * SEQ + tid * 16 + i] = off + loc[i];
        } else {
            bf16_t* Vl = (bf16_t*)smem; const int v2 = u - 16, bh = v2 >> 6, blk = v2 & 63, b = bh >> 3, hh = bh & 7, t0 = blk * 128;
            { const int l = tid >> 2, c16 = (tid & 3) * 16; const size_t r = (size_t)b * SEQ + t0 + l; float a[8], c[8];
              unpack8(*(const uint4*)(H + r * HS + 2304 + hh * 64 + c16), a); unpack8(*(const uint4*)(H + r * HS + 2304 + hh * 64 + c16 + 8), c);
              float ss = 0.f;
#pragma unroll
              for (int e = 0; e < 8; ++e) ss += a[e] * a[e] + c[e] * c[e];
              ss += __shfl_xor(ss, 1); ss += __shfl_xor(ss, 2); const float rstd = rsqrtf(ss * (1.f / 64.f) + 1e-6f);
#pragma unroll
              for (int e = 0; e < 8; ++e) { a[e] *= rstd * p.od_kn_w[c16 + e]; c[e] *= rstd * p.od_kn_w[c16 + 8 + e]; }
              bf16_t* dst = KN + ((size_t)bh * SEQ + t0 + l) * 64 + c16; *(uint4*)dst = pack8(a); *(uint4*)(dst + 8) = pack8(c); }
#pragma unroll
            for (int it = 0; it < 2; ++it) { const int g = tid + it * 512, s = g >> 3, c8 = (g & 7) * 8; const size_t r = (size_t)b * SEQ + t0 + s;
                *(uint4*)(Vl + s * 72 + c8) = *(const uint4*)(H + r * HS + 2816 + hh * 64 + c8); }
            __syncthreads();
#pragma unroll
            for (int it = 0; it < 2; ++it) { const int g = tid + it * 512, e = g >> 4, s8 = (g & 15) * 8; uint4 o;
                o.x = (unsigned)Vl[(s8 + 0) * 72 + e] | ((unsigned)Vl[(s8 + 1) * 72 + e] << 16); o.y = (unsigned)Vl[(s8 + 2) * 72 + e] | ((unsigned)Vl[(s8 + 3) * 72 + e] << 16);
                o.z = (unsigned)Vl[(s8 + 4) * 72 + e] | ((unsigned)Vl[(s8 + 5) * 72 + e] << 16); o.w = (unsigned)Vl[(s8 + 6) * 72 + e] | ((unsigned)Vl[(s8 + 7) * 72 + e] << 16);
                *(uint4*)(VT + ((size_t)bh * 64 + e) * SEQ + t0 + s8) = o; }
        }
    }
    {
        float* KNRM = (float*)(p.ws + O_KNRM);
#pragma unroll 4
        for (int idx = obid() * 512 + tid; idx < TOK * 64; idx += gridDim.x * 512) {
            const int r = idx >> 6, c8 = (idx & 63) * 8, t = r & (SEQ - 1); float cur[8], prv[8]; float ss = 0.f;
            { const uint4 rc = *(const uint4*)(H + (size_t)r * HS + 512 + c8), rp = *(const uint4*)(H + (size_t)(t > 0 ? r - 1 : r) * HS + 512 + c8); const float pm = t > 0 ? 1.f : 0.f;
              unpack8(rc, cur); unpack8(rp, prv);
#pragma unroll
              for (int e = 0; e < 8; ++e) prv[e] *= pm; }
#pragma unroll
            for (int e = 0; e < 8; ++e) { const float v = (cur[e] + (prv[e] - cur[e]) * p.od_mu[512 + c8 + e]) * p.od_k_k[c8 + e]; ss += v * v; }
            ss += __shfl_xor(ss, 1); ss += __shfl_xor(ss, 2); ss += __shfl_xor(ss, 4);
            if ((idx & 7) == 0) KNRM[(size_t)r * 8 + (c8 >> 6)] = 1.f / fmaxf(sqrtf(ss), 1e-12f);
        }
    }
#pragma unroll 4
    for (int idx = obid() * 512 + tid; idx < TOK * 32; idx += gridDim.x * 512) {
        const int r = idx >> 5, j8 = (idx & 31) * 8, t = r & (SEQ - 1); float cur[8], prv[8], o[8];
        { const uint4 rc = *(const uint4*)(H + (size_t)r * HS + 1536 + j8), rp = *(const uint4*)(H + (size_t)(t > 0 ? r - 1 : r) * HS + 1536 + j8); const float pm = t > 0 ? 1.f : 0.f;
          unpack8(rc, cur); unpack8(rp, prv);
#pragma unroll
          for (int e = 0; e < 8; ++e) prv[e] *= pm; }
#pragma unroll
        for (int e = 0; e < 8; ++e) { const float v = cur[e] + (prv[e] - cur[e]) * p.od_mu[1536 + j8 + e];
            o[e] = (j8 < 64) ? tanhf(v) : ((j8 < 128) ? v : sigm_(v)); }
        *(uint4*)(AP + (size_t)r * 256 + j8) = pack8(o);
    }
}
DI void fox_unit(const Params& p, unsigned char* smem, int bh, int qb) {
    bf16_t* Qs = (bf16_t*)smem; bf16_t* Ks = (bf16_t*)(smem + 18432); bf16_t* Vts = (bf16_t*)(smem + 36864); float* ck = (float*)(smem + 89600);
    const bf16_t* H = (const bf16_t*)(p.ws + O_H); const float* FC = (const float*)(p.ws + O_FC); const bf16_t* KN = (const bf16_t*)(p.ws + O_KN); const bf16_t* VT = (const bf16_t*)(p.ws + O_VT);
    bf16_t* Y = (bf16_t*)(p.ws + O_XN);
    const int tid = otid(), lane = tid & 63, w = tid >> 6, b = bh >> 3, hh = bh & 7; const size_t r0 = (size_t)b * SEQ + qb * 128;
    const float LOG2E = 1.4426950408889634f;
    __syncthreads();
    { const int l = tid >> 2, c16 = (tid & 3) * 16; float a[8], c[8];
      unpack8(*(const uint4*)(H + (r0 + l) * HS + 1792 + hh * 64 + c16), a); unpack8(*(const uint4*)(H + (r0 + l) * HS + 1792 + hh * 64 + c16 + 8), c);
      float ss = 0.f;
#pragma unroll
      for (int e = 0; e < 8; ++e) ss += a[e] * a[e] + c[e] * c[e];
      ss += __shfl_xor(ss, 1); ss += __shfl_xor(ss, 2); const float rstd = rsqrtf(ss * (1.f / 64.f) + 1e-6f) * (0.125f * LOG2E);
#pragma unroll
      for (int e = 0; e < 8; ++e) { a[e] *= rstd * p.od_qn_w[c16 + e]; c[e] *= rstd * p.od_qn_w[c16 + 8 + e]; }
      *(uint4*)(Qs + l * 72 + c16) = pack8(a); *(uint4*)(Qs + l * 72 + c16 + 8) = pack8(c); }
    float mrow = -1e30f, lsum = 0.f; f32x4 O[4];
#pragma unroll
    for (int j = 0; j < 4; ++j) O[j] = (f32x4){0.f, 0.f, 0.f, 0.f};
    const int q4 = (lane >> 4) * 4, lq = 16 * w + (lane & 15);
    uint4 kreg0, kreg1, vreg0, vreg1; float ckreg = 0.f;
    const int g0 = tid, g1 = tid + 512;
#define FOX_ISSUE(kb_) { \
        kreg0 = *(const uint4*)(KN + ((size_t)bh * SEQ + (kb_) * 128 + (g0 >> 3)) * 64 + (g0 & 7) * 8); \
        kreg1 = *(const uint4*)(KN + ((size_t)bh * SEQ + (kb_) * 128 + (g1 >> 3)) * 64 + (g1 & 7) * 8); \
        vreg0 = *(const uint4*)(VT + ((size_t)bh * 64 + (g0 >> 4)) * SEQ + (kb_) * 128 + (g0 & 15) * 8); \
        vreg1 = *(const uint4*)(VT + ((size_t)bh * 64 + (g1 >> 4)) * SEQ + (kb_) * 128 + (g1 & 15) * 8); \
        if (tid < 128) ckreg = FC[(size_t)bh * SEQ + (kb_) * 128 + tid]; }
    FOX_ISSUE(0)
    for (int kb = 0; kb <= qb; ++kb) {
        __syncthreads();
        *(uint4*)(Ks + (g0 >> 3) * 72 + (g0 & 7) * 8) = kreg0; *(uint4*)(Ks + (g1 >> 3) * 72 + (g1 & 7) * 8) = kreg1;
        *(uint4*)(Vts + (g0 >> 4) * 136 + (g0 & 15) * 8) = vreg0; *(uint4*)(Vts + (g1 >> 4) * 136 + (g1 & 15) * 8) = vreg1;
        if (tid < 128) ck[tid] = -ckreg * LOG2E;
        __syncthreads();
        if (kb < qb) FOX_ISSUE(kb + 1)
        f32x4 S[8];
        { const bf16x8 q0 = ldfrag(Qs, 16 * w, 72, 0, lane), q1 = ldfrag(Qs, 16 * w, 72, 32, lane);
#pragma unroll
          for (int nt = 0; nt < 8; ++nt) { f32x4 z = *(const f32x4*)(ck + nt * 16 + q4); z = MFMA16(ldfrag(Ks, nt * 16, 72, 0, lane), q0, z); S[nt] = MFMA16(ldfrag(Ks, nt * 16, 72, 32, lane), q1, z); } }
        if (kb == qb) {
#pragma unroll
            for (int nt = 0; nt < 8; ++nt)
#pragma unroll
                for (int j = 0; j < 4; ++j) if (nt * 16 + q4 + j > lq) S[nt][j] = -1e30f;
        }
        float mx = S[0][0];
#pragma unroll
        for (int nt = 0; nt < 8; ++nt)
#pragma unroll
            for (int j = 0; j < 4; ++j) mx = fmaxf(mx, S[nt][j]);
        mx = fmaxf(mx, __shfl_xor(mx, 16)); mx = fmaxf(mx, __shfl_xor(mx, 32));
        const float mnew = fmaxf(mrow, mx); const float alpha = __builtin_amdgcn_exp2f(mrow - mnew); mrow = mnew;
        float rs = 0.f;
#pragma unroll
        for (int nt = 0; nt < 8; ++nt)
#pragma unroll
            for (int j = 0; j < 4; ++j) { const float pv = __builtin_amdgcn_exp2f(S[nt][j] - mnew); S[nt][j] = pv; rs += pv; }
        lsum = lsum * alpha + rs;
#pragma unroll
        for (int et = 0; et < 4; ++et) O[et] = O[et] * alpha;
#pragma unroll
        for (int ks = 0; ks < 4; ++ks) {
            uint4 pw; pw.x = cvt_pk_bf16(S[2 * ks][0], S[2 * ks][1]); pw.y = cvt_pk_bf16(S[2 * ks][2], S[2 * ks][3]); pw.z = cvt_pk_bf16(S[2 * ks + 1][0], S[2 * ks + 1][1]); pw.w = cvt_pk_bf16(S[2 * ks + 1][2], S[2 * ks + 1][3]);
            const bf16x8 pf = __builtin_bit_cast(bf16x8, pw);
#pragma unroll
            for (int et = 0; et < 4; ++et) { const bf16_t* vp = Vts + (et * 16 + (lane & 15)) * 136 + ks * 32 + q4;
                uint4 vw; const uint2 lo = *(const uint2*)vp, hi = *(const uint2*)(vp + 16); vw.x = lo.x; vw.y = lo.y; vw.z = hi.x; vw.w = hi.y;
                O[et] = MFMA16(__builtin_bit_cast(bf16x8, vw), pf, O[et]); }
        }
    }
    lsum += __shfl_xor(lsum, 16); lsum += __shfl_xor(lsum, 32);
    const float inv = 1.f / lsum;
#pragma unroll
    for (int et = 0; et < 4; ++et) { uint2 o; o.x = pack2(O[et][0] * inv, O[et][1] * inv); o.y = pack2(O[et][2] * inv, O[et][3] * inv);
        *(uint2*)(Y + (r0 + lq) * DM + 512 + hh * 64 + et * 16 + q4) = o; }
}
constexpr int RW_T = 32, RW_BUF = 43008;
struct RwRegs { unsigned short r[9], k[9], v[9], om[8], a[8]; float kn[8]; };
#define RW_BAR() do { asm volatile("s_waitcnt lgkmcnt(0)" ::: "memory"); __builtin_amdgcn_s_barrier(); asm volatile("" ::: "memory"); } while (0)
DI void rwkv_unit(const Params& p, unsigned char* smem, int bh, int rg) {
    const bf16_t* H = (const bf16_t*)(p.ws + O_H); const bf16_t* LW = (const bf16_t*)(p.ws + O_LW); bf16_t* Y = (bf16_t*)(p.ws + O_XN); const float* KNRM = (const float*)(p.ws + O_KNRM);
    const int tid = otid(), lane = tid & 63, w = tid >> 6, b = bh >> 3, hh = bh & 7; const size_t rb = (size_t)b * SEQ;
    float* ysh = (float*)(smem + 2 * RW_BUF);
    const int NCH = SEQ / RW_T;
    __syncthreads();
    if (w < 2) {
        float S0 = 0.f, S1 = 0.f, S2 = 0.f, S3 = 0.f; const int kq = lane & 15, row = w * 4 + (lane >> 4);
        RW_BAR();
        for (int ch = 0; ch < NCH; ++ch) {
            const float* bufp = (const float*)(smem + (ch & 1) * RW_BUF) + kq * 4; const float* vp = (const float*)(smem + (ch & 1) * RW_BUF) + 10240 + row; float* yo = ysh + (ch & 1) * 256 + row;
#define RW_LOAD(R, W, K, Q, B, V, tt) { R = *(const f32x4*)(bufp + (tt) * 64); W = *(const f32x4*)(bufp + 2048 + (tt) * 64); K = *(const f32x4*)(bufp + 4096 + (tt) * 64); \
                Q = *(const f32x4*)(bufp + 6144 + (tt) * 64); B = *(const f32x4*)(bufp + 8192 + (tt) * 64); V = vp[(tt) * 8]; }
#define DPPF(x, ctrl) __builtin_bit_cast(float, __builtin_amdgcn_update_dpp(0, __builtin_bit_cast(int, (x)), (ctrl), 0xF, 0xF, true))
            f32x4 prevR = {0.f, 0.f, 0.f, 0.f}; float yacc = 0.f;
            f32x4 rN, wN, kN, qN, bN; float vN;
            RW_LOAD(rN, wN, kN, qN, bN, vN, 0)
            __builtin_amdgcn_sched_barrier(0);
#pragma unroll
            for (int tt = 0; tt < RW_T; ++tt) {
                const f32x4 R = rN, W = wN, K = kN, Q = qN, B = bN; const float V = vN;
                if (tt + 1 < RW_T) RW_LOAD(rN, wN, kN, qN, bN, vN, tt + 1)
                float d = S0 * Q[0] + S1 * Q[1] + S2 * Q[2] + S3 * Q[3];
                if (tt > 0) {
                    float y = S0 * prevR[0] + S1 * prevR[1] + S2 * prevR[2] + S3 * prevR[3];
                    d += DPPF(d, 0xB1); y += DPPF(y, 0xB1); d += DPPF(d, 0x4E); y += DPPF(y, 0x4E); d += DPPF(d, 0x141); y += DPPF(y, 0x141); d += DPPF(d, 0x140); y += DPPF(y, 0x140);
                    yacc = (kq == ((tt - 1) & 15)) ? y : yacc;
                    if (tt == 16) yo[kq * 8] = yacc;
                } else d = dpp_red16(d);
                const float sa = -d;
                S0 = (S0 * W[0] + V * K[0]) + sa * B[0]; S1 = (S1 * W[1] + V * K[1]) + sa * B[1]; S2 = (S2 * W[2] + V * K[2]) + sa * B[2]; S3 = (S3 * W[3] + V * K[3]) + sa * B[3];
                prevR = R;
                if (tt & 1) __builtin_amdgcn_sched_barrier(0);
            }
            { float y = S0 * prevR[0] + S1 * prevR[1] + S2 * prevR[2] + S3 * prevR[3]; y = dpp_red16(y); yacc = (kq == 15) ? y : yacc; yo[(16 + kq) * 8] = yacc; }
            RW_BAR();
        }
    } else if (w == 4 || w == 5) {
        const unsigned* ta0; const unsigned* ta1; const unsigned* ta2; size_t st0, st1, st2;
        { int L = lane; int tok = L / 5, which = L - tok * 5; ta0 = (const unsigned*)(which < 3 ? H + (rb + tok) * HS + which * 512 + hh * 64 : LW + (rb + tok) * 1536 + (which - 3) * 512 + hh * 64); st0 = which < 3 ? (size_t)HS * 2 : (size_t)1536 * 2;
          L = lane + 64; tok = L / 5; which = L - tok * 5; ta1 = (const unsigned*)(which < 3 ? H + (rb + tok) * HS + which * 512 + hh * 64 : LW + (rb + tok) * 1536 + (which - 3) * 512 + hh * 64); st1 = which < 3 ? (size_t)HS * 2 : (size_t)1536 * 2;
          L = lane + 128 > 159 ? 159 : lane + 128; tok = L / 5; which = L - tok * 5; ta2 = (const unsigned*)(which < 3 ? H + (rb + tok) * HS + which * 512 + hh * 64 : LW + (rb + tok) * 1536 + (which - 3) * 512 + hh * 64); st2 = which < 3 ? (size_t)HS * 2 : (size_t)1536 * 2; }
        unsigned x0 = 0, x1 = 0, x2 = 0, y0 = 0, y1 = 0, y2 = 0, z0 = 0, z1 = 0, z2 = 0, pacc = 0;
        RW_BAR();
        for (int ch = 0; ch < NCH; ++ch) {
            if (w == 4) { int cc = ch + 6; cc = cc > NCH - 1 ? NCH - 1 : cc; const size_t tb = (size_t)cc * RW_T;
                pacc ^= x0 ^ x1 ^ x2; x0 = y0; x1 = y1; x2 = y2; y0 = z0; y1 = z1; y2 = z2;
                z0 = *(const unsigned*)((const char*)ta0 + tb * st0); z1 = *(const unsigned*)((const char*)ta1 + tb * st1); z2 = *(const unsigned*)((const char*)ta2 + tb * st2); }
            RW_BAR();
        }
        pacc ^= x0 ^ x1 ^ x2 ^ y0 ^ y1 ^ y2 ^ z0 ^ z1 ^ z2; if (pacc == 0x9e3779b9u && rg == 77) Y[0] = 0;
    } else {
        const int lw = (w & 1) + ((w >> 2) << 1), col = hh * 64 + lane; RwRegs ra;
        const float mur = p.od_mu[col], muk = p.od_mu[512 + col], muv = p.od_mu[1024 + col], kk_w = p.od_k_k[col], ka_w = p.od_k_a[col];
        auto issue = [&](int ch, RwRegs& rr) {
            const int tbase = ch * RW_T + lw * 8;
#pragma unroll
            for (int i = 0; i < 9; ++i) { const int t = tbase + i - 1;
                if (t >= 0) { const bf16_t* hp = H + (rb + t) * HS; rr.r[i] = hp[col]; rr.k[i] = hp[512 + col]; rr.v[i] = hp[1024 + col]; } else { rr.r[i] = 0; rr.k[i] = 0; rr.v[i] = 0; }
                if (i > 0) { const bf16_t* lp = LW + (rb + t) * 1536; rr.om[i - 1] = lp[col]; rr.a[i - 1] = lp[512 + col]; rr.kn[i - 1] = KNRM[(rb + t) * 8 + hh]; } }
        };
        auto process = [&](int ch, const RwRegs& rr) {
            float* bufp = (float*)(smem + (ch & 1) * RW_BUF);
#pragma unroll
            for (int i = 1; i < 9; ++i) { const int tt = lw * 8 + i - 1;
                const float rc = bf2f(rr.r[i]), rp = bf2f(rr.r[i - 1]), kc = bf2f(rr.k[i]), kp = bf2f(rr.k[i - 1]), vc = bf2f(rr.v[i]), vp = bf2f(rr.v[i - 1]);
                const float rl = rc + (rp - rc) * mur, kl = kc + (kp - kc) * muk, vl = vc + (vp - vc) * muv; const float a = bf2f(rr.a[i - 1]), wv = 1.f - bf2f(rr.om[i - 1]);
                const float kk = kl * kk_w * rr.kn[i - 1];
                bufp[tt * 64 + lane] = rl; bufp[2048 + tt * 64 + lane] = wv; bufp[4096 + tt * 64 + lane] = kl * (1.f + (a - 1.f) * ka_w); bufp[6144 + tt * 64 + lane] = kk; bufp[8192 + tt * 64 + lane] = kk * a;
                if ((lane >> 3) == rg) bufp[10240 + tt * 8 + (lane & 7)] = vl; }
        };
        issue(0, ra); process(0, ra); issue(1, ra);
        RW_BAR();
        for (int ch = 0; ch < NCH; ++ch) {
            if (ch + 1 < NCH) { process(ch + 1, ra); if (ch + 2 < NCH) issue(ch + 2, ra); }
            if (ch > 0 && lw < 2) { const float* yi = ysh + ((ch - 1) & 1) * 256; const int t2 = lw * 64 + lane, tt = t2 >> 2, pr = (t2 & 3) * 2;
                *(unsigned*)(Y + (rb + (ch - 1) * RW_T + tt) * DM + hh * 64 + rg * 8 + pr) = pack2(yi[tt * 8 + pr], yi[tt * 8 + pr + 1]); }
            RW_BAR();
        }
        if (lw < 2) { const float* yi = ysh + ((NCH - 1) & 1) * 256; const int t2 = lw * 64 + lane, tt = t2 >> 2, pr = (t2 & 3) * 2;
          *(unsigned*)(Y + (rb + (NCH - 1) * RW_T + tt) * DM + hh * 64 + rg * 8 + pr) = pack2(yi[tt * 8 + pr], yi[tt * 8 + pr + 1]); }
    }
    __syncthreads();
}
DI void phase_l1_mix(const Params& p, unsigned char* smem, int pass) {
    unsigned* ctr = (unsigned*)(p.ws + O_CTL) + pass * 4; int* sh = (int*)(smem + 90112);
    if (obid() < 128 && pass != 2) rwkv_unit(p, smem, obid() >> 3, obid() & 7);
    for (;;) {
        __syncthreads(); if (otid() == 0) *sh = (int)atomicAdd(ctr, 1u); __syncthreads();
        const int u = *sh; if (u >= 1024) break;
        fox_unit(p, smem, u & 15, 63 - (u >> 4));
    }
}
DI void phase_rwkv_fin(const Params& p) {
    const bf16_t* H = (const bf16_t*)(p.ws + O_H); const bf16_t* LW = (const bf16_t*)(p.ws + O_LW); bf16_t* Y = (bf16_t*)(p.ws + O_XN);
    const int lane = otid() & 63, wv = otid() >> 6;
#pragma unroll 4
    for (int task = obid() * 8 + wv; task < TOK * 8; task += gridDim.x * 8) {
        const int r = task >> 3, hh = task & 7, t = r & (SEQ - 1), col = hh * 64 + lane; const bf16_t* hp = H + (size_t)r * HS;
        const float y = bf2f(Y[(size_t)r * DM + col]); const float mean = red64(y) * (1.f / 64.f); const float dy = y - mean; const float var = red64(dy * dy) * (1.f / 64.f);
        const float yln = dy * rsqrtf(var + 64e-5f) * p.od_ln_w[col] + p.od_ln_b[col];
        const bf16_t* hq = t > 0 ? hp - HS : hp; const float pm = t > 0 ? 1.f : 0.f;
        const float rc = bf2f(hp[col]), kc = bf2f(hp[512 + col]), vc = bf2f(hp[1024 + col]); const float rp = bf2f(hq[col]) * pm, kp = bf2f(hq[512 + col]) * pm, vp = bf2f(hq[1024 + col]) * pm;
        const float rl = rc + (rp - rc) * p.od_mu[col], kl = kc + (kp - kc) * p.od_mu[512 + col], vl = vc + (vp - vc) * p.od_mu[1024 + col];
        const float a = bf2f(LW[(size_t)r * 1536 + 512 + col]), g = bf2f(LW[(size_t)r * 1536 + 1024 + col]);
        const float kt = kl * (1.f + (a - 1.f) * p.od_k_a[col]); const float bonus = red64(rl * kt * p.od_r_k[col]) * vl;
        Y[(size_t)r * DM + col] = f2bf((yln + bonus) * g);
    }
}
#define XB_TMO      128
#define XB_XCNT(j)  (256  + 64 * (j))
#define XB_XSUB(j)  (1280 + 64 * (j))
#define XB_XGEN(j)  (2304 + 64 * (j))
#define XB_TOP      3328
#define XB_TOPGEN   3392
#define XCD_BAR_WORDS 3456
#define XB_SPIN_CAP (1u << 18)
#define LAS __attribute__((address_space(3)))

__device__ __forceinline__ unsigned xb_ld(unsigned* p)              { return __hip_atomic_load(p, __ATOMIC_RELAXED, __HIP_MEMORY_SCOPE_AGENT); }
__device__ __forceinline__ unsigned xb_add(unsigned* p, unsigned v) { return __hip_atomic_fetch_add(p, v, __ATOMIC_RELAXED, __HIP_MEMORY_SCOPE_AGENT); }
__device__ __forceinline__ unsigned xb_xcc_id() { return (unsigned)__builtin_amdgcn_s_getreg((3 << 11) | 20) & 0xFu; }
#define XB_SPIN(cond, bar) do { unsigned _sp = 0; while (cond) { __builtin_amdgcn_s_sleep(1); \
    if ((++_sp & 255u) == 0u) { if (xb_ld(&(bar)[XB_TMO])) break; if (_sp > XB_SPIN_CAP) { atomicAdd(&(bar)[XB_TMO], 1u); break; } } } } while (0)

struct XcdBarrier {
    unsigned* bar; unsigned x;
    volatile LAS unsigned* st;
};

__device__ __forceinline__ XcdBarrier xcd_barrier_post(unsigned* bar, volatile LAS unsigned* st) {
    XcdBarrier b; b.bar = bar; b.x = xb_xcc_id(); b.st = st;
    if (threadIdx.x == 0) (void)xb_add(&bar[XB_XCNT(b.x)], 1u);
    return b;
}
__device__ __forceinline__ void xcd_barrier_complete(unsigned* bar, unsigned x, unsigned& nloc, unsigned& nx) {
    const unsigned G = gridDim.x * gridDim.y * gridDim.z;
    unsigned sum, cnt, mine, sp = 0u;
    for (;;) {
        sum = 0u; cnt = 0u; mine = 0u;
#pragma unroll
        for (unsigned j = 0; j < 16; ++j) { const unsigned c = xb_ld(&bar[XB_XCNT(j)]); sum += c; cnt += (c > 0u) ? 1u : 0u; mine = (j == x) ? c : mine; }
        if (sum == G) break;
        __builtin_amdgcn_s_sleep(1);
        if ((++sp & 255u) == 0u) { if (xb_ld(&bar[XB_TMO])) break; if (sp > XB_SPIN_CAP) { atomicAdd(&bar[XB_TMO], 1u); break; } }
    }
    nloc = mine > 0u ? mine : 1u; nx = cnt > 0u ? cnt : 1u;
}

__device__ __forceinline__ void xcd_barrier(const XcdBarrier& b) {
    asm volatile("s_waitcnt vmcnt(0)" ::: "memory");
    __syncthreads();
    if (threadIdx.x == 0) {
        unsigned* bar = b.bar;
        __builtin_amdgcn_s_waitcnt(0);
        unsigned nloc = b.st[0], nx = b.st[1];
        if (nloc == 0u) { xcd_barrier_complete(bar, b.x, nloc, nx); b.st[0] = nloc; b.st[1] = nx; }
        const unsigned old = xb_add(&bar[XB_XSUB(b.x)], 1u);
        const unsigned gen = old / nloc;
        if (old + 1u == (gen + 1u) * nloc) {
            __builtin_amdgcn_fence(__ATOMIC_RELEASE, "agent");
            asm volatile("s_waitcnt vmcnt(0)" ::: "memory");
            const unsigned og = xb_add(&bar[XB_TOP], 1u);
            const unsigned tg = og / nx;
            if (og + 1u == (tg + 1u) * nx) xb_add(&bar[XB_TOPGEN], 1u);
            else XB_SPIN(xb_ld(&bar[XB_TOPGEN]) == tg, bar);
            __builtin_amdgcn_fence(__ATOMIC_ACQUIRE, "agent");
            xb_add(&bar[XB_XGEN(b.x)], 1u);
            asm volatile("s_waitcnt vmcnt(0)" ::: "memory");
        } else {
            XB_SPIN(xb_ld(&bar[XB_XGEN(b.x)]) == gen, bar);
            __builtin_amdgcn_fence(__ATOMIC_ACQUIRE, "agent");
            asm volatile("s_waitcnt vmcnt(0)" ::: "memory");
        }
    }
    __syncthreads();
}


__global__ void __launch_bounds__(512, 2) fwd_megakernel(Params p) {
    extern __shared__ __attribute__((aligned(16))) unsigned char smem[];
    cg::grid_group grid = cg::this_grid();
    unsigned char* ws = p.ws;
    bf16_t* XN = (bf16_t*)(ws + O_XN); bf16_t* Hb = (bf16_t*)(ws + O_H); float* aux = (float*)(ws + O_AUX);
    const bf16_t* t_in = (const bf16_t*)(ws + O_WT_IN); const bf16_t* t_out = (const bf16_t*)(ws + O_WT_OUT); const bf16_t* t_up = (const bf16_t*)(ws + O_WT_UP);
    const bf16_t* t_dn = (const bf16_t*)(ws + O_WT_DN); const bf16_t* t_lr = (const bf16_t*)(ws + O_WT_LR);
    if (blockIdx.x == 0 && threadIdx.x < 16) ((unsigned*)(ws + O_CTL))[threadIdx.x] = 0u;
    if (threadIdx.x == 0) *(uint4*)(smem + 131072) = make_uint4(0u, 0u, 0u, 0u);
    __syncthreads();
    const XcdBarrier xb = xcd_barrier_post((unsigned*)(ws + O_BAR), (volatile LAS unsigned*)(smem + 131072));
#define GSYNC() xcd_barrier(xb)
#define GEMM_H(layer) { EpiH E; E.H = Hb; E.aux = aux; E.auxc = layer ? 3328 : 1280; run_gemm(smem, XN, t_in, 3584, 1024, E); }
#define GEMM_OUT(layer) { EpiRes E; E.res = layer ? p.out : p.x; E.out = p.out; run_gemm(smem, XN, t_out, 1024, 1024, E); }
#define GEMM_UP(layer) { EpiGU E; E.GC = (bf16_t*)(ws + O_G); E.U = (bf16_t*)(ws + O_U); E.cw = p.ffn_conv_w + (size_t)(layer) * 3 * DFF; E.cb = p.ffn_conv_b + (size_t)(layer) * DFF; run_gemm(smem, XN, t_up, 2 * DFF, 1024, E); }
#define GEMM_DN() { EpiRes E; E.res = p.out; E.out = p.out; run_gemm(smem, (const bf16_t*)(ws + O_U), t_dn, 1024, DFF, E); }
    phase_weights(p, smem, 0, 0); phase_rmsnorm(p.x, p.ev_norm_w, XN);
    if (p.ws == nullptr) grid.sync();
    GSYNC();
    GEMM_H(0) phase_weights(p, smem, 0, 1); GSYNC();
#if PROBE == 2
    GEMM_H(0) GSYNC();
#endif
    phase_m1(p, smem); GSYNC();
#if PROBE == 3
    phase_m1(p, smem); GSYNC();
#endif
    phase_m2(p); GSYNC();
#if PROBE == 6
    GSYNC(); GSYNC(); GSYNC(); GSYNC(); GSYNC(); GSYNC(); GSYNC(); GSYNC(); GSYNC(); GSYNC();
#endif
#if PROBE == 7
    phase_weights(p, smem, 0, 0); GSYNC(); phase_rmsnorm(p.x, p.ev_norm_w, XN); GSYNC(); phase_rmsnorm(p.x, p.ev_norm_w, XN); GSYNC();
#endif
    phase_m3(p, smem); GSYNC();
#if PROBE == 3
    phase_m3(p, smem); GSYNC();
#endif
    GEMM_OUT(0) GSYNC();
#if PROBE == 2
    GEMM_OUT(0) GSYNC();
#endif
    phase_rmsnorm(p.out, p.ffn_norm_w, XN); GSYNC();
    GEMM_UP(0) phase_weights(p, smem, 0, 2); phase_weights(p, smem, 1, 0, 128); GSYNC();
    phase_ffn_fix(p, 0); GSYNC();
    GEMM_DN() GSYNC();
    phase_rmsnorm(p.out, p.od_norm_w, XN); GSYNC();
    GEMM_H(1) phase_weights(p, smem, 1, 1); GSYNC();
    phase_l1_prep(p, smem); GSYNC();
    { EpiLR E; E.LW = (bf16_t*)(ws + O_LW); E.w0 = p.od_w0; E.a0 = p.od_a0; run_gemm(smem, (const bf16_t*)(ws + O_AP), t_lr, 1536, 256, E); } GSYNC();
    phase_l1_mix(p, smem, 0); GSYNC();
#if PROBE == 4
    phase_l1_mix(p, smem, 1); GSYNC();
#endif
#if PROBE == 5
    phase_l1_mix(p, smem, 2); GSYNC();
#endif
    phase_rwkv_fin(p); GSYNC();
    GEMM_OUT(1) GSYNC();
    phase_rmsnorm(p.out, p.ffn_norm_w + DM, XN); GSYNC();
    GEMM_UP(1) phase_weights(p, smem, 1, 2); GSYNC();
    phase_ffn_fix(p, 1); GSYNC();
    GEMM_DN()
}

extern "C" void kernel_launch(void* const* d_in, const int* in_sizes, int n_in, void* d_out, int out_size, void* d_ws, size_t ws_size, hipStream_t stream) {
    static int grid_blocks = 0;
    if (grid_blocks == 0) {
        int dev = 0, cus = 0, per_cu = 0;
        hipGetDevice(&dev); hipDeviceGetAttribute(&cus, hipDeviceAttributeMultiprocessorCount, dev);
        if (hipFuncSetAttribute((const void*)fwd_megakernel, hipFuncAttributeMaxDynamicSharedMemorySize, LDS_BYTES) != hipSuccess) fprintf(stderr, "hipFuncSetAttribute failed\n");
        hipOccupancyMaxActiveBlocksPerMultiprocessor(&per_cu, (const void*)fwd_megakernel, 512, LDS_BYTES);
        (void)hipGetLastError();
        if (per_cu < 1) fprintf(stderr, "occupancy query says %d blocks per CU\n", per_cu);
        grid_blocks = cus > 0 ? cus : 256;
        if (ws_size < WS_NEED) fprintf(stderr, "workspace too small: %zu < %zu\n", ws_size, (size_t)WS_NEED);
    }
    Params p{};
    const float** pp = (const float**)&p;
    for (int i = 0; i < 33; ++i) pp[i] = (const float*)d_in[i];
    p.out = (float*)d_out; p.ws = (unsigned char*)d_ws;
    (void)hipMemsetAsync((char*)d_ws + O_BAR, 0, 16384, stream);
    void* args[] = {&p};
    hipError_t e = hipLaunchCooperativeKernel((const void*)fwd_megakernel, dim3(grid_blocks), dim3(512), args, LDS_BYTES, stream);
    if (e != hipSuccess) fprintf(stderr, "cooperative launch failed: %s (grid %d)\n", hipGetErrorString(e), grid_blocks);
}
```

```cpp
#include <hip/hip_runtime.h>
#include <hip/hip_cooperative_groups.h>
#include <cstdio>
#ifndef PROBE
#define PROBE 0
#endif
namespace cg = cooperative_groups;
namespace pg8 {
#define PG8_LAS __attribute__((address_space(3)))
typedef unsigned short bf16_t;
typedef short bf16x8 __attribute__((ext_vector_type(8)));
typedef float f32x4 __attribute__((ext_vector_type(4)));
typedef unsigned u32x4 __attribute__((ext_vector_type(4)));
constexpr int BM = 256, BK = 64, HALF = 128, HTB = HALF * BK * 2  , STAGE_BYTES = 8 * HTB, NXCD = 8, WGM = 8;

__host__ __device__ __forceinline__ int lds_byte(int r, int c) { const int st = (r >> 4) * 2 + (c >> 5), rr = r & 15, cc = c & 31, ob = rr * 64 + cc * 2; return st * 1024 + (ob ^ (((ob >> 9) & 1) << 5)); }
__host__ __device__ __forceinline__ void stage_rc(int b, int& R, int& C) { const int st = b / 1024, sb = b % 1024, swz = sb ^ (((sb >> 9) & 1) << 5); R = (st >> 1) * 16 + swz / 64; C = (st & 1) * 32 + (swz % 64) / 2; }
__host__ __device__ __forceinline__ int perm32(int rho) { const int n = rho >> 4, i = rho & 15; return 8 * (i >> 2) + 4 * n + (i & 3); }

struct Unit { int pm, pn; };
struct Gemm { const bf16_t* A; const bf16_t* Bt; int M, N, K; };

struct StaticOrder {
    int nM, nN, nwg, G, c;
    __host__ __device__ void init(int M, int N, int G_, int c_) { nM = M / BM; nN = N / BM; nwg = nM * nN; G = G_; c = c_; }
    __host__ __device__ bool next(int i, Unit& u) const {
        const long L = (long)i * G + c; if (L >= nwg) return false;
        int wgid = (int)L; { const int q = nwg / NXCD, r = nwg % NXCD, xcd = wgid % NXCD, off = wgid / NXCD; wgid = (xcd < r ? xcd * (q + 1) : r * (q + 1) + (xcd - r) * q) + off; }
        const int nig = WGM * nN, gid = wgid / nig, fm = gid * WGM, gsz = (nM - fm) < WGM ? (nM - fm) : WGM;
        u.pm = fm + ((wgid % nig) % gsz); u.pn = (wgid % nig) / gsz; return true;
    }
    __device__ __forceinline__ void a_ready(const Unit&) const {}
    __device__ __forceinline__ void done(const Unit&) const {}
};
__device__ __forceinline__ unsigned cvt_pk_bf16(float lo, float hi) { unsigned r; asm volatile("v_cvt_pk_bf16_f32 %0, %1, %2" : "=v"(r) : "v"(lo), "v"(hi)); return r; }

template <class Epi, class Sched, bool STAMP = false>
__device__ __forceinline__ void gemm_phase(PG8_LAS unsigned char* lds, const Gemm g, const Sched& S, const Epi& E, unsigned long long* stamps) {
    int tid_ = threadIdx.x; asm volatile("" : "+v"(tid_)); const int tid = tid_, wid = __builtin_amdgcn_readfirstlane(tid >> 6), lane = tid & 63, wr = wid >> 2, wc = wid & 3, fr = lane & 15, fq = lane >> 4;
    const int K = g.K, nt = K / BK;
    int ts_lo = 0, ts_hi = 0, nts = 0; const unsigned long long rt_entry = STAMP ? (unsigned long long)wall_clock64() : 0ull;
#define PG8_STAMP() do { if (STAMP && wid == 0 && nts < 64) { const unsigned long long _c = (unsigned long long)clock64(); \
        ts_lo = (lane == nts) ? (int)(unsigned)_c : ts_lo; ts_hi = (lane == nts) ? (int)(unsigned)(_c >> 32) : ts_hi; ++nts; } } while (0)
    PG8_STAMP();
    unsigned voffA[2], voffB[2];
#pragma unroll
    for (int i = 0; i < 2; ++i) { int R, C; stage_rc(tid * 16 + i * 8192, R, C); const int Rb = Epi::PERM ? ((R & ~31) + perm32(R & 31)) : R;
        voffA[i] = (unsigned)(R * K + C) * 2u; voffB[i] = (unsigned)(Rb * K + C) * 2u; }
    const size_t kstep = (size_t)(BK * 2);
    const size_t hstep = (size_t)HALF * K * 2;
    const size_t tstep = 2 * hstep;
    const unsigned ldsw = (unsigned)wid * 1024u;
    const int aoff = lds_byte(wr * 64 + fr, fq * 8), boff = lds_byte(wc * 32 + fr, fq * 8);
#define PG8_SA(b, h) (((b) * 2 + (h)) * HTB)
#define PG8_SB(b, h) ((4 + (b) * 2 + (h)) * HTB)
#define PG8_STAGE(bufoff, gbase, voff) do { _Pragma("unroll") for (int _i = 0; _i < 2; ++_i) \
        __builtin_amdgcn_global_load_lds((const unsigned*)((const char*)(gbase) + (voff)[_i]), (PG8_LAS unsigned*)(lds + (bufoff) + ldsw + _i * 8192), 16, 0, 0); } while (0)
#define PG8_LDA(dst, b, h) do { _Pragma("unroll") for (int m = 0; m < 4; ++m) _Pragma("unroll") for (int k = 0; k < 2; ++k) dst[m][k] = *(const PG8_LAS bf16x8*)(lds + PG8_SA(b, h) + aoff + m * 2048 + k * 1024); } while (0)
#define PG8_LDB(dst, b, h) do { _Pragma("unroll") for (int n = 0; n < 2; ++n) _Pragma("unroll") for (int k = 0; k < 2; ++k) dst[n][k] = *(const PG8_LAS bf16x8*)(lds + PG8_SB(b, h) + boff + n * 2048 + k * 1024); } while (0)
#define PG8_MMA(ai, bj, At, Bt) do { __builtin_amdgcn_s_setprio(1); _Pragma("unroll") for (int m = 0; m < 4; ++m) _Pragma("unroll") for (int n = 0; n < 2; ++n) _Pragma("unroll") for (int k = 0; k < 2; ++k) \
        acc[ai][bj][m][n] = __builtin_amdgcn_mfma_f32_16x16x32_bf16(Bt[n][k], At[m][k], acc[ai][bj][m][n], 0, 0, 0); __builtin_amdgcn_s_setprio(0); } while (0)
#define PG8_WAIT_V(n) asm volatile("s_waitcnt vmcnt(" #n ")" ::: "memory")
#define PG8_WAIT_L(n) asm volatile("s_waitcnt lgkmcnt(" #n ")" ::: "memory")
#define PG8_BAR __builtin_amdgcn_s_barrier()
#define PG8_SCHED __builtin_amdgcn_sched_barrier(0)
    Unit cur, nxt; int ui = 0;
    if (!S.next(0, cur)) return;
    f32x4 acc[2][2][4][2];
#pragma unroll
    for (int a = 0; a < 2; ++a)
#pragma unroll
        for (int b = 0; b < 2; ++b)
#pragma unroll
            for (int m = 0; m < 4; ++m)
#pragma unroll
                for (int n = 0; n < 2; ++n) acc[a][b][m][n] = (f32x4){0.f, 0.f, 0.f, 0.f};
    bf16x8 At[4][2], B0[2][2], B1[2][2];
    const char* cA = (const char*)g.A + (size_t)cur.pm * tstep; const char* cB = (const char*)g.Bt + (size_t)cur.pn * tstep;
    S.a_ready(cur);
    PG8_STAGE(PG8_SB(0, 0), cB, voffB); PG8_STAGE(PG8_SA(0, 0), cA, voffA); PG8_STAGE(PG8_SB(0, 1), cB + hstep, voffB); PG8_STAGE(PG8_SA(0, 1), cA + hstep, voffA);
    if (wr == 1) PG8_BAR;
    PG8_WAIT_V(4); PG8_BAR;
    PG8_STAGE(PG8_SB(1, 0), cB + kstep, voffB); PG8_STAGE(PG8_SA(1, 0), cA + kstep, voffA); PG8_STAGE(PG8_SB(1, 1), cB + hstep + kstep, voffB);
    PG8_WAIT_V(6); PG8_BAR;
    PG8_STAMP();
    for (;;) {
        const bool has_next = S.next(ui + 1, nxt);
        const char* nA = has_next ? (const char*)g.A + (size_t)nxt.pm * tstep : cA; const char* nB = has_next ? (const char*)g.Bt + (size_t)nxt.pn * tstep : cB;
        for (int t = 0; t < nt; t += 2) {
            const bool last = (t == nt - 2);
            const char* a1 = cA + (size_t)(t + 1) * kstep;
            const char* a2 = last ? nA : cA + (size_t)(t + 2) * kstep; const char* b2 = last ? nB : cB + (size_t)(t + 2) * kstep;
            const char* a3 = a2 + kstep; const char* b3 = b2 + kstep;
            if (last && has_next) S.a_ready(nxt);
            PG8_LDB(B0, 0, 0); PG8_SCHED; PG8_LDA(At, 0, 0); PG8_STAGE(PG8_SA(1, 1), a1 + hstep, voffA);
            PG8_WAIT_L(8); PG8_BAR; PG8_WAIT_L(0); PG8_MMA(0, 0, At, B0); PG8_BAR; PG8_SCHED;
            PG8_LDB(B1, 0, 1); PG8_STAGE(PG8_SB(0, 0), b2, voffB);
            PG8_BAR; PG8_WAIT_L(0); PG8_MMA(0, 1, At, B1); PG8_BAR;
            PG8_LDA(At, 0, 1); PG8_STAGE(PG8_SA(0, 0), a2, voffA);
            PG8_BAR; PG8_WAIT_L(0); PG8_MMA(1, 0, At, B0); PG8_BAR; PG8_SCHED;
            PG8_STAGE(PG8_SB(0, 1), b2 + hstep, voffB);
            PG8_WAIT_V(6); PG8_BAR; PG8_MMA(1, 1, At, B1); PG8_BAR;
            PG8_LDB(B0, 1, 0); PG8_SCHED; PG8_LDA(At, 1, 0); PG8_STAGE(PG8_SA(0, 1), a2 + hstep, voffA);
            PG8_WAIT_L(8); PG8_BAR; PG8_WAIT_L(0); PG8_MMA(0, 0, At, B0); PG8_BAR; PG8_SCHED;
            PG8_LDB(B1, 1, 1); PG8_STAGE(PG8_SB(1, 0), b3, voffB);
            PG8_BAR; PG8_WAIT_L(0); PG8_MMA(0, 1, At, B1); PG8_BAR;
            PG8_LDA(At, 1, 1); PG8_STAGE(PG8_SA(1, 0), a3, voffA);
            PG8_BAR; PG8_WAIT_L(0); PG8_MMA(1, 0, At, B0); PG8_BAR; PG8_SCHED;
            PG8_STAGE(PG8_SB(1, 1), b3 + hstep, voffB);
            PG8_WAIT_V(6); PG8_BAR; PG8_MMA(1, 1, At, B1); PG8_BAR;
        }
        PG8_STAMP();
        if constexpr (!Epi::AFTER_DRAIN) { E(acc, cur, wr, wc, fr, fq); S.done(cur); }
        PG8_STAMP();
        if (!has_next) break;
#pragma unroll
        for (int a = 0; a < 2; ++a)
#pragma unroll
            for (int b = 0; b < 2; ++b)
#pragma unroll
                for (int m = 0; m < 4; ++m)
#pragma unroll
                    for (int n = 0; n < 2; ++n) acc[a][b][m][n] = (f32x4){0.f, 0.f, 0.f, 0.f};
        cur = nxt; cA = nA; cB = nB; ++ui;
    }
    PG8_WAIT_V(0);
    if (wr == 0) PG8_BAR;
    PG8_BAR;
    if constexpr (Epi::AFTER_DRAIN) { E.fused(acc, cur, wr, wc, fr, fq, lds, wid, lane); S.done(cur); }
    PG8_STAMP();
    if (STAMP && wid == 0) { stamps[lane] = lane < nts ? (((unsigned long long)(unsigned)ts_hi << 32) | (unsigned)ts_lo) : 0ull;
        if (lane == 62) stamps[62] = rt_entry; if (lane == 63) stamps[63] = (unsigned long long)wall_clock64(); }
#undef PG8_STAMP
#undef PG8_SA
#undef PG8_SB
#undef PG8_STAGE
#undef PG8_LDA
#undef PG8_LDB
#undef PG8_MMA
#undef PG8_WAIT_V
#undef PG8_WAIT_L
#undef PG8_BAR
#undef PG8_SCHED
}
}

using pg8::bf16_t; using pg8::bf16x8; using pg8::f32x4; using pg8::Unit; using pg8::cvt_pk_bf16;
#define DI __device__ __forceinline__
constexpr int TOK = 16384, SEQ = 8192, DM = 1024, HS = 3336, DFF = 2816;
constexpr size_t O_CTL = 0, O_CD = 256, O_AUX = 4352, O_ROPE = 528640, O_FC = 2625792, O_WT = 3150080;
constexpr size_t O_WT_IN = O_WT, O_WT_OUT = O_WT_IN + 7340032, O_WT_UP = O_WT_OUT + 2097152, O_WT_DN = O_WT_UP + 11534336, O_WT_LR = O_WT_DN + 5767168;
constexpr size_t O_XN = O_WT + 27525120, O_R1 = O_XN + 33554432;
constexpr size_t O_H = O_R1, O_ST = O_R1 + 109314048, O_YG = O_ST + 33554432;
constexpr size_t O_G = O_R1, O_U = O_R1 + 92274688;
constexpr size_t O_LW = O_R1 + 109314048, O_KN = O_LW + 50331648, O_VT = O_KN + 16777216, O_AP = O_VT + 16777216;
constexpr size_t O_KNRM = O_AP + 8388608;
constexpr size_t O_BAR = O_KNRM + 524288;
constexpr size_t WS_NEED = O_BAR + 16384;
constexpr int LDS_BYTES = 131072 + 256;

struct Params {
    const float* x; const float* ev_norm_w; const float* ev_w_in; const float* ev_conv_w; const float* ev_conv_b; const float* ev_dt_bias; const float* ev_a_log;
    const float* ev_d; const float* ev_ssd_norm_w; const float* ev_ret_norm_w; const float* ev_w_out;
    const float* od_norm_w; const float* od_w_in; const float* od_mu; const float* od_w0; const float* od_w_up; const float* od_a0; const float* od_a_up;
    const float* od_g_up; const float* od_k_k; const float* od_k_a; const float* od_r_k; const float* od_ln_w; const float* od_ln_b;
    const float* od_qn_w; const float* od_kn_w; const float* od_f_bias; const float* od_w_out;
    const float* ffn_norm_w; const float* ffn_w_up; const float* ffn_conv_w; const float* ffn_conv_b; const float* ffn_w_down;
    float* out; unsigned char* ws;
};

DI unsigned cvtpk(float lo, float hi) { unsigned r; asm("v_cvt_pk_bf16_f32 %0, %1, %2" : "=v"(r) : "v"(lo), "v"(hi)); return r; }
DI unsigned short f2bf(float f) { return (unsigned short)(cvtpk(f, f) & 0xffffu); }
DI float bf2f(unsigned short b) { return __uint_as_float(((unsigned)b) << 16); }
DI unsigned pack2(float lo, float hi) { return cvtpk(lo, hi); }
DI float bflo(unsigned w) { return __uint_as_float(w << 16); }
DI float bfhi(unsigned w) { return __uint_as_float(w & 0xffff0000u); }
DI void unpack8(const uint4 r, float (&o)[8]) { o[0] = bflo(r.x); o[1] = bfhi(r.x); o[2] = bflo(r.y); o[3] = bfhi(r.y); o[4] = bflo(r.z); o[5] = bfhi(r.z); o[6] = bflo(r.w); o[7] = bfhi(r.w); }
DI uint4 pack8(const float (&o)[8]) { uint4 r; r.x = pack2(o[0], o[1]); r.y = pack2(o[2], o[3]); r.z = pack2(o[4], o[5]); r.w = pack2(o[6], o[7]); return r; }
DI float silu_(float x) { return x * __builtin_amdgcn_rcpf(1.f + __expf(-x)); }
DI float sigm_(float x) { return __builtin_amdgcn_rcpf(1.f + __expf(-x)); }
DI float softplus_(float x) { return fmaxf(x, 0.f) + log1pf(__expf(-fabsf(x))); }
DI bf16x8 ldfrag(const bf16_t* base, int row0, int ld, int k0, int lane) { return *(const bf16x8*)(base + (row0 + (lane & 15)) * ld + k0 + (lane >> 4) * 8); }
#define MFMA16(a, b, c) __builtin_amdgcn_mfma_f32_16x16x32_bf16((a), (b), (c), 0, 0, 0)
DI float red16(float v) { v += __shfl_xor(v, 1); v += __shfl_xor(v, 2); v += __shfl_xor(v, 4); v += __shfl_xor(v, 8); return v; }
DI float max16(float v) { v = fmaxf(v, __shfl_xor(v, 1)); v = fmaxf(v, __shfl_xor(v, 2)); v = fmaxf(v, __shfl_xor(v, 4)); v = fmaxf(v, __shfl_xor(v, 8)); return v; }
DI float red64(float v) { v += __shfl_xor(v, 32); v += __shfl_xor(v, 16); return red16(v); }
DI float dpp_red16(float x) {
    x += __builtin_bit_cast(float, __builtin_amdgcn_update_dpp(0, __builtin_bit_cast(int, x), 0xB1, 0xF, 0xF, true));
    x += __builtin_bit_cast(float, __builtin_amdgcn_update_dpp(0, __builtin_bit_cast(int, x), 0x4E, 0xF, 0xF, true));
    x += __builtin_bit_cast(float, __builtin_amdgcn_update_dpp(0, __builtin_bit_cast(int, x), 0x141, 0xF, 0xF, true));
    x += __builtin_bit_cast(float, __builtin_amdgcn_update_dpp(0, __builtin_bit_cast(int, x), 0x140, 0xF, 0xF, true));
    return x;
}

DI int otid() { int t = threadIdx.x; asm volatile("" : "+v"(t)); return t; }
DI int obid() { int b = blockIdx.x; asm volatile("" : "+s"(b)); return b; }
struct EpiH {
    static constexpr bool PERM = false, AFTER_DRAIN = false;
    bf16_t* H; float* aux; int auxc;
    DI void operator()(const f32x4 (&acc)[2][2][4][2], const Unit& u, int wr, int wc, int fr, int fq) const {
        const int row0 = u.pm * 256 + wr * 64 + fr, col0 = u.pn * 256 + wc * 32 + 4 * fq;
#pragma unroll
        for (int ai = 0; ai < 2; ++ai)
#pragma unroll
            for (int m = 0; m < 4; ++m) { const size_t r = (size_t)(row0 + ai * 128 + m * 16);
#pragma unroll
                for (int bj = 0; bj < 2; ++bj)
#pragma unroll
                    for (int n = 0; n < 2; ++n) { const int c = col0 + bj * 128 + n * 16; const f32x4 v = acc[ai][bj][m][n];
                        if (c < HS) { uint2 w; w.x = cvt_pk_bf16(v[0], v[1]); w.y = cvt_pk_bf16(v[2], v[3]); *(uint2*)(H + r * HS + c) = w;
                            if (c == auxc || c == auxc + 4) *(f32x4*)(aux + r * 8 + (c - auxc)) = v; } } }
    }
};
struct EpiRes {
    static constexpr bool PERM = false, AFTER_DRAIN = false;
    const float* res; float* out;
    DI void operator()(const f32x4 (&acc)[2][2][4][2], const Unit& u, int wr, int wc, int fr, int fq) const {
        const int row0 = u.pm * 256 + wr * 64 + fr, col0 = u.pn * 256 + wc * 32 + 4 * fq;
#pragma unroll
        for (int ai = 0; ai < 2; ++ai)
#pragma unroll
            for (int m = 0; m < 4; ++m) { const size_t r = (size_t)(row0 + ai * 128 + m * 16);
#pragma unroll
                for (int bj = 0; bj < 2; ++bj)
#pragma unroll
                    for (int n = 0; n < 2; ++n) { const int c = col0 + bj * 128 + n * 16;
                        const f32x4 rv = *(const f32x4*)(res + r * DM + c); *(f32x4*)(out + r * DM + c) = rv + acc[ai][bj][m][n]; } }
    }
};
DI float gu_ror1(float x) { float r; asm volatile("s_nop 1\n\tv_mov_b32_dpp %0, %1 row_ror:1 row_mask:0xf bank_mask:0xf bound_ctrl:1" : "=v"(r) : "v"(x)); return r; }
DI float gu_ror2(float x) { float r; asm volatile("s_nop 1\n\tv_mov_b32_dpp %0, %1 row_ror:2 row_mask:0xf bank_mask:0xf bound_ctrl:1" : "=v"(r) : "v"(x)); return r; }
struct EpiGU {
    static constexpr bool PERM = false, AFTER_DRAIN = false;
    bf16_t* GC; bf16_t* U; const float* cw; const float* cb;
    DI void operator()(const f32x4 (&acc)[2][2][4][2], const Unit& u, int wr, int wc, int fr, int fq) const {
        const int row0 = u.pm * 256 + wr * 64 + fr, col0 = u.pn * 128 + wc * 32 + 4 * fq;
#define GU_ROR(x, n) gu_ror##n(x)
#pragma unroll
        for (int n = 0; n < 2; ++n) { const int c = col0 + n * 16;
            const f32x4 w0 = *(const f32x4*)(cw + c), w1 = *(const f32x4*)(cw + DFF + c), w2 = *(const f32x4*)(cw + 2 * DFF + c), bb = *(const f32x4*)(cb + c);
#pragma unroll
            for (int ai = 0; ai < 2; ++ai)
#pragma unroll
                for (int m = 0; m < 4; ++m) { const size_t r = (size_t)(row0 + ai * 128 + m * 16); const size_t slab = r >> 6;
                    const f32x4 g = acc[ai][0][m][n], v = acc[ai][1][m][n]; const f32x4 gp = acc[ai][0][m > 0 ? m - 1 : 0][n];
                    f32x4 o;
#pragma unroll
                    for (int j = 0; j < 4; ++j) { const float p1 = GU_ROR(g[j], 1), q1 = GU_ROR(gp[j], 1), p2 = GU_ROR(g[j], 2), q2 = GU_ROR(gp[j], 2);
                        const float g1 = fr == 0 ? q1 : p1, g2 = fr < 2 ? q2 : p2;
                        const float a = bb[j] + w0[j] * g2 + w1[j] * g1 + w2[j] * g[j]; o[j] = silu_(a) * v[j]; }
                    const bool defer = (m == 0) && (fr < 2);
                    uint2 w;
                    w.x = cvt_pk_bf16(defer ? v[0] : o[0], defer ? v[1] : o[1]); w.y = cvt_pk_bf16(defer ? v[2] : o[2], defer ? v[3] : o[3]);
                    *(uint2*)(U + r * DFF + c) = w;
                    if (defer || (m == 3 && fr >= 14)) { const int slot = defer ? 2 + fr : fr - 14; uint2 gw; gw.x = cvt_pk_bf16(g[0], g[1]); gw.y = cvt_pk_bf16(g[2], g[3]);
                        *(uint2*)(GC + (slab * 4 + slot) * DFF + c) = gw; } }
        }
#undef GU_ROR
    }
};
struct EpiLR {
    static constexpr bool PERM = false, AFTER_DRAIN = false;
    bf16_t* LW; const float* w0; const float* a0;
    DI void operator()(const f32x4 (&acc)[2][2][4][2], const Unit& u, int wr, int wc, int fr, int fq) const {
        const int row0 = u.pm * 256 + wr * 64 + fr, col0 = u.pn * 256 + wc * 32 + 4 * fq;
#pragma unroll
        for (int ai = 0; ai < 2; ++ai)
#pragma unroll
            for (int m = 0; m < 4; ++m) { const size_t r = (size_t)(row0 + ai * 128 + m * 16);
#pragma unroll
                for (int bj = 0; bj < 2; ++bj)
#pragma unroll
                    for (int n = 0; n < 2; ++n) { const int c = col0 + bj * 128 + n * 16; f32x4 v = acc[ai][bj][m][n];
                        if (c < 512) { const f32x4 b = *(const f32x4*)(w0 + c);
#pragma unroll
                            for (int j = 0; j < 4; ++j) v[j] = 1.f - __expf(-0.606531f * sigm_(b[j] + v[j])); }
                        else if (c < 1024) { const f32x4 b = *(const f32x4*)(a0 + c - 512);
#pragma unroll
                            for (int j = 0; j < 4; ++j) v[j] = sigm_(b[j] + v[j]); }
                        uint2 w; w.x = cvt_pk_bf16(v[0], v[1]); w.y = cvt_pk_bf16(v[2], v[3]); *(uint2*)(LW + r * 1536 + c) = w; } }
    }
};
template <class Epi> DI void run_gemm(unsigned char* smem, const bf16_t* A, const bf16_t* Bt, int N, int K, const Epi& E) {
    pg8::Gemm g; g.A = A; g.Bt = Bt; g.M = TOK; g.N = N; g.K = K;
    pg8::StaticOrder S; S.init(TOK, N, (int)gridDim.x, obid());
    pg8::gemm_phase<Epi, pg8::StaticOrder, false>((PG8_LAS unsigned char*)smem, g, S, E, nullptr);
}

DI void conv_tile4(const float* W, int Nsrc, int K, bf16_t* Wt, int nd0, int sc0, int nvalid, int k0, float* tile) {
    const int tid = otid(), j = tid & 63, kb = tid >> 6;
    float v[32];
#pragma unroll
    for (int i = 0; i < 32; ++i) { const int kk = kb + 8 * i; v[i] = (j < nvalid) ? W[(size_t)(k0 + kk) * Nsrc + sc0 + j] : 0.f; }
#pragma unroll
    for (int i = 0; i < 32; ++i) { const int kk = kb + 8 * i; tile[kk * 65 + j] = v[i]; }
    __syncthreads();
    const int nl = tid >> 3, ks = (tid & 7) * 8;
#pragma unroll
    for (int q = 0; q < 4; ++q) { const float* tq = tile + q * 64 * 65; uint4 o;
        o.x = pack2(tq[(ks + 0) * 65 + nl], tq[(ks + 1) * 65 + nl]); o.y = pack2(tq[(ks + 2) * 65 + nl], tq[(ks + 3) * 65 + nl]);
        o.z = pack2(tq[(ks + 4) * 65 + nl], tq[(ks + 5) * 65 + nl]); o.w = pack2(tq[(ks + 6) * 65 + nl], tq[(ks + 7) * 65 + nl]);
        *(uint4*)(Wt + (size_t)(nd0 + nl) * K + k0 + q * 64 + ks) = o; }
    __syncthreads();
}
DI void phase_weights(const Params& p, unsigned char* smem, int layer, int part, int b0 = 0) {
    float* tile = (float*)smem;
    const float* w_in = layer ? p.od_w_in : p.ev_w_in; const float* w_out = layer ? p.od_w_out : p.ev_w_out;
    const float* w_up = p.ffn_w_up + (size_t)layer * DM * 2 * DFF; const float* w_dn = p.ffn_w_down + (size_t)layer * DFF * DM;
    bf16_t* t_in = (bf16_t*)(p.ws + O_WT_IN); bf16_t* t_out = (bf16_t*)(p.ws + O_WT_OUT); bf16_t* t_up = (bf16_t*)(p.ws + O_WT_UP); bf16_t* t_dn = (bf16_t*)(p.ws + O_WT_DN);
    if (part == 0) {
        if (obid() < b0) return;
        for (int job = obid() - b0; job < 288; job += (int)gridDim.x - b0) {
            if (job < 224) { const int nt = job >> 2, kt = job & 3, nd0 = nt * 64; int nv = HS - nd0; nv = nv < 0 ? 0 : (nv > 64 ? 64 : nv);
                conv_tile4(w_in, HS, 1024, t_in, nd0, nd0, nv, kt * 256, tile); }
            else { const int j2 = job - 224, nt = j2 >> 2, kt = j2 & 3; conv_tile4(w_out, 1024, 1024, t_out, nt * 64, nt * 64, 64, kt * 256, tile); }
        }
    } else {
        const int nb = (int)gridDim.x - 128, lb = obid() - 128;
        if (lb < 0) return;
        if (part == 1) { for (int job = lb; job < 352; job += nb) { const int nt = job >> 2, kt = job & 3, nd0 = nt * 64; const int pn = nd0 >> 8, bj = (nd0 >> 7) & 1, j0 = nd0 & 127;
                conv_tile4(w_up, 2 * DFF, 1024, t_up, nd0, bj * DFF + 128 * pn + j0, 64, kt * 256, tile); } }
        else { for (int job = lb; job < 176; job += nb) { const int nt = job / 11, kt = job % 11; conv_tile4(w_dn, 1024, DFF, t_dn, nt * 64, nt * 64, 64, kt * 256, tile); } }
        return;
    }
    const int gtid = (obid() - b0) * 512 + otid(), gsz = ((int)gridDim.x - b0) * 512;
    if (layer == 0) {
        float* rc = (float*)(p.ws + O_ROPE); float* rs = rc + SEQ * 32;
        for (int idx = gtid; idx < SEQ * 32; idx += gsz) { const int pos = idx >> 5, i = idx & 31;
            const float inv = (float)exp(-(double)i * (9.210340371976184 / 32.0)); const float ang = (float)pos * inv;
            const double a = (double)ang; const double n = rint(a * 0.15915494309189535); const double r = a - n * 6.283185307179586; const double r2 = r * r;
            double sn = 1.0 / 121645100408832000.0, cs = 1.0 / 2432902008176640000.0;
            sn = sn * r2 - 1.0 / 355687428096000.0; sn = sn * r2 + 1.0 / 1307674368000.0; sn = sn * r2 - 1.0 / 6227020800.0; sn = sn * r2 + 1.0 / 39916800.0;
            sn = sn * r2 - 1.0 / 362880.0; sn = sn * r2 + 1.0 / 5040.0; sn = sn * r2 - 1.0 / 120.0; sn = sn * r2 + 1.0 / 6.0; sn = sn * r2 * -1.0 + 1.0; sn = sn * r;
            cs = cs * r2 - 1.0 / 6402373705728000.0; cs = cs * r2 + 1.0 / 20922789888000.0; cs = cs * r2 - 1.0 / 87178291200.0; cs = cs * r2 + 1.0 / 479001600.0;
            cs = cs * r2 - 1.0 / 3628800.0; cs = cs * r2 + 1.0 / 40320.0; cs = cs * r2 - 1.0 / 720.0; cs = cs * r2 + 1.0 / 24.0; cs = cs * r2 - 0.5; cs = cs * r2 + 1.0;
            rc[idx] = (float)cs; rs[idx] = (float)sn; }
    } else {
        bf16_t* t_lr = (bf16_t*)(p.ws + O_WT_LR);
        for (int idx = gtid; idx < 1536 * 256; idx += gsz) { const int n = idx >> 8, k = idx & 255; float v = 0.f;
            if (n < 512) { if (k < 64) v = p.od_w_up[k * 512 + n]; }
            else if (n < 1024) { if (k >= 64 && k < 128) v = p.od_a_up[(k - 64) * 512 + n - 512]; }
            else { if (k >= 128) v = p.od_g_up[(k - 128) * 512 + n - 1024]; }
            t_lr[idx] = f2bf(v); }
    }
}
DI void phase_rmsnorm(const float* x, const float* w, bf16_t* xn) {
    const int lane = otid() & 63, wv = otid() >> 6;
    f32x4 ww[4];
#pragma unroll
    for (int i = 0; i < 4; ++i) ww[i] = *(const f32x4*)(w + i * 256 + lane * 4);
    for (int r0 = (obid() * 8 + wv) * 4; r0 < TOK; r0 += gridDim.x * 8 * 4) {
        f32x4 v[4][4];
#pragma unroll
        for (int q = 0; q < 4; ++q)
#pragma unroll
            for (int i = 0; i < 4; ++i) v[q][i] = *(const f32x4*)(x + (size_t)(r0 + q) * DM + i * 256 + lane * 4);
#pragma unroll
        for (int q = 0; q < 4; ++q) { float ss = 0.f;
#pragma unroll
            for (int i = 0; i < 4; ++i) ss += v[q][i][0] * v[q][i][0] + v[q][i][1] * v[q][i][1] + v[q][i][2] * v[q][i][2] + v[q][i][3] * v[q][i][3];
            ss = red64(ss); const float rstd = rsqrtf(ss * (1.f / DM) + 1e-6f);
#pragma unroll
            for (int i = 0; i < 4; ++i) { uint2 o; o.x = pack2(v[q][i][0] * rstd * ww[i][0], v[q][i][1] * rstd * ww[i][1]); o.y = pack2(v[q][i][2] * rstd * ww[i][2], v[q][i][3] * rstd * ww[i][3]);
                *(uint2*)(xn + (size_t)(r0 + q) * DM + i * 256 + lane * 4) = o; } }
    }
}
DI void ssd_conv8_raw(const Params& p, const uint4 r0, const uint4 r1, const uint4 r2, const uint4 r3, int t, int ch, float (&o)[8]) {
    const float m0 = t >= 3 ? 1.f : 0.f, m1 = t >= 2 ? 1.f : 0.f, m2 = t >= 1 ? 1.f : 0.f;
    float acc[8], xv[8];
    { const f32x4 b0 = *(const f32x4*)(p.ev_conv_b + ch), b1 = *(const f32x4*)(p.ev_conv_b + ch + 4);
      acc[0] = b0[0]; acc[1] = b0[1]; acc[2] = b0[2]; acc[3] = b0[3]; acc[4] = b1[0]; acc[5] = b1[1]; acc[6] = b1[2]; acc[7] = b1[3]; }
#define SSD_TAP(k, raw, msk) { unpack8(raw, xv); const f32x4 w0 = *(const f32x4*)(p.ev_conv_w + (k) * 768 + ch) * (msk), w1 = *(const f32x4*)(p.ev_conv_w + (k) * 768 + ch + 4) * (msk); \
        acc[0] += w0[0] * xv[0]; acc[1] += w0[1] * xv[1]; acc[2] += w0[2] * xv[2]; acc[3] += w0[3] * xv[3]; acc[4] += w1[0] * xv[4]; acc[5] += w1[1] * xv[5]; acc[6] += w1[2] * xv[6]; acc[7] += w1[3] * xv[7]; }
    SSD_TAP(0, r0, m0) SSD_TAP(1, r1, m1) SSD_TAP(2, r2, m2) SSD_TAP(3, r3, 1.f)
#pragma unroll
    for (int e = 0; e < 8; ++e) o[e] = silu_(acc[e]);
}
DI void ssd_taps(const bf16_t* H, int b, int t, int ch, uint4& r0, uint4& r1, uint4& r2, uint4& r3) {
    const bf16_t* base = H + (size_t)b * SEQ * HS + 512 + ch;
    const int t0 = t - 3 < 0 ? 0 : t - 3, t1 = t - 2 < 0 ? 0 : t - 2, t2 = t - 1 < 0 ? 0 : t - 1;
    r0 = *(const uint4*)(base + (size_t)t0 * HS); r1 = *(const uint4*)(base + (size_t)t1 * HS); r2 = *(const uint4*)(base + (size_t)t2 * HS); r3 = *(const uint4*)(base + (size_t)t * HS);
}
DI void ssd_conv8(const Params& p, const bf16_t* H, int b, int t, int ch, float (&o)[8]) { uint4 r0, r1, r2, r3; ssd_taps(H, b, t, ch, r0, r1, r2, r3); ssd_conv8_raw(p, r0, r1, r2, r3, t, ch, o); }
DI float ret_lg(int hh) { return log1pf(-exp2f(-5.f - (float)hh)); }
DI float chunk_aux(const Params& p, int b, int hh, int t0) { const int tid = otid(); return tid < 128 ? ((const float*)(p.ws + O_AUX))[((size_t)b * SEQ + t0 + tid) * 8 + hh] : 0.f; }
DI void chunk_decay(const Params& p, int mixer, int hh, float auxv, float* acs, float* dts) {
    const int tid = otid(), lane = tid & 63;
    float v = 0.f;
    if (tid < 128) {
        if (mixer == 0) { const float dt = softplus_(auxv + p.ev_dt_bias[hh]); dts[tid] = dt; v = -expf(p.ev_a_log[hh]) * dt; }
        else { dts[tid] = 1.f; v = ret_lg(hh); }
    }
#pragma unroll
    for (int off = 1; off < 64; off <<= 1) { const float t = __shfl_up(v, off); if (lane >= off) v += t; }
    if (tid == 63) acs[256] = v;
    __syncthreads();
    if (tid >= 64 && tid < 128) v += acs[256];
    if (tid < 128) acs[tid] = v;
    __syncthreads();
}
DI void phase_m1(const Params& p, unsigned char* smem) {
    bf16_t* Kt = (bf16_t*)smem; bf16_t* Vt = (bf16_t*)(smem + 17408); float* acs = (float*)(smem + 34816); float* dts = acs + 128;
    const bf16_t* H = (const bf16_t*)(p.ws + O_H); float* ST = (float*)(p.ws + O_ST); float* CD = (float*)(p.ws + O_CD);
    const float* rc = (const float*)(p.ws + O_ROPE); const float* rs = rc + SEQ * 32;
    const int tid = otid(), lane = tid & 63, w = tid >> 6;
    for (int u = obid(); u < 2048; u += gridDim.x) {
        const int mixer = u >> 10, bh = (u >> 6) & 15, c = u & 63, b = bh >> 3, hh = bh & 7, t0 = c * 128;
        chunk_decay(p, mixer, hh, mixer == 0 ? chunk_aux(p, b, hh, t0) : 0.f, acs, dts);
        const float aend = acs[127];
        if (mixer == 0) {
#pragma unroll
            for (int it = 0; it < 2; ++it) { const int g = tid + it * 512, s = g >> 3, c8 = (g & 7) * 8; float o[8];
                const float sc = __expf(aend - acs[s]) * dts[s];
                ssd_conv8(p, H, b, t0 + s, 512 + (hh >> 2) * 64 + c8, o);
#pragma unroll
                for (int e = 0; e < 8; ++e) Kt[(c8 + e) * 136 + s] = f2bf(o[e] * sc);
                ssd_conv8(p, H, b, t0 + s, hh * 64 + c8, o);
#pragma unroll
                for (int e = 0; e < 8; ++e) Vt[(c8 + e) * 136 + s] = f2bf(o[e]); }
            if (tid == 0) CD[bh * 64 + c] = __expf(aend);
        } else {
            { const int s = tid >> 2, i0 = (tid & 3) * 8; const size_t r = (size_t)b * SEQ + t0 + s; float k1[8], k2[8];
              unpack8(*(const uint4*)(H + r * HS + 1800 + hh * 64 + i0), k1); unpack8(*(const uint4*)(H + r * HS + 1800 + hh * 64 + 32 + i0), k2);
              const float sc = __expf(aend - acs[s]) * 0.125f;
#pragma unroll
              for (int e = 0; e < 8; ++e) { const float cs = rc[(t0 + s) * 32 + i0 + e], sn = rs[(t0 + s) * 32 + i0 + e];
                  Kt[(i0 + e) * 136 + s] = f2bf((k1[e] * cs - k2[e] * sn) * sc); Kt[(32 + i0 + e) * 136 + s] = f2bf((k1[e] * sn + k2[e] * cs) * sc); } }
#pragma unroll
            for (int it = 0; it < 2; ++it) { const int g = tid + it * 512, s = g >> 3, c8 = (g & 7) * 8; const size_t r = (size_t)b * SEQ + t0 + s; float v[8];
                unpack8(*(const uint4*)(H + r * HS + 2312 + hh * 64 + c8), v);
#pragma unroll
                for (int e = 0; e < 8; ++e) Vt[(c8 + e) * 136 + s] = (unsigned short)f2bf(v[e]); }
        }
        __syncthreads();
        { const int mt = w & 3, nt0 = (w >> 2) * 2; f32x4 a0 = {0.f, 0.f, 0.f, 0.f}, a1 = {0.f, 0.f, 0.f, 0.f};
#pragma unroll
          for (int ks = 0; ks < 4; ++ks) { const bf16x8 af = ldfrag(Kt, mt * 16, 136, ks * 32, lane);
              a0 = MFMA16(af, ldfrag(Vt, nt0 * 16, 136, ks * 32, lane), a0); a1 = MFMA16(af, ldfrag(Vt, nt0 * 16 + 16, 136, ks * 32, lane), a1); }
          float* dst = ST + (size_t)u * 4096 + mt * 16 + (lane >> 4) * 4;
          *(f32x4*)(dst + (nt0 * 16 + (lane & 15)) * 64) = a0; *(f32x4*)(dst + (nt0 * 16 + 16 + (lane & 15)) * 64) = a1; }
        __syncthreads();
    }
}
DI void phase_m2(const Params& p) {
    float* ST = (float*)(p.ws + O_ST); const float* CD = (const float*)(p.ws + O_CD);
    for (int idx = obid() * 512 + otid(); idx < 32 * 4096; idx += gridDim.x * 512) {
        const int mb = idx >> 12, e = idx & 4095, mixer = mb >> 4, bh = mb & 15; float run = 0.f;
        const float gdec = __expf(128.f * ret_lg(bh & 7));
#pragma unroll 8
        for (int c = 0; c < 64; ++c) { const size_t o = ((size_t)(mb * 64 + c)) * 4096 + e; const float v = ST[o]; ST[o] = run;
            const float dec = mixer == 0 ? CD[bh * 64 + c] : gdec; run = run * dec + v; }
    }
}
struct M3Pre { uint4 a0, a1, a2, a3, a4, a5, a6, a7; f32x4 st0, st1; float aux; };
template <int MIXER> DI void m3_issue(const Params& p, int b, int c, int hh, M3Pre& R) {
    const bf16_t* H = (const bf16_t*)(p.ws + O_H); const float* ST = (const float*)(p.ws + O_ST);
    const int tid = otid(), t0 = c * 128, bh = b * 8 + hh; const size_t u = (size_t)((MIXER * 16 + bh) * 64 + c);
    if (MIXER == 0) {
        { const int g = tid, s = g >> 3, c8 = (g & 7) * 8; ssd_taps(H, b, t0 + s, hh * 64 + c8, R.a0, R.a1, R.a2, R.a3); }
        { const int g = tid + 512, s = g >> 3, c8 = (g & 7) * 8; ssd_taps(H, b, t0 + s, hh * 64 + c8, R.a4, R.a5, R.a6, R.a7); }
        R.aux = chunk_aux(p, b, hh, t0);
    } else {
        { const int s = tid >> 2, i0 = (tid & 3) * 8; const size_t r = (size_t)b * SEQ + t0 + s;
          R.a0 = *(const uint4*)(H + r * HS + 1288 + hh * 64 + i0); R.a1 = *(const uint4*)(H + r * HS + 1288 + hh * 64 + 32 + i0);
          R.a2 = *(const uint4*)(H + r * HS + 1800 + hh * 64 + i0); R.a3 = *(const uint4*)(H + r * HS + 1800 + hh * 64 + 32 + i0); }
        { const int g = tid, s = g >> 3, c8 = (g & 7) * 8; R.a4 = *(const uint4*)(H + ((size_t)b * SEQ + t0 + s) * HS + 2312 + hh * 64 + c8); }
        { const int g = tid + 512, s = g >> 3, c8 = (g & 7) * 8; R.a5 = *(const uint4*)(H + ((size_t)b * SEQ + t0 + s) * HS + 2312 + hh * 64 + c8); }
        R.aux = 0.f;
    }
    { const int pr = tid >> 3, n8 = (tid & 7) * 8; const float* src = ST + u * 4096 + pr * 64 + n8; R.st0 = *(const f32x4*)src; R.st1 = *(const f32x4*)(src + 4); }
}
template <int MIXER> DI void m3_head(const Params& p, unsigned char* smem, int b, int c, int hh, float (&ssq)[4], M3Pre& R) {
    bf16_t* Qs = (bf16_t*)smem; bf16_t* Ks = (bf16_t*)(smem + 18432); bf16_t* Vt = (bf16_t*)(smem + 36864); bf16_t* Rt = (bf16_t*)(smem + 54272); bf16_t* Ps = (bf16_t*)(smem + 63488);
    float* acs = (float*)(smem + 98304); float* dts = acs + 128;
    const bf16_t* H = (const bf16_t*)(p.ws + O_H); float* YG = (float*)(p.ws + O_YG); bf16_t* Y = (bf16_t*)(p.ws + O_XN);
    const float* rc = (const float*)(p.ws + O_ROPE); const float* rs = rc + SEQ * 32;
    const int tid = otid(), lane = tid & 63, w = tid >> 6, t0 = c * 128;
    __syncthreads();
    chunk_decay(p, MIXER, hh, R.aux, acs, dts);
    if (MIXER == 0) {
        if ((hh & 3) == 0) {
#pragma unroll
            for (int it = 0; it < 2; ++it) { const int g = tid + it * 512, s = g >> 3, c8 = (g & 7) * 8; float o[8];
                ssd_conv8(p, H, b, t0 + s, 640 + (hh >> 2) * 64 + c8, o); *(uint4*)(Qs + s * 72 + c8) = pack8(o);
                ssd_conv8(p, H, b, t0 + s, 512 + (hh >> 2) * 64 + c8, o); *(uint4*)(Ks + s * 72 + c8) = pack8(o); } }
        { const int g = tid, s = g >> 3, c8 = (g & 7) * 8; float o[8]; ssd_conv8_raw(p, R.a0, R.a1, R.a2, R.a3, t0 + s, hh * 64 + c8, o);
#pragma unroll
          for (int e = 0; e < 8; ++e) Vt[(c8 + e) * 136 + s] = f2bf(o[e]); }
        { const int g = tid + 512, s = g >> 3, c8 = (g & 7) * 8; float o[8]; ssd_conv8_raw(p, R.a4, R.a5, R.a6, R.a7, t0 + s, hh * 64 + c8, o);
#pragma unroll
          for (int e = 0; e < 8; ++e) Vt[(c8 + e) * 136 + s] = f2bf(o[e]); }
    } else {
        { const int s = tid >> 2, i0 = (tid & 3) * 8; float a1[8], a2[8], o1[8], o2[8];
          unpack8(R.a0, a1); unpack8(R.a1, a2);
#pragma unroll
          for (int e = 0; e < 8; ++e) { const float cs = rc[(t0 + s) * 32 + i0 + e], sn = rs[(t0 + s) * 32 + i0 + e]; o1[e] = a1[e] * cs - a2[e] * sn; o2[e] = a1[e] * sn + a2[e] * cs; }
          *(uint4*)(Qs + s * 72 + i0) = pack8(o1); *(uint4*)(Qs + s * 72 + 32 + i0) = pack8(o2);
          unpack8(R.a2, a1); unpack8(R.a3, a2);
#pragma unroll
          for (int e = 0; e < 8; ++e) { const float cs = rc[(t0 + s) * 32 + i0 + e], sn = rs[(t0 + s) * 32 + i0 + e]; o1[e] = (a1[e] * cs - a2[e] * sn) * 0.125f; o2[e] = (a1[e] * sn + a2[e] * cs) * 0.125f; }
          *(uint4*)(Ks + s * 72 + i0) = pack8(o1); *(uint4*)(Ks + s * 72 + 32 + i0) = pack8(o2); }
        { const int g = tid, s = g >> 3, c8 = (g & 7) * 8; const uint4 raw = R.a4; const unsigned short* rv = (const unsigned short*)&raw;
#pragma unroll
          for (int e = 0; e < 8; ++e) Vt[(c8 + e) * 136 + s] = rv[e]; }
        { const int g = tid + 512, s = g >> 3, c8 = (g & 7) * 8; const uint4 raw = R.a5; const unsigned short* rv = (const unsigned short*)&raw;
#pragma unroll
          for (int e = 0; e < 8; ++e) Vt[(c8 + e) * 136 + s] = rv[e]; }
    }
    { const int pr = tid >> 3, n8 = (tid & 7) * 8; const f32x4 x0 = R.st0, x1 = R.st1;
      uint4 o; o.x = pack2(x0[0], x0[1]); o.y = pack2(x0[2], x0[3]); o.z = pack2(x1[0], x1[1]); o.w = pack2(x1[2], x1[3]); *(uint4*)(Rt + pr * 72 + n8) = o; }
    __syncthreads();
    if (hh < 7) m3_issue<MIXER>(p, b, c, hh + 1, R);
    const int nks = (w >> 1) + 1;
    const int lrow = 16 * w + (lane >> 4) * 4;
    unsigned short gate[4][4];
#pragma unroll
    for (int nt = 0; nt < 4; ++nt)
#pragma unroll
        for (int j = 0; j < 4; ++j) gate[nt][j] = H[((size_t)b * SEQ + t0 + lrow + j) * HS + (MIXER == 0 ? 0 : 2824) + hh * 64 + nt * 16 + (lane & 15)];
    {
        const bf16x8 q0 = ldfrag(Qs, 16 * w, 72, 0, lane), q1 = ldfrag(Qs, 16 * w, 72, 32, lane);
        float al[4];
#pragma unroll
        for (int j = 0; j < 4; ++j) al[j] = acs[lrow + j];
        for (int nt = 0; nt < 2 * nks; ++nt) { f32x4 sacc = {0.f, 0.f, 0.f, 0.f};
            sacc = MFMA16(q0, ldfrag(Ks, nt * 16, 72, 0, lane), sacc); sacc = MFMA16(q1, ldfrag(Ks, nt * 16, 72, 32, lane), sacc);
            const int s = nt * 16 + (lane & 15); const float as = acs[s], ds = dts[s];
#pragma unroll
            for (int j = 0; j < 4; ++j) { const float pv = (s <= lrow + j) ? sacc[j] * __expf(al[j] - as) * ds : 0.f; Ps[(lrow + j) * 136 + s] = f2bf(pv); } }
    }
    __syncthreads();
    f32x4 yd[4], yo[4];
#pragma unroll
    for (int nt = 0; nt < 4; ++nt) { yd[nt] = (f32x4){0.f, 0.f, 0.f, 0.f}; yo[nt] = (f32x4){0.f, 0.f, 0.f, 0.f}; }
    for (int ks = 0; ks < nks; ++ks) { const bf16x8 pf = ldfrag(Ps, 16 * w, 136, ks * 32, lane);
#pragma unroll
        for (int nt = 0; nt < 4; ++nt) yd[nt] = MFMA16(pf, ldfrag(Vt, nt * 16, 136, ks * 32, lane), yd[nt]); }
#pragma unroll
    for (int ks = 0; ks < 2; ++ks) { const bf16x8 qf = ldfrag(Qs, 16 * w, 72, ks * 32, lane);
#pragma unroll
        for (int nt = 0; nt < 4; ++nt) yo[nt] = MFMA16(qf, ldfrag(Rt, nt * 16, 72, ks * 32, lane), yo[nt]); }
    float ea[4];
#pragma unroll
    for (int j = 0; j < 4; ++j) ea[j] = __expf(acs[lrow + j]);
    if (MIXER == 0) {
        const float dsk = p.ev_d[hh];
#pragma unroll
        for (int nt = 0; nt < 4; ++nt) { const int pc = nt * 16 + (lane & 15);
#pragma unroll
            for (int j = 0; j < 4; ++j) { const size_t r = (size_t)b * SEQ + t0 + lrow + j;
                const float y = yd[nt][j] + ea[j] * yo[nt][j] + dsk * bf2f(Vt[pc * 136 + lrow + j]);
                const float z = bf2f(gate[nt][j]); const float yg = y * silu_(z); ssq[j] += yg * yg; YG[r * 512 + hh * 64 + pc] = yg; } }
    } else {
        float s2[4];
#pragma unroll
        for (int j = 0; j < 4; ++j) { float a = 0.f;
#pragma unroll
            for (int nt = 0; nt < 4; ++nt) { const float y = yd[nt][j] + ea[j] * yo[nt][j]; yd[nt][j] = y; a += y * y; }
            s2[j] = rsqrtf(red16(a) * (1.f / 64.f) + 1e-6f); }
#pragma unroll
        for (int nt = 0; nt < 4; ++nt) { const int pc = nt * 16 + (lane & 15); const float nw = p.ev_ret_norm_w[hh * 64 + pc];
#pragma unroll
            for (int j = 0; j < 4; ++j) { const size_t r = (size_t)b * SEQ + t0 + lrow + j; const float g = bf2f(gate[nt][j]);
                Y[r * DM + 512 + hh * 64 + pc] = f2bf(silu_(g) * yd[nt][j] * s2[j] * nw); } }
    }
}
DI void phase_m3(const Params& p, unsigned char* smem) {
    const int lane = otid() & 63, w = otid() >> 6;
    for (int u = obid(); u < 256; u += gridDim.x) {
        const int mixer = u >> 7, b = (u >> 6) & 1, c = u & 63; float ssq[4] = {0.f, 0.f, 0.f, 0.f};
        if (mixer == 0) {
            M3Pre R; m3_issue<0>(p, b, c, 0, R);
            for (int hh = 0; hh < 8; ++hh) m3_head<0>(p, smem, b, c, hh, ssq, R);
            float* YG = (float*)(p.ws + O_YG); bf16_t* Y = (bf16_t*)(p.ws + O_XN); const int lrow = 16 * w + (lane >> 4) * 4;
            float rstd[4];
#pragma unroll
            for (int j = 0; j < 4; ++j) rstd[j] = rsqrtf(red16(ssq[j]) * (1.f / 512.f) + 1e-6f);
            for (int cc = 0; cc < 32; ++cc) { const int col = cc * 16 + (lane & 15); const float nw = p.ev_ssd_norm_w[col];
#pragma unroll
                for (int j = 0; j < 4; ++j) { const size_t r = (size_t)b * SEQ + c * 128 + lrow + j;
                    const float v = __hip_atomic_load(YG + r * 512 + col, __ATOMIC_RELAXED, __HIP_MEMORY_SCOPE_AGENT); Y[r * DM + col] = f2bf(v * rstd[j] * nw); } }
        } else {
            M3Pre R; m3_issue<1>(p, b, c, 0, R);
            for (int hh = 0; hh < 8; ++hh) m3_head<1>(p, smem, b, c, hh, ssq, R);
        }
    }
}
DI void phase_ffn_fix(const Params& p, int layer) {
    const bf16_t* GC = (const bf16_t*)(p.ws + O_G); bf16_t* U = (bf16_t*)(p.ws + O_U);
    const float* cw = p.ffn_conv_w + (size_t)layer * 3 * DFF; const float* cb = p.ffn_conv_b + (size_t)layer * DFF;
    for (int idx = obid() * 512 + otid(); idx < 256 * 2 * (DFF / 8); idx += gridDim.x * 512) {
        const int c8 = (idx % (DFF / 8)) * 8, ri = idx / (DFF / 8), k = ri >> 1, i = ri & 1, r = k * 64 + i, t = r & (SEQ - 1);
        const int kp = k > 0 ? k - 1 : 0;
        const bf16_t* s0 = GC + ((size_t)kp * 4 + (i == 0 ? 0 : 1)) * DFF + c8;
        const bf16_t* s1 = i == 0 ? GC + ((size_t)kp * 4 + 1) * DFF + c8 : GC + ((size_t)k * 4 + 2) * DFF + c8;
        const bf16_t* s2 = GC + ((size_t)k * 4 + 2 + i) * DFF + c8;
        const float m0 = (t - 2 >= 0) ? 1.f : 0.f, m1 = (t - 1 >= 0) ? 1.f : 0.f;
        const uint4 r0 = *(const uint4*)s0, r1 = *(const uint4*)s1, r2 = *(const uint4*)s2, ru = *(const uint4*)(U + (size_t)r * DFF + c8);
        float acc[8], g[8], uv[8];
        { const f32x4 b0 = *(const f32x4*)(cb + c8), b1 = *(const f32x4*)(cb + c8 + 4); acc[0] = b0[0]; acc[1] = b0[1]; acc[2] = b0[2]; acc[3] = b0[3]; acc[4] = b1[0]; acc[5] = b1[1]; acc[6] = b1[2]; acc[7] = b1[3]; }
#define FIX_TAP(kk, raw, msk) { unpack8(raw, g); const f32x4 w0 = *(const f32x4*)(cw + (kk) * DFF + c8) * (msk), w1 = *(const f32x4*)(cw + (kk) * DFF + c8 + 4) * (msk); \
            acc[0] += w0[0] * g[0]; acc[1] += w0[1] * g[1]; acc[2] += w0[2] * g[2]; acc[3] += w0[3] * g[3]; acc[4] += w1[0] * g[4]; acc[5] += w1[1] * g[5]; acc[6] += w1[2] * g[6]; acc[7] += w1[3] * g[7]; }
        FIX_TAP(0, r0, m0) FIX_TAP(1, r1, m1) FIX_TAP(2, r2, 1.f)
        unpack8(ru, uv);
#pragma unroll
        for (int e2 = 0; e2 < 8; ++e2) acc[e2] = silu_(acc[e2]) * uv[e2];
        *(uint4*)(U + (size_t)r * DFF + c8) = pack8(acc);
    }
}
DI void phase_l1_prep(const Params& p, unsigned char* smem) {
    const bf16_t* H = (const bf16_t*)(p.ws + O_H); const float* aux = (const float*)(p.ws + O_AUX); float* FC = (float*)(p.ws + O_FC);
    bf16_t* KN = (bf16_t*)(p.ws + O_KN); bf16_t* VT = (bf16_t*)(p.ws + O_VT); bf16_t* AP = (bf16_t*)(p.ws + O_AP);
    const int tid = otid();
    for (int u = obid(); u < 16 + 1024; u += gridDim.x) {
        __syncthreads();
        if (u < 16) {
            float* tot = (float*)smem; const int bh = u, b = bh >> 3, hh = bh & 7; const float fb = p.od_f_bias[hh]; float loc[16]; float run = 0.f;
#pragma unroll
            for (int i = 0; i < 16; ++i) { const float xv = aux[((size_t)b * SEQ + tid * 16 + i) * 8 + hh] + fb; run += -softplus_(-xv); loc[i] = run; }
            tot[tid] = run; __syncthreads();
            float off = 0.f; for (int i = 0; i < tid; ++i) off += tot[i];
#pragma unroll
            for (int i = 0; i < 16; ++i) FC[(size_t)bh * SEQ + tid * 16 + i] = off + loc[i];
        } else {
            bf16_t* Vl = (bf16_t*)smem; const int v2 = u - 16, bh = v2 >> 6, blk = v2 & 63, b = bh >> 3, hh = bh & 7, t0 = blk * 128;
            { const int l = tid >> 2, c16 = (tid & 3) * 16; const size_t r = (size_t)b * SEQ + t0 + l; float a[8], c[8];
              unpack8(*(const uint4*)(H + r * HS + 2304 + hh * 64 + c16), a); unpack8(*(const uint4*)(H + r * HS + 2304 + hh * 64 + c16 + 8), c);
              float ss = 0.f;
#pragma unroll
              for (int e = 0; e < 8; ++e) ss += a[e] * a[e] + c[e] * c[e];
              ss += __shfl_xor(ss, 1); ss += __shfl_xor(ss, 2); const float rstd = rsqrtf(ss * (1.f / 64.f) + 1e-6f);
#pragma unroll
              for (int e = 0; e < 8; ++e) { a[e] *= rstd * p.od_kn_w[c16 + e]; c[e] *= rstd * p.od_kn_w[c16 + 8 + e]; }
              bf16_t* dst = KN + ((size_t)bh * SEQ + t0 + l) * 64 + c16; *(uint4*)dst = pack8(a); *(uint4*)(dst + 8) = pack8(c); }
#pragma unroll
            for (int it = 0; it < 2; ++it) { const int g = tid + it * 512, s = g >> 3, c8 = (g & 7) * 8; const size_t r = (size_t)b * SEQ + t0 + s;
                *(uint4*)(Vl + s * 72 + c8) = *(const uint4*)(H + r * HS + 2816 + hh * 64 + c8); }
            __syncthreads();
#pragma unroll
            for (int it = 0; it < 2; ++it) { const int g = tid + it * 512, e = g >> 4, s8 = (g & 15) * 8; uint4 o;
                o.x = (unsigned)Vl[(s8 + 0) * 72 + e] | ((unsigned)Vl[(s8 + 1) * 72 + e] << 16); o.y = (unsigned)Vl[(s8 + 2) * 72 + e] | ((unsigned)Vl[(s8 + 3) * 72 + e] << 16);
                o.z = (unsigned)Vl[(s8 + 4) * 72 + e] | ((unsigned)Vl[(s8 + 5) * 72 + e] << 16); o.w = (unsigned)Vl[(s8 + 6) * 72 + e] | ((unsigned)Vl[(s8 + 7) * 72 + e] << 16);
                *(uint4*)(VT + ((size_t)bh * 64 + e) * SEQ + t0 + s8) = o; }
        }
    }
    {
        float* KNRM = (float*)(p.ws + O_KNRM);
#pragma unroll 4
        for (int idx = obid() * 512 + tid; idx < TOK * 64; idx += gridDim.x * 512) {
            const int r = idx >> 6, c8 = (idx & 63) * 8, t = r & (SEQ - 1); float cur[8], prv[8]; float ss = 0.f;
            { const uint4 rc = *(const uint4*)(H + (size_t)r * HS + 512 + c8), rp = *(const uint4*)(H + (size_t)(t > 0 ? r - 1 : r) * HS + 512 + c8); const float pm = t > 0 ? 1.f : 0.f;
              unpack8(rc, cur); unpack8(rp, prv);
#pragma unroll
              for (int e = 0; e < 8; ++e) prv[e] *= pm; }
#pragma unroll
            for (int e = 0; e < 8; ++e) { const float v = (cur[e] + (prv[e] - cur[e]) * p.od_mu[512 + c8 + e]) * p.od_k_k[c8 + e]; ss += v * v; }
            ss += __shfl_xor(ss, 1); ss += __shfl_xor(ss, 2); ss += __shfl_xor(ss, 4);
            if ((idx & 7) == 0) KNRM[(size_t)r * 8 + (c8 >> 6)] = 1.f / fmaxf(sqrtf(ss), 1e-12f);
        }
    }
#pragma unroll 4
    for (int idx = obid() * 512 + tid; idx < TOK * 32; idx += gridDim.x * 512) {
        const int r = idx >> 5, j8 = (idx & 31) * 8, t = r & (SEQ - 1); float cur[8], prv[8], o[8];
        { const uint4 rc = *(const uint4*)(H + (size_t)r * HS + 1536 + j8), rp = *(const uint4*)(H + (size_t)(t > 0 ? r - 1 : r) * HS + 1536 + j8); const float pm = t > 0 ? 1.f : 0.f;
          unpack8(rc, cur); unpack8(rp, prv);
#pragma unroll
          for (int e = 0; e < 8; ++e) prv[e] *= pm; }
#pragma unroll
        for (int e = 0; e < 8; ++e) { const float v = cur[e] + (prv[e] - cur[e]) * p.od_mu[1536 + j8 + e];
            o[e] = (j8 < 64) ? tanhf(v) : ((j8 < 128) ? v : sigm_(v)); }
        *(uint4*)(AP + (size_t)r * 256 + j8) = pack8(o);
    }
}
DI void fox_unit(const Params& p, unsigned char* smem, int bh, int qb) {
    bf16_t* Qs = (bf16_t*)smem; bf16_t* Ks = (bf16_t*)(smem + 18432); bf16_t* Vts = (bf16_t*)(smem + 36864); float* ck = (float*)(smem + 89600);
    const bf16_t* H = (const bf16_t*)(p.ws + O_H); const float* FC = (const float*)(p.ws + O_FC); const bf16_t* KN = (const bf16_t*)(p.ws + O_KN); const bf16_t* VT = (const bf16_t*)(p.ws + O_VT);
    bf16_t* Y = (bf16_t*)(p.ws + O_XN);
    const int tid = otid(), lane = tid & 63, w = tid >> 6, b = bh >> 3, hh = bh & 7; const size_t r0 = (size_t)b * SEQ + qb * 128;
    const float LOG2E = 1.4426950408889634f;
    __syncthreads();
    { const int l = tid >> 2, c16 = (tid & 3) * 16; float a[8], c[8];
      unpack8(*(const uint4*)(H + (r0 + l) * HS + 1792 + hh * 64 + c16), a); unpack8(*(const uint4*)(H + (r0 + l) * HS + 1792 + hh * 64 + c16 + 8), c);
      float ss = 0.f;
#pragma unroll
      for (int e = 0; e < 8; ++e) ss += a[e] * a[e] + c[e] * c[e];
      ss += __shfl_xor(ss, 1); ss += __shfl_xor(ss, 2); const float rstd = rsqrtf(ss * (1.f / 64.f) + 1e-6f) * (0.125f * LOG2E);
#pragma unroll
      for (int e = 0; e < 8; ++e) { a[e] *= rstd * p.od_qn_w[c16 + e]; c[e] *= rstd * p.od_qn_w[c16 + 8 + e]; }
      *(uint4*)(Qs + l * 72 + c16) = pack8(a); *(uint4*)(Qs + l * 72 + c16 + 8) = pack8(c); }
    float mrow = -1e30f, lsum = 0.f; f32x4 O[4];
#pragma unroll
    for (int j = 0; j < 4; ++j) O[j] = (f32x4){0.f, 0.f, 0.f, 0.f};
    const int q4 = (lane >> 4) * 4, lq = 16 * w + (lane & 15);
    uint4 kreg0, kreg1, vreg0, vreg1; float ckreg = 0.f;
    const int g0 = tid, g1 = tid + 512;
#define FOX_ISSUE(kb_) { \
        kreg0 = *(const uint4*)(KN + ((size_t)bh * SEQ + (kb_) * 128 + (g0 >> 3)) * 64 + (g0 & 7) * 8); \
        kreg1 = *(const uint4*)(KN + ((size_t)bh * SEQ + (kb_) * 128 + (g1 >> 3)) * 64 + (g1 & 7) * 8); \
        vreg0 = *(const uint4*)(VT + ((size_t)bh * 64 + (g0 >> 4)) * SEQ + (kb_) * 128 + (g0 & 15) * 8); \
        vreg1 = *(const uint4*)(VT + ((size_t)bh * 64 + (g1 >> 4)) * SEQ + (kb_) * 128 + (g1 & 15) * 8); \
        if (tid < 128) ckreg = FC[(size_t)bh * SEQ + (kb_) * 128 + tid]; }
    FOX_ISSUE(0)
    for (int kb = 0; kb <= qb; ++kb) {
        __syncthreads();
        *(uint4*)(Ks + (g0 >> 3) * 72 + (g0 & 7) * 8) = kreg0; *(uint4*)(Ks + (g1 >> 3) * 72 + (g1 & 7) * 8) = kreg1;
        *(uint4*)(Vts + (g0 >> 4) * 136 + (g0 & 15) * 8) = vreg0; *(uint4*)(Vts + (g1 >> 4) * 136 + (g1 & 15) * 8) = vreg1;
        if (tid < 128) ck[tid] = -ckreg * LOG2E;
        __syncthreads();
        if (kb < qb) FOX_ISSUE(kb + 1)
        f32x4 S[8];
        { const bf16x8 q0 = ldfrag(Qs, 16 * w, 72, 0, lane), q1 = ldfrag(Qs, 16 * w, 72, 32, lane);
#pragma unroll
          for (int nt = 0; nt < 8; ++nt) { f32x4 z = *(const f32x4*)(ck + nt * 16 + q4); z = MFMA16(ldfrag(Ks, nt * 16, 72, 0, lane), q0, z); S[nt] = MFMA16(ldfrag(Ks, nt * 16, 72, 32, lane), q1, z); } }
        if (kb == qb) {
#pragma unroll
            for (int nt = 0; nt < 8; ++nt)
#pragma unroll
                for (int j = 0; j < 4; ++j) if (nt * 16 + q4 + j > lq) S[nt][j] = -1e30f;
        }
        float mx = S[0][0];
#pragma unroll
        for (int nt = 0; nt < 8; ++nt)
#pragma unroll
            for (int j = 0; j < 4; ++j) mx = fmaxf(mx, S[nt][j]);
        mx = fmaxf(mx, __shfl_xor(mx, 16)); mx = fmaxf(mx, __shfl_xor(mx, 32));
        const float mnew = fmaxf(mrow, mx); const float alpha = __builtin_amdgcn_exp2f(mrow - mnew); mrow = mnew;
        float rs = 0.f;
#pragma unroll
        for (int nt = 0; nt < 8; ++nt)
#pragma unroll
            for (int j = 0; j < 4; ++j) { const float pv = __builtin_amdgcn_exp2f(S[nt][j] - mnew); S[nt][j] = pv; rs += pv; }
        lsum = lsum * alpha + rs;
#pragma unroll
        for (int et = 0; et < 4; ++et) O[et] = O[et] * alpha;
#pragma unroll
        for (int ks = 0; ks < 4; ++ks) {
            uint4 pw; pw.x = cvt_pk_bf16(S[2 * ks][0], S[2 * ks][1]); pw.y = cvt_pk_bf16(S[2 * ks][2], S[2 * ks][3]); pw.z = cvt_pk_bf16(S[2 * ks + 1][0], S[2 * ks + 1][1]); pw.w = cvt_pk_bf16(S[2 * ks + 1][2], S[2 * ks + 1][3]);
            const bf16x8 pf = __builtin_bit_cast(bf16x8, pw);
#pragma unroll
            for (int et = 0; et < 4; ++et) { const bf16_t* vp = Vts + (et * 16 + (lane & 15)) * 136 + ks * 32 + q4;
                uint4 vw; const uint2 lo = *(const uint2*)vp, hi = *(const uint2*)(vp + 16); vw.x = lo.x; vw.y = lo.y; vw.z = hi.x; vw.w = hi.y;
                O[et] = MFMA16(__builtin_bit_cast(bf16x8, vw), pf, O[et]); }
        }
    }
    lsum += __shfl_xor(lsum, 16); lsum += __shfl_xor(lsum, 32);
    const float inv = 1.f / lsum;
#pragma unroll
    for (int et = 0; et < 4; ++et) { uint2 o; o.x = pack2(O[et][0] * inv, O[et][1] * inv); o.y = pack2(O[et][2] * inv, O[et][3] * inv);
        *(uint2*)(Y + (r0 + lq) * DM + 512 + hh * 64 + et * 16 + q4) = o; }
}
constexpr int RW_T = 32, RW_BUF = 43008;
struct RwRegs { unsigned short r[9], k[9], v[9], om[8], a[8]; float kn[8]; };
#define RW_BAR() do { asm volatile("s_waitcnt lgkmcnt(0)" ::: "memory"); __builtin_amdgcn_s_barrier(); asm volatile("" ::: "memory"); } while (0)
DI void rwkv_unit(const Params& p, unsigned char* smem, int bh, int rg) {
    const bf16_t* H = (const bf16_t*)(p.ws + O_H); const bf16_t* LW = (const bf16_t*)(p.ws + O_LW); bf16_t* Y = (bf16_t*)(p.ws + O_XN); const float* KNRM = (const float*)(p.ws + O_KNRM);
    const int tid = otid(), lane = tid & 63, w = tid >> 6, b = bh >> 3, hh = bh & 7; const size_t rb = (size_t)b * SEQ;
    float* ysh = (float*)(smem + 2 * RW_BUF);
    const int NCH = SEQ / RW_T;
    __syncthreads();
    if (w < 2) {
        float S0 = 0.f, S1 = 0.f, S2 = 0.f, S3 = 0.f; const int kq = lane & 15, row = w * 4 + (lane >> 4);
        RW_BAR();
        for (int ch = 0; ch < NCH; ++ch) {
            const float* bufp = (const float*)(smem + (ch & 1) * RW_BUF) + kq * 4; const float* vp = (const float*)(smem + (ch & 1) * RW_BUF) + 10240 + row; float* yo = ysh + (ch & 1) * 256 + row;
#define RW_LOAD(R, W, K, Q, B, V, tt) { R = *(const f32x4*)(bufp + (tt) * 64); W = *(const f32x4*)(bufp + 2048 + (tt) * 64); K = *(const f32x4*)(bufp + 4096 + (tt) * 64); \
                Q = *(const f32x4*)(bufp + 6144 + (tt) * 64); B = *(const f32x4*)(bufp + 8192 + (tt) * 64); V = vp[(tt) * 8]; }
#define DPPF(x, ctrl) __builtin_bit_cast(float, __builtin_amdgcn_update_dpp(0, __builtin_bit_cast(int, (x)), (ctrl), 0xF, 0xF, true))
            f32x4 prevR = {0.f, 0.f, 0.f, 0.f}; float yacc = 0.f;
            f32x4 rN, wN, kN, qN, bN; float vN;
            RW_LOAD(rN, wN, kN, qN, bN, vN, 0)
            __builtin_amdgcn_sched_barrier(0);
#pragma unroll
            for (int tt = 0; tt < RW_T; ++tt) {
                const f32x4 R = rN, W = wN, K = kN, Q = qN, B = bN; const float V = vN;
                if (tt + 1 < RW_T) RW_LOAD(rN, wN, kN, qN, bN, vN, tt + 1)
                float d = S0 * Q[0] + S1 * Q[1] + S2 * Q[2] + S3 * Q[3];
                if (tt > 0) {
                    float y = S0 * prevR[0] + S1 * prevR[1] + S2 * prevR[2] + S3 * prevR[3];
                    d += DPPF(d, 0xB1); y += DPPF(y, 0xB1); d += DPPF(d, 0x4E); y += DPPF(y, 0x4E); d += DPPF(d, 0x141); y += DPPF(y, 0x141); d += DPPF(d, 0x140); y += DPPF(y, 0x140);
                    yacc = (kq == ((tt - 1) & 15)) ? y : yacc;
                    if (tt == 16) yo[kq * 8] = yacc;
                } else d = dpp_red16(d);
                const float sa = -d;
                S0 = (S0 * W[0] + V * K[0]) + sa * B[0]; S1 = (S1 * W[1] + V * K[1]) + sa * B[1]; S2 = (S2 * W[2] + V * K[2]) + sa * B[2]; S3 = (S3 * W[3] + V * K[3]) + sa * B[3];
                prevR = R;
                if (tt & 1) __builtin_amdgcn_sched_barrier(0);
            }
            { float y = S0 * prevR[0] + S1 * prevR[1] + S2 * prevR[2] + S3 * prevR[3]; y = dpp_red16(y); yacc = (kq == 15) ? y : yacc; yo[(16 + kq) * 8] = yacc; }
            RW_BAR();
        }
    } else if (w == 4 || w == 5) {
        const unsigned* ta0; const unsigned* ta1; const unsigned* ta2; size_t st0, st1, st2;
        { int L = lane; int tok = L / 5, which = L - tok * 5; ta0 = (const unsigned*)(which < 3 ? H + (rb + tok) * HS + which * 512 + hh * 64 : LW + (rb + tok) * 1536 + (which - 3) * 512 + hh * 64); st0 = which < 3 ? (size_t)HS * 2 : (size_t)1536 * 2;
          L = lane + 64; tok = L / 5; which = L - tok * 5; ta1 = (const unsigned*)(which < 3 ? H + (rb + tok) * HS + which * 512 + hh * 64 : LW + (rb + tok) * 1536 + (which - 3) * 512 + hh * 64); st1 = which < 3 ? (size_t)HS * 2 : (size_t)1536 * 2;
          L = lane + 128 > 159 ? 159 : lane + 128; tok = L / 5; which = L - tok * 5; ta2 = (const unsigned*)(which < 3 ? H + (rb + tok) * HS + which * 512 + hh * 64 : LW + (rb + tok) * 1536 + (which - 3) * 512 + hh * 64); st2 = which < 3 ? (size_t)HS * 2 : (size_t)1536 * 2; }
        unsigned x0 = 0, x1 = 0, x2 = 0, y0 = 0, y1 = 0, y2 = 0, z0 = 0, z1 = 0, z2 = 0, pacc = 0;
        RW_BAR();
        for (int ch = 0; ch < NCH; ++ch) {
            if (w == 4) { int cc = ch + 6; cc = cc > NCH - 1 ? NCH - 1 : cc; const size_t tb = (size_t)cc * RW_T;
                pacc ^= x0 ^ x1 ^ x2; x0 = y0; x1 = y1; x2 = y2; y0 = z0; y1 = z1; y2 = z2;
                z0 = *(const unsigned*)((const char*)ta0 + tb * st0); z1 = *(const unsigned*)((const char*)ta1 + tb * st1); z2 = *(const unsigned*)((const char*)ta2 + tb * st2); }
            RW_BAR();
        }
        pacc ^= x0 ^ x1 ^ x2 ^ y0 ^ y1 ^ y2 ^ z0 ^ z1 ^ z2; if (pacc == 0x9e3779b9u && rg == 77) Y[0] = 0;
    } else {
        const int lw = (w & 1) + ((w >> 2) << 1), col = hh * 64 + lane; RwRegs ra;
        const float mur = p.od_mu[col], muk = p.od_mu[512 + col], muv = p.od_mu[1024 + col], kk_w = p.od_k_k[col], ka_w = p.od_k_a[col];
        auto issue = [&](int ch, RwRegs& rr) {
            const int tbase = ch * RW_T + lw * 8;
#pragma unroll
            for (int i = 0; i < 9; ++i) { const int t = tbase + i - 1;
                if (t >= 0) { const bf16_t* hp = H + (rb + t) * HS; rr.r[i] = hp[col]; rr.k[i] = hp[512 + col]; rr.v[i] = hp[1024 + col]; } else { rr.r[i] = 0; rr.k[i] = 0; rr.v[i] = 0; }
                if (i > 0) { const bf16_t* lp = LW + (rb + t) * 1536; rr.om[i - 1] = lp[col]; rr.a[i - 1] = lp[512 + col]; rr.kn[i - 1] = KNRM[(rb + t) * 8 + hh]; } }
        };
        auto process = [&](int ch, const RwRegs& rr) {
            float* bufp = (float*)(smem + (ch & 1) * RW_BUF);
#pragma unroll
            for (int i = 1; i < 9; ++i) { const int tt = lw * 8 + i - 1;
                const float rc = bf2f(rr.r[i]), rp = bf2f(rr.r[i - 1]), kc = bf2f(rr.k[i]), kp = bf2f(rr.k[i - 1]), vc = bf2f(rr.v[i]), vp = bf2f(rr.v[i - 1]);
                const float rl = rc + (rp - rc) * mur, kl = kc + (kp - kc) * muk, vl = vc + (vp - vc) * muv; const float a = bf2f(rr.a[i - 1]), wv = 1.f - bf2f(rr.om[i - 1]);
                const float kk = kl * kk_w * rr.kn[i - 1];
                bufp[tt * 64 + lane] = rl; bufp[2048 + tt * 64 + lane] = wv; bufp[4096 + tt * 64 + lane] = kl * (1.f + (a - 1.f) * ka_w); bufp[6144 + tt * 64 + lane] = kk; bufp[8192 + tt * 64 + lane] = kk * a;
                if ((lane >> 3) == rg) bufp[10240 + tt * 8 + (lane & 7)] = vl; }
        };
        issue(0, ra); process(0, ra); issue(1, ra);
        RW_BAR();
        for (int ch = 0; ch < NCH; ++ch) {
            if (ch + 1 < NCH) { process(ch + 1, ra); if (ch + 2 < NCH) issue(ch + 2, ra); }
            if (ch > 0 && lw < 2) { const float* yi = ysh + ((ch - 1) & 1) * 256; const int t2 = lw * 64 + lane, tt = t2 >> 2, pr = (t2 & 3) * 2;
                *(unsigned*)(Y + (rb + (ch - 1) * RW_T + tt) * DM + hh * 64 + rg * 8 + pr) = pack2(yi[tt * 8 + pr], yi[tt * 8 + pr + 1]); }
            RW_BAR();
        }
        if (lw < 2) { const float* yi = ysh + ((NCH - 1) & 1) * 256; const int t2 = lw * 64 + lane, tt = t2 >> 2, pr = (t2 & 3) * 2;
          *(unsigned*)(Y + (rb + (NCH - 1) * RW_T + tt) * DM + hh * 64 + rg * 8 + pr) = pack2(yi[tt * 8 + pr], yi[tt * 8 + pr + 1]); }
    }
    __syncthreads();
}
DI void phase_l1_mix(const Params& p, unsigned char* smem, int pass) {
    unsigned* ctr = (unsigned*)(p.ws + O_CTL) + pass * 4; int* sh = (int*)(smem + 90112);
    if (obid() < 128 && pass != 2) rwkv_unit(p, smem, obid() >> 3, obid() & 7);
    for (;;) {
        __syncthreads(); if (otid() == 0) *sh = (int)atomicAdd(ctr, 1u); __syncthreads();
        const int u = *sh; if (u >= 1024) break;
        fox_unit(p, smem, u & 15, 63 - (u >> 4));
    }
}
DI void phase_rwkv_fin(const Params& p) {
    const bf16_t* H = (const bf16_t*)(p.ws + O_H); const bf16_t* LW = (const bf16_t*)(p.ws + O_LW); bf16_t* Y = (bf16_t*)(p.ws + O_XN);
    const int lane = otid() & 63, wv = otid() >> 6;
#pragma unroll 4
    for (int task = obid() * 8 + wv; task < TOK * 8; task += gridDim.x * 8) {
        const int r = task >> 3, hh = task & 7, t = r & (SEQ - 1), col = hh * 64 + lane; const bf16_t* hp = H + (size_t)r * HS;
        const float y = bf2f(Y[(size_t)r * DM + col]); const float mean = red64(y) * (1.f / 64.f); const float dy = y - mean; const float var = red64(dy * dy) * (1.f / 64.f);
        const float yln = dy * rsqrtf(var + 64e-5f) * p.od_ln_w[col] + p.od_ln_b[col];
        const bf16_t* hq = t > 0 ? hp - HS : hp; const float pm = t > 0 ? 1.f : 0.f;
        const float rc = bf2f(hp[col]), kc = bf2f(hp[512 + col]), vc = bf2f(hp[1024 + col]); const float rp = bf2f(hq[col]) * pm, kp = bf2f(hq[512 + col]) * pm, vp = bf2f(hq[1024 + col]) * pm;
        const float rl = rc + (rp - rc) * p.od_mu[col], kl = kc + (kp - kc) * p.od_mu[512 + col], vl = vc + (vp - vc) * p.od_mu[1024 + col];
        const float a = bf2f(LW[(size_t)r * 1536 + 512 + col]), g = bf2f(LW[(size_t)r * 1536 + 1024 + col]);
        const float kt = kl * (1.f + (a - 1.f) * p.od_k_a[col]); const float bonus = red64(rl * kt * p.od_r_k[col]) * vl;
        Y[(size_t)r * DM + col] = f2bf((yln + bonus) * g);
    }
}
#define XB_TMO      128
#define XB_XCNT(j)  (256  + 64 * (j))
#define XB_XSUB(j)  (1280 + 64 * (j))
#define XB_XGEN(j)  (2304 + 64 * (j))
#define XB_TOP      3328
#define XB_TOPGEN   3392
#define XCD_BAR_WORDS 3456
#define XB_SPIN_CAP (1u << 18)
#define LAS __attribute__((address_space(3)))

__device__ __forceinline__ unsigned xb_ld(unsigned* p)              { return __hip_atomic_load(p, __ATOMIC_RELAXED, __HIP_MEMORY_SCOPE_AGENT); }
__device__ __forceinline__ unsigned xb_add(unsigned* p, unsigned v) { return __hip_atomic_fetch_add(p, v, __ATOMIC_RELAXED, __HIP_MEMORY_SCOPE_AGENT); }
__device__ __forceinline__ unsigned xb_xcc_id() { return (unsigned)__builtin_amdgcn_s_getreg((3 << 11) | 20) & 0xFu; }
#define XB_SPIN(cond, bar) do { unsigned _sp = 0; while (cond) { __builtin_amdgcn_s_sleep(1); \
    if ((++_sp & 255u) == 0u) { if (xb_ld(&(bar)[XB_TMO])) break; if (_sp > XB_SPIN_CAP) { atomicAdd(&(bar)[XB_TMO], 1u); break; } } } } while (0)

struct XcdBarrier {
    unsigned* bar; unsigned x;
    volatile LAS unsigned* st;
};

__device__ __forceinline__ XcdBarrier xcd_barrier_post(unsigned* bar, volatile LAS unsigned* st) {
    XcdBarrier b; b.bar = bar; b.x = xb_xcc_id(); b.st = st;
    if (threadIdx.x == 0) (void)xb_add(&bar[XB_XCNT(b.x)], 1u);
    return b;
}
__device__ __forceinline__ void xcd_barrier_complete(unsigned* bar, unsigned x, unsigned& nloc, unsigned& nx) {
    const unsigned G = gridDim.x * gridDim.y * gridDim.z;
    unsigned sum, cnt, mine, sp = 0u;
    for (;;) {
        sum = 0u; cnt = 0u; mine = 0u;
#pragma unroll
        for (unsigned j = 0; j < 16; ++j) { const unsigned c = xb_ld(&bar[XB_XCNT(j)]); sum += c; cnt += (c > 0u) ? 1u : 0u; mine = (j == x) ? c : mine; }
        if (sum == G) break;
        __builtin_amdgcn_s_sleep(1);
        if ((++sp & 255u) == 0u) { if (xb_ld(&bar[XB_TMO])) break; if (sp > XB_SPIN_CAP) { atomicAdd(&bar[XB_TMO], 1u); break; } }
    }
    nloc = mine > 0u ? mine : 1u; nx = cnt > 0u ? cnt : 1u;
}

__device__ __forceinline__ void xcd_barrier(const XcdBarrier& b) {
    asm volatile("s_waitcnt vmcnt(0)" ::: "memory");
    __syncthreads();
    if (threadIdx.x == 0) {
        unsigned* bar = b.bar;
        __builtin_amdgcn_s_waitcnt(0);
        unsigned nloc = b.st[0], nx = b.st[1];
        if (nloc == 0u) { xcd_barrier_complete(bar, b.x, nloc, nx); b.st[0] = nloc; b.st[1] = nx; }
        const unsigned old = xb_add(&bar[XB_XSUB(b.x)], 1u);
        const unsigned gen = old / nloc;
        if (old + 1u == (gen + 1u) * nloc) {
            __builtin_amdgcn_fence(__ATOMIC_RELEASE, "agent");
            asm volatile("s_waitcnt vmcnt(0)" ::: "memory");
            const unsigned og = xb_add(&bar[XB_TOP], 1u);
            const unsigned tg = og / nx;
            if (og + 1u == (tg + 1u) * nx) xb_add(&bar[XB_TOPGEN], 1u);
            else XB_SPIN(xb_ld(&bar[XB_TOPGEN]) == tg, bar);
            __builtin_amdgcn_fence(__ATOMIC_ACQUIRE, "agent");
            xb_add(&bar[XB_XGEN(b.x)], 1u);
            asm volatile("s_waitcnt vmcnt(0)" ::: "memory");
        } else {
            XB_SPIN(xb_ld(&bar[XB_XGEN(b.x)]) == gen, bar);
            __builtin_amdgcn_fence(__ATOMIC_ACQUIRE, "agent");
            asm volatile("s_waitcnt vmcnt(0)" ::: "memory");
        }
    }
    __syncthreads();
}


__global__ void __launch_bounds__(512, 2) fwd_megakernel(Params p) {
    extern __shared__ __attribute__((aligned(16))) unsigned char smem[];
    cg::grid_group grid = cg::this_grid();
    unsigned char* ws = p.ws;
    bf16_t* XN = (bf16_t*)(ws + O_XN); bf16_t* Hb = (bf16_t*)(ws + O_H); float* aux = (float*)(ws + O_AUX);
    const bf16_t* t_in = (const bf16_t*)(ws + O_WT_IN); const bf16_t* t_out = (const bf16_t*)(ws + O_WT_OUT); const bf16_t* t_up = (const bf16_t*)(ws + O_WT_UP);
    const bf16_t* t_dn = (const bf16_t*)(ws + O_WT_DN); const bf16_t* t_lr = (const bf16_t*)(ws + O_WT_LR);
    if (blockIdx.x == 0 && threadIdx.x < 16) ((unsigned*)(ws + O_CTL))[threadIdx.x] = 0u;
    if (threadIdx.x == 0) *(uint4*)(smem + 131072) = make_uint4(0u, 0u, 0u, 0u);
    __syncthreads();
    const XcdBarrier xb = xcd_barrier_post((unsigned*)(ws + O_BAR), (volatile LAS unsigned*)(smem + 131072));
#define GSYNC() xcd_barrier(xb)
#define GEMM_H(layer) { EpiH E; E.H = Hb; E.aux = aux; E.auxc = layer ? 3328 : 1280; run_gemm(smem, XN, t_in, 3584, 1024, E); }
#define GEMM_OUT(layer) { EpiRes E; E.res = layer ? p.out : p.x; E.out = p.out; run_gemm(smem, XN, t_out, 1024, 1024, E); }
#define GEMM_UP(layer) { EpiGU E; E.GC = (bf16_t*)(ws + O_G); E.U = (bf16_t*)(ws + O_U); E.cw = p.ffn_conv_w + (size_t)(layer) * 3 * DFF; E.cb = p.ffn_conv_b + (size_t)(layer) * DFF; run_gemm(smem, XN, t_up, 2 * DFF, 1024, E); }
#define GEMM_DN() { EpiRes E; E.res = p.out; E.out = p.out; run_gemm(smem, (const bf16_t*)(ws + O_U), t_dn, 1024, DFF, E); }
    phase_weights(p, smem, 0, 0); phase_rmsnorm(p.x, p.ev_norm_w, XN);
    if (p.ws == nullptr) grid.sync();
    GSYNC();
    GEMM_H(0) phase_weights(p, smem, 0, 1); GSYNC();
#if PROBE == 2
    GEMM_H(0) GSYNC();
#endif
    phase_m1(p, smem); GSYNC();
#if PROBE == 3
    phase_m1(p, smem); GSYNC();
#endif
    phase_m2(p); GSYNC();
#if PROBE == 6
    GSYNC(); GSYNC(); GSYNC(); GSYNC(); GSYNC(); GSYNC(); GSYNC(); GSYNC(); GSYNC(); GSYNC();
#endif
#if PROBE == 7
    phase_weights(p, smem, 0, 0); GSYNC(); phase_rmsnorm(p.x, p.ev_norm_w, XN); GSYNC(); phase_rmsnorm(p.x, p.ev_norm_w, XN); GSYNC();
#endif
    phase_m3(p, smem); GSYNC();
#if PROBE == 3
    phase_m3(p, smem); GSYNC();
#endif
    GEMM_OUT(0) GSYNC();
#if PROBE == 2
    GEMM_OUT(0) GSYNC();
#endif
    phase_rmsnorm(p.out, p.ffn_norm_w, XN); GSYNC();
    GEMM_UP(0) phase_weights(p, smem, 0, 2); phase_weights(p, smem, 1, 0, 128); GSYNC();
    phase_ffn_fix(p, 0); GSYNC();
    GEMM_DN() GSYNC();
    phase_rmsnorm(p.out, p.od_norm_w, XN); GSYNC();
    GEMM_H(1) phase_weights(p, smem, 1, 1); GSYNC();
    phase_l1_prep(p, smem); GSYNC();
    { EpiLR E; E.LW = (bf16_t*)(ws + O_LW); E.w0 = p.od_w0; E.a0 = p.od_a0; run_gemm(smem, (const bf16_t*)(ws + O_AP), t_lr, 1536, 256, E); } GSYNC();
    phase_l1_mix(p, smem, 0); GSYNC();
#if PROBE == 4
    phase_l1_mix(p, smem, 1); GSYNC();
#endif
#if PROBE == 5
    phase_l1_mix(p, smem, 2); GSYNC();
#endif
    phase_rwkv_fin(p); GSYNC();
    GEMM_OUT(1) GSYNC();
    phase_rmsnorm(p.out, p.ffn_norm_w + DM, XN); GSYNC();
    GEMM_UP(1) phase_weights(p, smem, 1, 2); GSYNC();
    phase_ffn_fix(p, 1); GSYNC();
    GEMM_DN()
}

extern "C" void kernel_launch(void* const* d_in, const int* in_sizes, int n_in, void* d_out, int out_size, void* d_ws, size_t ws_size, hipStream_t stream) {
    static int grid_blocks = 0;
    if (grid_blocks == 0) {
        int dev = 0, cus = 0, per_cu = 0;
        hipGetDevice(&dev); hipDeviceGetAttribute(&cus, hipDeviceAttributeMultiprocessorCount, dev);
        if (hipFuncSetAttribute((const void*)fwd_megakernel, hipFuncAttributeMaxDynamicSharedMemorySize, LDS_BYTES) != hipSuccess) fprintf(stderr, "hipFuncSetAttribute failed\n");
        hipOccupancyMaxActiveBlocksPerMultiprocessor(&per_cu, (const void*)fwd_megakernel, 512, LDS_BYTES);
        (void)hipGetLastError();
        if (per_cu < 1) fprintf(stderr, "occupancy query says %d blocks per CU\n", per_cu);
        grid_blocks = cus > 0 ? cus : 256;
        if (ws_size < WS_NEED) fprintf(stderr, "workspace too small: %zu < %zu\n", ws_size, (size_t)WS_NEED);
    }
    Params p{};
    const float** pp = (const float**)&p;
    for (int i = 0; i < 33; ++i) pp[i] = (const float*)d_in[i];
    p.out = (float*)d_out; p.ws = (unsigned char*)d_ws;
    (void)hipMemsetAsync((char*)d_ws + O_BAR, 0, 16384, stream);
    void* args[] = {&p};
    hipError_t e = hipLaunchCooperativeKernel((const void*)fwd_megakernel, dim3(grid_blocks), dim3(512), args, LDS_BYTES, stream);
    if (e != hipSuccess) fprintf(stderr, "cooperative launch failed: %s (grid %d)\n", hipGetErrorString(e), grid_blocks);
}
```

```cpp
#include <hip/hip_runtime.h>
#include <hip/hip_cooperative_groups.h>
#include <cstdio>
#ifndef PROBE
#define PROBE 0
#endif
namespace cg = cooperative_groups;
namespace pg8 {
#define PG8_LAS __attribute__((address_space(3)))
typedef unsigned short bf16_t;
typedef short bf16x8 __attribute__((ext_vector_type(8)));
typedef float f32x4 __attribute__((ext_vector_type(4)));
typedef unsigned u32x4 __attribute__((ext_vector_type(4)));
constexpr int BM = 256, BK = 64, HALF = 128, HTB = HALF * BK * 2  , STAGE_BYTES = 8 * HTB, NXCD = 8, WGM = 8;

__host__ __device__ __forceinline__ int lds_byte(int r, int c) { const int st = (r >> 4) * 2 + (c >> 5), rr = r & 15, cc = c & 31, ob = rr * 64 + cc * 2; return st * 1024 + (ob ^ (((ob >> 9) & 1) << 5)); }
__host__ __device__ __forceinline__ void stage_rc(int b, int& R, int& C) { const int st = b / 1024, sb = b % 1024, swz = sb ^ (((sb >> 9) & 1) << 5); R = (st >> 1) * 16 + swz / 64; C = (st & 1) * 32 + (swz % 64) / 2; }
__host__ __device__ __forceinline__ int perm32(int rho) { const int n = rho >> 4, i = rho & 15; return 8 * (i >> 2) + 4 * n + (i & 3); }

struct Unit { int pm, pn; };
struct Gemm { const bf16_t* A; const bf16_t* Bt; int M, N, K; };

struct StaticOrder {
    int nM, nN, nwg, G, c;
    __host__ __device__ void init(int M, int N, int G_, int c_) { nM = M / BM; nN = N / BM; nwg = nM * nN; G = G_; c = c_; }
    __host__ __device__ bool next(int i, Unit& u) const {
        const long L = (long)i * G + c; if (L >= nwg) return false;
        int wgid = (int)L; { const int q = nwg / NXCD, r = nwg % NXCD, xcd = wgid % NXCD, off = wgid / NXCD; wgid = (xcd < r ? xcd * (q + 1) : r * (q + 1) + (xcd - r) * q) + off; }
        const int nig = WGM * nN, gid = wgid / nig, fm = gid * WGM, gsz = (nM - fm) < WGM ? (nM - fm) : WGM;
        u.pm = fm + ((wgid % nig) % gsz); u.pn = (wgid % nig) / gsz; return true;
    }
    __device__ __forceinline__ void a_ready(const Unit&) const {}
    __device__ __forceinline__ void done(const Unit&) const {}
};
__device__ __forceinline__ unsigned cvt_pk_bf16(float lo, float hi) { unsigned r; asm volatile("v_cvt_pk_bf16_f32 %0, %1, %2" : "=v"(r) : "v"(lo), "v"(hi)); return r; }

template <class Epi, class Sched, bool STAMP = false>
__device__ __forceinline__ void gemm_phase(PG8_LAS unsigned char* lds, const Gemm g, const Sched& S, const Epi& E, unsigned long long* stamps) {
    int tid_ = threadIdx.x; asm volatile("" : "+v"(tid_)); const int tid = tid_, wid = __builtin_amdgcn_readfirstlane(tid >> 6), lane = tid & 63, wr = wid >> 2, wc = wid & 3, fr = lane & 15, fq = lane >> 4;
    const int K = g.K, nt = K / BK;
    int ts_lo = 0, ts_hi = 0, nts = 0; const unsigned long long rt_entry = STAMP ? (unsigned long long)wall_clock64() : 0ull;
#define PG8_STAMP() do { if (STAMP && wid == 0 && nts < 64) { const unsigned long long _c = (unsigned long long)clock64(); \
        ts_lo = (lane == nts) ? (int)(unsigned)_c : ts_lo; ts_hi = (lane == nts) ? (int)(unsigned)(_c >> 32) : ts_hi; ++nts; } } while (0)
    PG8_STAMP();
    unsigned voffA[2], voffB[2];
#pragma unroll
    for (int i = 0; i < 2; ++i) { int R, C; stage_rc(tid * 16 + i * 8192, R, C); const int Rb = Epi::PERM ? ((R & ~31) + perm32(R & 31)) : R;
        voffA[i] = (unsigned)(R * K + C) * 2u; voffB[i] = (unsigned)(Rb * K + C) * 2u; }
    const size_t kstep = (size_t)(BK * 2);
    const size_t hstep = (size_t)HALF * K * 2;
    const size_t tstep = 2 * hstep;
    const unsigned ldsw = (unsigned)wid * 1024u;
    const int aoff = lds_byte(wr * 64 + fr, fq * 8), boff = lds_byte(wc * 32 + fr, fq * 8);
#define PG8_SA(b, h) (((b) * 2 + (h)) * HTB)
#define PG8_SB(b, h) ((4 + (b) * 2 + (h)) * HTB)
#define PG8_STAGE(bufoff, gbase, voff) do { _Pragma("unroll") for (int _i = 0; _i < 2; ++_i) \
        __builtin_amdgcn_global_load_lds((const unsigned*)((const char*)(gbase) + (voff)[_i]), (PG8_LAS unsigned*)(lds + (bufoff) + ldsw + _i * 8192), 16, 0, 0); } while (0)
#define PG8_LDA(dst, b, h) do { _Pragma("unroll") for (int m = 0; m < 4; ++m) _Pragma("unroll") for (int k = 0; k < 2; ++k) dst[m][k] = *(const PG8_LAS bf16x8*)(lds + PG8_SA(b, h) + aoff + m * 2048 + k * 1024); } while (0)
#define PG8_LDB(dst, b, h) do { _Pragma("unroll") for (int n = 0; n < 2; ++n) _Pragma("unroll") for (int k = 0; k < 2; ++k) dst[n][k] = *(const PG8_LAS bf16x8*)(lds + PG8_SB(b, h) + boff + n * 2048 + k * 1024); } while (0)
#define PG8_MMA(ai, bj, At, Bt) do { __builtin_amdgcn_s_setprio(1); _Pragma("unroll") for (int m = 0; m < 4; ++m) _Pragma("unroll") for (int n = 0; n < 2; ++n) _Pragma("unroll") for (int k = 0; k < 2; ++k) \
        acc[ai][bj][m][n] = __builtin_amdgcn_mfma_f32_16x16x32_bf16(Bt[n][k], At[m][k], acc[ai][bj][m][n], 0, 0, 0); __builtin_amdgcn_s_setprio(0); } while (0)
#define PG8_WAIT_V(n) asm volatile("s_waitcnt vmcnt(" #n ")" ::: "memory")
#define PG8_WAIT_L(n) asm volatile("s_waitcnt lgkmcnt(" #n ")" ::: "memory")
#define PG8_BAR __builtin_amdgcn_s_barrier()
#define PG8_SCHED __builtin_amdgcn_sched_barrier(0)
    Unit cur, nxt; int ui = 0;
    if (!S.next(0, cur)) return;
    f32x4 acc[2][2][4][2];
#pragma unroll
    for (int a = 0; a < 2; ++a)
#pragma unroll
        for (int b = 0; b < 2; ++b)
#pragma unroll
            for (int m = 0; m < 4; ++m)
#pragma unroll
                for (int n = 0; n < 2; ++n) acc[a][b][m][n] = (f32x4){0.f, 0.f, 0.f, 0.f};
    bf16x8 At[4][2], B0[2][2], B1[2][2];
    const char* cA = (const char*)g.A + (size_t)cur.pm * tstep; const char* cB = (const char*)g.Bt + (size_t)cur.pn * tstep;
    S.a_ready(cur);
    PG8_STAGE(PG8_SB(0, 0), cB, voffB); PG8_STAGE(PG8_SA(0, 0), cA, voffA); PG8_STAGE(PG8_SB(0, 1), cB + hstep, voffB); PG8_STAGE(PG8_SA(0, 1), cA + hstep, voffA);
    if (wr == 1) PG8_BAR;
    PG8_WAIT_V(4); PG8_BAR;
    PG8_STAGE(PG8_SB(1, 0), cB + kstep, voffB); PG8_STAGE(PG8_SA(1, 0), cA + kstep, voffA); PG8_STAGE(PG8_SB(1, 1), cB + hstep + kstep, voffB);
    PG8_WAIT_V(6); PG8_BAR;
    PG8_STAMP();
    for (;;) {
        const bool has_next = S.next(ui + 1, nxt);
        const char* nA = has_next ? (const char*)g.A + (size_t)nxt.pm * tstep : cA; const char* nB = has_next ? (const char*)g.Bt + (size_t)nxt.pn * tstep : cB;
        for (int t = 0; t < nt; t += 2) {
            const bool last = (t == nt - 2);
            const char* a1 = cA + (size_t)(t + 1) * kstep;
            const char* a2 = last ? nA : cA + (size_t)(t + 2) * kstep; const char* b2 = last ? nB : cB + (size_t)(t + 2) * kstep;
            const char* a3 = a2 + kstep; const char* b3 = b2 + kstep;
            if (last && has_next) S.a_ready(nxt);
            PG8_LDB(B0, 0, 0); PG8_SCHED; PG8_LDA(At, 0, 0); PG8_STAGE(PG8_SA(1, 1), a1 + hstep, voffA);
            PG8_WAIT_L(8); PG8_BAR; PG8_WAIT_L(0); PG8_MMA(0, 0, At, B0); PG8_BAR; PG8_SCHED;
            PG8_LDB(B1, 0, 1); PG8_STAGE(PG8_SB(0, 0), b2, voffB);
            PG8_BAR; PG8_WAIT_L(0); PG8_MMA(0, 1, At, B1); PG8_BAR;
            PG8_LDA(At, 0, 1); PG8_STAGE(PG8_SA(0, 0), a2, voffA);
            PG8_BAR; PG8_WAIT_L(0); PG8_MMA(1, 0, At, B0); PG8_BAR; PG8_SCHED;
            PG8_STAGE(PG8_SB(0, 1), b2 + hstep, voffB);
            PG8_WAIT_V(6); PG8_BAR; PG8_MMA(1, 1, At, B1); PG8_BAR;
            PG8_LDB(B0, 1, 0); PG8_SCHED; PG8_LDA(At, 1, 0); PG8_STAGE(PG8_SA(0, 1), a2 + hstep, voffA);
            PG8_WAIT_L(8); PG8_BAR; PG8_WAIT_L(0); PG8_MMA(0, 0, At, B0); PG8_BAR; PG8_SCHED;
            PG8_LDB(B1, 1, 1); PG8_STAGE(PG8_SB(1, 0), b3, voffB);
            PG8_BAR; PG8_WAIT_L(0); PG8_MMA(0, 1, At, B1); PG8_BAR;
            PG8_LDA(At, 1, 1); PG8_STAGE(PG8_SA(1, 0), a3, voffA);
            PG8_BAR; PG8_WAIT_L(0); PG8_MMA(1, 0, At, B0); PG8_BAR; PG8_SCHED;
            PG8_STAGE(PG8_SB(1, 1), b3 + hstep, voffB);
            PG8_WAIT_V(6); PG8_BAR; PG8_MMA(1, 1, At, B1); PG8_BAR;
        }
        PG8_STAMP();
        if constexpr (!Epi::AFTER_DRAIN) { E(acc, cur, wr, wc, fr, fq); S.done(cur); }
        PG8_STAMP();
        if (!has_next) break;
#pragma unroll
        for (int a = 0; a < 2; ++a)
#pragma unroll
            for (int b = 0; b < 2; ++b)
#pragma unroll
                for (int m = 0; m < 4; ++m)
#pragma unroll
                    for (int n = 0; n < 2; ++n) acc[a][b][m][n] = (f32x4){0.f, 0.f, 0.f, 0.f};
        cur = nxt; cA = nA; cB = nB; ++ui;
    }
    PG8_WAIT_V(0);
    if (wr == 0) PG8_BAR;
    PG8_BAR;
    if constexpr (Epi::AFTER_DRAIN) { E.fused(acc, cur, wr, wc, fr, fq, lds, wid, lane); S.done(cur); }
    PG8_STAMP();
    if (STAMP && wid == 0) { stamps[lane] = lane < nts ? (((unsigned long long)(unsigned)ts_hi << 32) | (unsigned)ts_lo) : 0ull;
        if (lane == 62) stamps[62] = rt_entry; if (lane == 63) stamps[63] = (unsigned long long)wall_clock64(); }
#undef PG8_STAMP
#undef PG8_SA
#undef PG8_SB
#undef PG8_STAGE
#undef PG8_LDA
#undef PG8_LDB
#undef PG8_MMA
#undef PG8_WAIT_V
#undef PG8_WAIT_L
#undef PG8_BAR
#undef PG8_SCHED
}
}

using pg8::bf16_t; using pg8::bf16x8; using pg8::f32x4; using pg8::Unit; using pg8::cvt_pk_bf16;
#define DI __device__ __forceinline__
constexpr int TOK = 16384, SEQ = 8192, DM = 1024, HS = 3336, DFF = 2816;
constexpr size_t O_CTL = 0, O_CD = 256, O_AUX = 4352, O_ROPE = 528640, O_FC = 2625792, O_WT = 3150080;
constexpr size_t O_WT_IN = O_WT, O_WT_OUT = O_WT_IN + 7340032, O_WT_UP = O_WT_OUT + 2097152, O_WT_DN = O_WT_UP + 11534336, O_WT_LR = O_WT_DN + 5767168;
constexpr size_t O_XN = O_WT + 27525120, O_R1 = O_XN + 33554432;
constexpr size_t O_H = O_R1, O_ST = O_R1 + 109314048, O_YG = O_ST + 33554432;
constexpr size_t O_G = O_R1, O_U = O_R1 + 92274688;
constexpr size_t O_LW = O_R1 + 109314048, O_KN = O_LW + 50331648, O_VT = O_KN + 16777216, O_AP = O_VT + 16777216;
constexpr size_t O_KNRM = O_AP + 8388608;
constexpr size_t O_BAR = O_KNRM + 524288;
constexpr size_t WS_NEED = O_BAR + 16384;
constexpr int LDS_BYTES = 131072 + 256;

struct Params {
    const float* x; const float* ev_norm_w; const float* ev_w_in; const float* ev_conv_w; const float* ev_conv_b; const float* ev_dt_bias; const float* ev_a_log;
    const float* ev_d; const float* ev_ssd_norm_w; const float* ev_ret_norm_w; const float* ev_w_out;
    const float* od_norm_w; const float* od_w_in; const float* od_mu; const float* od_w0; const float* od_w_up; const float* od_a0; const float* od_a_up;
    const float* od_g_up; const float* od_k_k; const float* od_k_a; const float* od_r_k; const float* od_ln_w; const float* od_ln_b;
    const float* od_qn_w; const float* od_kn_w; const float* od_f_bias; const float* od_w_out;
    const float* ffn_norm_w; const float* ffn_w_up; const float* ffn_conv_w; const float* ffn_conv_b; const float* ffn_w_down;
    float* out; unsigned char* ws;
};

DI unsigned cvtpk(float lo, float hi) { unsigned r; asm("v_cvt_pk_bf16_f32 %0, %1, %2" : "=v"(r) : "v"(lo), "v"(hi)); return r; }
DI unsigned short f2bf(float f) { return (unsigned short)(cvtpk(f, f) & 0xffffu); }
DI float bf2f(unsigned short b) { return __uint_as_float(((unsigned)b) << 16); }
DI unsigned pack2(float lo, float hi) { return cvtpk(lo, hi); }
DI float bflo(unsigned w) { return __uint_as_float(w << 16); }
DI float bfhi(unsigned w) { return __uint_as_float(w & 0xffff0000u); }
DI void unpack8(const uint4 r, float (&o)[8]) { o[0] = bflo(r.x); o[1] = bfhi(r.x); o[2] = bflo(r.y); o[3] = bfhi(r.y); o[4] = bflo(r.z); o[5] = bfhi(r.z); o[6] = bflo(r.w); o[7] = bfhi(r.w); }
DI uint4 pack8(const float (&o)[8]) { uint4 r; r.x = pack2(o[0], o[1]); r.y = pack2(o[2], o[3]); r.z = pack2(o[4], o[5]); r.w = pack2(o[6], o[7]); return r; }
DI float silu_(float x) { return x * __builtin_amdgcn_rcpf(1.f + __expf(-x)); }
DI float sigm_(float x) { return __builtin_amdgcn_rcpf(1.f + __expf(-x)); }
DI float softplus_(float x) { return fmaxf(x, 0.f) + log1pf(__expf(-fabsf(x))); }
DI bf16x8 ldfrag(const bf16_t* base, int row0, int ld, int k0, int lane) { return *(const bf16x8*)(base + (row0 + (lane & 15)) * ld + k0 + (lane >> 4) * 8); }
#define MFMA16(a, b, c) __builtin_amdgcn_mfma_f32_16x16x32_bf16((a), (b), (c), 0, 0, 0)
DI float red16(float v) { v += __shfl_xor(v, 1); v += __shfl_xor(v, 2); v += __shfl_xor(v, 4); v += __shfl_xor(v, 8); return v; }
DI float max16(float v) { v = fmaxf(v, __shfl_xor(v, 1)); v = fmaxf(v, __shfl_xor(v, 2)); v = fmaxf(v, __shfl_xor(v, 4)); v = fmaxf(v, __shfl_xor(v, 8)); return v; }
DI float red64(float v) { v += __shfl_xor(v, 32); v += __shfl_xor(v, 16); return red16(v); }
DI float dpp_red16(float x) {
    x += __builtin_bit_cast(float, __builtin_amdgcn_update_dpp(0, __builtin_bit_cast(int, x), 0xB1, 0xF, 0xF, true));
    x += __builtin_bit_cast(float, __builtin_amdgcn_update_dpp(0, __builtin_bit_cast(int, x), 0x4E, 0xF, 0xF, true));
    x += __builtin_bit_cast(float, __builtin_amdgcn_update_dpp(0, __builtin_bit_cast(int, x), 0x141, 0xF, 0xF, true));
    x += __builtin_bit_cast(float, __builtin_amdgcn_update_dpp(0, __builtin_bit_cast(int, x), 0x140, 0xF, 0xF, true));
    return x;
}

DI int otid() { int t = threadIdx.x; asm volatile("" : "+v"(t)); return t; }
DI int obid() { int b = blockIdx.x; asm volatile("" : "+s"(b)); return b; }
struct EpiH {
    static constexpr bool PERM = false, AFTER_DRAIN = false;
    bf16_t* H; float* aux; int auxc;
    DI void operator()(const f32x4 (&acc)[2][2][4][2], const Unit& u, int wr, int wc, int fr, int fq) const {
        const int row0 = u.pm * 256 + wr * 64 + fr, col0 = u.pn * 256 + wc * 32 + 4 * fq;
#pragma unroll
        for (int ai = 0; ai < 2; ++ai)
#pragma unroll
            for (int m = 0; m < 4; ++m) { const size_t r = (size_t)(row0 + ai * 128 + m * 16);
#pragma unroll
                for (int bj = 0; bj < 2; ++bj)
#pragma unroll
                    for (int n = 0; n < 2; ++n) { const int c = col0 + bj * 128 + n * 16; const f32x4 v = acc[ai][bj][m][n];
                        if (c < HS) { uint2 w; w.x = cvt_pk_bf16(v[0], v[1]); w.y = cvt_pk_bf16(v[2], v[3]); *(uint2*)(H + r * HS + c) = w;
                            if (c == auxc || c == auxc + 4) *(f32x4*)(aux + r * 8 + (c - auxc)) = v; } } }
    }
};
struct EpiRes {
    static constexpr bool PERM = false, AFTER_DRAIN = false;
    const float* res; float* out;
    DI void operator()(const f32x4 (&acc)[2][2][4][2], const Unit& u, int wr, int wc, int fr, int fq) const {
        const int row0 = u.pm * 256 + wr * 64 + fr, col0 = u.pn * 256 + wc * 32 + 4 * fq;
#pragma unroll
        for (int ai = 0; ai < 2; ++ai)
#pragma unroll
            for (int m = 0; m < 4; ++m) { const size_t r = (size_t)(row0 + ai * 128 + m * 16);
#pragma unroll
                for (int bj = 0; bj < 2; ++bj)
#pragma unroll
                    for (int n = 0; n < 2; ++n) { const int c = col0 + bj * 128 + n * 16;
                        const f32x4 rv = *(const f32x4*)(res + r * DM + c); *(f32x4*)(out + r * DM + c) = rv + acc[ai][bj][m][n]; } }
    }
};
DI float gu_ror1(float x) { float r; asm volatile("s_nop 1\n\tv_mov_b32_dpp %0, %1 row_ror:1 row_mask:0xf bank_mask:0xf bound_ctrl:1" : "=v"(r) : "v"(x)); return r; }
DI float gu_ror2(float x) { float r; asm volatile("s_nop 1\n\tv_mov_b32_dpp %0, %1 row_ror:2 row_mask:0xf bank_mask:0xf bound_ctrl:1" : "=v"(r) : "v"(x)); return r; }
struct EpiGU {
    static constexpr bool PERM = false, AFTER_DRAIN = false;
    bf16_t* GC; bf16_t* U; const float* cw; const float* cb;
    DI void operator()(const f32x4 (&acc)[2][2][4][2], const Unit& u, int wr, int wc, int fr, int fq) const {
        const int row0 = u.pm * 256 + wr * 64 + fr, col0 = u.pn * 128 + wc * 32 + 4 * fq;
#define GU_ROR(x, n) gu_ror##n(x)
#pragma unroll
        for (int n = 0; n < 2; ++n) { const int c = col0 + n * 16;
            const f32x4 w0 = *(const f32x4*)(cw + c), w1 = *(const f32x4*)(cw + DFF + c), w2 = *(const f32x4*)(cw + 2 * DFF + c), bb = *(const f32x4*)(cb + c);
#pragma unroll
            for (int ai = 0; ai < 2; ++ai)
#pragma unroll
                for (int m = 0; m < 4; ++m) { const size_t r = (size_t)(row0 + ai * 128 + m * 16); const size_t slab = r >> 6;
                    const f32x4 g = acc[ai][0][m][n], v = acc[ai][1][m][n]; const f32x4 gp = acc[ai][0][m > 0 ? m - 1 : 0][n];
                    f32x4 o;
#pragma unroll
                    for (int j = 0; j < 4; ++j) {
                        const float g1 = GU_ROR(fr == 15 ? gp[j] : g[j], 1), g2 = GU_ROR(fr >= 14 ? gp[j] : g[j], 2);
                        const float a = bb[j] + w0[j] * g2 + w1[j] * g1 + w2[j] * g[j]; o[j] = silu_(a) * v[j]; }
                    const bool defer = (m == 0) && (fr < 2);
                    uint2 w;
                    w.x = cvt_pk_bf16(defer ? v[0] : o[0], defer ? v[1] : o[1]); w.y = cvt_pk_bf16(defer ? v[2] : o[2], defer ? v[3] : o[3]);
                    *(uint2*)(U + r * DFF + c) = w;
                    if (defer || (m == 3 && fr >= 14)) { const int slot = defer ? 2 + fr : fr - 14; uint2 gw; gw.x = cvt_pk_bf16(g[0], g[1]); gw.y = cvt_pk_bf16(g[2], g[3]);
                        *(uint2*)(GC + (slab * 4 + slot) * DFF + c) = gw; } }
        }
#undef GU_ROR
    }
};
struct EpiLR {
    static constexpr bool PERM = false, AFTER_DRAIN = false;
    bf16_t* LW; const float* w0; const float* a0;
    DI void operator()(const f32x4 (&acc)[2][2][4][2], const Unit& u, int wr, int wc, int fr, int fq) const {
        const int row0 = u.pm * 256 + wr * 64 + fr, col0 = u.pn * 256 + wc * 32 + 4 * fq;
#pragma unroll
        for (int ai = 0; ai < 2; ++ai)
#pragma unroll
            for (int m = 0; m < 4; ++m) { const size_t r = (size_t)(row0 + ai * 128 + m * 16);
#pragma unroll
                for (int bj = 0; bj < 2; ++bj)
#pragma unroll
                    for (int n = 0; n < 2; ++n) { const int c = col0 + bj * 128 + n * 16; f32x4 v = acc[ai][bj][m][n];
                        if (c < 512) { const f32x4 b = *(const f32x4*)(w0 + c);
#pragma unroll
                            for (int j = 0; j < 4; ++j) v[j] = 1.f - __expf(-0.606531f * sigm_(b[j] + v[j])); }
                        else if (c < 1024) { const f32x4 b = *(const f32x4*)(a0 + c - 512);
#pragma unroll
                            for (int j = 0; j < 4; ++j) v[j] = sigm_(b[j] + v[j]); }
                        uint2 w; w.x = cvt_pk_bf16(v[0], v[1]); w.y = cvt_pk_bf16(v[2], v[3]); *(uint2*)(LW + r * 1536 + c) = w; } }
    }
};
template <class Epi> DI void run_gemm(unsigned char* smem, const bf16_t* A, const bf16_t* Bt, int N, int K, const Epi& E) {
    pg8::Gemm g; g.A = A; g.Bt = Bt; g.M = TOK; g.N = N; g.K = K;
    pg8::StaticOrder S; S.init(TOK, N, (int)gridDim.x, obid());
    pg8::gemm_phase<Epi, pg8::StaticOrder, false>((PG8_LAS unsigned char*)smem, g, S, E, nullptr);
}

DI void conv_tile4(const float* W, int Nsrc, int K, bf16_t* Wt, int nd0, int sc0, int nvalid, int k0, float* tile) {
    const int tid = otid(), j = tid & 63, kb = tid >> 6;
    float v[32];
#pragma unroll
    for (int i = 0; i < 32; ++i) { const int kk = kb + 8 * i; v[i] = (j < nvalid) ? W[(size_t)(k0 + kk) * Nsrc + sc0 + j] : 0.f; }
#pragma unroll
    for (int i = 0; i < 32; ++i) { const int kk = kb + 8 * i; tile[kk * 65 + j] = v[i]; }
    __syncthreads();
    const int nl = tid >> 3, ks = (tid & 7) * 8;
#pragma unroll
    for (int q = 0; q < 4; ++q) { const float* tq = tile + q * 64 * 65; uint4 o;
        o.x = pack2(tq[(ks + 0) * 65 + nl], tq[(ks + 1) * 65 + nl]); o.y = pack2(tq[(ks + 2) * 65 + nl], tq[(ks + 3) * 65 + nl]);
        o.z = pack2(tq[(ks + 4) * 65 + nl], tq[(ks + 5) * 65 + nl]); o.w = pack2(tq[(ks + 6) * 65 + nl], tq[(ks + 7) * 65 + nl]);
        *(uint4*)(Wt + (size_t)(nd0 + nl) * K + k0 + q * 64 + ks) = o; }
    __syncthreads();
}
DI void phase_weights(const Params& p, unsigned char* smem, int layer, int part, int b0 = 0) {
    float* tile = (float*)smem;
    const float* w_in = layer ? p.od_w_in : p.ev_w_in; const float* w_out = layer ? p.od_w_out : p.ev_w_out;
    const float* w_up = p.ffn_w_up + (size_t)layer * DM * 2 * DFF; const float* w_dn = p.ffn_w_down + (size_t)layer * DFF * DM;
    bf16_t* t_in = (bf16_t*)(p.ws + O_WT_IN); bf16_t* t_out = (bf16_t*)(p.ws + O_WT_OUT); bf16_t* t_up = (bf16_t*)(p.ws + O_WT_UP); bf16_t* t_dn = (bf16_t*)(p.ws + O_WT_DN);
    if (part == 0) {
        if (obid() < b0) return;
        for (int job = obid() - b0; job < 288; job += (int)gridDim.x - b0) {
            if (job < 224) { const int nt = job >> 2, kt = job & 3, nd0 = nt * 64; int nv = HS - nd0; nv = nv < 0 ? 0 : (nv > 64 ? 64 : nv);
                conv_tile4(w_in, HS, 1024, t_in, nd0, nd0, nv, kt * 256, tile); }
            else { const int j2 = job - 224, nt = j2 >> 2, kt = j2 & 3; conv_tile4(w_out, 1024, 1024, t_out, nt * 64, nt * 64, 64, kt * 256, tile); }
        }
    } else {
        const int nb = (int)gridDim.x - 128, lb = obid() - 128;
        if (lb < 0) return;
        if (part == 1) { for (int job = lb; job < 352; job += nb) { const int nt = job >> 2, kt = job & 3, nd0 = nt * 64; const int pn = nd0 >> 8, bj = (nd0 >> 7) & 1, j0 = nd0 & 127;
                conv_tile4(w_up, 2 * DFF, 1024, t_up, nd0, bj * DFF + 128 * pn + j0, 64, kt * 256, tile); } }
        else { for (int job = lb; job < 176; job += nb) { const int nt = job / 11, kt = job % 11; conv_tile4(w_dn, 1024, DFF, t_dn, nt * 64, nt * 64, 64, kt * 256, tile); } }
        return;
    }
    const int gtid = (obid() - b0) * 512 + otid(), gsz = ((int)gridDim.x - b0) * 512;
    if (layer == 0) {
        float* rc = (float*)(p.ws + O_ROPE); float* rs = rc + SEQ * 32;
        for (int idx = gtid; idx < SEQ * 32; idx += gsz) { const int pos = idx >> 5, i = idx & 31;
            const float inv = (float)exp(-(double)i * (9.210340371976184 / 32.0)); const float ang = (float)pos * inv;
            const double a = (double)ang; const double n = rint(a * 0.15915494309189535); const double r = a - n * 6.283185307179586; const double r2 = r * r;
            double sn = 1.0 / 121645100408832000.0, cs = 1.0 / 2432902008176640000.0;
            sn = sn * r2 - 1.0 / 355687428096000.0; sn = sn * r2 + 1.0 / 1307674368000.0; sn = sn * r2 - 1.0 / 6227020800.0; sn = sn * r2 + 1.0 / 39916800.0;
            sn = sn * r2 - 1.0 / 362880.0; sn = sn * r2 + 1.0 / 5040.0; sn = sn * r2 - 1.0 / 120.0; sn = sn * r2 + 1.0 / 6.0; sn = sn * r2 * -1.0 + 1.0; sn = sn * r;
            cs = cs * r2 - 1.0 / 6402373705728000.0; cs = cs * r2 + 1.0 / 20922789888000.0; cs = cs * r2 - 1.0 / 87178291200.0; cs = cs * r2 + 1.0 / 479001600.0;
            cs = cs * r2 - 1.0 / 3628800.0; cs = cs * r2 + 1.0 / 40320.0; cs = cs * r2 - 1.0 / 720.0; cs = cs * r2 + 1.0 / 24.0; cs = cs * r2 - 0.5; cs = cs * r2 + 1.0;
            rc[idx] = (float)cs; rs[idx] = (float)sn; }
    } else {
        bf16_t* t_lr = (bf16_t*)(p.ws + O_WT_LR);
        for (int idx = gtid; idx < 1536 * 256; idx += gsz) { const int n = idx >> 8, k = idx & 255; float v = 0.f;
            if (n < 512) { if (k < 64) v = p.od_w_up[k * 512 + n]; }
            else if (n < 1024) { if (k >= 64 && k < 128) v = p.od_a_up[(k - 64) * 512 + n - 512]; }
            else { if (k >= 128) v = p.od_g_up[(k - 128) * 512 + n - 1024]; }
            t_lr[idx] = f2bf(v); }
    }
}
DI void phase_rmsnorm(const float* x, const float* w, bf16_t* xn) {
    const int lane = otid() & 63, wv = otid() >> 6;
    f32x4 ww[4];
#pragma unroll
    for (int i = 0; i < 4; ++i) ww[i] = *(const f32x4*)(w + i * 256 + lane * 4);
    for (int r0 = (obid() * 8 + wv) * 4; r0 < TOK; r0 += gridDim.x * 8 * 4) {
        f32x4 v[4][4];
#pragma unroll
        for (int q = 0; q < 4; ++q)
#pragma unroll
            for (int i = 0; i < 4; ++i) v[q][i] = *(const f32x4*)(x + (size_t)(r0 + q) * DM + i * 256 + lane * 4);
#pragma unroll
        for (int q = 0; q < 4; ++q) { float ss = 0.f;
#pragma unroll
            for (int i = 0; i < 4; ++i) ss += v[q][i][0] * v[q][i][0] + v[q][i][1] * v[q][i][1] + v[q][i][2] * v[q][i][2] + v[q][i][3] * v[q][i][3];
            ss = red64(ss); const float rstd = rsqrtf(ss * (1.f / DM) + 1e-6f);
#pragma unroll
            for (int i = 0; i < 4; ++i) { uint2 o; o.x = pack2(v[q][i][0] * rstd * ww[i][0], v[q][i][1] * rstd * ww[i][1]); o.y = pack2(v[q][i][2] * rstd * ww[i][2], v[q][i][3] * rstd * ww[i][3]);
                *(uint2*)(xn + (size_t)(r0 + q) * DM + i * 256 + lane * 4) = o; } }
    }
}
DI void ssd_conv8_raw(const Params& p, const uint4 r0, const uint4 r1, const uint4 r2, const uint4 r3, int t, int ch, float (&o)[8]) {
    const float m0 = t >= 3 ? 1.f : 0.f, m1 = t >= 2 ? 1.f : 0.f, m2 = t >= 1 ? 1.f : 0.f;
    float acc[8], xv[8];
    { const f32x4 b0 = *(const f32x4*)(p.ev_conv_b + ch), b1 = *(const f32x4*)(p.ev_conv_b + ch + 4);
      acc[0] = b0[0]; acc[1] = b0[1]; acc[2] = b0[2]; acc[3] = b0[3]; acc[4] = b1[0]; acc[5] = b1[1]; acc[6] = b1[2]; acc[7] = b1[3]; }
#define SSD_TAP(k, raw, msk) { unpack8(raw, xv); const f32x4 w0 = *(const f32x4*)(p.ev_conv_w + (k) * 768 + ch) * (msk), w1 = *(const f32x4*)(p.ev_conv_w + (k) * 768 + ch + 4) * (msk); \
        acc[0] += w0[0] * xv[0]; acc[1] += w0[1] * xv[1]; acc[2] += w0[2] * xv[2]; acc[3] += w0[3] * xv[3]; acc[4] += w1[0] * xv[4]; acc[5] += w1[1] * xv[5]; acc[6] += w1[2] * xv[6]; acc[7] += w1[3] * xv[7]; }
    SSD_TAP(0, r0, m0) SSD_TAP(1, r1, m1) SSD_TAP(2, r2, m2) SSD_TAP(3, r3, 1.f)
#pragma unroll
    for (int e = 0; e < 8; ++e) o[e] = silu_(acc[e]);
}
DI void ssd_taps(const bf16_t* H, int b, int t, int ch, uint4& r0, uint4& r1, uint4& r2, uint4& r3) {
    const bf16_t* base = H + (size_t)b * SEQ * HS + 512 + ch;
    const int t0 = t - 3 < 0 ? 0 : t - 3, t1 = t - 2 < 0 ? 0 : t - 2, t2 = t - 1 < 0 ? 0 : t - 1;
    r0 = *(const uint4*)(base + (size_t)t0 * HS); r1 = *(const uint4*)(base + (size_t)t1 * HS); r2 = *(const uint4*)(base + (size_t)t2 * HS); r3 = *(const uint4*)(base + (size_t)t * HS);
}
DI void ssd_conv8(const Params& p, const bf16_t* H, int b, int t, int ch, float (&o)[8]) { uint4 r0, r1, r2, r3; ssd_taps(H, b, t, ch, r0, r1, r2, r3); ssd_conv8_raw(p, r0, r1, r2, r3, t, ch, o); }
DI float ret_lg(int hh) { return log1pf(-exp2f(-5.f - (float)hh)); }
DI float chunk_aux(const Params& p, int b, int hh, int t0) { const int tid = otid(); return tid < 128 ? ((const float*)(p.ws + O_AUX))[((size_t)b * SEQ + t0 + tid) * 8 + hh] : 0.f; }
DI void chunk_decay(const Params& p, int mixer, int hh, float auxv, float* acs, float* dts) {
    const int tid = otid(), lane = tid & 63;
    float v = 0.f;
    if (tid < 128) {
        if (mixer == 0) { const float dt = softplus_(auxv + p.ev_dt_bias[hh]); dts[tid] = dt; v = -expf(p.ev_a_log[hh]) * dt; }
        else { dts[tid] = 1.f; v = ret_lg(hh); }
    }
#pragma unroll
    for (int off = 1; off < 64; off <<= 1) { const float t = __shfl_up(v, off); if (lane >= off) v += t; }
    if (tid == 63) acs[256] = v;
    __syncthreads();
    if (tid >= 64 && tid < 128) v += acs[256];
    if (tid < 128) acs[tid] = v;
    __syncthreads();
}
DI void phase_m1(const Params& p, unsigned char* smem) {
    bf16_t* Kt = (bf16_t*)smem; bf16_t* Vt = (bf16_t*)(smem + 17408); float* acs = (float*)(smem + 34816); float* dts = acs + 128;
    const bf16_t* H = (const bf16_t*)(p.ws + O_H); float* ST = (float*)(p.ws + O_ST); float* CD = (float*)(p.ws + O_CD);
    const float* rc = (const float*)(p.ws + O_ROPE); const float* rs = rc + SEQ * 32;
    const int tid = otid(), lane = tid & 63, w = tid >> 6;
    for (int u = obid(); u < 2048; u += gridDim.x) {
        const int mixer = u >> 10, bh = (u >> 6) & 15, c = u & 63, b = bh >> 3, hh = bh & 7, t0 = c * 128;
        chunk_decay(p, mixer, hh, mixer == 0 ? chunk_aux(p, b, hh, t0) : 0.f, acs, dts);
        const float aend = acs[127];
        if (mixer == 0) {
#pragma unroll
            for (int it = 0; it < 2; ++it) { const int g = tid + it * 512, s = g >> 3, c8 = (g & 7) * 8; float o[8];
                const float sc = __expf(aend - acs[s]) * dts[s];
                ssd_conv8(p, H, b, t0 + s, 512 + (hh >> 2) * 64 + c8, o);
#pragma unroll
                for (int e = 0; e < 8; ++e) Kt[(c8 + e) * 136 + s] = f2bf(o[e] * sc);
                ssd_conv8(p, H, b, t0 + s, hh * 64 + c8, o);
#pragma unroll
                for (int e = 0; e < 8; ++e) Vt[(c8 + e) * 136 + s] = f2bf(o[e]); }
            if (tid == 0) CD[bh * 64 + c] = __expf(aend);
        } else {
            { const int s = tid >> 2, i0 = (tid & 3) * 8; const size_t r = (size_t)b * SEQ + t0 + s; float k1[8], k2[8];
              unpack8(*(const uint4*)(H + r * HS + 1800 + hh * 64 + i0), k1); unpack8(*(const uint4*)(H + r * HS + 1800 + hh * 64 + 32 + i0), k2);
              const float sc = __expf(aend - acs[s]) * 0.125f;
#pragma unroll
              for (int e = 0; e < 8; ++e) { const float cs = rc[(t0 + s) * 32 + i0 + e], sn = rs[(t0 + s) * 32 + i0 + e];
                  Kt[(i0 + e) * 136 + s] = f2bf((k1[e] * cs - k2[e] * sn) * sc); Kt[(32 + i0 + e) * 136 + s] = f2bf((k1[e] * sn + k2[e] * cs) * sc); } }
#pragma unroll
            for (int it = 0; it < 2; ++it) { const int g = tid + it * 512, s = g >> 3, c8 = (g & 7) * 8; const size_t r = (size_t)b * SEQ + t0 + s; float v[8];
                unpack8(*(const uint4*)(H + r * HS + 2312 + hh * 64 + c8), v);
#pragma unroll
                for (int e = 0; e < 8; ++e) Vt[(c8 + e) * 136 + s] = (unsigned short)f2bf(v[e]); }
        }
        __syncthreads();
        { const int mt = w & 3, nt0 = (w >> 2) * 2; f32x4 a0 = {0.f, 0.f, 0.f, 0.f}, a1 = {0.f, 0.f, 0.f, 0.f};
#pragma unroll
          for (int ks = 0; ks < 4; ++ks) { const bf16x8 af = ldfrag(Kt, mt * 16, 136, ks * 32, lane);
              a0 = MFMA16(af, ldfrag(Vt, nt0 * 16, 136, ks * 32, lane), a0); a1 = MFMA16(af, ldfrag(Vt, nt0 * 16 + 16, 136, ks * 32, lane), a1); }
          float* dst = ST + (size_t)u * 4096 + mt * 16 + (lane >> 4) * 4;
          *(f32x4*)(dst + (nt0 * 16 + (lane & 15)) * 64) = a0; *(f32x4*)(dst + (nt0 * 16 + 16 + (lane & 15)) * 64) = a1; }
        __syncthreads();
    }
}
DI void phase_m2(const Params& p) {
    float* ST = (float*)(p.ws + O_ST); const float* CD = (const float*)(p.ws + O_CD);
    for (int idx = obid() * 512 + otid(); idx < 32 * 4096; idx += gridDim.x * 512) {
        const int mb = idx >> 12, e = idx & 4095, mixer = mb >> 4, bh = mb & 15; float run = 0.f;
        const float gdec = __expf(128.f * ret_lg(bh & 7));
#pragma unroll 8
        for (int c = 0; c < 64; ++c) { const size_t o = ((size_t)(mb * 64 + c)) * 4096 + e; const float v = ST[o]; ST[o] = run;
            const float dec = mixer == 0 ? CD[bh * 64 + c] : gdec; run = run * dec + v; }
    }
}
struct M3Pre { uint4 a0, a1, a2, a3, a4, a5, a6, a7; f32x4 st0, st1; float aux; };
template <int MIXER> DI void m3_issue(const Params& p, int b, int c, int hh, M3Pre& R) {
    const bf16_t* H = (const bf16_t*)(p.ws + O_H); const float* ST = (const float*)(p.ws + O_ST);
    const int tid = otid(), t0 = c * 128, bh = b * 8 + hh; const size_t u = (size_t)((MIXER * 16 + bh) * 64 + c);
    if (MIXER == 0) {
        { const int g = tid, s = g >> 3, c8 = (g & 7) * 8; ssd_taps(H, b, t0 + s, hh * 64 + c8, R.a0, R.a1, R.a2, R.a3); }
        { const int g = tid + 512, s = g >> 3, c8 = (g & 7) * 8; ssd_taps(H, b, t0 + s, hh * 64 + c8, R.a4, R.a5, R.a6, R.a7); }
        R.aux = chunk_aux(p, b, hh, t0);
    } else {
        { const int s = tid >> 2, i0 = (tid & 3) * 8; const size_t r = (size_t)b * SEQ + t0 + s;
          R.a0 = *(const uint4*)(H + r * HS + 1288 + hh * 64 + i0); R.a1 = *(const uint4*)(H + r * HS + 1288 + hh * 64 + 32 + i0);
          R.a2 = *(const uint4*)(H + r * HS + 1800 + hh * 64 + i0); R.a3 = *(const uint4*)(H + r * HS + 1800 + hh * 64 + 32 + i0); }
        { const int g = tid, s = g >> 3, c8 = (g & 7) * 8; R.a4 = *(const uint4*)(H + ((size_t)b * SEQ + t0 + s) * HS + 2312 + hh * 64 + c8); }
        { const int g = tid + 512, s = g >> 3, c8 = (g & 7) * 8; R.a5 = *(const uint4*)(H + ((size_t)b * SEQ + t0 + s) * HS + 2312 + hh * 64 + c8); }
        R.aux = 0.f;
    }
    { const int pr = tid >> 3, n8 = (tid & 7) * 8; const float* src = ST + u * 4096 + pr * 64 + n8; R.st0 = *(const f32x4*)src; R.st1 = *(const f32x4*)(src + 4); }
}
template <int MIXER> DI void m3_head(const Params& p, unsigned char* smem, int b, int c, int hh, float (&ssq)[4], M3Pre& R) {
    bf16_t* Qs = (bf16_t*)smem; bf16_t* Ks = (bf16_t*)(smem + 18432); bf16_t* Vt = (bf16_t*)(smem + 36864); bf16_t* Rt = (bf16_t*)(smem + 54272); bf16_t* Ps = (bf16_t*)(smem + 63488);
    float* acs = (float*)(smem + 98304); float* dts = acs + 128;
    const bf16_t* H = (const bf16_t*)(p.ws + O_H); float* YG = (float*)(p.ws + O_YG); bf16_t* Y = (bf16_t*)(p.ws + O_XN);
    const float* rc = (const float*)(p.ws + O_ROPE); const float* rs = rc + SEQ * 32;
    const int tid = otid(), lane = tid & 63, w = tid >> 6, t0 = c * 128;
    __syncthreads();
    chunk_decay(p, MIXER, hh, R.aux, acs, dts);
    if (MIXER == 0) {
        if ((hh & 3) == 0) {
#pragma unroll
            for (int it = 0; it < 2; ++it) { const int g = tid + it * 512, s = g >> 3, c8 = (g & 7) * 8; float o[8];
                ssd_conv8(p, H, b, t0 + s, 640 + (hh >> 2) * 64 + c8, o); *(uint4*)(Qs + s * 72 + c8) = pack8(o);
                ssd_conv8(p, H, b, t0 + s, 512 + (hh >> 2) * 64 + c8, o); *(uint4*)(Ks + s * 72 + c8) = pack8(o); } }
        { const int g = tid, s = g >> 3, c8 = (g & 7) * 8; float o[8]; ssd_conv8_raw(p, R.a0, R.a1, R.a2, R.a3, t0 + s, hh * 64 + c8, o);
#pragma unroll
          for (int e = 0; e < 8; ++e) Vt[(c8 + e) * 136 + s] = f2bf(o[e]); }
        { const int g = tid + 512, s = g >> 3, c8 = (g & 7) * 8; float o[8]; ssd_conv8_raw(p, R.a4, R.a5, R.a6, R.a7, t0 + s, hh * 64 + c8, o);
#pragma unroll
          for (int e = 0; e < 8; ++e) Vt[(c8 + e) * 136 + s] = f2bf(o[e]); }
    } else {
        { const int s = tid >> 2, i0 = (tid & 3) * 8; float a1[8], a2[8], o1[8], o2[8];
          unpack8(R.a0, a1); unpack8(R.a1, a2);
#pragma unroll
          for (int e = 0; e < 8; ++e) { const float cs = rc[(t0 + s) * 32 + i0 + e], sn = rs[(t0 + s) * 32 + i0 + e]; o1[e] = a1[e] * cs - a2[e] * sn; o2[e] = a1[e] * sn + a2[e] * cs; }
          *(uint4*)(Qs + s * 72 + i0) = pack8(o1); *(uint4*)(Qs + s * 72 + 32 + i0) = pack8(o2);
          unpack8(R.a2, a1); unpack8(R.a3, a2);
#pragma unroll
          for (int e = 0; e < 8; ++e) { const float cs = rc[(t0 + s) * 32 + i0 + e], sn = rs[(t0 + s) * 32 + i0 + e]; o1[e] = (a1[e] * cs - a2[e] * sn) * 0.125f; o2[e] = (a1[e] * sn + a2[e] * cs) * 0.125f; }
          *(uint4*)(Ks + s * 72 + i0) = pack8(o1); *(uint4*)(Ks + s * 72 + 32 + i0) = pack8(o2); }
        { const int g = tid, s = g >> 3, c8 = (g & 7) * 8; const uint4 raw = R.a4; const unsigned short* rv = (const unsigned short*)&raw;
#pragma unroll
          for (int e = 0; e < 8; ++e) Vt[(c8 + e) * 136 + s] = rv[e]; }
        { const int g = tid + 512, s = g >> 3, c8 = (g & 7) * 8; const uint4 raw = R.a5; const unsigned short* rv = (const unsigned short*)&raw;
#pragma unroll
          for (int e = 0; e < 8; ++e) Vt[(c8 + e) * 136 + s] = rv[e]; }
    }
    { const int pr = tid >> 3, n8 = (tid & 7) * 8; const f32x4 x0 = R.st0, x1 = R.st1;
      uint4 o; o.x = pack2(x0[0], x0[1]); o.y = pack2(x0[2], x0[3]); o.z = pack2(x1[0], x1[1]); o.w = pack2(x1[2], x1[3]); *(uint4*)(Rt + pr * 72 + n8) = o; }
    __syncthreads();
    if (hh < 7) m3_issue<MIXER>(p, b, c, hh + 1, R);
    const int nks = (w >> 1) + 1;
    const int lrow = 16 * w + (lane >> 4) * 4;
    unsigned short gate[4][4];
#pragma unroll
    for (int nt = 0; nt < 4; ++nt)
#pragma unroll
        for (int j = 0; j < 4; ++j) gate[nt][j] = H[((size_t)b * SEQ + t0 + lrow + j) * HS + (MIXER == 0 ? 0 : 2824) + hh * 64 + nt * 16 + (lane & 15)];
    {
        const bf16x8 q0 = ldfrag(Qs, 16 * w, 72, 0, lane), q1 = ldfrag(Qs, 16 * w, 72, 32, lane);
        float al[4];
#pragma unroll
        for (int j = 0; j < 4; ++j) al[j] = acs[lrow + j];
        for (int nt = 0; nt < 2 * nks; ++nt) { f32x4 sacc = {0.f, 0.f, 0.f, 0.f};
            sacc = MFMA16(q0, ldfrag(Ks, nt * 16, 72, 0, lane), sacc); sacc = MFMA16(q1, ldfrag(Ks, nt * 16, 72, 32, lane), sacc);
            const int s = nt * 16 + (lane & 15); const float as = acs[s], ds = dts[s];
#pragma unroll
            for (int j = 0; j < 4; ++j) { const float pv = (s <= lrow + j) ? sacc[j] * __expf(al[j] - as) * ds : 0.f; Ps[(lrow + j) * 136 + s] = f2bf(pv); } }
    }
    __syncthreads();
    f32x4 yd[4], yo[4];
#pragma unroll
    for (int nt = 0; nt < 4; ++nt) { yd[nt] = (f32x4){0.f, 0.f, 0.f, 0.f}; yo[nt] = (f32x4){0.f, 0.f, 0.f, 0.f}; }
    for (int ks = 0; ks < nks; ++ks) { const bf16x8 pf = ldfrag(Ps, 16 * w, 136, ks * 32, lane);
#pragma unroll
        for (int nt = 0; nt < 4; ++nt) yd[nt] = MFMA16(pf, ldfrag(Vt, nt * 16, 136, ks * 32, lane), yd[nt]); }
#pragma unroll
    for (int ks = 0; ks < 2; ++ks) { const bf16x8 qf = ldfrag(Qs, 16 * w, 72, ks * 32, lane);
#pragma unroll
        for (int nt = 0; nt < 4; ++nt) yo[nt] = MFMA16(qf, ldfrag(Rt, nt * 16, 72, ks * 32, lane), yo[nt]); }
    float ea[4];
#pragma unroll
    for (int j = 0; j < 4; ++j) ea[j] = __expf(acs[lrow + j]);
    if (MIXER == 0) {
        const float dsk = p.ev_d[hh];
#pragma unroll
        for (int nt = 0; nt < 4; ++nt) { const int pc = nt * 16 + (lane & 15);
#pragma unroll
            for (int j = 0; j < 4; ++j) { const size_t r = (size_t)b * SEQ + t0 + lrow + j;
                const float y = yd[nt][j] + ea[j] * yo[nt][j] + dsk * bf2f(Vt[pc * 136 + lrow + j]);
                const float z = bf2f(gate[nt][j]); const float yg = y * silu_(z); ssq[j] += yg * yg; YG[r * 512 + hh * 64 + pc] = yg; } }
    } else {
        float s2[4];
#pragma unroll
        for (int j = 0; j < 4; ++j) { float a = 0.f;
#pragma unroll
            for (int nt = 0; nt < 4; ++nt) { const float y = yd[nt][j] + ea[j] * yo[nt][j]; yd[nt][j] = y; a += y * y; }
            s2[j] = rsqrtf(red16(a) * (1.f / 64.f) + 1e-6f); }
#pragma unroll
        for (int nt = 0; nt < 4; ++nt) { const int pc = nt * 16 + (lane & 15); const float nw = p.ev_ret_norm_w[hh * 64 + pc];
#pragma unroll
            for (int j = 0; j < 4; ++j) { const size_t r = (size_t)b * SEQ + t0 + lrow + j; const float g = bf2f(gate[nt][j]);
                Y[r * DM + 512 + hh * 64 + pc] = f2bf(silu_(g) * yd[nt][j] * s2[j] * nw); } }
    }
}
DI void phase_m3(const Params& p, unsigned char* smem) {
    const int lane = otid() & 63, w = otid() >> 6;
    for (int u = obid(); u < 256; u += gridDim.x) {
        const int mixer = u >> 7, b = (u >> 6) & 1, c = u & 63; float ssq[4] = {0.f, 0.f, 0.f, 0.f};
        if (mixer == 0) {
            M3Pre R; m3_issue<0>(p, b, c, 0, R);
            for (int hh = 0; hh < 8; ++hh) m3_head<0>(p, smem, b, c, hh, ssq, R);
            float* YG = (float*)(p.ws + O_YG); bf16_t* Y = (bf16_t*)(p.ws + O_XN); const int lrow = 16 * w + (lane >> 4) * 4;
            float rstd[4];
#pragma unroll
            for (int j = 0; j < 4; ++j) rstd[j] = rsqrtf(red16(ssq[j]) * (1.f / 512.f) + 1e-6f);
            for (int cc = 0; cc < 32; ++cc) { const int col = cc * 16 + (lane & 15); const float nw = p.ev_ssd_norm_w[col];
#pragma unroll
                for (int j = 0; j < 4; ++j) { const size_t r = (size_t)b * SEQ + c * 128 + lrow + j;
                    const float v = __hip_atomic_load(YG + r * 512 + col, __ATOMIC_RELAXED, __HIP_MEMORY_SCOPE_AGENT); Y[r * DM + col] = f2bf(v * rstd[j] * nw); } }
        } else {
            M3Pre R; m3_issue<1>(p, b, c, 0, R);
            for (int hh = 0; hh < 8; ++hh) m3_head<1>(p, smem, b, c, hh, ssq, R);
        }
    }
}
DI void phase_ffn_fix(const Params& p, int layer) {
    const bf16_t* GC = (const bf16_t*)(p.ws + O_G); bf16_t* U = (bf16_t*)(p.ws + O_U);
    const float* cw = p.ffn_conv_w + (size_t)layer * 3 * DFF; const float* cb = p.ffn_conv_b + (size_t)layer * DFF;
    for (int idx = obid() * 512 + otid(); idx < 256 * 2 * (DFF / 8); idx += gridDim.x * 512) {
        const int c8 = (idx % (DFF / 8)) * 8, ri = idx / (DFF / 8), k = ri >> 1, i = ri & 1, r = k * 64 + i, t = r & (SEQ - 1);
        const int kp = k > 0 ? k - 1 : 0;
        const bf16_t* s0 = GC + ((size_t)kp * 4 + (i == 0 ? 0 : 1)) * DFF + c8;
        const bf16_t* s1 = i == 0 ? GC + ((size_t)kp * 4 + 1) * DFF + c8 : GC + ((size_t)k * 4 + 2) * DFF + c8;
        const bf16_t* s2 = GC + ((size_t)k * 4 + 2 + i) * DFF + c8;
        const float m0 = (t - 2 >= 0) ? 1.f : 0.f, m1 = (t - 1 >= 0) ? 1.f : 0.f;
        const uint4 r0 = *(const uint4*)s0, r1 = *(const uint4*)s1, r2 = *(const uint4*)s2, ru = *(const uint4*)(U + (size_t)r * DFF + c8);
        float acc[8], g[8], uv[8];
        { const f32x4 b0 = *(const f32x4*)(cb + c8), b1 = *(const f32x4*)(cb + c8 + 4); acc[0] = b0[0]; acc[1] = b0[1]; acc[2] = b0[2]; acc[3] = b0[3]; acc[4] = b1[0]; acc[5] = b1[1]; acc[6] = b1[2]; acc[7] = b1[3]; }
#define FIX_TAP(kk, raw, msk) { unpack8(raw, g); const f32x4 w0 = *(const f32x4*)(cw + (kk) * DFF + c8) * (msk), w1 = *(const f32x4*)(cw + (kk) * DFF + c8 + 4) * (msk); \
            acc[0] += w0[0] * g[0]; acc[1] += w0[1] * g[1]; acc[2] += w0[2] * g[2]; acc[3] += w0[3] * g[3]; acc[4] += w1[0] * g[4]; acc[5] += w1[1] * g[5]; acc[6] += w1[2] * g[6]; acc[7] += w1[3] * g[7]; }
        FIX_TAP(0, r0, m0) FIX_TAP(1, r1, m1) FIX_TAP(2, r2, 1.f)
        unpack8(ru, uv);
#pragma unroll
        for (int e2 = 0; e2 < 8; ++e2) acc[e2] = silu_(acc[e2]) * uv[e2];
        *(uint4*)(U + (size_t)r * DFF + c8) = pack8(acc);
    }
}
DI void phase_l1_prep(const Params& p, unsigned char* smem) {
    const bf16_t* H = (const bf16_t*)(p.ws + O_H); const float* aux = (const float*)(p.ws + O_AUX); float* FC = (float*)(p.ws + O_FC);
    bf16_t* KN = (bf16_t*)(p.ws + O_KN); bf16_t* VT = (bf16_t*)(p.ws + O_VT); bf16_t* AP = (bf16_t*)(p.ws + O_AP);
    const int tid = otid();
    for (int u = obid(); u < 16 + 1024; u += gridDim.x) {
        __syncthreads();
        if (u < 16) {
            float* tot = (float*)smem; const int bh = u, b = bh >> 3, hh = bh & 7; const float fb = p.od_f_bias[hh]; float loc[16]; float run = 0.f;
#pragma unroll
            for (int i = 0; i < 16; ++i) { const float xv = aux[((size_t)b * SEQ + tid * 16 + i) * 8 + hh] + fb; run += -softplus_(-xv); loc[i] = run; }
            tot[tid] = run; __syncthreads();
            float off = 0.f; for (int i = 0; i < tid; ++i) off += tot[i];
#pragma unroll
            for (int i = 0; i < 16; ++i) FC[(size_t)bh * SEQ + tid * 16 + i] = off + loc[i];
        } else {
            bf16_t* Vl = (bf16_t*)smem; const int v2 = u - 16, bh = v2 >> 6, blk = v2 & 63, b = bh >> 3, hh = bh & 7, t0 = blk * 128;
            { const int l = tid >> 2, c16 = (tid & 3) * 16; const size_t r = (size_t)b * SEQ + t0 + l; float a[8], c[8];
              unpack8(*(const uint4*)(H + r * HS + 2304 + hh * 64 + c16), a); unpack8(*(const uint4*)(H + r * HS + 2304 + hh * 64 + c16 + 8), c);
              float ss = 0.f;
#pragma unroll
              for (int e = 0; e < 8; ++e) ss += a[e] * a[e] + c[e] * c[e];
              ss += __shfl_xor(ss, 1); ss += __shfl_xor(ss, 2); const float rstd = rsqrtf(ss * (1.f / 64.f) + 1e-6f);
#pragma unroll
              for (int e = 0; e < 8; ++e) { a[e] *= rstd * p.od_kn_w[c16 + e]; c[e] *= rstd * p.od_kn_w[c16 + 8 + e]; }
              bf16_t* dst = KN + ((size_t)bh * SEQ + t0 + l) * 64 + c16; *(uint4*)dst = pack8(a); *(uint4*)(dst + 8) = pack8(c); }
#pragma unroll
            for (int it = 0; it < 2; ++it) { const int g = tid + it * 512, s = g >> 3, c8 = (g & 7) * 8; const size_t r = (size_t)b * SEQ + t0 + s;
                *(uint4*)(Vl + s * 72 + c8) = *(const uint4*)(H + r * HS + 2816 + hh * 64 + c8); }
            __syncthreads();
#pragma unroll
            for (int it = 0; it < 2; ++it) { const int g = tid + it * 512, e = g >> 4, s8 = (g & 15) * 8; uint4 o;
                o.x = (unsigned)Vl[(s8 + 0) * 72 + e] | ((unsigned)Vl[(s8 + 1) * 72 + e] << 16); o.y = (unsigned)Vl[(s8 + 2) * 72 + e] | ((unsigned)Vl[(s8 + 3) * 72 + e] << 16);
                o.z = (unsigned)Vl[(s8 + 4) * 72 + e] | ((unsigned)Vl[(s8 + 5) * 72 + e] << 16); o.w = (unsigned)Vl[(s8 + 6) * 72 + e] | ((unsigned)Vl[(s8 + 7) * 72 + e] << 16);
                *(uint4*)(VT + ((size_t)bh * 64 + e) * SEQ + t0 + s8) = o; }
        }
    }
    {
        float* KNRM = (float*)(p.ws + O_KNRM);
#pragma unroll 4
        for (int idx = obid() * 512 + tid; idx < TOK * 64; idx += gridDim.x * 512) {
            const int r = idx >> 6, c8 = (idx & 63) * 8, t = r & (SEQ - 1); float cur[8], prv[8]; float ss = 0.f;
            { const uint4 rc = *(const uint4*)(H + (size_t)r * HS + 512 + c8), rp = *(const uint4*)(H + (size_t)(t > 0 ? r - 1 : r) * HS + 512 + c8); const float pm = t > 0 ? 1.f : 0.f;
              unpack8(rc, cur); unpack8(rp, prv);
#pragma unroll
              for (int e = 0; e < 8; ++e) prv[e] *= pm; }
#pragma unroll
            for (int e = 0; e < 8; ++e) { const float v = (cur[e] + (prv[e] - cur[e]) * p.od_mu[512 + c8 + e]) * p.od_k_k[c8 + e]; ss += v * v; }
            ss += __shfl_xor(ss, 1); ss += __shfl_xor(ss, 2); ss += __shfl_xor(ss, 4);
            if ((idx & 7) == 0) KNRM[(size_t)r * 8 + (c8 >> 6)] = 1.f / fmaxf(sqrtf(ss), 1e-12f);
        }
    }
#pragma unroll 4
    for (int idx = obid() * 512 + tid; idx < TOK * 32; idx += gridDim.x * 512) {
        const int r = idx >> 5, j8 = (idx & 31) * 8, t = r & (SEQ - 1); float cur[8], prv[8], o[8];
        { const uint4 rc = *(const uint4*)(H + (size_t)r * HS + 1536 + j8), rp = *(const uint4*)(H + (size_t)(t > 0 ? r - 1 : r) * HS + 1536 + j8); const float pm = t > 0 ? 1.f : 0.f;
          unpack8(rc, cur); unpack8(rp, prv);
#pragma unroll
          for (int e = 0; e < 8; ++e) prv[e] *= pm; }
#pragma unroll
        for (int e = 0; e < 8; ++e) { const float v = cur[e] + (prv[e] - cur[e]) * p.od_mu[1536 + j8 + e];
            o[e] = (j8 < 64) ? tanhf(v) : ((j8 < 128) ? v : sigm_(v)); }
        *(uint4*)(AP + (size_t)r * 256 + j8) = pack8(o);
    }
}
DI void fox_unit(const Params& p, unsigned char* smem, int bh, int qb) {
    bf16_t* Qs = (bf16_t*)smem; bf16_t* Ks = (bf16_t*)(smem + 18432); bf16_t* Vts = (bf16_t*)(smem + 36864); float* ck = (float*)(smem + 89600);
    const bf16_t* H = (const bf16_t*)(p.ws + O_H); const float* FC = (const float*)(p.ws + O_FC); const bf16_t* KN = (const bf16_t*)(p.ws + O_KN); const bf16_t* VT = (const bf16_t*)(p.ws + O_VT);
    bf16_t* Y = (bf16_t*)(p.ws + O_XN);
    const int tid = otid(), lane = tid & 63, w = tid >> 6, b = bh >> 3, hh = bh & 7; const size_t r0 = (size_t)b * SEQ + qb * 128;
    const float LOG2E = 1.4426950408889634f;
    __syncthreads();
    { const int l = tid >> 2, c16 = (tid & 3) * 16; float a[8], c[8];
      unpack8(*(const uint4*)(H + (r0 + l) * HS + 1792 + hh * 64 + c16), a); unpack8(*(const uint4*)(H + (r0 + l) * HS + 1792 + hh * 64 + c16 + 8), c);
      float ss = 0.f;
#pragma unroll
      for (int e = 0; e < 8; ++e) ss += a[e] * a[e] + c[e] * c[e];
      ss += __shfl_xor(ss, 1); ss += __shfl_xor(ss, 2); const float rstd = rsqrtf(ss * (1.f / 64.f) + 1e-6f) * (0.125f * LOG2E);
#pragma unroll
      for (int e = 0; e < 8; ++e) { a[e] *= rstd * p.od_qn_w[c16 + e]; c[e] *= rstd * p.od_qn_w[c16 + 8 + e]; }
      *(uint4*)(Qs + l * 72 + c16) = pack8(a); *(uint4*)(Qs + l * 72 + c16 + 8) = pack8(c); }
    float mrow = -1e30f, lsum = 0.f; f32x4 O[4];
#pragma unroll
    for (int j = 0; j < 4; ++j) O[j] = (f32x4){0.f, 0.f, 0.f, 0.f};
    const int q4 = (lane >> 4) * 4, lq = 16 * w + (lane & 15);
    uint4 kreg0, kreg1, vreg0, vreg1; float ckreg = 0.f;
    const int g0 = tid, g1 = tid + 512;
#define FOX_ISSUE(kb_) { \
        kreg0 = *(const uint4*)(KN + ((size_t)bh * SEQ + (kb_) * 128 + (g0 >> 3)) * 64 + (g0 & 7) * 8); \
        kreg1 = *(const uint4*)(KN + ((size_t)bh * SEQ + (kb_) * 128 + (g1 >> 3)) * 64 + (g1 & 7) * 8); \
        vreg0 = *(const uint4*)(VT + ((size_t)bh * 64 + (g0 >> 4)) * SEQ + (kb_) * 128 + (g0 & 15) * 8); \
        vreg1 = *(const uint4*)(VT + ((size_t)bh * 64 + (g1 >> 4)) * SEQ + (kb_) * 128 + (g1 & 15) * 8); \
        if (tid < 128) ckreg = FC[(size_t)bh * SEQ + (kb_) * 128 + tid]; }
    FOX_ISSUE(0)
    for (int kb = 0; kb <= qb; ++kb) {
        __syncthreads();
        *(uint4*)(Ks + (g0 >> 3) * 72 + (g0 & 7) * 8) = kreg0; *(uint4*)(Ks + (g1 >> 3) * 72 + (g1 & 7) * 8) = kreg1;
        *(uint4*)(Vts + (g0 >> 4) * 136 + (g0 & 15) * 8) = vreg0; *(uint4*)(Vts + (g1 >> 4) * 136 + (g1 & 15) * 8) = vreg1;
        if (tid < 128) ck[tid] = -ckreg * LOG2E;
        __syncthreads();
        if (kb < qb) FOX_ISSUE(kb + 1)
        f32x4 S[8];
        { const bf16x8 q0 = ldfrag(Qs, 16 * w, 72, 0, lane), q1 = ldfrag(Qs, 16 * w, 72, 32, lane);
#pragma unroll
          for (int nt = 0; nt < 8; ++nt) { f32x4 z = *(const f32x4*)(ck + nt * 16 + q4); z = MFMA16(ldfrag(Ks, nt * 16, 72, 0, lane), q0, z); S[nt] = MFMA16(ldfrag(Ks, nt * 16, 72, 32, lane), q1, z); } }
        if (kb == qb) {
#pragma unroll
            for (int nt = 0; nt < 8; ++nt)
#pragma unroll
                for (int j = 0; j < 4; ++j) if (nt * 16 + q4 + j > lq) S[nt][j] = -1e30f;
        }
        float mx = S[0][0];
#pragma unroll
        for (int nt = 0; nt < 8; ++nt)
#pragma unroll
            for (int j = 0; j < 4; ++j) mx = fmaxf(mx, S[nt][j]);
        mx = fmaxf(mx, __shfl_xor(mx, 16)); mx = fmaxf(mx, __shfl_xor(mx, 32));
        const float mnew = fmaxf(mrow, mx); const float alpha = __builtin_amdgcn_exp2f(mrow - mnew); mrow = mnew;
        float rs = 0.f;
#pragma unroll
        for (int nt = 0; nt < 8; ++nt)
#pragma unroll
            for (int j = 0; j < 4; ++j) { const float pv = __builtin_amdgcn_exp2f(S[nt][j] - mnew); S[nt][j] = pv; rs += pv; }
        lsum = lsum * alpha + rs;
#pragma unroll
        for (int et = 0; et < 4; ++et) O[et] = O[et] * alpha;
#pragma unroll
        for (int ks = 0; ks < 4; ++ks) {
            uint4 pw; pw.x = cvt_pk_bf16(S[2 * ks][0], S[2 * ks][1]); pw.y = cvt_pk_bf16(S[2 * ks][2], S[2 * ks][3]); pw.z = cvt_pk_bf16(S[2 * ks + 1][0], S[2 * ks + 1][1]); pw.w = cvt_pk_bf16(S[2 * ks + 1][2], S[2 * ks + 1][3]);
            const bf16x8 pf = __builtin_bit_cast(bf16x8, pw);
#pragma unroll
            for (int et = 0; et < 4; ++et) { const bf16_t* vp = Vts + (et * 16 + (lane & 15)) * 136 + ks * 32 + q4;
                uint4 vw; const uint2 lo = *(const uint2*)vp, hi = *(const uint2*)(vp + 16); vw.x = lo.x; vw.y = lo.y; vw.z = hi.x; vw.w = hi.y;
                O[et] = MFMA16(__builtin_bit_cast(bf16x8, vw), pf, O[et]); }
        }
    }
    lsum += __shfl_xor(lsum, 16); lsum += __shfl_xor(lsum, 32);
    const float inv = 1.f / lsum;
#pragma unroll
    for (int et = 0; et < 4; ++et) { uint2 o; o.x = pack2(O[et][0] * inv, O[et][1] * inv); o.y = pack2(O[et][2] * inv, O[et][3] * inv);
        *(uint2*)(Y + (r0 + lq) * DM + 512 + hh * 64 + et * 16 + q4) = o; }
}
constexpr int RW_T = 32, RW_BUF = 43008;
struct RwRegs { unsigned short r[9], k[9], v[9], om[8], a[8]; float kn[8]; };
#define RW_BAR() do { asm volatile("s_waitcnt lgkmcnt(0)" ::: "memory"); __builtin_amdgcn_s_barrier(); asm volatile("" ::: "memory"); } while (0)
DI void rwkv_unit(const Params& p, unsigned char* smem, int bh, int rg) {
    const bf16_t* H = (const bf16_t*)(p.ws + O_H); const bf16_t* LW = (const bf16_t*)(p.ws + O_LW); bf16_t* Y = (bf16_t*)(p.ws + O_XN); const float* KNRM = (const float*)(p.ws + O_KNRM);
    const int tid = otid(), lane = tid & 63, w = tid >> 6, b = bh >> 3, hh = bh & 7; const size_t rb = (size_t)b * SEQ;
    float* ysh = (float*)(smem + 2 * RW_BUF);
    const int NCH = SEQ / RW_T;
    __syncthreads();
    if (w < 2) {
        float S0 = 0.f, S1 = 0.f, S2 = 0.f, S3 = 0.f; const int kq = lane & 15, row = w * 4 + (lane >> 4);
        RW_BAR();
        for (int ch = 0; ch < NCH; ++ch) {
            const float* bufp = (const float*)(smem + (ch & 1) * RW_BUF) + kq * 4; const float* vp = (const float*)(smem + (ch & 1) * RW_BUF) + 10240 + row; float* yo = ysh + (ch & 1) * 256 + row;
#define RW_LOAD(R, W, K, Q, B, V, tt) { R = *(const f32x4*)(bufp + (tt) * 64); W = *(const f32x4*)(bufp + 2048 + (tt) * 64); K = *(const f32x4*)(bufp + 4096 + (tt) * 64); \
                Q = *(const f32x4*)(bufp + 6144 + (tt) * 64); B = *(const f32x4*)(bufp + 8192 + (tt) * 64); V = vp[(tt) * 8]; }
#define DPPF(x, ctrl) __builtin_bit_cast(float, __builtin_amdgcn_update_dpp(0, __builtin_bit_cast(int, (x)), (ctrl), 0xF, 0xF, true))
            f32x4 prevR = {0.f, 0.f, 0.f, 0.f}; float yacc = 0.f;
            f32x4 rN, wN, kN, qN, bN; float vN;
            RW_LOAD(rN, wN, kN, qN, bN, vN, 0)
            __builtin_amdgcn_sched_barrier(0);
#pragma unroll
            for (int tt = 0; tt < RW_T; ++tt) {
                const f32x4 R = rN, W = wN, K = kN, Q = qN, B = bN; const float V = vN;
                if (tt + 1 < RW_T) RW_LOAD(rN, wN, kN, qN, bN, vN, tt + 1)
                float d = S0 * Q[0] + S1 * Q[1] + S2 * Q[2] + S3 * Q[3];
                if (tt > 0) {
                    float y = S0 * prevR[0] + S1 * prevR[1] + S2 * prevR[2] + S3 * prevR[3];
                    d += DPPF(d, 0xB1); y += DPPF(y, 0xB1); d += DPPF(d, 0x4E); y += DPPF(y, 0x4E); d += DPPF(d, 0x141); y += DPPF(y, 0x141); d += DPPF(d, 0x140); y += DPPF(y, 0x140);
                    yacc = (kq == ((tt - 1) & 15)) ? y : yacc;
                    if (tt == 16) yo[kq * 8] = yacc;
                } else d = dpp_red16(d);
                const float sa = -d;
                S0 = (S0 * W[0] + V * K[0]) + sa * B[0]; S1 = (S1 * W[1] + V * K[1]) + sa * B[1]; S2 = (S2 * W[2] + V * K[2]) + sa * B[2]; S3 = (S3 * W[3] + V * K[3]) + sa * B[3];
                prevR = R;
                if (tt & 1) __builtin_amdgcn_sched_barrier(0);
            }
            { float y = S0 * prevR[0] + S1 * prevR[1] + S2 * prevR[2] + S3 * prevR[3]; y = dpp_red16(y); yacc = (kq == 15) ? y : yacc; yo[(16 + kq) * 8] = yacc; }
            RW_BAR();
        }
    } else if (w == 4 || w == 5) {
        const unsigned* ta0; const unsigned* ta1; const unsigned* ta2; size_t st0, st1, st2;
        { int L = lane; int tok = L / 5, which = L - tok * 5; ta0 = (const unsigned*)(which < 3 ? H + (rb + tok) * HS + which * 512 + hh * 64 : LW + (rb + tok) * 1536 + (which - 3) * 512 + hh * 64); st0 = which < 3 ? (size_t)HS * 2 : (size_t)1536 * 2;
          L = lane + 64; tok = L / 5; which = L - tok * 5; ta1 = (const unsigned*)(which < 3 ? H + (rb + tok) * HS + which * 512 + hh * 64 : LW + (rb + tok) * 1536 + (which - 3) * 512 + hh * 64); st1 = which < 3 ? (size_t)HS * 2 : (size_t)1536 * 2;
          L = lane + 128 > 159 ? 159 : lane + 128; tok = L / 5; which = L - tok * 5; ta2 = (const unsigned*)(which < 3 ? H + (rb + tok) * HS + which * 512 + hh * 64 : LW + (rb + tok) * 1536 + (which - 3) * 512 + hh * 64); st2 = which < 3 ? (size_t)HS * 2 : (size_t)1536 * 2; }
        unsigned x0 = 0, x1 = 0, x2 = 0, y0 = 0, y1 = 0, y2 = 0, z0 = 0, z1 = 0, z2 = 0, pacc = 0;
        RW_BAR();
        for (int ch = 0; ch < NCH; ++ch) {
            if (w == 4) { int cc = ch + 6; cc = cc > NCH - 1 ? NCH - 1 : cc; const size_t tb = (size_t)cc * RW_T;
                pacc ^= x0 ^ x1 ^ x2; x0 = y0; x1 = y1; x2 = y2; y0 = z0; y1 = z1; y2 = z2;
                z0 = *(const unsigned*)((const char*)ta0 + tb * st0); z1 = *(const unsigned*)((const char*)ta1 + tb * st1); z2 = *(const unsigned*)((const char*)ta2 + tb * st2); }
            RW_BAR();
        }
        pacc ^= x0 ^ x1 ^ x2 ^ y0 ^ y1 ^ y2 ^ z0 ^ z1 ^ z2; if (pacc == 0x9e3779b9u && rg == 77) Y[0] = 0;
    } else {
        const int lw = (w & 1) + ((w >> 2) << 1), col = hh * 64 + lane; RwRegs ra;
        const float mur = p.od_mu[col], muk = p.od_mu[512 + col], muv = p.od_mu[1024 + col], kk_w = p.od_k_k[col], ka_w = p.od_k_a[col];
        auto issue = [&](int ch, RwRegs& rr) {
            const int tbase = ch * RW_T + lw * 8;
#pragma unroll
            for (int i = 0; i < 9; ++i) { const int t = tbase + i - 1;
                if (t >= 0) { const bf16_t* hp = H + (rb + t) * HS; rr.r[i] = hp[col]; rr.k[i] = hp[512 + col]; rr.v[i] = hp[1024 + col]; } else { rr.r[i] = 0; rr.k[i] = 0; rr.v[i] = 0; }
                if (i > 0) { const bf16_t* lp = LW + (rb + t) * 1536; rr.om[i - 1] = lp[col]; rr.a[i - 1] = lp[512 + col]; rr.kn[i - 1] = KNRM[(rb + t) * 8 + hh]; } }
        };
        auto process = [&](int ch, const RwRegs& rr) {
            float* bufp = (float*)(smem + (ch & 1) * RW_BUF);
#pragma unroll
            for (int i = 1; i < 9; ++i) { const int tt = lw * 8 + i - 1;
                const float rc = bf2f(rr.r[i]), rp = bf2f(rr.r[i - 1]), kc = bf2f(rr.k[i]), kp = bf2f(rr.k[i - 1]), vc = bf2f(rr.v[i]), vp = bf2f(rr.v[i - 1]);
                const float rl = rc + (rp - rc) * mur, kl = kc + (kp - kc) * muk, vl = vc + (vp - vc) * muv; const float a = bf2f(rr.a[i - 1]), wv = 1.f - bf2f(rr.om[i - 1]);
                const float kk = kl * kk_w * rr.kn[i - 1];
                bufp[tt * 64 + lane] = rl; bufp[2048 + tt * 64 + lane] = wv; bufp[4096 + tt * 64 + lane] = kl * (1.f + (a - 1.f) * ka_w); bufp[6144 + tt * 64 + lane] = kk; bufp[8192 + tt * 64 + lane] = kk * a;
                if ((lane >> 3) == rg) bufp[10240 + tt * 8 + (lane & 7)] = vl; }
        };
        issue(0, ra); process(0, ra); issue(1, ra);
        RW_BAR();
        for (int ch = 0; ch < NCH; ++ch) {
            if (ch + 1 < NCH) { process(ch + 1, ra); if (ch + 2 < NCH) issue(ch + 2, ra); }
            if (ch > 0 && lw < 2) { const float* yi = ysh + ((ch - 1) & 1) * 256; const int t2 = lw * 64 + lane, tt = t2 >> 2, pr = (t2 & 3) * 2;
                *(unsigned*)(Y + (rb + (ch - 1) * RW_T + tt) * DM + hh * 64 + rg * 8 + pr) = pack2(yi[tt * 8 + pr], yi[tt * 8 + pr + 1]); }
            RW_BAR();
        }
        if (lw < 2) { const float* yi = ysh + ((NCH - 1) & 1) * 256; const int t2 = lw * 64 + lane, tt = t2 >> 2, pr = (t2 & 3) * 2;
          *(unsigned*)(Y + (rb + (NCH - 1) * RW_T + tt) * DM + hh * 64 + rg * 8 + pr) = pack2(yi[tt * 8 + pr], yi[tt * 8 + pr + 1]); }
    }
    __syncthreads();
}
DI void phase_l1_mix(const Params& p, unsigned char* smem, int pass) {
    unsigned* ctr = (unsigned*)(p.ws + O_CTL) + pass * 4; int* sh = (int*)(smem + 90112);
    if (obid() < 128 && pass != 2) rwkv_unit(p, smem, obid() >> 3, obid() & 7);
    for (;;) {
        __syncthreads(); if (otid() == 0) *sh = (int)atomicAdd(ctr, 1u); __syncthreads();
        const int u = *sh; if (u >= 1024) break;
        fox_unit(p, smem, u & 15, 63 - (u >> 4));
    }
}
DI void phase_rwkv_fin(const Params& p) {
    const bf16_t* H = (const bf16_t*)(p.ws + O_H); const bf16_t* LW = (const bf16_t*)(p.ws + O_LW); bf16_t* Y = (bf16_t*)(p.ws + O_XN);
    const int lane = otid() & 63, wv = otid() >> 6;
#pragma unroll 4
    for (int task = obid() * 8 + wv; task < TOK * 8; task += gridDim.x * 8) {
        const int r = task >> 3, hh = task & 7, t = r & (SEQ - 1), col = hh * 64 + lane; const bf16_t* hp = H + (size_t)r * HS;
        const float y = bf2f(Y[(size_t)r * DM + col]); const float mean = red64(y) * (1.f / 64.f); const float dy = y - mean; const float var = red64(dy * dy) * (1.f / 64.f);
        const float yln = dy * rsqrtf(var + 64e-5f) * p.od_ln_w[col] + p.od_ln_b[col];
        const bf16_t* hq = t > 0 ? hp - HS : hp; const float pm = t > 0 ? 1.f : 0.f;
        const float rc = bf2f(hp[col]), kc = bf2f(hp[512 + col]), vc = bf2f(hp[1024 + col]); const float rp = bf2f(hq[col]) * pm, kp = bf2f(hq[512 + col]) * pm, vp = bf2f(hq[1024 + col]) * pm;
        const float rl = rc + (rp - rc) * p.od_mu[col], kl = kc + (kp - kc) * p.od_mu[512 + col], vl = vc + (vp - vc) * p.od_mu[1024 + col];
        const float a = bf2f(LW[(size_t)r * 1536 + 512 + col]), g = bf2f(LW[(size_t)r * 1536 + 1024 + col]);
        const float kt = kl * (1.f + (a - 1.f) * p.od_k_a[col]); const float bonus = red64(rl * kt * p.od_r_k[col]) * vl;
        Y[(size_t)r * DM + col] = f2bf((yln + bonus) * g);
    }
}
#define XB_TMO      128
#define XB_XCNT(j)  (256  + 64 * (j))
#define XB_XSUB(j)  (1280 + 64 * (j))
#define XB_XGEN(j)  (2304 + 64 * (j))
#define XB_TOP      3328
#define XB_TOPGEN   3392
#define XCD_BAR_WORDS 3456
#define XB_SPIN_CAP (1u << 18)
#define LAS __attribute__((address_space(3)))

__device__ __forceinline__ unsigned xb_ld(unsigned* p)              { return __hip_atomic_load(p, __ATOMIC_RELAXED, __HIP_MEMORY_SCOPE_AGENT); }
__device__ __forceinline__ unsigned xb_add(unsigned* p, unsigned v) { return __hip_atomic_fetch_add(p, v, __ATOMIC_RELAXED, __HIP_MEMORY_SCOPE_AGENT); }
__device__ __forceinline__ unsigned xb_xcc_id() { return (unsigned)__builtin_amdgcn_s_getreg((3 << 11) | 20) & 0xFu; }
#define XB_SPIN(cond, bar) do { unsigned _sp = 0; while (cond) { __builtin_amdgcn_s_sleep(1); \
    if ((++_sp & 255u) == 0u) { if (xb_ld(&(bar)[XB_TMO])) break; if (_sp > XB_SPIN_CAP) { atomicAdd(&(bar)[XB_TMO], 1u); break; } } } } while (0)

struct XcdBarrier {
    unsigned* bar; unsigned x;
    volatile LAS unsigned* st;
};

__device__ __forceinline__ XcdBarrier xcd_barrier_post(unsigned* bar, volatile LAS unsigned* st) {
    XcdBarrier b; b.bar = bar; b.x = xb_xcc_id(); b.st = st;
    if (threadIdx.x == 0) (void)xb_add(&bar[XB_XCNT(b.x)], 1u);
    return b;
}
__device__ __forceinline__ void xcd_barrier_complete(unsigned* bar, unsigned x, unsigned& nloc, unsigned& nx) {
    const unsigned G = gridDim.x * gridDim.y * gridDim.z;
    unsigned sum, cnt, mine, sp = 0u;
    for (;;) {
        sum = 0u; cnt = 0u; mine = 0u;
#pragma unroll
        for (unsigned j = 0; j < 16; ++j) { const unsigned c = xb_ld(&bar[XB_XCNT(j)]); sum += c; cnt += (c > 0u) ? 1u : 0u; mine = (j == x) ? c : mine; }
        if (sum == G) break;
        __builtin_amdgcn_s_sleep(1);
        if ((++sp & 255u) == 0u) { if (xb_ld(&bar[XB_TMO])) break; if (sp > XB_SPIN_CAP) { atomicAdd(&bar[XB_TMO], 1u); break; } }
    }
    nloc = mine > 0u ? mine : 1u; nx = cnt > 0u ? cnt : 1u;
}

__device__ __forceinline__ void xcd_barrier(const XcdBarrier& b) {
    asm volatile("s_waitcnt vmcnt(0)" ::: "memory");
    __syncthreads();
    if (threadIdx.x == 0) {
        unsigned* bar = b.bar;
        __builtin_amdgcn_s_waitcnt(0);
        unsigned nloc = b.st[0], nx = b.st[1];
        if (nloc == 0u) { xcd_barrier_complete(bar, b.x, nloc, nx); b.st[0] = nloc; b.st[1] = nx; }
        const unsigned old = xb_add(&bar[XB_XSUB(b.x)], 1u);
        const unsigned gen = old / nloc;
        if (old + 1u == (gen + 1u) * nloc) {
            __builtin_amdgcn_fence(__ATOMIC_RELEASE, "agent");
            asm volatile("s_waitcnt vmcnt(0)" ::: "memory");
            const unsigned og = xb_add(&bar[XB_TOP], 1u);
            const unsigned tg = og / nx;
            if (og + 1u == (tg + 1u) * nx) xb_add(&bar[XB_TOPGEN], 1u);
            else XB_SPIN(xb_ld(&bar[XB_TOPGEN]) == tg, bar);
            __builtin_amdgcn_fence(__ATOMIC_ACQUIRE, "agent");
            xb_add(&bar[XB_XGEN(b.x)], 1u);
            asm volatile("s_waitcnt vmcnt(0)" ::: "memory");
        } else {
            XB_SPIN(xb_ld(&bar[XB_XGEN(b.x)]) == gen, bar);
            __builtin_amdgcn_fence(__ATOMIC_ACQUIRE, "agent");
            asm volatile("s_waitcnt vmcnt(0)" ::: "memory");
        }
    }
    __syncthreads();
}


__global__ void __launch_bounds__(512, 2) fwd_megakernel(Params p) {
    extern __shared__ __attribute__((aligned(16))) unsigned char smem[];
    cg::grid_group grid = cg::this_grid();
    unsigned char* ws = p.ws;
    bf16_t* XN = (bf16_t*)(ws + O_XN); bf16_t* Hb = (bf16_t*)(ws + O_H); float* aux = (float*)(ws + O_AUX);
    const bf16_t* t_in = (const bf16_t*)(ws + O_WT_IN); const bf16_t* t_out = (const bf16_t*)(ws + O_WT_OUT); const bf16_t* t_up = (const bf16_t*)(ws + O_WT_UP);
    const bf16_t* t_dn = (const bf16_t*)(ws + O_WT_DN); const bf16_t* t_lr = (const bf16_t*)(ws + O_WT_LR);
    if (blockIdx.x == 0 && threadIdx.x < 16) ((unsigned*)(ws + O_CTL))[threadIdx.x] = 0u;
    if (threadIdx.x == 0) *(uint4*)(smem + 131072) = make_uint4(0u, 0u, 0u, 0u);
    __syncthreads();
    const XcdBarrier xb = xcd_barrier_post((unsigned*)(ws + O_BAR), (volatile LAS unsigned*)(smem + 131072));
#define GSYNC() xcd_barrier(xb)
#define GEMM_H(layer) { EpiH E; E.H = Hb; E.aux = aux; E.auxc = layer ? 3328 : 1280; run_gemm(smem, XN, t_in, 3584, 1024, E); }
#define GEMM_OUT(layer) { EpiRes E; E.res = layer ? p.out : p.x; E.out = p.out; run_gemm(smem, XN, t_out, 1024, 1024, E); }
#define GEMM_UP(layer) { EpiGU E; E.GC = (bf16_t*)(ws + O_G); E.U = (bf16_t*)(ws + O_U); E.cw = p.ffn_conv_w + (size_t)(layer) * 3 * DFF; E.cb = p.ffn_conv_b + (size_t)(layer) * DFF; run_gemm(smem, XN, t_up, 2 * DFF, 1024, E); }
#define GEMM_DN() { EpiRes E; E.res = p.out; E.out = p.out; run_gemm(smem, (const bf16_t*)(ws + O_U), t_dn, 1024, DFF, E); }
    phase_weights(p, smem, 0, 0); phase_rmsnorm(p.x, p.ev_norm_w, XN);
    if (p.ws == nullptr) grid.sync();
    GSYNC();
    GEMM_H(0) phase_weights(p, smem, 0, 1); GSYNC();
#if PROBE == 2
    GEMM_H(0) GSYNC();
#endif
    phase_m1(p, smem); GSYNC();
#if PROBE == 3
    phase_m1(p, smem); GSYNC();
#endif
    phase_m2(p); GSYNC();
#if PROBE == 6
    GSYNC(); GSYNC(); GSYNC(); GSYNC(); GSYNC(); GSYNC(); GSYNC(); GSYNC(); GSYNC(); GSYNC();
#endif
#if PROBE == 7
    phase_weights(p, smem, 0, 0); GSYNC(); phase_rmsnorm(p.x, p.ev_norm_w, XN); GSYNC(); phase_rmsnorm(p.x, p.ev_norm_w, XN); GSYNC();
#endif
    phase_m3(p, smem); GSYNC();
#if PROBE == 3
    phase_m3(p, smem); GSYNC();
#endif
    GEMM_OUT(0) GSYNC();
#if PROBE == 2
    GEMM_OUT(0) GSYNC();
#endif
    phase_rmsnorm(p.out, p.ffn_norm_w, XN); GSYNC();
    GEMM_UP(0) phase_weights(p, smem, 0, 2); phase_weights(p, smem, 1, 0, 128); GSYNC();
    phase_ffn_fix(p, 0); GSYNC();
    GEMM_DN() GSYNC();
    phase_rmsnorm(p.out, p.od_norm_w, XN); GSYNC();
    GEMM_H(1) phase_weights(p, smem, 1, 1); GSYNC();
    phase_l1_prep(p, smem); GSYNC();
    { EpiLR E; E.LW = (bf16_t*)(ws + O_LW); E.w0 = p.od_w0; E.a0 = p.od_a0; run_gemm(smem, (const bf16_t*)(ws + O_AP), t_lr, 1536, 256, E); } GSYNC();
    phase_l1_mix(p, smem, 0); GSYNC();
#if PROBE == 4
    phase_l1_mix(p, smem, 1); GSYNC();
#endif
#if PROBE == 5
    phase_l1_mix(p, smem, 2); GSYNC();
#endif
    phase_rwkv_fin(p); GSYNC();
    GEMM_OUT(1) GSYNC();
    phase_rmsnorm(p.out, p.ffn_norm_w + DM, XN); GSYNC();
    GEMM_UP(1) phase_weights(p, smem, 1, 2); GSYNC();
    phase_ffn_fix(p, 1); GSYNC();
    GEMM_DN()
}

extern "C" void kernel_launch(void* const* d_in, const int* in_sizes, int n_in, void* d_out, int out_size, void* d_ws, size_t ws_size, hipStream_t stream) {
    static int grid_blocks = 0;
    if (grid_blocks == 0) {
        int dev = 0, cus = 0, per_cu = 0;
        hipGetDevice(&dev); hipDeviceGetAttribute(&cus, hipDeviceAttributeMultiprocessorCount, dev);
        if (hipFuncSetAttribute((const void*)fwd_megakernel, hipFuncAttributeMaxDynamicSharedMemorySize, LDS_BYTES) != hipSuccess) fprintf(stderr, "hipFuncSetAttribute failed\n");
        hipOccupancyMaxActiveBlocksPerMultiprocessor(&per_cu, (const void*)fwd_megakernel, 512, LDS_BYTES);
        (void)hipGetLastError();
        if (per_cu < 1) fprintf(stderr, "occupancy query says %d blocks per CU\n", per_cu);
        grid_blocks = cus > 0 ? cus : 256;
        if (ws_size < WS_NEED) fprintf(stderr, "workspace too small: %zu < %zu\n", ws_size, (size_t)WS_NEED);
    }
    Params p{};
    const float** pp = (const float**)&p;
    for (int i = 0; i < 33; ++i) pp[i] = (const float*)d_in[i];
    p.out = (float*)d_out; p.ws = (unsigned char*)d_ws;
    (void)hipMemsetAsync((char*)d_ws + O_BAR, 0, 16384, stream);
    void* args[] = {&p};
    hipError_t e = hipLaunchCooperativeKernel((const void*)fwd_megakernel, dim3(grid_blocks), dim3(512), args, LDS_BYTES, stream);
    if (e != hipSuccess) fprintf(stderr, "cooperative launch failed: %s (grid %d)\n", hipGetErrorString(e), grid_blocks);
}
```

```cpp
#include <hip/hip_runtime.h>
#include <hip/hip_cooperative_groups.h>
#include <cstdio>
#ifndef PROBE
#define PROBE 0
#endif
namespace cg = cooperative_groups;
namespace pg8 {
#define PG8_LAS __attribute__((address_space(3)))
typedef unsigned short bf16_t;
typedef short bf16x8 __attribute__((ext_vector_type(8)));
typedef float f32x4 __attribute__((ext_vector_type(4)));
typedef unsigned u32x4 __attribute__((ext_vector_type(4)));
constexpr int BM = 256, BK = 64, HALF = 128, HTB = HALF * BK * 2  , STAGE_BYTES = 8 * HTB, NXCD = 8, WGM = 8;

__host__ __device__ __forceinline__ int lds_byte(int r, int c) { const int st = (r >> 4) * 2 + (c >> 5), rr = r & 15, cc = c & 31, ob = rr * 64 + cc * 2; return st * 1024 + (ob ^ (((ob >> 9) & 1) << 5)); }
__host__ __device__ __forceinline__ void stage_rc(int b, int& R, int& C) { const int st = b / 1024, sb = b % 1024, swz = sb ^ (((sb >> 9) & 1) << 5); R = (st >> 1) * 16 + swz / 64; C = (st & 1) * 32 + (swz % 64) / 2; }
__host__ __device__ __forceinline__ int perm32(int rho) { const int n = rho >> 4, i = rho & 15; return 8 * (i >> 2) + 4 * n + (i & 3); }

struct Unit { int pm, pn; };
struct Gemm { const bf16_t* A; const bf16_t* Bt; int M, N, K; };

struct StaticOrder {
    int nM, nN, nwg, G, c;
    __host__ __device__ void init(int M, int N, int G_, int c_) { nM = M / BM; nN = N / BM; nwg = nM * nN; G = G_; c = c_; }
    __host__ __device__ bool next(int i, Unit& u) const {
        const long L = (long)i * G + c; if (L >= nwg) return false;
        int wgid = (int)L; { const int q = nwg / NXCD, r = nwg % NXCD, xcd = wgid % NXCD, off = wgid / NXCD; wgid = (xcd < r ? xcd * (q + 1) : r * (q + 1) + (xcd - r) * q) + off; }
        const int nig = WGM * nN, gid = wgid / nig, fm = gid * WGM, gsz = (nM - fm) < WGM ? (nM - fm) : WGM;
        u.pm = fm + ((wgid % nig) % gsz); u.pn = (wgid % nig) / gsz; return true;
    }
    __device__ __forceinline__ void a_ready(const Unit&) const {}
    __device__ __forceinline__ void done(const Unit&) const {}
};
__device__ __forceinline__ unsigned cvt_pk_bf16(float lo, float hi) { unsigned r; asm volatile("v_cvt_pk_bf16_f32 %0, %1, %2" : "=v"(r) : "v"(lo), "v"(hi)); return r; }

template <class Epi, class Sched, bool STAMP = false>
__device__ __forceinline__ void gemm_phase(PG8_LAS unsigned char* lds, const Gemm g, const Sched& S, const Epi& E, unsigned long long* stamps) {
    int tid_ = threadIdx.x; asm volatile("" : "+v"(tid_)); const int tid = tid_, wid = __builtin_amdgcn_readfirstlane(tid >> 6), lane = tid & 63, wr = wid >> 2, wc = wid & 3, fr = lane & 15, fq = lane >> 4;
    const int K = g.K, nt = K / BK;
    int ts_lo = 0, ts_hi = 0, nts = 0; const unsigned long long rt_entry = STAMP ? (unsigned long long)wall_clock64() : 0ull;
#define PG8_STAMP() do { if (STAMP && wid == 0 && nts < 64) { const unsigned long long _c = (unsigned long long)clock64(); \
        ts_lo = (lane == nts) ? (int)(unsigned)_c : ts_lo; ts_hi = (lane == nts) ? (int)(unsigned)(_c >> 32) : ts_hi; ++nts; } } while (0)
    PG8_STAMP();
    unsigned voffA[2], voffB[2];
#pragma unroll
    for (int i = 0; i < 2; ++i) { int R, C; stage_rc(tid * 16 + i * 8192, R, C); const int Rb = Epi::PERM ? ((R & ~31) + perm32(R & 31)) : R;
        voffA[i] = (unsigned)(R * K + C) * 2u; voffB[i] = (unsigned)(Rb * K + C) * 2u; }
    const size_t kstep = (size_t)(BK * 2);
    const size_t hstep = (size_t)HALF * K * 2;
    const size_t tstep = 2 * hstep;
    const unsigned ldsw = (unsigned)wid * 1024u;
    const int aoff = lds_byte(wr * 64 + fr, fq * 8), boff = lds_byte(wc * 32 + fr, fq * 8);
#define PG8_SA(b, h) (((b) * 2 + (h)) * HTB)
#define PG8_SB(b, h) ((4 + (b) * 2 + (h)) * HTB)
#define PG8_STAGE(bufoff, gbase, voff) do { _Pragma("unroll") for (int _i = 0; _i < 2; ++_i) \
        __builtin_amdgcn_global_load_lds((const unsigned*)((const char*)(gbase) + (voff)[_i]), (PG8_LAS unsigned*)(lds + (bufoff) + ldsw + _i * 8192), 16, 0, 0); } while (0)
#define PG8_LDA(dst, b, h) do { _Pragma("unroll") for (int m = 0; m < 4; ++m) _Pragma("unroll") for (int k = 0; k < 2; ++k) dst[m][k] = *(const PG8_LAS bf16x8*)(lds + PG8_SA(b, h) + aoff + m * 2048 + k * 1024); } while (0)
#define PG8_LDB(dst, b, h) do { _Pragma("unroll") for (int n = 0; n < 2; ++n) _Pragma("unroll") for (int k = 0; k < 2; ++k) dst[n][k] = *(const PG8_LAS bf16x8*)(lds + PG8_SB(b, h) + boff + n * 2048 + k * 1024); } while (0)
#define PG8_MMA(ai, bj, At, Bt) do { __builtin_amdgcn_s_setprio(1); _Pragma("unroll") for (int m = 0; m < 4; ++m) _Pragma("unroll") for (int n = 0; n < 2; ++n) _Pragma("unroll") for (int k = 0; k < 2; ++k) \
        acc[ai][bj][m][n] = __builtin_amdgcn_mfma_f32_16x16x32_bf16(Bt[n][k], At[m][k], acc[ai][bj][m][n], 0, 0, 0); __builtin_amdgcn_s_setprio(0); } while (0)
#define PG8_WAIT_V(n) asm volatile("s_waitcnt vmcnt(" #n ")" ::: "memory")
#define PG8_WAIT_L(n) asm volatile("s_waitcnt lgkmcnt(" #n ")" ::: "memory")
#define PG8_BAR __builtin_amdgcn_s_barrier()
#define PG8_SCHED __builtin_amdgcn_sched_barrier(0)
    Unit cur, nxt; int ui = 0;
    if (!S.next(0, cur)) return;
    f32x4 acc[2][2][4][2];
#pragma unroll
    for (int a = 0; a < 2; ++a)
#pragma unroll
        for (int b = 0; b < 2; ++b)
#pragma unroll
            for (int m = 0; m < 4; ++m)
#pragma unroll
                for (int n = 0; n < 2; ++n) acc[a][b][m][n] = (f32x4){0.f, 0.f, 0.f, 0.f};
    bf16x8 At[4][2], B0[2][2], B1[2][2];
    const char* cA = (const char*)g.A + (size_t)cur.pm * tstep; const char* cB = (const char*)g.Bt + (size_t)cur.pn * tstep;
    S.a_ready(cur);
    PG8_STAGE(PG8_SB(0, 0), cB, voffB); PG8_STAGE(PG8_SA(0, 0), cA, voffA); PG8_STAGE(PG8_SB(0, 1), cB + hstep, voffB); PG8_STAGE(PG8_SA(0, 1), cA + hstep, voffA);
    if (wr == 1) PG8_BAR;
    PG8_WAIT_V(4); PG8_BAR;
    PG8_STAGE(PG8_SB(1, 0), cB + kstep, voffB); PG8_STAGE(PG8_SA(1, 0), cA + kstep, voffA); PG8_STAGE(PG8_SB(1, 1), cB + hstep + kstep, voffB);
    PG8_WAIT_V(6); PG8_BAR;
    PG8_STAMP();
    for (;;) {
        const bool has_next = S.next(ui + 1, nxt);
        const char* nA = has_next ? (const char*)g.A + (size_t)nxt.pm * tstep : cA; const char* nB = has_next ? (const char*)g.Bt + (size_t)nxt.pn * tstep : cB;
        for (int t = 0; t < nt; t += 2) {
            const bool last = (t == nt - 2);
            const char* a1 = cA + (size_t)(t + 1) * kstep;
            const char* a2 = last ? nA : cA + (size_t)(t + 2) * kstep; const char* b2 = last ? nB : cB + (size_t)(t + 2) * kstep;
            const char* a3 = a2 + kstep; const char* b3 = b2 + kstep;
            if (last && has_next) S.a_ready(nxt);
            PG8_LDB(B0, 0, 0); PG8_SCHED; PG8_LDA(At, 0, 0); PG8_STAGE(PG8_SA(1, 1), a1 + hstep, voffA);
            PG8_WAIT_L(8); PG8_BAR; PG8_WAIT_L(0); PG8_MMA(0, 0, At, B0); PG8_BAR; PG8_SCHED;
            PG8_LDB(B1, 0, 1); PG8_STAGE(PG8_SB(0, 0), b2, voffB);
            PG8_BAR; PG8_WAIT_L(0); PG8_MMA(0, 1, At, B1); PG8_BAR;
            PG8_LDA(At, 0, 1); PG8_STAGE(PG8_SA(0, 0), a2, voffA);
            PG8_BAR; PG8_WAIT_L(0); PG8_MMA(1, 0, At, B0); PG8_BAR; PG8_SCHED;
            PG8_STAGE(PG8_SB(0, 1), b2 + hstep, voffB);
            PG8_WAIT_V(6); PG8_BAR; PG8_MMA(1, 1, At, B1); PG8_BAR;
            PG8_LDB(B0, 1, 0); PG8_SCHED; PG8_LDA(At, 1, 0); PG8_STAGE(PG8_SA(0, 1), a2 + hstep, voffA);
            PG8_WAIT_L(8); PG8_BAR; PG8_WAIT_L(0); PG8_MMA(0, 0, At, B0); PG8_BAR; PG8_SCHED;
            PG8_LDB(B1, 1, 1); PG8_STAGE(PG8_SB(1, 0), b3, voffB);
            PG8_BAR; PG8_WAIT_L(0); PG8_MMA(0, 1, At, B1); PG8_BAR;
            PG8_LDA(At, 1, 1); PG8_STAGE(PG8_SA(1, 0), a3, voffA);
            PG8_BAR; PG8_WAIT_L(0); PG8_MMA(1, 0, At, B0); PG8_BAR; PG8_SCHED;
            PG8_STAGE(PG8_SB(1, 1), b3 + hstep, voffB);
            PG8_WAIT_V(6); PG8_BAR; PG8_MMA(1, 1, At, B1); PG8_BAR;
        }
        PG8_STAMP();
        if constexpr (!Epi::AFTER_DRAIN) { E(acc, cur, wr, wc, fr, fq); S.done(cur); }
        PG8_STAMP();
        if (!has_next) break;
#pragma unroll
        for (int a = 0; a < 2; ++a)
#pragma unroll
            for (int b = 0; b < 2; ++b)
#pragma unroll
                for (int m = 0; m < 4; ++m)
#pragma unroll
                    for (int n = 0; n < 2; ++n) acc[a][b][m][n] = (f32x4){0.f, 0.f, 0.f, 0.f};
        cur = nxt; cA = nA; cB = nB; ++ui;
    }
    PG8_WAIT_V(0);
    if (wr == 0) PG8_BAR;
    PG8_BAR;
    if constexpr (Epi::AFTER_DRAIN) { E.fused(acc, cur, wr, wc, fr, fq, lds, wid, lane); S.done(cur); }
    PG8_STAMP();
    if (STAMP && wid == 0) { stamps[lane] = lane < nts ? (((unsigned long long)(unsigned)ts_hi << 32) | (unsigned)ts_lo) : 0ull;
        if (lane == 62) stamps[62] = rt_entry; if (lane == 63) stamps[63] = (unsigned long long)wall_clock64(); }
#undef PG8_STAMP
#undef PG8_SA
#undef PG8_SB
#undef PG8_STAGE
#undef PG8_LDA
#undef PG8_LDB
#undef PG8_MMA
#undef PG8_WAIT_V
#undef PG8_WAIT_L
#undef PG8_BAR
#undef PG8_SCHED
}
}

using pg8::bf16_t; using pg8::bf16x8; using pg8::f32x4; using pg8::Unit; using pg8::cvt_pk_bf16;
#define DI __device__ __forceinline__
constexpr int TOK = 16384, SEQ = 8192, DM = 1024, HS = 3336, DFF = 2816;
constexpr size_t O_CTL = 0, O_CD = 256, O_AUX = 4352, O_ROPE = 528640, O_FC = 2625792, O_WT = 3150080;
constexpr size_t O_WT_IN = O_WT, O_WT_OUT = O_WT_IN + 7340032, O_WT_UP = O_WT_OUT + 2097152, O_WT_DN = O_WT_UP + 11534336, O_WT_LR = O_WT_DN + 5767168;
constexpr size_t O_XN = O_WT + 27525120, O_R1 = O_XN + 33554432;
constexpr size_t O_H = O_R1, O_ST = O_R1 + 109314048, O_YG = O_ST + 33554432;
constexpr size_t O_G = O_R1, O_U = O_R1 + 92274688;
constexpr size_t O_LW = O_R1 + 109314048, O_KN = O_LW + 50331648, O_VT = O_KN + 16777216, O_AP = O_VT + 16777216;
constexpr size_t O_KNRM = O_AP + 8388608;
constexpr size_t O_BAR = O_KNRM + 524288;
constexpr size_t WS_NEED = O_BAR + 16384;
constexpr int LDS_BYTES = 131072 + 256;

struct Params {
    const float* x; const float* ev_norm_w; const float* ev_w_in; const float* ev_conv_w; const float* ev_conv_b; const float* ev_dt_bias; const float* ev_a_log;
    const float* ev_d; const float* ev_ssd_norm_w; const float* ev_ret_norm_w; const float* ev_w_out;
    const float* od_norm_w; const float* od_w_in; const float* od_mu; const float* od_w0; const float* od_w_up; const float* od_a0; const float* od_a_up;
    const float* od_g_up; const float* od_k_k; const float* od_k_a; const float* od_r_k; const float* od_ln_w; const float* od_ln_b;
    const float* od_qn_w; const float* od_kn_w; const float* od_f_bias; const float* od_w_out;
    const float* ffn_norm_w; const float* ffn_w_up; const float* ffn_conv_w; const float* ffn_conv_b; const float* ffn_w_down;
    float* out; unsigned char* ws;
};

DI unsigned cvtpk(float lo, float hi) { unsigned r; asm("v_cvt_pk_bf16_f32 %0, %1, %2" : "=v"(r) : "v"(lo), "v"(hi)); return r; }
DI unsigned short f2bf(float f) { return (unsigned short)(cvtpk(f, f) & 0xffffu); }
DI float bf2f(unsigned short b) { return __uint_as_float(((unsigned)b) << 16); }
DI unsigned pack2(float lo, float hi) { return cvtpk(lo, hi); }
DI float bflo(unsigned w) { return __uint_as_float(w << 16); }
DI float bfhi(unsigned w) { return __uint_as_float(w & 0xffff0000u); }
DI void unpack8(const uint4 r, float (&o)[8]) { o[0] = bflo(r.x); o[1] = bfhi(r.x); o[2] = bflo(r.y); o[3] = bfhi(r.y); o[4] = bflo(r.z); o[5] = bfhi(r.z); o[6] = bflo(r.w); o[7] = bfhi(r.w); }
DI uint4 pack8(const float (&o)[8]) { uint4 r; r.x = pack2(o[0], o[1]); r.y = pack2(o[2], o[3]); r.z = pack2(o[4], o[5]); r.w = pack2(o[6], o[7]); return r; }
DI float silu_(float x) { return x * __builtin_amdgcn_rcpf(1.f + __expf(-x)); }
DI float sigm_(float x) { return __builtin_amdgcn_rcpf(1.f + __expf(-x)); }
DI float softplus_(float x) { return fmaxf(x, 0.f) + log1pf(__expf(-fabsf(x))); }
DI bf16x8 ldfrag(const bf16_t* base, int row0, int ld, int k0, int lane) { return *(const bf16x8*)(base + (row0 + (lane & 15)) * ld + k0 + (lane >> 4) * 8); }
#define MFMA16(a, b, c) __builtin_amdgcn_mfma_f32_16x16x32_bf16((a), (b), (c), 0, 0, 0)
DI float red16(float v) { v += __shfl_xor(v, 1); v += __shfl_xor(v, 2); v += __shfl_xor(v, 4); v += __shfl_xor(v, 8); return v; }
DI float max16(float v) { v = fmaxf(v, __shfl_xor(v, 1)); v = fmaxf(v, __shfl_xor(v, 2)); v = fmaxf(v, __shfl_xor(v, 4)); v = fmaxf(v, __shfl_xor(v, 8)); return v; }
DI float red64(float v) { v += __shfl_xor(v, 32); v += __shfl_xor(v, 16); return red16(v); }
DI float dpp_red16(float x) {
    x += __builtin_bit_cast(float, __builtin_amdgcn_update_dpp(0, __builtin_bit_cast(int, x), 0xB1, 0xF, 0xF, true));
    x += __builtin_bit_cast(float, __builtin_amdgcn_update_dpp(0, __builtin_bit_cast(int, x), 0x4E, 0xF, 0xF, true));
    x += __builtin_bit_cast(float, __builtin_amdgcn_update_dpp(0, __builtin_bit_cast(int, x), 0x141, 0xF, 0xF, true));
    x += __builtin_bit_cast(float, __builtin_amdgcn_update_dpp(0, __builtin_bit_cast(int, x), 0x140, 0xF, 0xF, true));
    return x;
}

DI int otid() { int t = threadIdx.x; asm volatile("" : "+v"(t)); return t; }
DI int obid() { int b = blockIdx.x; asm volatile("" : "+s"(b)); return b; }
struct EpiH {
    static constexpr bool PERM = false, AFTER_DRAIN = false;
    bf16_t* H; float* aux; int auxc;
    DI void operator()(const f32x4 (&acc)[2][2][4][2], const Unit& u, int wr, int wc, int fr, int fq) const {
        const int row0 = u.pm * 256 + wr * 64 + fr, col0 = u.pn * 256 + wc * 32 + 4 * fq;
#pragma unroll
        for (int ai = 0; ai < 2; ++ai)
#pragma unroll
            for (int m = 0; m < 4; ++m) { const size_t r = (size_t)(row0 + ai * 128 + m * 16);
#pragma unroll
                for (int bj = 0; bj < 2; ++bj)
#pragma unroll
                    for (int n = 0; n < 2; ++n) { const int c = col0 + bj * 128 + n * 16; const f32x4 v = acc[ai][bj][m][n];
                        if (c < HS) { uint2 w; w.x = cvt_pk_bf16(v[0], v[1]); w.y = cvt_pk_bf16(v[2], v[3]); *(uint2*)(H + r * HS + c) = w;
                            if (c == auxc || c == auxc + 4) *(f32x4*)(aux + r * 8 + (c - auxc)) = v; } } }
    }
};
struct EpiRes {
    static constexpr bool PERM = false, AFTER_DRAIN = false;
    const float* res; float* out;
    DI void operator()(const f32x4 (&acc)[2][2][4][2], const Unit& u, int wr, int wc, int fr, int fq) const {
        const int row0 = u.pm * 256 + wr * 64 + fr, col0 = u.pn * 256 + wc * 32 + 4 * fq;
#pragma unroll
        for (int ai = 0; ai < 2; ++ai)
#pragma unroll
            for (int m = 0; m < 4; ++m) { const size_t r = (size_t)(row0 + ai * 128 + m * 16);
#pragma unroll
                for (int bj = 0; bj < 2; ++bj)
#pragma unroll
                    for (int n = 0; n < 2; ++n) { const int c = col0 + bj * 128 + n * 16;
                        const f32x4 rv = *(const f32x4*)(res + r * DM + c); *(f32x4*)(out + r * DM + c) = rv + acc[ai][bj][m][n]; } }
    }
};
DI float gu_ror1(float x) { float r; asm volatile("s_nop 1\n\tv_mov_b32_dpp %0, %1 row_ror:1 row_mask:0xf bank_mask:0xf bound_ctrl:1" : "=v"(r) : "v"(x)); return r; }
DI float gu_ror2(float x) { float r; asm volatile("s_nop 1\n\tv_mov_b32_dpp %0, %1 row_ror:2 row_mask:0xf bank_mask:0xf bound_ctrl:1" : "=v"(r) : "v"(x)); return r; }
struct EpiGU {
    static constexpr bool PERM = false, AFTER_DRAIN = false;
    bf16_t* GC; bf16_t* U; const float* cw; const float* cb;
    DI void operator()(const f32x4 (&acc)[2][2][4][2], const Unit& u, int wr, int wc, int fr, int fq) const {
        const int row0 = u.pm * 256 + wr * 64 + fr, col0 = u.pn * 128 + wc * 32 + 4 * fq;
#define GU_ROR(x, n) gu_ror##n(x)
#pragma unroll
        for (int n = 0; n < 2; ++n) { const int c = col0 + n * 16;
            const f32x4 w0 = *(const f32x4*)(cw + c), w1 = *(const f32x4*)(cw + DFF + c), w2 = *(const f32x4*)(cw + 2 * DFF + c), bb = *(const f32x4*)(cb + c);
#pragma unroll
            for (int ai = 0; ai < 2; ++ai)
#pragma unroll
                for (int m = 0; m < 4; ++m) { const size_t r = (size_t)(row0 + ai * 128 + m * 16); const size_t slab = r >> 6;
                    const f32x4 g = acc[ai][0][m][n], v = acc[ai][1][m][n]; const f32x4 gp = acc[ai][0][m > 0 ? m - 1 : 0][n];
                    f32x4 o;
                    f32x4 s1, s2; float g1a, g1b, g1c, g1d, g2a, g2b, g2c, g2d;
#pragma unroll
                    for (int j = 0; j < 4; ++j) { s1[j] = fr == 15 ? gp[j] : g[j]; s2[j] = fr >= 14 ? gp[j] : g[j]; }
                    asm volatile("s_nop 1\n\tv_mov_b32_dpp %0, %4 row_ror:1 row_mask:0xf bank_mask:0xf bound_ctrl:1\n\tv_mov_b32_dpp %1, %5 row_ror:1 row_mask:0xf bank_mask:0xf bound_ctrl:1\n\t"
                                 "v_mov_b32_dpp %2, %6 row_ror:1 row_mask:0xf bank_mask:0xf bound_ctrl:1\n\tv_mov_b32_dpp %3, %7 row_ror:1 row_mask:0xf bank_mask:0xf bound_ctrl:1"
                                 : "=&v"(g1a), "=&v"(g1b), "=&v"(g1c), "=&v"(g1d) : "v"(s1[0]), "v"(s1[1]), "v"(s1[2]), "v"(s1[3]));
                    asm volatile("s_nop 1\n\tv_mov_b32_dpp %0, %4 row_ror:2 row_mask:0xf bank_mask:0xf bound_ctrl:1\n\tv_mov_b32_dpp %1, %5 row_ror:2 row_mask:0xf bank_mask:0xf bound_ctrl:1\n\t"
                                 "v_mov_b32_dpp %2, %6 row_ror:2 row_mask:0xf bank_mask:0xf bound_ctrl:1\n\tv_mov_b32_dpp %3, %7 row_ror:2 row_mask:0xf bank_mask:0xf bound_ctrl:1"
                                 : "=&v"(g2a), "=&v"(g2b), "=&v"(g2c), "=&v"(g2d) : "v"(s2[0]), "v"(s2[1]), "v"(s2[2]), "v"(s2[3]));
                    const f32x4 g1v = {g1a, g1b, g1c, g1d}, g2v = {g2a, g2b, g2c, g2d};
#pragma unroll
                    for (int j = 0; j < 4; ++j) { const float g1 = g1v[j], g2 = g2v[j];
                        const float a = bb[j] + w0[j] * g2 + w1[j] * g1 + w2[j] * g[j]; o[j] = silu_(a) * v[j]; }
                    const bool defer = (m == 0) && (fr < 2);
                    uint2 w;
                    w.x = cvt_pk_bf16(defer ? v[0] : o[0], defer ? v[1] : o[1]); w.y = cvt_pk_bf16(defer ? v[2] : o[2], defer ? v[3] : o[3]);
                    *(uint2*)(U + r * DFF + c) = w;
                    if (defer || (m == 3 && fr >= 14)) { const int slot = defer ? 2 + fr : fr - 14; uint2 gw; gw.x = cvt_pk_bf16(g[0], g[1]); gw.y = cvt_pk_bf16(g[2], g[3]);
                        *(uint2*)(GC + (slab * 4 + slot) * DFF + c) = gw; } }
        }
#undef GU_ROR
    }
};
struct EpiLR {
    static constexpr bool PERM = false, AFTER_DRAIN = false;
    bf16_t* LW; const float* w0; const float* a0;
    DI void operator()(const f32x4 (&acc)[2][2][4][2], const Unit& u, int wr, int wc, int fr, int fq) const {
        const int row0 = u.pm * 256 + wr * 64 + fr, col0 = u.pn * 256 + wc * 32 + 4 * fq;
#pragma unroll
        for (int ai = 0; ai < 2; ++ai)
#pragma unroll
            for (int m = 0; m < 4; ++m) { const size_t r = (size_t)(row0 + ai * 128 + m * 16);
#pragma unroll
                for (int bj = 0; bj < 2; ++bj)
#pragma unroll
                    for (int n = 0; n < 2; ++n) { const int c = col0 + bj * 128 + n * 16; f32x4 v = acc[ai][bj][m][n];
                        if (c < 512) { const f32x4 b = *(const f32x4*)(w0 + c);
#pragma unroll
                            for (int j = 0; j < 4; ++j) v[j] = 1.f - __expf(-0.606531f * sigm_(b[j] + v[j])); }
                        else if (c < 1024) { const f32x4 b = *(const f32x4*)(a0 + c - 512);
#pragma unroll
                            for (int j = 0; j < 4; ++j) v[j] = sigm_(b[j] + v[j]); }
                        uint2 w; w.x = cvt_pk_bf16(v[0], v[1]); w.y = cvt_pk_bf16(v[2], v[3]); *(uint2*)(LW + r * 1536 + c) = w; } }
    }
};
template <class Epi> DI void run_gemm(unsigned char* smem, const bf16_t* A, const bf16_t* Bt, int N, int K, const Epi& E) {
    pg8::Gemm g; g.A = A; g.Bt = Bt; g.M = TOK; g.N = N; g.K = K;
    pg8::StaticOrder S; S.init(TOK, N, (int)gridDim.x, obid());
    pg8::gemm_phase<Epi, pg8::StaticOrder, false>((PG8_LAS unsigned char*)smem, g, S, E, nullptr);
}

DI void conv_tile4(const float* W, int Nsrc, int K, bf16_t* Wt, int nd0, int sc0, int nvalid, int k0, float* tile) {
    const int tid = otid(), j = tid & 63, kb = tid >> 6;
    float v[32];
#pragma unroll
    for (int i = 0; i < 32; ++i) { const int kk = kb + 8 * i; v[i] = (j < nvalid) ? W[(size_t)(k0 + kk) * Nsrc + sc0 + j] : 0.f; }
#pragma unroll
    for (int i = 0; i < 32; ++i) { const int kk = kb + 8 * i; tile[kk * 65 + j] = v[i]; }
    __syncthreads();
    const int nl = tid >> 3, ks = (tid & 7) * 8;
#pragma unroll
    for (int q = 0; q < 4; ++q) { const float* tq = tile + q * 64 * 65; uint4 o;
        o.x = pack2(tq[(ks + 0) * 65 + nl], tq[(ks + 1) * 65 + nl]); o.y = pack2(tq[(ks + 2) * 65 + nl], tq[(ks + 3) * 65 + nl]);
        o.z = pack2(tq[(ks + 4) * 65 + nl], tq[(ks + 5) * 65 + nl]); o.w = pack2(tq[(ks + 6) * 65 + nl], tq[(ks + 7) * 65 + nl]);
        *(uint4*)(Wt + (size_t)(nd0 + nl) * K + k0 + q * 64 + ks) = o; }
    __syncthreads();
}
DI void phase_weights(const Params& p, unsigned char* smem, int layer, int part, int b0 = 0) {
    float* tile = (float*)smem;
    const float* w_in = layer ? p.od_w_in : p.ev_w_in; const float* w_out = layer ? p.od_w_out : p.ev_w_out;
    const float* w_up = p.ffn_w_up + (size_t)layer * DM * 2 * DFF; const float* w_dn = p.ffn_w_down + (size_t)layer * DFF * DM;
    bf16_t* t_in = (bf16_t*)(p.ws + O_WT_IN); bf16_t* t_out = (bf16_t*)(p.ws + O_WT_OUT); bf16_t* t_up = (bf16_t*)(p.ws + O_WT_UP); bf16_t* t_dn = (bf16_t*)(p.ws + O_WT_DN);
    if (part == 0) {
        if (obid() < b0) return;
        for (int job = obid() - b0; job < 288; job += (int)gridDim.x - b0) {
            if (job < 224) { const int nt = job >> 2, kt = job & 3, nd0 = nt * 64; int nv = HS - nd0; nv = nv < 0 ? 0 : (nv > 64 ? 64 : nv);
                conv_tile4(w_in, HS, 1024, t_in, nd0, nd0, nv, kt * 256, tile); }
            else { const int j2 = job - 224, nt = j2 >> 2, kt = j2 & 3; conv_tile4(w_out, 1024, 1024, t_out, nt * 64, nt * 64, 64, kt * 256, tile); }
        }
    } else {
        const int nb = (int)gridDim.x - 128, lb = obid() - 128;
        if (lb < 0) return;
        if (part == 1) { for (int job = lb; job < 352; job += nb) { const int nt = job >> 2, kt = job & 3, nd0 = nt * 64; const int pn = nd0 >> 8, bj = (nd0 >> 7) & 1, j0 = nd0 & 127;
                conv_tile4(w_up, 2 * DFF, 1024, t_up, nd0, bj * DFF + 128 * pn + j0, 64, kt * 256, tile); } }
        else { for (int job = lb; job < 176; job += nb) { const int nt = job / 11, kt = job % 11; conv_tile4(w_dn, 1024, DFF, t_dn, nt * 64, nt * 64, 64, kt * 256, tile); } }
        return;
    }
    const int gtid = (obid() - b0) * 512 + otid(), gsz = ((int)gridDim.x - b0) * 512;
    if (layer == 0) {
        float* rc = (float*)(p.ws + O_ROPE); float* rs = rc + SEQ * 32;
        for (int idx = gtid; idx < SEQ * 32; idx += gsz) { const int pos = idx >> 5, i = idx & 31;
            const float inv = (float)exp(-(double)i * (9.210340371976184 / 32.0)); const float ang = (float)pos * inv;
            const double a = (double)ang; const double n = rint(a * 0.15915494309189535); const double r = a - n * 6.283185307179586; const double r2 = r * r;
            double sn = 1.0 / 121645100408832000.0, cs = 1.0 / 2432902008176640000.0;
            sn = sn * r2 - 1.0 / 355687428096000.0; sn = sn * r2 + 1.0 / 1307674368000.0; sn = sn * r2 - 1.0 / 6227020800.0; sn = sn * r2 + 1.0 / 39916800.0;
            sn = sn * r2 - 1.0 / 362880.0; sn = sn * r2 + 1.0 / 5040.0; sn = sn * r2 - 1.0 / 120.0; sn = sn * r2 + 1.0 / 6.0; sn = sn * r2 * -1.0 + 1.0; sn = sn * r;
            cs = cs * r2 - 1.0 / 6402373705728000.0; cs = cs * r2 + 1.0 / 20922789888000.0; cs = cs * r2 - 1.0 / 87178291200.0; cs = cs * r2 + 1.0 / 479001600.0;
            cs = cs * r2 - 1.0 / 3628800.0; cs = cs * r2 + 1.0 / 40320.0; cs = cs * r2 - 1.0 / 720.0; cs = cs * r2 + 1.0 / 24.0; cs = cs * r2 - 0.5; cs = cs * r2 + 1.0;
            rc[idx] = (float)cs; rs[idx] = (float)sn; }
    } else {
        bf16_t* t_lr = (bf16_t*)(p.ws + O_WT_LR);
        for (int idx = gtid; idx < 1536 * 256; idx += gsz) { const int n = idx >> 8, k = idx & 255; float v = 0.f;
            if (n < 512) { if (k < 64) v = p.od_w_up[k * 512 + n]; }
            else if (n < 1024) { if (k >= 64 && k < 128) v = p.od_a_up[(k - 64) * 512 + n - 512]; }
            else { if (k >= 128) v = p.od_g_up[(k - 128) * 512 + n - 1024]; }
            t_lr[idx] = f2bf(v); }
    }
}
DI void phase_rmsnorm(const float* x, const float* w, bf16_t* xn) {
    const int lane = otid() & 63, wv = otid() >> 6;
    f32x4 ww[4];
#pragma unroll
    for (int i = 0; i < 4; ++i) ww[i] = *(const f32x4*)(w + i * 256 + lane * 4);
    for (int r0 = (obid() * 8 + wv) * 4; r0 < TOK; r0 += gridDim.x * 8 * 4) {
        f32x4 v[4][4];
#pragma unroll
        for (int q = 0; q < 4; ++q)
#pragma unroll
            for (int i = 0; i < 4; ++i) v[q][i] = *(const f32x4*)(x + (size_t)(r0 + q) * DM + i * 256 + lane * 4);
#pragma unroll
        for (int q = 0; q < 4; ++q) { float ss = 0.f;
#pragma unroll
            for (int i = 0; i < 4; ++i) ss += v[q][i][0] * v[q][i][0] + v[q][i][1] * v[q][i][1] + v[q][i][2] * v[q][i][2] + v[q][i][3] * v[q][i][3];
            ss = red64(ss); const float rstd = rsqrtf(ss * (1.f / DM) + 1e-6f);
#pragma unroll
            for (int i = 0; i < 4; ++i) { uint2 o; o.x = pack2(v[q][i][0] * rstd * ww[i][0], v[q][i][1] * rstd * ww[i][1]); o.y = pack2(v[q][i][2] * rstd * ww[i][2], v[q][i][3] * rstd * ww[i][3]);
                *(uint2*)(xn + (size_t)(r0 + q) * DM + i * 256 + lane * 4) = o; } }
    }
}
DI void ssd_conv8_raw(const Params& p, const uint4 r0, const uint4 r1, const uint4 r2, const uint4 r3, int t, int ch, float (&o)[8]) {
    const float m0 = t >= 3 ? 1.f : 0.f, m1 = t >= 2 ? 1.f : 0.f, m2 = t >= 1 ? 1.f : 0.f;
    float acc[8], xv[8];
    { const f32x4 b0 = *(const f32x4*)(p.ev_conv_b + ch), b1 = *(const f32x4*)(p.ev_conv_b + ch + 4);
      acc[0] = b0[0]; acc[1] = b0[1]; acc[2] = b0[2]; acc[3] = b0[3]; acc[4] = b1[0]; acc[5] = b1[1]; acc[6] = b1[2]; acc[7] = b1[3]; }
#define SSD_TAP(k, raw, msk) { unpack8(raw, xv); const f32x4 w0 = *(const f32x4*)(p.ev_conv_w + (k) * 768 + ch) * (msk), w1 = *(const f32x4*)(p.ev_conv_w + (k) * 768 + ch + 4) * (msk); \
        acc[0] += w0[0] * xv[0]; acc[1] += w0[1] * xv[1]; acc[2] += w0[2] * xv[2]; acc[3] += w0[3] * xv[3]; acc[4] += w1[0] * xv[4]; acc[5] += w1[1] * xv[5]; acc[6] += w1[2] * xv[6]; acc[7] += w1[3] * xv[7]; }
    SSD_TAP(0, r0, m0) SSD_TAP(1, r1, m1) SSD_TAP(2, r2, m2) SSD_TAP(3, r3, 1.f)
#pragma unroll
    for (int e = 0; e < 8; ++e) o[e] = silu_(acc[e]);
}
DI void ssd_taps(const bf16_t* H, int b, int t, int ch, uint4& r0, uint4& r1, uint4& r2, uint4& r3) {
    const bf16_t* base = H + (size_t)b * SEQ * HS + 512 + ch;
    const int t0 = t - 3 < 0 ? 0 : t - 3, t1 = t - 2 < 0 ? 0 : t - 2, t2 = t - 1 < 0 ? 0 : t - 1;
    r0 = *(const uint4*)(base + (size_t)t0 * HS); r1 = *(const uint4*)(base + (size_t)t1 * HS); r2 = *(const uint4*)(base + (size_t)t2 * HS); r3 = *(const uint4*)(base + (size_t)t * HS);
}
DI void ssd_conv8(const Params& p, const bf16_t* H, int b, int t, int ch, float (&o)[8]) { uint4 r0, r1, r2, r3; ssd_taps(H, b, t, ch, r0, r1, r2, r3); ssd_conv8_raw(p, r0, r1, r2, r3, t, ch, o); }
DI float ret_lg(int hh) { return log1pf(-exp2f(-5.f - (float)hh)); }
DI float chunk_aux(const Params& p, int b, int hh, int t0) { const int tid = otid(); return tid < 128 ? ((const float*)(p.ws + O_AUX))[((size_t)b * SEQ + t0 + tid) * 8 + hh] : 0.f; }
DI void chunk_decay(const Params& p, int mixer, int hh, float auxv, float* acs, float* dts) {
    const int tid = otid(), lane = tid & 63;
    float v = 0.f;
    if (tid < 128) {
        if (mixer == 0) { const float dt = softplus_(auxv + p.ev_dt_bias[hh]); dts[tid] = dt; v = -expf(p.ev_a_log[hh]) * dt; }
        else { dts[tid] = 1.f; v = ret_lg(hh); }
    }
#pragma unroll
    for (int off = 1; off < 64; off <<= 1) { const float t = __shfl_up(v, off); if (lane >= off) v += t; }
    if (tid == 63) acs[256] = v;
    __syncthreads();
    if (tid >= 64 && tid < 128) v += acs[256];
    if (tid < 128) acs[tid] = v;
    __syncthreads();
}
DI void phase_m1(const Params& p, unsigned char* smem) {
    bf16_t* Kt = (bf16_t*)smem; bf16_t* Vt = (bf16_t*)(smem + 17408); float* acs = (float*)(smem + 34816); float* dts = acs + 128;
    const bf16_t* H = (const bf16_t*)(p.ws + O_H); float* ST = (float*)(p.ws + O_ST); float* CD = (float*)(p.ws + O_CD);
    const float* rc = (const float*)(p.ws + O_ROPE); const float* rs = rc + SEQ * 32;
    const int tid = otid(), lane = tid & 63, w = tid >> 6;
    for (int u = obid(); u < 2048; u += gridDim.x) {
        const int mixer = u >> 10, bh = (u >> 6) & 15, c = u & 63, b = bh >> 3, hh = bh & 7, t0 = c * 128;
        chunk_decay(p, mixer, hh, mixer == 0 ? chunk_aux(p, b, hh, t0) : 0.f, acs, dts);
        const float aend = acs[127];
        if (mixer == 0) {
#pragma unroll
            for (int it = 0; it < 2; ++it) { const int g = tid + it * 512, s = g >> 3, c8 = (g & 7) * 8; float o[8];
                const float sc = __expf(aend - acs[s]) * dts[s];
                ssd_conv8(p, H, b, t0 + s, 512 + (hh >> 2) * 64 + c8, o);
#pragma unroll
                for (int e = 0; e < 8; ++e) Kt[(c8 + e) * 136 + s] = f2bf(o[e] * sc);
                ssd_conv8(p, H, b, t0 + s, hh * 64 + c8, o);
#pragma unroll
                for (int e = 0; e < 8; ++e) Vt[(c8 + e) * 136 + s] = f2bf(o[e]); }
            if (tid == 0) CD[bh * 64 + c] = __expf(aend);
        } else {
            { const int s = tid >> 2, i0 = (tid & 3) * 8; const size_t r = (size_t)b * SEQ + t0 + s; float k1[8], k2[8];
              unpack8(*(const uint4*)(H + r * HS + 1800 + hh * 64 + i0), k1); unpack8(*(const uint4*)(H + r * HS + 1800 + hh * 64 + 32 + i0), k2);
              const float sc = __expf(aend - acs[s]) * 0.125f;
#pragma unroll
              for (int e = 0; e < 8; ++e) { const float cs = rc[(t0 + s) * 32 + i0 + e], sn = rs[(t0 + s) * 32 + i0 + e];
                  Kt[(i0 + e) * 136 + s] = f2bf((k1[e] * cs - k2[e] * sn) * sc); Kt[(32 + i0 + e) * 136 + s] = f2bf((k1[e] * sn + k2[e] * cs) * sc); } }
#pragma unroll
            for (int it = 0; it < 2; ++it) { const int g = tid + it * 512, s = g >> 3, c8 = (g & 7) * 8; const size_t r = (size_t)b * SEQ + t0 + s; float v[8];
                unpack8(*(const uint4*)(H + r * HS + 2312 + hh * 64 + c8), v);
#pragma unroll
                for (int e = 0; e < 8; ++e) Vt[(c8 + e) * 136 + s] = (unsigned short)f2bf(v[e]); }
        }
        __syncthreads();
        { const int mt = w & 3, nt0 = (w >> 2) * 2; f32x4 a0 = {0.f, 0.f, 0.f, 0.f}, a1 = {0.f, 0.f, 0.f, 0.f};
#pragma unroll
          for (int ks = 0; ks < 4; ++ks) { const bf16x8 af = ldfrag(Kt, mt * 16, 136, ks * 32, lane);
              a0 = MFMA16(af, ldfrag(Vt, nt0 * 16, 136, ks * 32, lane), a0); a1 = MFMA16(af, ldfrag(Vt, nt0 * 16 + 16, 136, ks * 32, lane), a1); }
          float* dst = ST + (size_t)u * 4096 + mt * 16 + (lane >> 4) * 4;
          *(f32x4*)(dst + (nt0 * 16 + (lane & 15)) * 64) = a0; *(f32x4*)(dst + (nt0 * 16 + 16 + (lane & 15)) * 64) = a1; }
        __syncthreads();
    }
}
DI void phase_m2(const Params& p) {
    float* ST = (float*)(p.ws + O_ST); const float* CD = (const float*)(p.ws + O_CD);
    for (int idx = obid() * 512 + otid(); idx < 32 * 4096; idx += gridDim.x * 512) {
        const int mb = idx >> 12, e = idx & 4095, mixer = mb >> 4, bh = mb & 15; float run = 0.f;
        const float gdec = __expf(128.f * ret_lg(bh & 7));
#pragma unroll 8
        for (int c = 0; c < 64; ++c) { const size_t o = ((size_t)(mb * 64 + c)) * 4096 + e; const float v = ST[o]; ST[o] = run;
            const float dec = mixer == 0 ? CD[bh * 64 + c] : gdec; run = run * dec + v; }
    }
}
struct M3Pre { uint4 a0, a1, a2, a3, a4, a5, a6, a7; f32x4 st0, st1; float aux; };
template <int MIXER> DI void m3_issue(const Params& p, int b, int c, int hh, M3Pre& R) {
    const bf16_t* H = (const bf16_t*)(p.ws + O_H); const float* ST = (const float*)(p.ws + O_ST);
    const int tid = otid(), t0 = c * 128, bh = b * 8 + hh; const size_t u = (size_t)((MIXER * 16 + bh) * 64 + c);
    if (MIXER == 0) {
        { const int g = tid, s = g >> 3, c8 = (g & 7) * 8; ssd_taps(H, b, t0 + s, hh * 64 + c8, R.a0, R.a1, R.a2, R.a3); }
        { const int g = tid + 512, s = g >> 3, c8 = (g & 7) * 8; ssd_taps(H, b, t0 + s, hh * 64 + c8, R.a4, R.a5, R.a6, R.a7); }
        R.aux = chunk_aux(p, b, hh, t0);
    } else {
        { const int s = tid >> 2, i0 = (tid & 3) * 8; const size_t r = (size_t)b * SEQ + t0 + s;
          R.a0 = *(const uint4*)(H + r * HS + 1288 + hh * 64 + i0); R.a1 = *(const uint4*)(H + r * HS + 1288 + hh * 64 + 32 + i0);
          R.a2 = *(const uint4*)(H + r * HS + 1800 + hh * 64 + i0); R.a3 = *(const uint4*)(H + r * HS + 1800 + hh * 64 + 32 + i0); }
        { const int g = tid, s = g >> 3, c8 = (g & 7) * 8; R.a4 = *(const uint4*)(H + ((size_t)b * SEQ + t0 + s) * HS + 2312 + hh * 64 + c8); }
        { const int g = tid + 512, s = g >> 3, c8 = (g & 7) * 8; R.a5 = *(const uint4*)(H + ((size_t)b * SEQ + t0 + s) * HS + 2312 + hh * 64 + c8); }
        R.aux = 0.f;
    }
    { const int pr = tid >> 3, n8 = (tid & 7) * 8; const float* src = ST + u * 4096 + pr * 64 + n8; R.st0 = *(const f32x4*)src; R.st1 = *(const f32x4*)(src + 4); }
}
template <int MIXER> DI void m3_head(const Params& p, unsigned char* smem, int b, int c, int hh, float (&ssq)[4], M3Pre& R) {
    bf16_t* Qs = (bf16_t*)smem; bf16_t* Ks = (bf16_t*)(smem + 18432); bf16_t* Vt = (bf16_t*)(smem + 36864); bf16_t* Rt = (bf16_t*)(smem + 54272); bf16_t* Ps = (bf16_t*)(smem + 63488);
    float* acs = (float*)(smem + 98304); float* dts = acs + 128;
    const bf16_t* H = (const bf16_t*)(p.ws + O_H); float* YG = (float*)(p.ws + O_YG); bf16_t* Y = (bf16_t*)(p.ws + O_XN);
    const float* rc = (const float*)(p.ws + O_ROPE); const float* rs = rc + SEQ * 32;
    const int tid = otid(), lane = tid & 63, w = tid >> 6, t0 = c * 128;
    __syncthreads();
    chunk_decay(p, MIXER, hh, R.aux, acs, dts);
    if (MIXER == 0) {
        if ((hh & 3) == 0) {
#pragma unroll
            for (int it = 0; it < 2; ++it) { const int g = tid + it * 512, s = g >> 3, c8 = (g & 7) * 8; float o[8];
                ssd_conv8(p, H, b, t0 + s, 640 + (hh >> 2) * 64 + c8, o); *(uint4*)(Qs + s * 72 + c8) = pack8(o);
                ssd_conv8(p, H, b, t0 + s, 512 + (hh >> 2) * 64 + c8, o); *(uint4*)(Ks + s * 72 + c8) = pack8(o); } }
        { const int g = tid, s = g >> 3, c8 = (g & 7) * 8; float o[8]; ssd_conv8_raw(p, R.a0, R.a1, R.a2, R.a3, t0 + s, hh * 64 + c8, o);
#pragma unroll
          for (int e = 0; e < 8; ++e) Vt[(c8 + e) * 136 + s] = f2bf(o[e]); }
        { const int g = tid + 512, s = g >> 3, c8 = (g & 7) * 8; float o[8]; ssd_conv8_raw(p, R.a4, R.a5, R.a6, R.a7, t0 + s, hh * 64 + c8, o);
#pragma unroll
          for (int e = 0; e < 8; ++e) Vt[(c8 + e) * 136 + s] = f2bf(o[e]); }
    } else {
        { const int s = tid >> 2, i0 = (tid & 3) * 8; float a1[8], a2[8], o1[8], o2[8];
          unpack8(R.a0, a1); unpack8(R.a1, a2);
#pragma unroll
          for (int e = 0; e < 8; ++e) { const float cs = rc[(t0 + s) * 32 + i0 + e], sn = rs[(t0 + s) * 32 + i0 + e]; o1[e] = a1[e] * cs - a2[e] * sn; o2[e] = a1[e] * sn + a2[e] * cs; }
          *(uint4*)(Qs + s * 72 + i0) = pack8(o1); *(uint4*)(Qs + s * 72 + 32 + i0) = pack8(o2);
          unpack8(R.a2, a1); unpack8(R.a3, a2);
#pragma unroll
          for (int e = 0; e < 8; ++e) { const float cs = rc[(t0 + s) * 32 + i0 + e], sn = rs[(t0 + s) * 32 + i0 + e]; o1[e] = (a1[e] * cs - a2[e] * sn) * 0.125f; o2[e] = (a1[e] * sn + a2[e] * cs) * 0.125f; }
          *(uint4*)(Ks + s * 72 + i0) = pack8(o1); *(uint4*)(Ks + s * 72 + 32 + i0) = pack8(o2); }
        { const int g = tid, s = g >> 3, c8 = (g & 7) * 8; const uint4 raw = R.a4; const unsigned short* rv = (const unsigned short*)&raw;
#pragma unroll
          for (int e = 0; e < 8; ++e) Vt[(c8 + e) * 136 + s] = rv[e]; }
        { const int g = tid + 512, s = g >> 3, c8 = (g & 7) * 8; const uint4 raw = R.a5; const unsigned short* rv = (const unsigned short*)&raw;
#pragma unroll
          for (int e = 0; e < 8; ++e) Vt[(c8 + e) * 136 + s] = rv[e]; }
    }
    { const int pr = tid >> 3, n8 = (tid & 7) * 8; const f32x4 x0 = R.st0, x1 = R.st1;
      uint4 o; o.x = pack2(x0[0], x0[1]); o.y = pack2(x0[2], x0[3]); o.z = pack2(x1[0], x1[1]); o.w = pack2(x1[2], x1[3]); *(uint4*)(Rt + pr * 72 + n8) = o; }
    __syncthreads();
    if (hh < 7) m3_issue<MIXER>(p, b, c, hh + 1, R);
    const int nks = (w >> 1) + 1;
    const int lrow = 16 * w + (lane >> 4) * 4;
    unsigned short gate[4][4];
#pragma unroll
    for (int nt = 0; nt < 4; ++nt)
#pragma unroll
        for (int j = 0; j < 4; ++j) gate[nt][j] = H[((size_t)b * SEQ + t0 + lrow + j) * HS + (MIXER == 0 ? 0 : 2824) + hh * 64 + nt * 16 + (lane & 15)];
    {
        const bf16x8 q0 = ldfrag(Qs, 16 * w, 72, 0, lane), q1 = ldfrag(Qs, 16 * w, 72, 32, lane);
        float al[4];
#pragma unroll
        for (int j = 0; j < 4; ++j) al[j] = acs[lrow + j];
        for (int nt = 0; nt < 2 * nks; ++nt) { f32x4 sacc = {0.f, 0.f, 0.f, 0.f};
            sacc = MFMA16(q0, ldfrag(Ks, nt * 16, 72, 0, lane), sacc); sacc = MFMA16(q1, ldfrag(Ks, nt * 16, 72, 32, lane), sacc);
            const int s = nt * 16 + (lane & 15); const float as = acs[s], ds = dts[s];
#pragma unroll
            for (int j = 0; j < 4; ++j) { const float pv = (s <= lrow + j) ? sacc[j] * __expf(al[j] - as) * ds : 0.f; Ps[(lrow + j) * 136 + s] = f2bf(pv); } }
    }
    __syncthreads();
    f32x4 yd[4], yo[4];
#pragma unroll
    for (int nt = 0; nt < 4; ++nt) { yd[nt] = (f32x4){0.f, 0.f, 0.f, 0.f}; yo[nt] = (f32x4){0.f, 0.f, 0.f, 0.f}; }
    for (int ks = 0; ks < nks; ++ks) { const bf16x8 pf = ldfrag(Ps, 16 * w, 136, ks * 32, lane);
#pragma unroll
        for (int nt = 0; nt < 4; ++nt) yd[nt] = MFMA16(pf, ldfrag(Vt, nt * 16, 136, ks * 32, lane), yd[nt]); }
#pragma unroll
    for (int ks = 0; ks < 2; ++ks) { const bf16x8 qf = ldfrag(Qs, 16 * w, 72, ks * 32, lane);
#pragma unroll
        for (int nt = 0; nt < 4; ++nt) yo[nt] = MFMA16(qf, ldfrag(Rt, nt * 16, 72, ks * 32, lane), yo[nt]); }
    float ea[4];
#pragma unroll
    for (int j = 0; j < 4; ++j) ea[j] = __expf(acs[lrow + j]);
    if (MIXER == 0) {
        const float dsk = p.ev_d[hh];
#pragma unroll
        for (int nt = 0; nt < 4; ++nt) { const int pc = nt * 16 + (lane & 15);
#pragma unroll
            for (int j = 0; j < 4; ++j) { const size_t r = (size_t)b * SEQ + t0 + lrow + j;
                const float y = yd[nt][j] + ea[j] * yo[nt][j] + dsk * bf2f(Vt[pc * 136 + lrow + j]);
                const float z = bf2f(gate[nt][j]); const float yg = y * silu_(z); ssq[j] += yg * yg; YG[r * 512 + hh * 64 + pc] = yg; } }
    } else {
        float s2[4];
#pragma unroll
        for (int j = 0; j < 4; ++j) { float a = 0.f;
#pragma unroll
            for (int nt = 0; nt < 4; ++nt) { const float y = yd[nt][j] + ea[j] * yo[nt][j]; yd[nt][j] = y; a += y * y; }
            s2[j] = rsqrtf(red16(a) * (1.f / 64.f) + 1e-6f); }
#pragma unroll
        for (int nt = 0; nt < 4; ++nt) { const int pc = nt * 16 + (lane & 15); const float nw = p.ev_ret_norm_w[hh * 64 + pc];
#pragma unroll
            for (int j = 0; j < 4; ++j) { const size_t r = (size_t)b * SEQ + t0 + lrow + j; const float g = bf2f(gate[nt][j]);
                Y[r * DM + 512 + hh * 64 + pc] = f2bf(silu_(g) * yd[nt][j] * s2[j] * nw); } }
    }
}
DI void phase_m3(const Params& p, unsigned char* smem) {
    const int lane = otid() & 63, w = otid() >> 6;
    for (int u = obid(); u < 256; u += gridDim.x) {
        const int mixer = u >> 7, b = (u >> 6) & 1, c = u & 63; float ssq[4] = {0.f, 0.f, 0.f, 0.f};
        if (mixer == 0) {
            M3Pre R; m3_issue<0>(p, b, c, 0, R);
            for (int hh = 0; hh < 8; ++hh) m3_head<0>(p, smem, b, c, hh, ssq, R);
            float* YG = (float*)(p.ws + O_YG); bf16_t* Y = (bf16_t*)(p.ws + O_XN); const int lrow = 16 * w + (lane >> 4) * 4;
            float rstd[4];
#pragma unroll
            for (int j = 0; j < 4; ++j) rstd[j] = rsqrtf(red16(ssq[j]) * (1.f / 512.f) + 1e-6f);
            for (int cc = 0; cc < 32; ++cc) { const int col = cc * 16 + (lane & 15); const float nw = p.ev_ssd_norm_w[col];
#pragma unroll
                for (int j = 0; j < 4; ++j) { const size_t r = (size_t)b * SEQ + c * 128 + lrow + j;
                    const float v = __hip_atomic_load(YG + r * 512 + col, __ATOMIC_RELAXED, __HIP_MEMORY_SCOPE_AGENT); Y[r * DM + col] = f2bf(v * rstd[j] * nw); } }
        } else {
            M3Pre R; m3_issue<1>(p, b, c, 0, R);
            for (int hh = 0; hh < 8; ++hh) m3_head<1>(p, smem, b, c, hh, ssq, R);
        }
    }
}
DI void phase_ffn_fix(const Params& p, int layer) {
    const bf16_t* GC = (const bf16_t*)(p.ws + O_G); bf16_t* U = (bf16_t*)(p.ws + O_U);
    const float* cw = p.ffn_conv_w + (size_t)layer * 3 * DFF; const float* cb = p.ffn_conv_b + (size_t)layer * DFF;
    for (int idx = obid() * 512 + otid(); idx < 256 * 2 * (DFF / 8); idx += gridDim.x * 512) {
        const int c8 = (idx % (DFF / 8)) * 8, ri = idx / (DFF / 8), k = ri >> 1, i = ri & 1, r = k * 64 + i, t = r & (SEQ - 1);
        const int kp = k > 0 ? k - 1 : 0;
        const bf16_t* s0 = GC + ((size_t)kp * 4 + (i == 0 ? 0 : 1)) * DFF + c8;
        const bf16_t* s1 = i == 0 ? GC + ((size_t)kp * 4 + 1) * DFF + c8 : GC + ((size_t)k * 4 + 2) * DFF + c8;
        const bf16_t* s2 = GC + ((size_t)k * 4 + 2 + i) * DFF + c8;
        const float m0 = (t - 2 >= 0) ? 1.f : 0.f, m1 = (t - 1 >= 0) ? 1.f : 0.f;
        const uint4 r0 = *(const uint4*)s0, r1 = *(const uint4*)s1, r2 = *(const uint4*)s2, ru = *(const uint4*)(U + (size_t)r * DFF + c8);
        float acc[8], g[8], uv[8];
        { const f32x4 b0 = *(const f32x4*)(cb + c8), b1 = *(const f32x4*)(cb + c8 + 4); acc[0] = b0[0]; acc[1] = b0[1]; acc[2] = b0[2]; acc[3] = b0[3]; acc[4] = b1[0]; acc[5] = b1[1]; acc[6] = b1[2]; acc[7] = b1[3]; }
#define FIX_TAP(kk, raw, msk) { unpack8(raw, g); const f32x4 w0 = *(const f32x4*)(cw + (kk) * DFF + c8) * (msk), w1 = *(const f32x4*)(cw + (kk) * DFF + c8 + 4) * (msk); \
            acc[0] += w0[0] * g[0]; acc[1] += w0[1] * g[1]; acc[2] += w0[2] * g[2]; acc[3] += w0[3] * g[3]; acc[4] += w1[0] * g[4]; acc[5] += w1[1] * g[5]; acc[6] += w1[2] * g[6]; acc[7] += w1[3] * g[7]; }
        FIX_TAP(0, r0, m0) FIX_TAP(1, r1, m1) FIX_TAP(2, r2, 1.f)
        unpack8(ru, uv);
#pragma unroll
        for (int e2 = 0; e2 < 8; ++e2) acc[e2] = silu_(acc[e2]) * uv[e2];
        *(uint4*)(U + (size_t)r * DFF + c8) = pack8(acc);
    }
}
DI void phase_l1_prep(const Params& p, unsigned char* smem) {
    const bf16_t* H = (const bf16_t*)(p.ws + O_H); const float* aux = (const float*)(p.ws + O_AUX); float* FC = (float*)(p.ws + O_FC);
    bf16_t* KN = (bf16_t*)(p.ws + O_KN); bf16_t* VT = (bf16_t*)(p.ws + O_VT); bf16_t* AP = (bf16_t*)(p.ws + O_AP);
    const int tid = otid();
    for (int u = obid(); u < 16 + 1024; u += gridDim.x) {
        __syncthreads();
        if (u < 16) {
            float* tot = (float*)smem; const int bh = u, b = bh >> 3, hh = bh & 7; const float fb = p.od_f_bias[hh]; float loc[16]; float run = 0.f;
#pragma unroll
            for (int i = 0; i < 16; ++i) { const float xv = aux[((size_t)b * SEQ + tid * 16 + i) * 8 + hh] + fb; run += -softplus_(-xv); loc[i] = run; }
            tot[tid] = run; __syncthreads();
            float off = 0.f; for (int i = 0; i < tid; ++i) off += tot[i];
#pragma unroll
            for (int i = 0; i < 16; ++i) FC[(size_t)bh * SEQ + tid * 16 + i] = off + loc[i];
        } else {
            bf16_t* Vl = (bf16_t*)smem; const int v2 = u - 16, bh = v2 >> 6, blk = v2 & 63, b = bh >> 3, hh = bh & 7, t0 = blk * 128;
            { const int l = tid >> 2, c16 = (tid & 3) * 16; const size_t r = (size_t)b * SEQ + t0 + l; float a[8], c[8];
              unpack8(*(const uint4*)(H + r * HS + 2304 + hh * 64 + c16), a); unpack8(*(const uint4*)(H + r * HS + 2304 + hh * 64 + c16 + 8), c);
              float ss = 0.f;
#pragma unroll
              for (int e = 0; e < 8; ++e) ss += a[e] * a[e] + c[e] * c[e];
              ss += __shfl_xor(ss, 1); ss += __shfl_xor(ss, 2); const float rstd = rsqrtf(ss * (1.f / 64.f) + 1e-6f);
#pragma unroll
              for (int e = 0; e < 8; ++e) { a[e] *= rstd * p.od_kn_w[c16 + e]; c[e] *= rstd * p.od_kn_w[c16 + 8 + e]; }
              bf16_t* dst = KN + ((size_t)bh * SEQ + t0 + l) * 64 + c16; *(uint4*)dst = pack8(a); *(uint4*)(dst + 8) = pack8(c); }
#pragma unroll
            for (int it = 0; it < 2; ++it) { const int g = tid + it * 512, s = g >> 3, c8 = (g & 7) * 8; const size_t r = (size_t)b * SEQ + t0 + s;
                *(uint4*)(Vl + s * 72 + c8) = *(const uint4*)(H + r * HS + 2816 + hh * 64 + c8); }
            __syncthreads();
#pragma unroll
            for (int it = 0; it < 2; ++it) { const int g = tid + it * 512, e = g >> 4, s8 = (g & 15) * 8; uint4 o;
                o.x = (unsigned)Vl[(s8 + 0) * 72 + e] | ((unsigned)Vl[(s8 + 1) * 72 + e] << 16); o.y = (unsigned)Vl[(s8 + 2) * 72 + e] | ((unsigned)Vl[(s8 + 3) * 72 + e] << 16);
                o.z = (unsigned)Vl[(s8 + 4) * 72 + e] | ((unsigned)Vl[(s8 + 5) * 72 + e] << 16); o.w = (unsigned)Vl[(s8 + 6) * 72 + e] | ((unsigned)Vl[(s8 + 7) * 72 + e] << 16);
                *(uint4*)(VT + ((size_t)bh * 64 + e) * SEQ + t0 + s8) = o; }
        }
    }
    {
        float* KNRM = (float*)(p.ws + O_KNRM);
#pragma unroll 4
        for (int idx = obid() * 512 + tid; idx < TOK * 64; idx += gridDim.x * 512) {
            const int r = idx >> 6, c8 = (idx & 63) * 8, t = r & (SEQ - 1); float cur[8], prv[8]; float ss = 0.f;
            { const uint4 rc = *(const uint4*)(H + (size_t)r * HS + 512 + c8), rp = *(const uint4*)(H + (size_t)(t > 0 ? r - 1 : r) * HS + 512 + c8); const float pm = t > 0 ? 1.f : 0.f;
              unpack8(rc, cur); unpack8(rp, prv);
#pragma unroll
              for (int e = 0; e < 8; ++e) prv[e] *= pm; }
#pragma unroll
            for (int e = 0; e < 8; ++e) { const float v = (cur[e] + (prv[e] - cur[e]) * p.od_mu[512 + c8 + e]) * p.od_k_k[c8 + e]; ss += v * v; }
            ss += __shfl_xor(ss, 1); ss += __shfl_xor(ss, 2); ss += __shfl_xor(ss, 4);
            if ((idx & 7) == 0) KNRM[(size_t)r * 8 + (c8 >> 6)] = 1.f / fmaxf(sqrtf(ss), 1e-12f);
        }
    }
#pragma unroll 4
    for (int idx = obid() * 512 + tid; idx < TOK * 32; idx += gridDim.x * 512) {
        const int r = idx >> 5, j8 = (idx & 31) * 8, t = r & (SEQ - 1); float cur[8], prv[8], o[8];
        { const uint4 rc = *(const uint4*)(H + (size_t)r * HS + 1536 + j8), rp = *(const uint4*)(H + (size_t)(t > 0 ? r - 1 : r) * HS + 1536 + j8); const float pm = t > 0 ? 1.f : 0.f;
          unpack8(rc, cur); unpack8(rp, prv);
#pragma unroll
          for (int e = 0; e < 8; ++e) prv[e] *= pm; }
#pragma unroll
        for (int e = 0; e < 8; ++e) { const float v = cur[e] + (prv[e] - cur[e]) * p.od_mu[1536 + j8 + e];
            o[e] = (j8 < 64) ? tanhf(v) : ((j8 < 128) ? v : sigm_(v)); }
        *(uint4*)(AP + (size_t)r * 256 + j8) = pack8(o);
    }
}
DI void fox_unit(const Params& p, unsigned char* smem, int bh, int qb) {
    bf16_t* Qs = (bf16_t*)smem; bf16_t* Ks = (bf16_t*)(smem + 18432); bf16_t* Vts = (bf16_t*)(smem + 36864); float* ck = (float*)(smem + 89600);
    const bf16_t* H = (const bf16_t*)(p.ws + O_H); const float* FC = (const float*)(p.ws + O_FC); const bf16_t* KN = (const bf16_t*)(p.ws + O_KN); const bf16_t* VT = (const bf16_t*)(p.ws + O_VT);
    bf16_t* Y = (bf16_t*)(p.ws + O_XN);
    const int tid = otid(), lane = tid & 63, w = tid >> 6, b = bh >> 3, hh = bh & 7; const size_t r0 = (size_t)b * SEQ + qb * 128;
    const float LOG2E = 1.4426950408889634f;
    __syncthreads();
    { const int l = tid >> 2, c16 = (tid & 3) * 16; float a[8], c[8];
      unpack8(*(const uint4*)(H + (r0 + l) * HS + 1792 + hh * 64 + c16), a); unpack8(*(const uint4*)(H + (r0 + l) * HS + 1792 + hh * 64 + c16 + 8), c);
      float ss = 0.f;
#pragma unroll
      for (int e = 0; e < 8; ++e) ss += a[e] * a[e] + c[e] * c[e];
      ss += __shfl_xor(ss, 1); ss += __shfl_xor(ss, 2); const float rstd = rsqrtf(ss * (1.f / 64.f) + 1e-6f) * (0.125f * LOG2E);
#pragma unroll
      for (int e = 0; e < 8; ++e) { a[e] *= rstd * p.od_qn_w[c16 + e]; c[e] *= rstd * p.od_qn_w[c16 + 8 + e]; }
      *(uint4*)(Qs + l * 72 + c16) = pack8(a); *(uint4*)(Qs + l * 72 + c16 + 8) = pack8(c); }
    float mrow = -1e30f, lsum = 0.f; f32x4 O[4];
#pragma unroll
    for (int j = 0; j < 4; ++j) O[j] = (f32x4){0.f, 0.f, 0.f, 0.f};
    const int q4 = (lane >> 4) * 4, lq = 16 * w + (lane & 15);
    uint4 kreg0, kreg1, vreg0, vreg1; float ckreg = 0.f;
    const int g0 = tid, g1 = tid + 512;
#define FOX_ISSUE(kb_) { \
        kreg0 = *(const uint4*)(KN + ((size_t)bh * SEQ + (kb_) * 128 + (g0 >> 3)) * 64 + (g0 & 7) * 8); \
        kreg1 = *(const uint4*)(KN + ((size_t)bh * SEQ + (kb_) * 128 + (g1 >> 3)) * 64 + (g1 & 7) * 8); \
        vreg0 = *(const uint4*)(VT + ((size_t)bh * 64 + (g0 >> 4)) * SEQ + (kb_) * 128 + (g0 & 15) * 8); \
        vreg1 = *(const uint4*)(VT + ((size_t)bh * 64 + (g1 >> 4)) * SEQ + (kb_) * 128 + (g1 & 15) * 8); \
        if (tid < 128) ckreg = FC[(size_t)bh * SEQ + (kb_) * 128 + tid]; }
    FOX_ISSUE(0)
    for (int kb = 0; kb <= qb; ++kb) {
        __syncthreads();
        *(uint4*)(Ks + (g0 >> 3) * 72 + (g0 & 7) * 8) = kreg0; *(uint4*)(Ks + (g1 >> 3) * 72 + (g1 & 7) * 8) = kreg1;
        *(uint4*)(Vts + (g0 >> 4) * 136 + (g0 & 15) * 8) = vreg0; *(uint4*)(Vts + (g1 >> 4) * 136 + (g1 & 15) * 8) = vreg1;
        if (tid < 128) ck[tid] = -ckreg * LOG2E;
        __syncthreads();
        if (kb < qb) FOX_ISSUE(kb + 1)
        f32x4 S[8];
        { const bf16x8 q0 = ldfrag(Qs, 16 * w, 72, 0, lane), q1 = ldfrag(Qs, 16 * w, 72, 32, lane);
#pragma unroll
          for (int nt = 0; nt < 8; ++nt) { f32x4 z = *(const f32x4*)(ck + nt * 16 + q4); z = MFMA16(ldfrag(Ks, nt * 16, 72, 0, lane), q0, z); S[nt] = MFMA16(ldfrag(Ks, nt * 16, 72, 32, lane), q1, z); } }
        if (kb == qb) {
#pragma unroll
            for (int nt = 0; nt < 8; ++nt)
#pragma unroll
                for (int j = 0; j < 4; ++j) if (nt * 16 + q4 + j > lq) S[nt][j] = -1e30f;
        }
        float mx = S[0][0];
#pragma unroll
        for (int nt = 0; nt < 8; ++nt)
#pragma unroll
            for (int j = 0; j < 4; ++j) mx = fmaxf(mx, S[nt][j]);
        mx = fmaxf(mx, __shfl_xor(mx, 16)); mx = fmaxf(mx, __shfl_xor(mx, 32));
        const float mnew = fmaxf(mrow, mx); const float alpha = __builtin_amdgcn_exp2f(mrow - mnew); mrow = mnew;
        float rs = 0.f;
#pragma unroll
        for (int nt = 0; nt < 8; ++nt)
#pragma unroll
            for (int j = 0; j < 4; ++j) { const float pv = __builtin_amdgcn_exp2f(S[nt][j] - mnew); S[nt][j] = pv; rs += pv; }
        lsum = lsum * alpha + rs;
#pragma unroll
        for (int et = 0; et < 4; ++et) O[et] = O[et] * alpha;
#pragma unroll
        for (int ks = 0; ks < 4; ++ks) {
            uint4 pw; pw.x = cvt_pk_bf16(S[2 * ks][0], S[2 * ks][1]); pw.y = cvt_pk_bf16(S[2 * ks][2], S[2 * ks][3]); pw.z = cvt_pk_bf16(S[2 * ks + 1][0], S[2 * ks + 1][1]); pw.w = cvt_pk_bf16(S[2 * ks + 1][2], S[2 * ks + 1][3]);
            const bf16x8 pf = __builtin_bit_cast(bf16x8, pw);
#pragma unroll
            for (int et = 0; et < 4; ++et) { const bf16_t* vp = Vts + (et * 16 + (lane & 15)) * 136 + ks * 32 + q4;
                uint4 vw; const uint2 lo = *(const uint2*)vp, hi = *(const uint2*)(vp + 16); vw.x = lo.x; vw.y = lo.y; vw.z = hi.x; vw.w = hi.y;
                O[et] = MFMA16(__builtin_bit_cast(bf16x8, vw), pf, O[et]); }
        }
    }
    lsum += __shfl_xor(lsum, 16); lsum += __shfl_xor(lsum, 32);
    const float inv = 1.f / lsum;
#pragma unroll
    for (int et = 0; et < 4; ++et) { uint2 o; o.x = pack2(O[et][0] * inv, O[et][1] * inv); o.y = pack2(O[et][2] * inv, O[et][3] * inv);
        *(uint2*)(Y + (r0 + lq) * DM + 512 + hh * 64 + et * 16 + q4) = o; }
}
constexpr int RW_T = 32, RW_BUF = 43008;
struct RwRegs { unsigned short r[9], k[9], v[9], om[8], a[8]; float kn[8]; };
#define RW_BAR() do { asm volatile("s_waitcnt lgkmcnt(0)" ::: "memory"); __builtin_amdgcn_s_barrier(); asm volatile("" ::: "memory"); } while (0)
DI void rwkv_unit(const Params& p, unsigned char* smem, int bh, int rg) {
    const bf16_t* H = (const bf16_t*)(p.ws + O_H); const bf16_t* LW = (const bf16_t*)(p.ws + O_LW); bf16_t* Y = (bf16_t*)(p.ws + O_XN); const float* KNRM = (const float*)(p.ws + O_KNRM);
    const int tid = otid(), lane = tid & 63, w = tid >> 6, b = bh >> 3, hh = bh & 7; const size_t rb = (size_t)b * SEQ;
    float* ysh = (float*)(smem + 2 * RW_BUF);
    const int NCH = SEQ / RW_T;
    __syncthreads();
    if (w < 2) {
        float S0 = 0.f, S1 = 0.f, S2 = 0.f, S3 = 0.f; const int kq = lane & 15, row = w * 4 + (lane >> 4);
        RW_BAR();
        for (int ch = 0; ch < NCH; ++ch) {
            const float* bufp = (const float*)(smem + (ch & 1) * RW_BUF) + kq * 4; const float* vp = (const float*)(smem + (ch & 1) * RW_BUF) + 10240 + row; float* yo = ysh + (ch & 1) * 256 + row;
#define RW_LOAD(R, W, K, Q, B, V, tt) { R = *(const f32x4*)(bufp + (tt) * 64); W = *(const f32x4*)(bufp + 2048 + (tt) * 64); K = *(const f32x4*)(bufp + 4096 + (tt) * 64); \
                Q = *(const f32x4*)(bufp + 6144 + (tt) * 64); B = *(const f32x4*)(bufp + 8192 + (tt) * 64); V = vp[(tt) * 8]; }
#define DPPF(x, ctrl) __builtin_bit_cast(float, __builtin_amdgcn_update_dpp(0, __builtin_bit_cast(int, (x)), (ctrl), 0xF, 0xF, true))
            f32x4 prevR = {0.f, 0.f, 0.f, 0.f}; float yacc = 0.f;
            f32x4 rN, wN, kN, qN, bN; float vN;
            RW_LOAD(rN, wN, kN, qN, bN, vN, 0)
            __builtin_amdgcn_sched_barrier(0);
#pragma unroll
            for (int tt = 0; tt < RW_T; ++tt) {
                const f32x4 R = rN, W = wN, K = kN, Q = qN, B = bN; const float V = vN;
                if (tt + 1 < RW_T) RW_LOAD(rN, wN, kN, qN, bN, vN, tt + 1)
                float d = S0 * Q[0] + S1 * Q[1] + S2 * Q[2] + S3 * Q[3];
                if (tt > 0) {
                    float y = S0 * prevR[0] + S1 * prevR[1] + S2 * prevR[2] + S3 * prevR[3];
                    d += DPPF(d, 0xB1); y += DPPF(y, 0xB1); d += DPPF(d, 0x4E); y += DPPF(y, 0x4E); d += DPPF(d, 0x141); y += DPPF(y, 0x141); d += DPPF(d, 0x140); y += DPPF(y, 0x140);
                    yacc = (kq == ((tt - 1) & 15)) ? y : yacc;
                    if (tt == 16) yo[kq * 8] = yacc;
                } else d = dpp_red16(d);
                const float sa = -d;
                S0 = (S0 * W[0] + V * K[0]) + sa * B[0]; S1 = (S1 * W[1] + V * K[1]) + sa * B[1]; S2 = (S2 * W[2] + V * K[2]) + sa * B[2]; S3 = (S3 * W[3] + V * K[3]) + sa * B[3];
                prevR = R;
                if (tt & 1) __builtin_amdgcn_sched_barrier(0);
            }
            { float y = S0 * prevR[0] + S1 * prevR[1] + S2 * prevR[2] + S3 * prevR[3]; y = dpp_red16(y); yacc = (kq == 15) ? y : yacc; yo[(16 + kq) * 8] = yacc; }
            RW_BAR();
        }
    } else if (w == 4 || w == 5) {
        const unsigned* ta0; const unsigned* ta1; const unsigned* ta2; size_t st0, st1, st2;
        { int L = lane; int tok = L / 5, which = L - tok * 5; ta0 = (const unsigned*)(which < 3 ? H + (rb + tok) * HS + which * 512 + hh * 64 : LW + (rb + tok) * 1536 + (which - 3) * 512 + hh * 64); st0 = which < 3 ? (size_t)HS * 2 : (size_t)1536 * 2;
          L = lane + 64; tok = L / 5; which = L - tok * 5; ta1 = (const unsigned*)(which < 3 ? H + (rb + tok) * HS + which * 512 + hh * 64 : LW + (rb + tok) * 1536 + (which - 3) * 512 + hh * 64); st1 = which < 3 ? (size_t)HS * 2 : (size_t)1536 * 2;
          L = lane + 128 > 159 ? 159 : lane + 128; tok = L / 5; which = L - tok * 5; ta2 = (const unsigned*)(which < 3 ? H + (rb + tok) * HS + which * 512 + hh * 64 : LW + (rb + tok) * 1536 + (which - 3) * 512 + hh * 64); st2 = which < 3 ? (size_t)HS * 2 : (size_t)1536 * 2; }
        unsigned x0 = 0, x1 = 0, x2 = 0, y0 = 0, y1 = 0, y2 = 0, z0 = 0, z1 = 0, z2 = 0, pacc = 0;
        RW_BAR();
        for (int ch = 0; ch < NCH; ++ch) {
            if (w == 4) { int cc = ch + 6; cc = cc > NCH - 1 ? NCH - 1 : cc; const size_t tb = (size_t)cc * RW_T;
                pacc ^= x0 ^ x1 ^ x2; x0 = y0; x1 = y1; x2 = y2; y0 = z0; y1 = z1; y2 = z2;
                z0 = *(const unsigned*)((const char*)ta0 + tb * st0); z1 = *(const unsigned*)((const char*)ta1 + tb * st1); z2 = *(const unsigned*)((const char*)ta2 + tb * st2); }
            RW_BAR();
        }
        pacc ^= x0 ^ x1 ^ x2 ^ y0 ^ y1 ^ y2 ^ z0 ^ z1 ^ z2; if (pacc == 0x9e3779b9u && rg == 77) Y[0] = 0;
    } else {
        const int lw = (w & 1) + ((w >> 2) << 1), col = hh * 64 + lane; RwRegs ra;
        const float mur = p.od_mu[col], muk = p.od_mu[512 + col], muv = p.od_mu[1024 + col], kk_w = p.od_k_k[col], ka_w = p.od_k_a[col];
        auto issue = [&](int ch, RwRegs& rr) {
            const int tbase = ch * RW_T + lw * 8;
#pragma unroll
            for (int i = 0; i < 9; ++i) { const int t = tbase + i - 1;
                if (t >= 0) { const bf16_t* hp = H + (rb + t) * HS; rr.r[i] = hp[col]; rr.k[i] = hp[512 + col]; rr.v[i] = hp[1024 + col]; } else { rr.r[i] = 0; rr.k[i] = 0; rr.v[i] = 0; }
                if (i > 0) { const bf16_t* lp = LW + (rb + t) * 1536; rr.om[i - 1] = lp[col]; rr.a[i - 1] = lp[512 + col]; rr.kn[i - 1] = KNRM[(rb + t) * 8 + hh]; } }
        };
        auto process = [&](int ch, const RwRegs& rr) {
            float* bufp = (float*)(smem + (ch & 1) * RW_BUF);
#pragma unroll
            for (int i = 1; i < 9; ++i) { const int tt = lw * 8 + i - 1;
                const float rc = bf2f(rr.r[i]), rp = bf2f(rr.r[i - 1]), kc = bf2f(rr.k[i]), kp = bf2f(rr.k[i - 1]), vc = bf2f(rr.v[i]), vp = bf2f(rr.v[i - 1]);
                const float rl = rc + (rp - rc) * mur, kl = kc + (kp - kc) * muk, vl = vc + (vp - vc) * muv; const float a = bf2f(rr.a[i - 1]), wv = 1.f - bf2f(rr.om[i - 1]);
                const float kk = kl * kk_w * rr.kn[i - 1];
                bufp[tt * 64 + lane] = rl; bufp[2048 + tt * 64 + lane] = wv; bufp[4096 + tt * 64 + lane] = kl * (1.f + (a - 1.f) * ka_w); bufp[6144 + tt * 64 + lane] = kk; bufp[8192 + tt * 64 + lane] = kk * a;
                if ((lane >> 3) == rg) bufp[10240 + tt * 8 + (lane & 7)] = vl; }
        };
        issue(0, ra); process(0, ra); issue(1, ra);
        RW_BAR();
        for (int ch = 0; ch < NCH; ++ch) {
            if (ch + 1 < NCH) { process(ch + 1, ra); if (ch + 2 < NCH) issue(ch + 2, ra); }
            if (ch > 0 && lw < 2) { const float* yi = ysh + ((ch - 1) & 1) * 256; const int t2 = lw * 64 + lane, tt = t2 >> 2, pr = (t2 & 3) * 2;
                *(unsigned*)(Y + (rb + (ch - 1) * RW_T + tt) * DM + hh * 64 + rg * 8 + pr) = pack2(yi[tt * 8 + pr], yi[tt * 8 + pr + 1]); }
            RW_BAR();
        }
        if (lw < 2) { const float* yi = ysh + ((NCH - 1) & 1) * 256; const int t2 = lw * 64 + lane, tt = t2 >> 2, pr = (t2 & 3) * 2;
          *(unsigned*)(Y + (rb + (NCH - 1) * RW_T + tt) * DM + hh * 64 + rg * 8 + pr) = pack2(yi[tt * 8 + pr], yi[tt * 8 + pr + 1]); }
    }
    __syncthreads();
}
DI void phase_l1_mix(const Params& p, unsigned char* smem, int pass) {
    unsigned* ctr = (unsigned*)(p.ws + O_CTL) + pass * 4; int* sh = (int*)(smem + 90112);
    if (obid() < 128 && pass != 2) rwkv_unit(p, smem, obid() >> 3, obid() & 7);
    for (;;) {
        __syncthreads(); if (otid() == 0) *sh = (int)atomicAdd(ctr, 1u); __syncthreads();
        const int u = *sh; if (u >= 1024) break;
        fox_unit(p, smem, u & 15, 63 - (u >> 4));
    }
}
DI void phase_rwkv_fin(const Params& p) {
    const bf16_t* H = (const bf16_t*)(p.ws + O_H); const bf16_t* LW = (const bf16_t*)(p.ws + O_LW); bf16_t* Y = (bf16_t*)(p.ws + O_XN);
    const int lane = otid() & 63, wv = otid() >> 6;
#pragma unroll 4
    for (int task = obid() * 8 + wv; task < TOK * 8; task += gridDim.x * 8) {
        const int r = task >> 3, hh = task & 7, t = r & (SEQ - 1), col = hh * 64 + lane; const bf16_t* hp = H + (size_t)r * HS;
        const float y = bf2f(Y[(size_t)r * DM + col]); const float mean = red64(y) * (1.f / 64.f); const float dy = y - mean; const float var = red64(dy * dy) * (1.f / 64.f);
        const float yln = dy * rsqrtf(var + 64e-5f) * p.od_ln_w[col] + p.od_ln_b[col];
        const bf16_t* hq = t > 0 ? hp - HS : hp; const float pm = t > 0 ? 1.f : 0.f;
        const float rc = bf2f(hp[col]), kc = bf2f(hp[512 + col]), vc = bf2f(hp[1024 + col]); const float rp = bf2f(hq[col]) * pm, kp = bf2f(hq[512 + col]) * pm, vp = bf2f(hq[1024 + col]) * pm;
        const float rl = rc + (rp - rc) * p.od_mu[col], kl = kc + (kp - kc) * p.od_mu[512 + col], vl = vc + (vp - vc) * p.od_mu[1024 + col];
        const float a = bf2f(LW[(size_t)r * 1536 + 512 + col]), g = bf2f(LW[(size_t)r * 1536 + 1024 + col]);
        const float kt = kl * (1.f + (a - 1.f) * p.od_k_a[col]); const float bonus = red64(rl * kt * p.od_r_k[col]) * vl;
        Y[(size_t)r * DM + col] = f2bf((yln + bonus) * g);
    }
}
#define XB_TMO      128
#define XB_XCNT(j)  (256  + 64 * (j))
#define XB_XSUB(j)  (1280 + 64 * (j))
#define XB_XGEN(j)  (2304 + 64 * (j))
#define XB_TOP      3328
#define XB_TOPGEN   3392
#define XCD_BAR_WORDS 3456
#define XB_SPIN_CAP (1u << 18)
#define LAS __attribute__((address_space(3)))

__device__ __forceinline__ unsigned xb_ld(unsigned* p)              { return __hip_atomic_load(p, __ATOMIC_RELAXED, __HIP_MEMORY_SCOPE_AGENT); }
__device__ __forceinline__ unsigned xb_add(unsigned* p, unsigned v) { return __hip_atomic_fetch_add(p, v, __ATOMIC_RELAXED, __HIP_MEMORY_SCOPE_AGENT); }
__device__ __forceinline__ unsigned xb_xcc_id() { return (unsigned)__builtin_amdgcn_s_getreg((3 << 11) | 20) & 0xFu; }
#define XB_SPIN(cond, bar) do { unsigned _sp = 0; while (cond) { __builtin_amdgcn_s_sleep(1); \
    if ((++_sp & 255u) == 0u) { if (xb_ld(&(bar)[XB_TMO])) break; if (_sp > XB_SPIN_CAP) { atomicAdd(&(bar)[XB_TMO], 1u); break; } } } } while (0)

struct XcdBarrier {
    unsigned* bar; unsigned x;
    volatile LAS unsigned* st;
};

__device__ __forceinline__ XcdBarrier xcd_barrier_post(unsigned* bar, volatile LAS unsigned* st) {
    XcdBarrier b; b.bar = bar; b.x = xb_xcc_id(); b.st = st;
    if (threadIdx.x == 0) (void)xb_add(&bar[XB_XCNT(b.x)], 1u);
    return b;
}
__device__ __forceinline__ void xcd_barrier_complete(unsigned* bar, unsigned x, unsigned& nloc, unsigned& nx) {
    const unsigned G = gridDim.x * gridDim.y * gridDim.z;
    unsigned sum, cnt, mine, sp = 0u;
    for (;;) {
        sum = 0u; cnt = 0u; mine = 0u;
#pragma unroll
        for (unsigned j = 0; j < 16; ++j) { const unsigned c = xb_ld(&bar[XB_XCNT(j)]); sum += c; cnt += (c > 0u) ? 1u : 0u; mine = (j == x) ? c : mine; }
        if (sum == G) break;
        __builtin_amdgcn_s_sleep(1);
        if ((++sp & 255u) == 0u) { if (xb_ld(&bar[XB_TMO])) break; if (sp > XB_SPIN_CAP) { atomicAdd(&bar[XB_TMO], 1u); break; } }
    }
    nloc = mine > 0u ? mine : 1u; nx = cnt > 0u ? cnt : 1u;
}

__device__ __forceinline__ void xcd_barrier(const XcdBarrier& b) {
    asm volatile("s_waitcnt vmcnt(0)" ::: "memory");
    __syncthreads();
    if (threadIdx.x == 0) {
        unsigned* bar = b.bar;
        __builtin_amdgcn_s_waitcnt(0);
        unsigned nloc = b.st[0], nx = b.st[1];
        if (nloc == 0u) { xcd_barrier_complete(bar, b.x, nloc, nx); b.st[0] = nloc; b.st[1] = nx; }
        const unsigned old = xb_add(&bar[XB_XSUB(b.x)], 1u);
        const unsigned gen = old / nloc;
        if (old + 1u == (gen + 1u) * nloc) {
            __builtin_amdgcn_fence(__ATOMIC_RELEASE, "agent");
            asm volatile("s_waitcnt vmcnt(0)" ::: "memory");
            const unsigned og = xb_add(&bar[XB_TOP], 1u);
            const unsigned tg = og / nx;
            if (og + 1u == (tg + 1u) * nx) xb_add(&bar[XB_TOPGEN], 1u);
            else XB_SPIN(xb_ld(&bar[XB_TOPGEN]) == tg, bar);
            __builtin_amdgcn_fence(__ATOMIC_ACQUIRE, "agent");
            xb_add(&bar[XB_XGEN(b.x)], 1u);
            asm volatile("s_waitcnt vmcnt(0)" ::: "memory");
        } else {
            XB_SPIN(xb_ld(&bar[XB_XGEN(b.x)]) == gen, bar);
            __builtin_amdgcn_fence(__ATOMIC_ACQUIRE, "agent");
            asm volatile("s_waitcnt vmcnt(0)" ::: "memory");
        }
    }
    __syncthreads();
}


__global__ void __launch_bounds__(512, 2) fwd_megakernel(Params p) {
    extern __shared__ __attribute__((aligned(16))) unsigned char smem[];
    cg::grid_group grid = cg::this_grid();
    unsigned char* ws = p.ws;
    bf16_t* XN = (bf16_t*)(ws + O_XN); bf16_t* Hb = (bf16_t*)(ws + O_H); float* aux = (float*)(ws + O_AUX);
    const bf16_t* t_in = (const bf16_t*)(ws + O_WT_IN); const bf16_t* t_out = (const bf16_t*)(ws + O_WT_OUT); const bf16_t* t_up = (const bf16_t*)(ws + O_WT_UP);
    const bf16_t* t_dn = (const bf16_t*)(ws + O_WT_DN); const bf16_t* t_lr = (const bf16_t*)(ws + O_WT_LR);
    if (blockIdx.x == 0 && threadIdx.x < 16) ((unsigned*)(ws + O_CTL))[threadIdx.x] = 0u;
    if (threadIdx.x == 0) *(uint4*)(smem + 131072) = make_uint4(0u, 0u, 0u, 0u);
    __syncthreads();
    const XcdBarrier xb = xcd_barrier_post((unsigned*)(ws + O_BAR), (volatile LAS unsigned*)(smem + 131072));
#define GSYNC() xcd_barrier(xb)
#define GEMM_H(layer) { EpiH E; E.H = Hb; E.aux = aux; E.auxc = layer ? 3328 : 1280; run_gemm(smem, XN, t_in, 3584, 1024, E); }
#define GEMM_OUT(layer) { EpiRes E; E.res = layer ? p.out : p.x; E.out = p.out; run_gemm(smem, XN, t_out, 1024, 1024, E); }
#define GEMM_UP(layer) { EpiGU E; E.GC = (bf16_t*)(ws + O_G); E.U = (bf16_t*)(ws + O_U); E.cw = p.ffn_conv_w + (size_t)(layer) * 3 * DFF; E.cb = p.ffn_conv_b + (size_t)(layer) * DFF; run_gemm(smem, XN, t_up, 2 * DFF, 1024, E); }
#define GEMM_DN() { EpiRes E; E.res = p.out; E.out = p.out; run_gemm(smem, (const bf16_t*)(ws + O_U), t_dn, 1024, DFF, E); }
    phase_weights(p, smem, 0, 0); phase_rmsnorm(p.x, p.ev_norm_w, XN);
    if (p.ws == nullptr) grid.sync();
    GSYNC();
    GEMM_H(0) phase_weights(p, smem, 0, 1); GSYNC();
#if PROBE == 2
    GEMM_H(0) GSYNC();
#endif
    phase_m1(p, smem); GSYNC();
#if PROBE == 3
    phase_m1(p, smem); GSYNC();
#endif
    phase_m2(p); GSYNC();
#if PROBE == 6
    GSYNC(); GSYNC(); GSYNC(); GSYNC(); GSYNC(); GSYNC(); GSYNC(); GSYNC(); GSYNC(); GSYNC();
#endif
#if PROBE == 7
    phase_weights(p, smem, 0, 0); GSYNC(); phase_rmsnorm(p.x, p.ev_norm_w, XN); GSYNC(); phase_rmsnorm(p.x, p.ev_norm_w, XN); GSYNC();
#endif
    phase_m3(p, smem); GSYNC();
#if PROBE == 3
    phase_m3(p, smem); GSYNC();
#endif
    GEMM_OUT(0) GSYNC();
#if PROBE == 2
    GEMM_OUT(0) GSYNC();
#endif
    phase_rmsnorm(p.out, p.ffn_norm_w, XN); GSYNC();
    GEMM_UP(0) phase_weights(p, smem, 0, 2); phase_weights(p, smem, 1, 0, 128); GSYNC();
    phase_ffn_fix(p, 0); GSYNC();
    GEMM_DN() GSYNC();
    phase_rmsnorm(p.out, p.od_norm_w, XN); GSYNC();
    GEMM_H(1) phase_weights(p, smem, 1, 1); GSYNC();
    phase_l1_prep(p, smem); GSYNC();
    { EpiLR E; E.LW = (bf16_t*)(ws + O_LW); E.w0 = p.od_w0; E.a0 = p.od_a0; run_gemm(smem, (const bf16_t*)(ws + O_AP), t_lr, 1536, 256, E); } GSYNC();
    phase_l1_mix(p, smem, 0); GSYNC();
#if PROBE == 4
    phase_l1_mix(p, smem, 1); GSYNC();
#endif
#if PROBE == 5
    phase_l1_mix(p, smem, 2); GSYNC();
#endif
    phase_rwkv_fin(p); GSYNC();
    GEMM_OUT(1) GSYNC();
    phase_rmsnorm(p.out, p.ffn_norm_w + DM, XN); GSYNC();
    GEMM_UP(1) phase_weights(p, smem, 1, 2); GSYNC();
    phase_ffn_fix(p, 1); GSYNC();
    GEMM_DN()
}

extern "C" void kernel_launch(void* const* d_in, const int* in_sizes, int n_in, void* d_out, int out_size, void* d_ws, size_t ws_size, hipStream_t stream) {
    static int grid_blocks = 0;
    if (grid_blocks == 0) {
        int dev = 0, cus = 0, per_cu = 0;
        hipGetDevice(&dev); hipDeviceGetAttribute(&cus, hipDeviceAttributeMultiprocessorCount, dev);
        if (hipFuncSetAttribute((const void*)fwd_megakernel, hipFuncAttributeMaxDynamicSharedMemorySize, LDS_BYTES) != hipSuccess) fprintf(stderr, "hipFuncSetAttribute failed\n");
        hipOccupancyMaxActiveBlocksPerMultiprocessor(&per_cu, (const void*)fwd_megakernel, 512, LDS_BYTES);
        (void)hipGetLastError();
        if (per_cu < 1) fprintf(stderr, "occupancy query says %d blocks per CU\n", per_cu);
        grid_blocks = cus > 0 ? cus : 256;
        if (ws_size < WS_NEED) fprintf(stderr, "workspace too small: %zu < %zu\n", ws_size, (size_t)WS_NEED);
    }
    Params p{};
    const float** pp = (const float**)&p;
    for (int i = 0; i < 33; ++i) pp[i] = (const float*)d_in[i];
    p.out = (float*)d_out; p.ws = (unsigned char*)d_ws;
    (void)hipMemsetAsync((char*)d_ws + O_BAR, 0, 16384, stream);
    void* args[] = {&p};
    hipError_t e = hipLaunchCooperativeKernel((const void*)fwd_megakernel, dim3(grid_blocks), dim3(512), args, LDS_BYTES, stream);
    if (e != hipSuccess) fprintf(stderr, "cooperative launch failed: %s (grid %d)\n", hipGetErrorString(e), grid_blocks);
}
```

```cpp
#include <hip/hip_runtime.h>
#include <hip/hip_cooperative_groups.h>
#include <cstdio>
#ifndef PROBE
#define PROBE 0
#endif
namespace cg = cooperative_groups;
namespace pg8 {
#define PG8_LAS __attribute__((address_space(3)))
typedef unsigned short bf16_t;
typedef short bf16x8 __attribute__((ext_vector_type(8)));
typedef float f32x4 __attribute__((ext_vector_type(4)));
typedef unsigned u32x4 __attribute__((ext_vector_type(4)));
constexpr int BM = 256, BK = 64, HALF = 128, HTB = HALF * BK * 2  , STAGE_BYTES = 8 * HTB, NXCD = 8, WGM = 8;

__host__ __device__ __forceinline__ int lds_byte(int r, int c) { const int st = (r >> 4) * 2 + (c >> 5), rr = r & 15, cc = c & 31, ob = rr * 64 + cc * 2; return st * 1024 + (ob ^ (((ob >> 9) & 1) << 5)); }
__host__ __device__ __forceinline__ void stage_rc(int b, int& R, int& C) { const int st = b / 1024, sb = b % 1024, swz = sb ^ (((sb >> 9) & 1) << 5); R = (st >> 1) * 16 + swz / 64; C = (st & 1) * 32 + (swz % 64) / 2; }
__host__ __device__ __forceinline__ int perm32(int rho) { const int n = rho >> 4, i = rho & 15; return 8 * (i >> 2) + 4 * n + (i & 3); }

struct Unit { int pm, pn; };
struct Gemm { const bf16_t* A; const bf16_t* Bt; int M, N, K; };

struct StaticOrder {
    int nM, nN, nwg, G, c;
    __host__ __device__ void init(int M, int N, int G_, int c_) { nM = M / BM; nN = N / BM; nwg = nM * nN; G = G_; c = c_; }
    __host__ __device__ bool next(int i, Unit& u) const {
        const long L = (long)i * G + c; if (L >= nwg) return false;
        int wgid = (int)L; { const int q = nwg / NXCD, r = nwg % NXCD, xcd = wgid % NXCD, off = wgid / NXCD; wgid = (xcd < r ? xcd * (q + 1) : r * (q + 1) + (xcd - r) * q) + off; }
        const int nig = WGM * nN, gid = wgid / nig, fm = gid * WGM, gsz = (nM - fm) < WGM ? (nM - fm) : WGM;
        u.pm = fm + ((wgid % nig) % gsz); u.pn = (wgid % nig) / gsz; return true;
    }
    __device__ __forceinline__ void a_ready(const Unit&) const {}
    __device__ __forceinline__ void done(const Unit&) const {}
};
__device__ __forceinline__ unsigned cvt_pk_bf16(float lo, float hi) { unsigned r; asm volatile("v_cvt_pk_bf16_f32 %0, %1, %2" : "=v"(r) : "v"(lo), "v"(hi)); return r; }

template <class Epi, class Sched, bool STAMP = false>
__device__ __forceinline__ void gemm_phase(PG8_LAS unsigned char* lds, const Gemm g, const Sched& S, const Epi& E, unsigned long long* stamps) {
    int tid_ = threadIdx.x; asm volatile("" : "+v"(tid_)); const int tid = tid_, wid = __builtin_amdgcn_readfirstlane(tid >> 6), lane = tid & 63, wr = wid >> 2, wc = wid & 3, fr = lane & 15, fq = lane >> 4;
    const int K = g.K, nt = K / BK;
    int ts_lo = 0, ts_hi = 0, nts = 0; const unsigned long long rt_entry = STAMP ? (unsigned long long)wall_clock64() : 0ull;
#define PG8_STAMP() do { if (STAMP && wid == 0 && nts < 64) { const unsigned long long _c = (unsigned long long)clock64(); \
        ts_lo = (lane == nts) ? (int)(unsigned)_c : ts_lo; ts_hi = (lane == nts) ? (int)(unsigned)(_c >> 32) : ts_hi; ++nts; } } while (0)
    PG8_STAMP();
    unsigned voffA[2], voffB[2];
#pragma unroll
    for (int i = 0; i < 2; ++i) { int R, C; stage_rc(tid * 16 + i * 8192, R, C); const int Rb = Epi::PERM ? ((R & ~31) + perm32(R & 31)) : R;
        voffA[i] = (unsigned)(R * K + C) * 2u; voffB[i] = (unsigned)(Rb * K + C) * 2u; }
    const size_t kstep = (size_t)(BK * 2);
    const size_t hstep = (size_t)HALF * K * 2;
    const size_t tstep = 2 * hstep;
    const unsigned ldsw = (unsigned)wid * 1024u;
    const int aoff = lds_byte(wr * 64 + fr, fq * 8), boff = lds_byte(wc * 32 + fr, fq * 8);
#define PG8_SA(b, h) (((b) * 2 + (h)) * HTB)
#define PG8_SB(b, h) ((4 + (b) * 2 + (h)) * HTB)
#define PG8_STAGE(bufoff, gbase, voff) do { _Pragma("unroll") for (int _i = 0; _i < 2; ++_i) \
        __builtin_amdgcn_global_load_lds((const unsigned*)((const char*)(gbase) + (voff)[_i]), (PG8_LAS unsigned*)(lds + (bufoff) + ldsw + _i * 8192), 16, 0, 0); } while (0)
#define PG8_LDA(dst, b, h) do { _Pragma("unroll") for (int m = 0; m < 4; ++m) _Pragma("unroll") for (int k = 0; k < 2; ++k) dst[m][k] = *(const PG8_LAS bf16x8*)(lds + PG8_SA(b, h) + aoff + m * 2048 + k * 1024); } while (0)
#define PG8_LDB(dst, b, h) do { _Pragma("unroll") for (int n = 0; n < 2; ++n) _Pragma("unroll") for (int k = 0; k < 2; ++k) dst[n][k] = *(const PG8_LAS bf16x8*)(lds + PG8_SB(b, h) + boff + n * 2048 + k * 1024); } while (0)
#define PG8_MMA(ai, bj, At, Bt) do { __builtin_amdgcn_s_setprio(1); _Pragma("unroll") for (int m = 0; m < 4; ++m) _Pragma("unroll") for (int n = 0; n < 2; ++n) _Pragma("unroll") for (int k = 0; k < 2; ++k) \
        acc[ai][bj][m][n] = __builtin_amdgcn_mfma_f32_16x16x32_bf16(Bt[n][k], At[m][k], acc[ai][bj][m][n], 0, 0, 0); __builtin_amdgcn_s_setprio(0); } while (0)
#define PG8_WAIT_V(n) asm volatile("s_waitcnt vmcnt(" #n ")" ::: "memory")
#define PG8_WAIT_L(n) asm volatile("s_waitcnt lgkmcnt(" #n ")" ::: "memory")
#define PG8_BAR __builtin_amdgcn_s_barrier()
#define PG8_SCHED __builtin_amdgcn_sched_barrier(0)
    Unit cur, nxt; int ui = 0;
    if (!S.next(0, cur)) return;
    f32x4 acc[2][2][4][2];
#pragma unroll
    for (int a = 0; a < 2; ++a)
#pragma unroll
        for (int b = 0; b < 2; ++b)
#pragma unroll
            for (int m = 0; m < 4; ++m)
#pragma unroll
                for (int n = 0; n < 2; ++n) acc[a][b][m][n] = (f32x4){0.f, 0.f, 0.f, 0.f};
    bf16x8 At[4][2], B0[2][2], B1[2][2];
    const char* cA = (const char*)g.A + (size_t)cur.pm * tstep; const char* cB = (const char*)g.Bt + (size_t)cur.pn * tstep;
    S.a_ready(cur);
    PG8_STAGE(PG8_SB(0, 0), cB, voffB); PG8_STAGE(PG8_SA(0, 0), cA, voffA); PG8_STAGE(PG8_SB(0, 1), cB + hstep, voffB); PG8_STAGE(PG8_SA(0, 1), cA + hstep, voffA);
    if (wr == 1) PG8_BAR;
    PG8_WAIT_V(4); PG8_BAR;
    PG8_STAGE(PG8_SB(1, 0), cB + kstep, voffB); PG8_STAGE(PG8_SA(1, 0), cA + kstep, voffA); PG8_STAGE(PG8_SB(1, 1), cB + hstep + kstep, voffB);
    PG8_WAIT_V(6); PG8_BAR;
    PG8_STAMP();
    for (;;) {
        const bool has_next = S.next(ui + 1, nxt);
        const char* nA = has_next ? (const char*)g.A + (size_t)nxt.pm * tstep : cA; const char* nB = has_next ? (const char*)g.Bt + (size_t)nxt.pn * tstep : cB;
        for (int t = 0; t < nt; t += 2) {
            const bool last = (t == nt - 2);
            const char* a1 = cA + (size_t)(t + 1) * kstep;
            const char* a2 = last ? nA : cA + (size_t)(t + 2) * kstep; const char* b2 = last ? nB : cB + (size_t)(t + 2) * kstep;
            const char* a3 = a2 + kstep; const char* b3 = b2 + kstep;
            if (last && has_next) S.a_ready(nxt);
            PG8_LDB(B0, 0, 0); PG8_SCHED; PG8_LDA(At, 0, 0); PG8_STAGE(PG8_SA(1, 1), a1 + hstep, voffA);
            PG8_WAIT_L(8); PG8_BAR; PG8_WAIT_L(0); PG8_MMA(0, 0, At, B0); PG8_BAR; PG8_SCHED;
            PG8_LDB(B1, 0, 1); PG8_STAGE(PG8_SB(0, 0), b2, voffB);
            PG8_BAR; PG8_WAIT_L(0); PG8_MMA(0, 1, At, B1); PG8_BAR;
            PG8_LDA(At, 0, 1); PG8_STAGE(PG8_SA(0, 0), a2, voffA);
            PG8_BAR; PG8_WAIT_L(0); PG8_MMA(1, 0, At, B0); PG8_BAR; PG8_SCHED;
            PG8_STAGE(PG8_SB(0, 1), b2 + hstep, voffB);
            PG8_WAIT_V(6); PG8_BAR; PG8_MMA(1, 1, At, B1); PG8_BAR;
            PG8_LDB(B0, 1, 0); PG8_SCHED; PG8_LDA(At, 1, 0); PG8_STAGE(PG8_SA(0, 1), a2 + hstep, voffA);
            PG8_WAIT_L(8); PG8_BAR; PG8_WAIT_L(0); PG8_MMA(0, 0, At, B0); PG8_BAR; PG8_SCHED;
            PG8_LDB(B1, 1, 1); PG8_STAGE(PG8_SB(1, 0), b3, voffB);
            PG8_BAR; PG8_WAIT_L(0); PG8_MMA(0, 1, At, B1); PG8_BAR;
            PG8_LDA(At, 1, 1); PG8_STAGE(PG8_SA(1, 0), a3, voffA);
            PG8_BAR; PG8_WAIT_L(0); PG8_MMA(1, 0, At, B0); PG8_BAR; PG8_SCHED;
            PG8_STAGE(PG8_SB(1, 1), b3 + hstep, voffB);
            PG8_WAIT_V(6); PG8_BAR; PG8_MMA(1, 1, At, B1); PG8_BAR;
        }
        PG8_STAMP();
        if constexpr (!Epi::AFTER_DRAIN) { E(acc, cur, wr, wc, fr, fq); S.done(cur); }
        PG8_STAMP();
        if (!has_next) break;
#pragma unroll
        for (int a = 0; a < 2; ++a)
#pragma unroll
            for (int b = 0; b < 2; ++b)
#pragma unroll
                for (int m = 0; m < 4; ++m)
#pragma unroll
                    for (int n = 0; n < 2; ++n) acc[a][b][m][n] = (f32x4){0.f, 0.f, 0.f, 0.f};
        cur = nxt; cA = nA; cB = nB; ++ui;
    }
    PG8_WAIT_V(0);
    if (wr == 0) PG8_BAR;
    PG8_BAR;
    if constexpr (Epi::AFTER_DRAIN) { E.fused(acc, cur, wr, wc, fr, fq, lds, wid, lane); S.done(cur); }
    PG8_STAMP();
    if (STAMP && wid == 0) { stamps[lane] = lane < nts ? (((unsigned long long)(unsigned)ts_hi << 32) | (unsigned)ts_lo) : 0ull;
        if (lane == 62) stamps[62] = rt_entry; if (lane == 63) stamps[63] = (unsigned long long)wall_clock64(); }
#undef PG8_STAMP
#undef PG8_SA
#undef PG8_SB
#undef PG8_STAGE
#undef PG8_LDA
#undef PG8_LDB
#undef PG8_MMA
#undef PG8_WAIT_V
#undef PG8_WAIT_L
#undef PG8_BAR
#undef PG8_SCHED
}
}

using pg8::bf16_t; using pg8::bf16x8; using pg8::f32x4; using pg8::Unit; using pg8::cvt_pk_bf16;
#define DI __device__ __forceinline__
constexpr int TOK = 16384, SEQ = 8192, DM = 1024, HS = 3336, DFF = 2816;
constexpr size_t O_CTL = 0, O_CD = 256, O_AUX = 4352, O_ROPE = 528640, O_FC = 2625792, O_WT = 3150080;
constexpr size_t O_WT_IN = O_WT, O_WT_OUT = O_WT_IN + 7340032, O_WT_UP = O_WT_OUT + 2097152, O_WT_DN = O_WT_UP + 11534336, O_WT_LR = O_WT_DN + 5767168;
constexpr size_t O_XN = O_WT + 27525120, O_R1 = O_XN + 33554432;
constexpr size_t O_H = O_R1, O_ST = O_R1 + 109314048, O_YG = O_ST + 33554432;
constexpr size_t O_G = O_R1, O_U = O_R1 + 92274688;
constexpr size_t O_LW = O_R1 + 109314048, O_KN = O_LW + 50331648, O_VT = O_KN + 16777216, O_AP = O_VT + 16777216;
constexpr size_t O_KNRM = O_AP + 8388608;
constexpr size_t O_BAR = O_KNRM + 524288;
constexpr size_t WS_NEED = O_BAR + 16384;
constexpr int LDS_BYTES = 131072 + 256;

struct Params {
    const float* x; const float* ev_norm_w; const float* ev_w_in; const float* ev_conv_w; const float* ev_conv_b; const float* ev_dt_bias; const float* ev_a_log;
    const float* ev_d; const float* ev_ssd_norm_w; const float* ev_ret_norm_w; const float* ev_w_out;
    const float* od_norm_w; const float* od_w_in; const float* od_mu; const float* od_w0; const float* od_w_up; const float* od_a0; const float* od_a_up;
    const float* od_g_up; const float* od_k_k; const float* od_k_a; const float* od_r_k; const float* od_ln_w; const float* od_ln_b;
    const float* od_qn_w; const float* od_kn_w; const float* od_f_bias; const float* od_w_out;
    const float* ffn_norm_w; const float* ffn_w_up; const float* ffn_conv_w; const float* ffn_conv_b; const float* ffn_w_down;
    float* out; unsigned char* ws;
};

DI unsigned cvtpk(float lo, float hi) { unsigned r; asm("v_cvt_pk_bf16_f32 %0, %1, %2" : "=v"(r) : "v"(lo), "v"(hi)); return r; }
DI unsigned short f2bf(float f) { return (unsigned short)(cvtpk(f, f) & 0xffffu); }
DI float bf2f(unsigned short b) { return __uint_as_float(((unsigned)b) << 16); }
DI unsigned pack2(float lo, float hi) { return cvtpk(lo, hi); }
DI float bflo(unsigned w) { return __uint_as_float(w << 16); }
DI float bfhi(unsigned w) { return __uint_as_float(w & 0xffff0000u); }
DI void unpack8(const uint4 r, float (&o)[8]) { o[0] = bflo(r.x); o[1] = bfhi(r.x); o[2] = bflo(r.y); o[3] = bfhi(r.y); o[4] = bflo(r.z); o[5] = bfhi(r.z); o[6] = bflo(r.w); o[7] = bfhi(r.w); }
DI uint4 pack8(const float (&o)[8]) { uint4 r; r.x = pack2(o[0], o[1]); r.y = pack2(o[2], o[3]); r.z = pack2(o[4], o[5]); r.w = pack2(o[6], o[7]); return r; }
DI float silu_(float x) { return x * __builtin_amdgcn_rcpf(1.f + __expf(-x)); }
DI float sigm_(float x) { return __builtin_amdgcn_rcpf(1.f + __expf(-x)); }
DI float softplus_(float x) { return fmaxf(x, 0.f) + log1pf(__expf(-fabsf(x))); }
DI bf16x8 ldfrag(const bf16_t* base, int row0, int ld, int k0, int lane) { return *(const bf16x8*)(base + (row0 + (lane & 15)) * ld + k0 + (lane >> 4) * 8); }
#define MFMA16(a, b, c) __builtin_amdgcn_mfma_f32_16x16x32_bf16((a), (b), (c), 0, 0, 0)
DI float red16(float v) { v += __shfl_xor(v, 1); v += __shfl_xor(v, 2); v += __shfl_xor(v, 4); v += __shfl_xor(v, 8); return v; }
DI float max16(float v) { v = fmaxf(v, __shfl_xor(v, 1)); v = fmaxf(v, __shfl_xor(v, 2)); v = fmaxf(v, __shfl_xor(v, 4)); v = fmaxf(v, __shfl_xor(v, 8)); return v; }
DI float red64(float v) { v += __shfl_xor(v, 32); v += __shfl_xor(v, 16); return red16(v); }
DI float dpp_red16(float x) {
    x += __builtin_bit_cast(float, __builtin_amdgcn_update_dpp(0, __builtin_bit_cast(int, x), 0xB1, 0xF, 0xF, true));
    x += __builtin_bit_cast(float, __builtin_amdgcn_update_dpp(0, __builtin_bit_cast(int, x), 0x4E, 0xF, 0xF, true));
    x += __builtin_bit_cast(float, __builtin_amdgcn_update_dpp(0, __builtin_bit_cast(int, x), 0x141, 0xF, 0xF, true));
    x += __builtin_bit_cast(float, __builtin_amdgcn_update_dpp(0, __builtin_bit_cast(int, x), 0x140, 0xF, 0xF, true));
    return x;
}

DI int otid() { int t = threadIdx.x; asm volatile("" : "+v"(t)); return t; }
DI int obid() { int b = blockIdx.x; asm volatile("" : "+s"(b)); return b; }
struct EpiH {
    static constexpr bool PERM = false, AFTER_DRAIN = false;
    bf16_t* H; float* aux; int auxc;
    DI void operator()(const f32x4 (&acc)[2][2][4][2], const Unit& u, int wr, int wc, int fr, int fq) const {
        const int row0 = u.pm * 256 + wr * 64 + fr, col0 = u.pn * 256 + wc * 32 + 4 * fq; const bool auxhere = (u.pn == (auxc >> 8));
#pragma unroll
        for (int ai = 0; ai < 2; ++ai)
#pragma unroll
            for (int m = 0; m < 4; ++m) { const size_t r = (size_t)(row0 + ai * 128 + m * 16);
#pragma unroll
                for (int bj = 0; bj < 2; ++bj)
#pragma unroll
                    for (int n = 0; n < 2; ++n) { const int c = col0 + bj * 128 + n * 16; const f32x4 v = acc[ai][bj][m][n];
                        if (c < HS) { uint2 w; w.x = cvt_pk_bf16(v[0], v[1]); w.y = cvt_pk_bf16(v[2], v[3]); *(uint2*)(H + r * HS + c) = w;
                            if (auxhere && (c == auxc || c == auxc + 4)) *(f32x4*)(aux + r * 8 + (c - auxc)) = v; } } }
    }
};
struct EpiRes {
    static constexpr bool PERM = false, AFTER_DRAIN = false;
    const float* res; float* out;
    DI void operator()(const f32x4 (&acc)[2][2][4][2], const Unit& u, int wr, int wc, int fr, int fq) const {
        const int row0 = u.pm * 256 + wr * 64 + fr, col0 = u.pn * 256 + wc * 32 + 4 * fq;
#pragma unroll
        for (int ai = 0; ai < 2; ++ai)
#pragma unroll
            for (int m = 0; m < 4; ++m) { const size_t r = (size_t)(row0 + ai * 128 + m * 16);
#pragma unroll
                for (int bj = 0; bj < 2; ++bj)
#pragma unroll
                    for (int n = 0; n < 2; ++n) { const int c = col0 + bj * 128 + n * 16;
                        const f32x4 rv = *(const f32x4*)(res + r * DM + c); *(f32x4*)(out + r * DM + c) = rv + acc[ai][bj][m][n]; } }
    }
};
DI float gu_ror1(float x) { float r; asm volatile("s_nop 1\n\tv_mov_b32_dpp %0, %1 row_ror:1 row_mask:0xf bank_mask:0xf bound_ctrl:1" : "=v"(r) : "v"(x)); return r; }
DI float gu_ror2(float x) { float r; asm volatile("s_nop 1\n\tv_mov_b32_dpp %0, %1 row_ror:2 row_mask:0xf bank_mask:0xf bound_ctrl:1" : "=v"(r) : "v"(x)); return r; }
struct EpiGU {
    static constexpr bool PERM = false, AFTER_DRAIN = false;
    bf16_t* GC; bf16_t* U; const float* cw; const float* cb;
    DI void operator()(const f32x4 (&acc)[2][2][4][2], const Unit& u, int wr, int wc, int fr, int fq) const {
        const int row0 = u.pm * 256 + wr * 64 + fr, col0 = u.pn * 128 + wc * 32 + 4 * fq;
#define GU_ROR(x, n) gu_ror##n(x)
#pragma unroll
        for (int n = 0; n < 2; ++n) { const int c = col0 + n * 16;
            const f32x4 w0 = *(const f32x4*)(cw + c), w1 = *(const f32x4*)(cw + DFF + c), w2 = *(const f32x4*)(cw + 2 * DFF + c), bb = *(const f32x4*)(cb + c);
#pragma unroll
            for (int ai = 0; ai < 2; ++ai)
#pragma unroll
                for (int m = 0; m < 4; ++m) { const size_t r = (size_t)(row0 + ai * 128 + m * 16); const size_t slab = r >> 6;
                    const f32x4 g = acc[ai][0][m][n], v = acc[ai][1][m][n]; const f32x4 gp = acc[ai][0][m > 0 ? m - 1 : 0][n];
                    f32x4 o;
                    f32x4 s1, s2; float g1a, g1b, g1c, g1d, g2a, g2b, g2c, g2d;
#pragma unroll
                    for (int j = 0; j < 4; ++j) { s1[j] = (m > 0 && fr == 15) ? gp[j] : g[j]; s2[j] = (m > 0 && fr >= 14) ? gp[j] : g[j]; }
                    asm volatile("s_nop 1\n\tv_mov_b32_dpp %0, %4 row_ror:1 row_mask:0xf bank_mask:0xf bound_ctrl:1\n\tv_mov_b32_dpp %1, %5 row_ror:1 row_mask:0xf bank_mask:0xf bound_ctrl:1\n\t"
                                 "v_mov_b32_dpp %2, %6 row_ror:1 row_mask:0xf bank_mask:0xf bound_ctrl:1\n\tv_mov_b32_dpp %3, %7 row_ror:1 row_mask:0xf bank_mask:0xf bound_ctrl:1"
                                 : "=&v"(g1a), "=&v"(g1b), "=&v"(g1c), "=&v"(g1d) : "v"(s1[0]), "v"(s1[1]), "v"(s1[2]), "v"(s1[3]));
                    asm volatile("s_nop 1\n\tv_mov_b32_dpp %0, %4 row_ror:2 row_mask:0xf bank_mask:0xf bound_ctrl:1\n\tv_mov_b32_dpp %1, %5 row_ror:2 row_mask:0xf bank_mask:0xf bound_ctrl:1\n\t"
                                 "v_mov_b32_dpp %2, %6 row_ror:2 row_mask:0xf bank_mask:0xf bound_ctrl:1\n\tv_mov_b32_dpp %3, %7 row_ror:2 row_mask:0xf bank_mask:0xf bound_ctrl:1"
                                 : "=&v"(g2a), "=&v"(g2b), "=&v"(g2c), "=&v"(g2d) : "v"(s2[0]), "v"(s2[1]), "v"(s2[2]), "v"(s2[3]));
                    const f32x4 g1v = {g1a, g1b, g1c, g1d}, g2v = {g2a, g2b, g2c, g2d};
#pragma unroll
                    for (int j = 0; j < 4; ++j) { const float g1 = g1v[j], g2 = g2v[j];
                        const float a = bb[j] + w0[j] * g2 + w1[j] * g1 + w2[j] * g[j]; o[j] = silu_(a) * v[j]; }
                    const bool defer = (m == 0) && (fr < 2);
                    uint2 w;
                    w.x = cvt_pk_bf16(defer ? v[0] : o[0], defer ? v[1] : o[1]); w.y = cvt_pk_bf16(defer ? v[2] : o[2], defer ? v[3] : o[3]);
                    *(uint2*)(U + r * DFF + c) = w;
                    if (defer || (m == 3 && fr >= 14)) { const int slot = defer ? 2 + fr : fr - 14; uint2 gw; gw.x = cvt_pk_bf16(g[0], g[1]); gw.y = cvt_pk_bf16(g[2], g[3]);
                        *(uint2*)(GC + (slab * 4 + slot) * DFF + c) = gw; } }
        }
#undef GU_ROR
    }
};
struct EpiLR {
    static constexpr bool PERM = false, AFTER_DRAIN = false;
    bf16_t* LW; const float* w0; const float* a0;
    DI void operator()(const f32x4 (&acc)[2][2][4][2], const Unit& u, int wr, int wc, int fr, int fq) const {
        const int row0 = u.pm * 256 + wr * 64 + fr, col0 = u.pn * 256 + wc * 32 + 4 * fq;
#pragma unroll
        for (int ai = 0; ai < 2; ++ai)
#pragma unroll
            for (int m = 0; m < 4; ++m) { const size_t r = (size_t)(row0 + ai * 128 + m * 16);
#pragma unroll
                for (int bj = 0; bj < 2; ++bj)
#pragma unroll
                    for (int n = 0; n < 2; ++n) { const int c = col0 + bj * 128 + n * 16; f32x4 v = acc[ai][bj][m][n];
                        if (c < 512) { const f32x4 b = *(const f32x4*)(w0 + c);
#pragma unroll
                            for (int j = 0; j < 4; ++j) v[j] = 1.f - __expf(-0.606531f * sigm_(b[j] + v[j])); }
                        else if (c < 1024) { const f32x4 b = *(const f32x4*)(a0 + c - 512);
#pragma unroll
                            for (int j = 0; j < 4; ++j) v[j] = sigm_(b[j] + v[j]); }
                        uint2 w; w.x = cvt_pk_bf16(v[0], v[1]); w.y = cvt_pk_bf16(v[2], v[3]); *(uint2*)(LW + r * 1536 + c) = w; } }
    }
};
template <class Epi> DI void run_gemm(unsigned char* smem, const bf16_t* A, const bf16_t* Bt, int N, int K, const Epi& E) {
    pg8::Gemm g; g.A = A; g.Bt = Bt; g.M = TOK; g.N = N; g.K = K;
    pg8::StaticOrder S; S.init(TOK, N, (int)gridDim.x, obid());
    pg8::gemm_phase<Epi, pg8::StaticOrder, false>((PG8_LAS unsigned char*)smem, g, S, E, nullptr);
}

DI void conv_tile4(const float* W, int Nsrc, int K, bf16_t* Wt, int nd0, int sc0, int nvalid, int k0, float* tile) {
    const int tid = otid(), j = tid & 63, kb = tid >> 6;
    float v[32];
#pragma unroll
    for (int i = 0; i < 32; ++i) { const int kk = kb + 8 * i; v[i] = (j < nvalid) ? W[(size_t)(k0 + kk) * Nsrc + sc0 + j] : 0.f; }
#pragma unroll
    for (int i = 0; i < 32; ++i) { const int kk = kb + 8 * i; tile[kk * 65 + j] = v[i]; }
    __syncthreads();
    const int nl = tid >> 3, ks = (tid & 7) * 8;
#pragma unroll
    for (int q = 0; q < 4; ++q) { const float* tq = tile + q * 64 * 65; uint4 o;
        o.x = pack2(tq[(ks + 0) * 65 + nl], tq[(ks + 1) * 65 + nl]); o.y = pack2(tq[(ks + 2) * 65 + nl], tq[(ks + 3) * 65 + nl]);
        o.z = pack2(tq[(ks + 4) * 65 + nl], tq[(ks + 5) * 65 + nl]); o.w = pack2(tq[(ks + 6) * 65 + nl], tq[(ks + 7) * 65 + nl]);
        *(uint4*)(Wt + (size_t)(nd0 + nl) * K + k0 + q * 64 + ks) = o; }
    __syncthreads();
}
DI void phase_weights(const Params& p, unsigned char* smem, int layer, int part, int b0 = 0) {
    float* tile = (float*)smem;
    const float* w_in = layer ? p.od_w_in : p.ev_w_in; const float* w_out = layer ? p.od_w_out : p.ev_w_out;
    const float* w_up = p.ffn_w_up + (size_t)layer * DM * 2 * DFF; const float* w_dn = p.ffn_w_down + (size_t)layer * DFF * DM;
    bf16_t* t_in = (bf16_t*)(p.ws + O_WT_IN); bf16_t* t_out = (bf16_t*)(p.ws + O_WT_OUT); bf16_t* t_up = (bf16_t*)(p.ws + O_WT_UP); bf16_t* t_dn = (bf16_t*)(p.ws + O_WT_DN);
    if (part == 0) {
        if (obid() < b0) return;
        for (int job = obid() - b0; job < 288; job += (int)gridDim.x - b0) {
            if (job < 224) { const int nt = job >> 2, kt = job & 3, nd0 = nt * 64; int nv = HS - nd0; nv = nv < 0 ? 0 : (nv > 64 ? 64 : nv);
                conv_tile4(w_in, HS, 1024, t_in, nd0, nd0, nv, kt * 256, tile); }
            else { const int j2 = job - 224, nt = j2 >> 2, kt = j2 & 3; conv_tile4(w_out, 1024, 1024, t_out, nt * 64, nt * 64, 64, kt * 256, tile); }
        }
    } else {
        const int nb = (int)gridDim.x - 128, lb = obid() - 128;
        if (lb < 0) return;
        if (part == 1) { for (int job = lb; job < 352; job += nb) { const int nt = job >> 2, kt = job & 3, nd0 = nt * 64; const int pn = nd0 >> 8, bj = (nd0 >> 7) & 1, j0 = nd0 & 127;
                conv_tile4(w_up, 2 * DFF, 1024, t_up, nd0, bj * DFF + 128 * pn + j0, 64, kt * 256, tile); } }
        else { for (int job = lb; job < 176; job += nb) { const int nt = job / 11, kt = job % 11; conv_tile4(w_dn, 1024, DFF, t_dn, nt * 64, nt * 64, 64, kt * 256, tile); } }
        return;
    }
    const int gtid = (obid() - b0) * 512 + otid(), gsz = ((int)gridDim.x - b0) * 512;
    if (layer == 0) {
        float* rc = (float*)(p.ws + O_ROPE); float* rs = rc + SEQ * 32;
        for (int idx = gtid; idx < SEQ * 32; idx += gsz) { const int pos = idx >> 5, i = idx & 31;
            const float inv = (float)exp(-(double)i * (9.210340371976184 / 32.0)); const float ang = (float)pos * inv;
            const double a = (double)ang; const double n = rint(a * 0.15915494309189535); const double r = a - n * 6.283185307179586; const double r2 = r * r;
            double sn = 1.0 / 121645100408832000.0, cs = 1.0 / 2432902008176640000.0;
            sn = sn * r2 - 1.0 / 355687428096000.0; sn = sn * r2 + 1.0 / 1307674368000.0; sn = sn * r2 - 1.0 / 6227020800.0; sn = sn * r2 + 1.0 / 39916800.0;
            sn = sn * r2 - 1.0 / 362880.0; sn = sn * r2 + 1.0 / 5040.0; sn = sn * r2 - 1.0 / 120.0; sn = sn * r2 + 1.0 / 6.0; sn = sn * r2 * -1.0 + 1.0; sn = sn * r;
            cs = cs * r2 - 1.0 / 6402373705728000.0; cs = cs * r2 + 1.0 / 20922789888000.0; cs = cs * r2 - 1.0 / 87178291200.0; cs = cs * r2 + 1.0 / 479001600.0;
            cs = cs * r2 - 1.0 / 3628800.0; cs = cs * r2 + 1.0 / 40320.0; cs = cs * r2 - 1.0 / 720.0; cs = cs * r2 + 1.0 / 24.0; cs = cs * r2 - 0.5; cs = cs * r2 + 1.0;
            rc[idx] = (float)cs; rs[idx] = (float)sn; }
    } else {
        bf16_t* t_lr = (bf16_t*)(p.ws + O_WT_LR);
        for (int idx = gtid; idx < 1536 * 256; idx += gsz) { const int n = idx >> 8, k = idx & 255; float v = 0.f;
            if (n < 512) { if (k < 64) v = p.od_w_up[k * 512 + n]; }
            else if (n < 1024) { if (k >= 64 && k < 128) v = p.od_a_up[(k - 64) * 512 + n - 512]; }
            else { if (k >= 128) v = p.od_g_up[(k - 128) * 512 + n - 1024]; }
            t_lr[idx] = f2bf(v); }
    }
}
DI void phase_rmsnorm(const float* x, const float* w, bf16_t* xn) {
    const int lane = otid() & 63, wv = otid() >> 6;
    f32x4 ww[4];
#pragma unroll
    for (int i = 0; i < 4; ++i) ww[i] = *(const f32x4*)(w + i * 256 + lane * 4);
    for (int r0 = (obid() * 8 + wv) * 4; r0 < TOK; r0 += gridDim.x * 8 * 4) {
        f32x4 v[4][4];
#pragma unroll
        for (int q = 0; q < 4; ++q)
#pragma unroll
            for (int i = 0; i < 4; ++i) v[q][i] = *(const f32x4*)(x + (size_t)(r0 + q) * DM + i * 256 + lane * 4);
#pragma unroll
        for (int q = 0; q < 4; ++q) { float ss = 0.f;
#pragma unroll
            for (int i = 0; i < 4; ++i) ss += v[q][i][0] * v[q][i][0] + v[q][i][1] * v[q][i][1] + v[q][i][2] * v[q][i][2] + v[q][i][3] * v[q][i][3];
            ss = red64(ss); const float rstd = rsqrtf(ss * (1.f / DM) + 1e-6f);
#pragma unroll
            for (int i = 0; i < 4; ++i) { uint2 o; o.x = pack2(v[q][i][0] * rstd * ww[i][0], v[q][i][1] * rstd * ww[i][1]); o.y = pack2(v[q][i][2] * rstd * ww[i][2], v[q][i][3] * rstd * ww[i][3]);
                *(uint2*)(xn + (size_t)(r0 + q) * DM + i * 256 + lane * 4) = o; } }
    }
}
DI void ssd_conv8_raw(const Params& p, const uint4 r0, const uint4 r1, const uint4 r2, const uint4 r3, int t, int ch, float (&o)[8]) {
    const float m0 = t >= 3 ? 1.f : 0.f, m1 = t >= 2 ? 1.f : 0.f, m2 = t >= 1 ? 1.f : 0.f;
    float acc[8], xv[8];
    { const f32x4 b0 = *(const f32x4*)(p.ev_conv_b + ch), b1 = *(const f32x4*)(p.ev_conv_b + ch + 4);
      acc[0] = b0[0]; acc[1] = b0[1]; acc[2] = b0[2]; acc[3] = b0[3]; acc[4] = b1[0]; acc[5] = b1[1]; acc[6] = b1[2]; acc[7] = b1[3]; }
#define SSD_TAP(k, raw, msk) { unpack8(raw, xv); const f32x4 w0 = *(const f32x4*)(p.ev_conv_w + (k) * 768 + ch) * (msk), w1 = *(const f32x4*)(p.ev_conv_w + (k) * 768 + ch + 4) * (msk); \
        acc[0] += w0[0] * xv[0]; acc[1] += w0[1] * xv[1]; acc[2] += w0[2] * xv[2]; acc[3] += w0[3] * xv[3]; acc[4] += w1[0] * xv[4]; acc[5] += w1[1] * xv[5]; acc[6] += w1[2] * xv[6]; acc[7] += w1[3] * xv[7]; }
    SSD_TAP(0, r0, m0) SSD_TAP(1, r1, m1) SSD_TAP(2, r2, m2) SSD_TAP(3, r3, 1.f)
#pragma unroll
    for (int e = 0; e < 8; ++e) o[e] = silu_(acc[e]);
}
DI void ssd_taps(const bf16_t* H, int b, int t, int ch, uint4& r0, uint4& r1, uint4& r2, uint4& r3) {
    const bf16_t* base = H + (size_t)b * SEQ * HS + 512 + ch;
    const int t0 = t - 3 < 0 ? 0 : t - 3, t1 = t - 2 < 0 ? 0 : t - 2, t2 = t - 1 < 0 ? 0 : t - 1;
    r0 = *(const uint4*)(base + (size_t)t0 * HS); r1 = *(const uint4*)(base + (size_t)t1 * HS); r2 = *(const uint4*)(base + (size_t)t2 * HS); r3 = *(const uint4*)(base + (size_t)t * HS);
}
DI void ssd_conv8(const Params& p, const bf16_t* H, int b, int t, int ch, float (&o)[8]) { uint4 r0, r1, r2, r3; ssd_taps(H, b, t, ch, r0, r1, r2, r3); ssd_conv8_raw(p, r0, r1, r2, r3, t, ch, o); }
DI float ret_lg(int hh) { return log1pf(-exp2f(-5.f - (float)hh)); }
DI float chunk_aux(const Params& p, int b, int hh, int t0) { const int tid = otid(); return tid < 128 ? ((const float*)(p.ws + O_AUX))[((size_t)b * SEQ + t0 + tid) * 8 + hh] : 0.f; }
DI void chunk_decay(const Params& p, int mixer, int hh, float auxv, float* acs, float* dts) {
    const int tid = otid(), lane = tid & 63;
    float v = 0.f;
    if (tid < 128) {
        if (mixer == 0) { const float dt = softplus_(auxv + p.ev_dt_bias[hh]); dts[tid] = dt; v = -expf(p.ev_a_log[hh]) * dt; }
        else { dts[tid] = 1.f; v = ret_lg(hh); }
    }
#pragma unroll
    for (int off = 1; off < 64; off <<= 1) { const float t = __shfl_up(v, off); if (lane >= off) v += t; }
    if (tid == 63) acs[256] = v;
    __syncthreads();
    if (tid >= 64 && tid < 128) v += acs[256];
    if (tid < 128) acs[tid] = v;
    __syncthreads();
}
DI void phase_m1(const Params& p, unsigned char* smem) {
    bf16_t* Kt = (bf16_t*)smem; bf16_t* Vt = (bf16_t*)(smem + 17408); float* acs = (float*)(smem + 34816); float* dts = acs + 128;
    const bf16_t* H = (const bf16_t*)(p.ws + O_H); float* ST = (float*)(p.ws + O_ST); float* CD = (float*)(p.ws + O_CD);
    const float* rc = (const float*)(p.ws + O_ROPE); const float* rs = rc + SEQ * 32;
    const int tid = otid(), lane = tid & 63, w = tid >> 6;
    for (int u = obid(); u < 2048; u += gridDim.x) {
        const int mixer = u >> 10, bh = (u >> 6) & 15, c = u & 63, b = bh >> 3, hh = bh & 7, t0 = c * 128;
        chunk_decay(p, mixer, hh, mixer == 0 ? chunk_aux(p, b, hh, t0) : 0.f, acs, dts);
        const float aend = acs[127];
        if (mixer == 0) {
#pragma unroll
            for (int it = 0; it < 2; ++it) { const int g = tid + it * 512, s = g >> 3, c8 = (g & 7) * 8; float o[8];
                const float sc = __expf(aend - acs[s]) * dts[s];
                ssd_conv8(p, H, b, t0 + s, 512 + (hh >> 2) * 64 + c8, o);
#pragma unroll
                for (int e = 0; e < 8; ++e) Kt[(c8 + e) * 136 + s] = f2bf(o[e] * sc);
                ssd_conv8(p, H, b, t0 + s, hh * 64 + c8, o);
#pragma unroll
                for (int e = 0; e < 8; ++e) Vt[(c8 + e) * 136 + s] = f2bf(o[e]); }
            if (tid == 0) CD[bh * 64 + c] = __expf(aend);
        } else {
            { const int s = tid >> 2, i0 = (tid & 3) * 8; const size_t r = (size_t)b * SEQ + t0 + s; float k1[8], k2[8];
              unpack8(*(const uint4*)(H + r * HS + 1800 + hh * 64 + i0), k1); unpack8(*(const uint4*)(H + r * HS + 1800 + hh * 64 + 32 + i0), k2);
              const float sc = __expf(aend - acs[s]) * 0.125f;
#pragma unroll
              for (int e = 0; e < 8; ++e) { const float cs = rc[(t0 + s) * 32 + i0 + e], sn = rs[(t0 + s) * 32 + i0 + e];
                  Kt[(i0 + e) * 136 + s] = f2bf((k1[e] * cs - k2[e] * sn) * sc); Kt[(32 + i0 + e) * 136 + s] = f2bf((k1[e] * sn + k2[e] * cs) * sc); } }
#pragma unroll
            for (int it = 0; it < 2; ++it) { const int g = tid + it * 512, s = g >> 3, c8 = (g & 7) * 8; const size_t r = (size_t)b * SEQ + t0 + s; float v[8];
                unpack8(*(const uint4*)(H + r * HS + 2312 + hh * 64 + c8), v);
#pragma unroll
                for (int e = 0; e < 8; ++e) Vt[(c8 + e) * 136 + s] = (unsigned short)f2bf(v[e]); }
        }
        __syncthreads();
        { const int mt = w & 3, nt0 = (w >> 2) * 2; f32x4 a0 = {0.f, 0.f, 0.f, 0.f}, a1 = {0.f, 0.f, 0.f, 0.f};
#pragma unroll
          for (int ks = 0; ks < 4; ++ks) { const bf16x8 af = ldfrag(Kt, mt * 16, 136, ks * 32, lane);
              a0 = MFMA16(af, ldfrag(Vt, nt0 * 16, 136, ks * 32, lane), a0); a1 = MFMA16(af, ldfrag(Vt, nt0 * 16 + 16, 136, ks * 32, lane), a1); }
          float* dst = ST + (size_t)u * 4096 + mt * 16 + (lane >> 4) * 4;
          *(f32x4*)(dst + (nt0 * 16 + (lane & 15)) * 64) = a0; *(f32x4*)(dst + (nt0 * 16 + 16 + (lane & 15)) * 64) = a1; }
        __syncthreads();
    }
}
DI void phase_m2(const Params& p) {
    float* ST = (float*)(p.ws + O_ST); const float* CD = (const float*)(p.ws + O_CD);
    for (int idx = obid() * 512 + otid(); idx < 32 * 4096; idx += gridDim.x * 512) {
        const int mb = idx >> 12, e = idx & 4095, mixer = mb >> 4, bh = mb & 15; float run = 0.f;
        const float gdec = __expf(128.f * ret_lg(bh & 7));
#pragma unroll 8
        for (int c = 0; c < 64; ++c) { const size_t o = ((size_t)(mb * 64 + c)) * 4096 + e; const float v = ST[o]; ST[o] = run;
            const float dec = mixer == 0 ? CD[bh * 64 + c] : gdec; run = run * dec + v; }
    }
}
struct M3Pre { uint4 a0, a1, a2, a3, a4, a5, a6, a7; f32x4 st0, st1; float aux; };
template <int MIXER> DI void m3_issue(const Params& p, int b, int c, int hh, M3Pre& R) {
    const bf16_t* H = (const bf16_t*)(p.ws + O_H); const float* ST = (const float*)(p.ws + O_ST);
    const int tid = otid(), t0 = c * 128, bh = b * 8 + hh; const size_t u = (size_t)((MIXER * 16 + bh) * 64 + c);
    if (MIXER == 0) {
        { const int g = tid, s = g >> 3, c8 = (g & 7) * 8; ssd_taps(H, b, t0 + s, hh * 64 + c8, R.a0, R.a1, R.a2, R.a3); }
        { const int g = tid + 512, s = g >> 3, c8 = (g & 7) * 8; ssd_taps(H, b, t0 + s, hh * 64 + c8, R.a4, R.a5, R.a6, R.a7); }
        R.aux = chunk_aux(p, b, hh, t0);
    } else {
        { const int s = tid >> 2, i0 = (tid & 3) * 8; const size_t r = (size_t)b * SEQ + t0 + s;
          R.a0 = *(const uint4*)(H + r * HS + 1288 + hh * 64 + i0); R.a1 = *(const uint4*)(H + r * HS + 1288 + hh * 64 + 32 + i0);
          R.a2 = *(const uint4*)(H + r * HS + 1800 + hh * 64 + i0); R.a3 = *(const uint4*)(H + r * HS + 1800 + hh * 64 + 32 + i0); }
        { const int g = tid, s = g >> 3, c8 = (g & 7) * 8; R.a4 = *(const uint4*)(H + ((size_t)b * SEQ + t0 + s) * HS + 2312 + hh * 64 + c8); }
        { const int g = tid + 512, s = g >> 3, c8 = (g & 7) * 8; R.a5 = *(const uint4*)(H + ((size_t)b * SEQ + t0 + s) * HS + 2312 + hh * 64 + c8); }
        R.aux = 0.f;
    }
    { const int pr = tid >> 3, n8 = (tid & 7) * 8; const float* src = ST + u * 4096 + pr * 64 + n8; R.st0 = *(const f32x4*)src; R.st1 = *(const f32x4*)(src + 4); }
}
template <int MIXER> DI void m3_head(const Params& p, unsigned char* smem, int b, int c, int hh, float (&ssq)[4], M3Pre& R) {
    bf16_t* Qs = (bf16_t*)smem; bf16_t* Ks = (bf16_t*)(smem + 18432); bf16_t* Vt = (bf16_t*)(smem + 36864); bf16_t* Rt = (bf16_t*)(smem + 54272); bf16_t* Ps = (bf16_t*)(smem + 63488);
    float* acs = (float*)(smem + 98304); float* dts = acs + 128;
    const bf16_t* H = (const bf16_t*)(p.ws + O_H); float* YG = (float*)(p.ws + O_YG); bf16_t* Y = (bf16_t*)(p.ws + O_XN);
    const float* rc = (const float*)(p.ws + O_ROPE); const float* rs = rc + SEQ * 32;
    const int tid = otid(), lane = tid & 63, w = tid >> 6, t0 = c * 128;
    __syncthreads();
    chunk_decay(p, MIXER, hh, R.aux, acs, dts);
    if (MIXER == 0) {
        if ((hh & 3) == 0) {
#pragma unroll
            for (int it = 0; it < 2; ++it) { const int g = tid + it * 512, s = g >> 3, c8 = (g & 7) * 8; float o[8];
                ssd_conv8(p, H, b, t0 + s, 640 + (hh >> 2) * 64 + c8, o); *(uint4*)(Qs + s * 72 + c8) = pack8(o);
                ssd_conv8(p, H, b, t0 + s, 512 + (hh >> 2) * 64 + c8, o); *(uint4*)(Ks + s * 72 + c8) = pack8(o); } }
        { const int g = tid, s = g >> 3, c8 = (g & 7) * 8; float o[8]; ssd_conv8_raw(p, R.a0, R.a1, R.a2, R.a3, t0 + s, hh * 64 + c8, o);
#pragma unroll
          for (int e = 0; e < 8; ++e) Vt[(c8 + e) * 136 + s] = f2bf(o[e]); }
        { const int g = tid + 512, s = g >> 3, c8 = (g & 7) * 8; float o[8]; ssd_conv8_raw(p, R.a4, R.a5, R.a6, R.a7, t0 + s, hh * 64 + c8, o);
#pragma unroll
          for (int e = 0; e < 8; ++e) Vt[(c8 + e) * 136 + s] = f2bf(o[e]); }
    } else {
        { const int s = tid >> 2, i0 = (tid & 3) * 8; float a1[8], a2[8], o1[8], o2[8];
          unpack8(R.a0, a1); unpack8(R.a1, a2);
#pragma unroll
          for (int e = 0; e < 8; ++e) { const float cs = rc[(t0 + s) * 32 + i0 + e], sn = rs[(t0 + s) * 32 + i0 + e]; o1[e] = a1[e] * cs - a2[e] * sn; o2[e] = a1[e] * sn + a2[e] * cs; }
          *(uint4*)(Qs + s * 72 + i0) = pack8(o1); *(uint4*)(Qs + s * 72 + 32 + i0) = pack8(o2);
          unpack8(R.a2, a1); unpack8(R.a3, a2);
#pragma unroll
          for (int e = 0; e < 8; ++e) { const float cs = rc[(t0 + s) * 32 + i0 + e], sn = rs[(t0 + s) * 32 + i0 + e]; o1[e] = (a1[e] * cs - a2[e] * sn) * 0.125f; o2[e] = (a1[e] * sn + a2[e] * cs) * 0.125f; }
          *(uint4*)(Ks + s * 72 + i0) = pack8(o1); *(uint4*)(Ks + s * 72 + 32 + i0) = pack8(o2); }
        { const int g = tid, s = g >> 3, c8 = (g & 7) * 8; const uint4 raw = R.a4; const unsigned short* rv = (const unsigned short*)&raw;
#pragma unroll
          for (int e = 0; e < 8; ++e) Vt[(c8 + e) * 136 + s] = rv[e]; }
        { const int g = tid + 512, s = g >> 3, c8 = (g & 7) * 8; const uint4 raw = R.a5; const unsigned short* rv = (const unsigned short*)&raw;
#pragma unroll
          for (int e = 0; e < 8; ++e) Vt[(c8 + e) * 136 + s] = rv[e]; }
    }
    { const int pr = tid >> 3, n8 = (tid & 7) * 8; const f32x4 x0 = R.st0, x1 = R.st1;
      uint4 o; o.x = pack2(x0[0], x0[1]); o.y = pack2(x0[2], x0[3]); o.z = pack2(x1[0], x1[1]); o.w = pack2(x1[2], x1[3]); *(uint4*)(Rt + pr * 72 + n8) = o; }
    __syncthreads();
    if (hh < 7) m3_issue<MIXER>(p, b, c, hh + 1, R);
    const int nks = (w >> 1) + 1;
    const int lrow = 16 * w + (lane >> 4) * 4;
    unsigned short gate[4][4];
#pragma unroll
    for (int nt = 0; nt < 4; ++nt)
#pragma unroll
        for (int j = 0; j < 4; ++j) gate[nt][j] = H[((size_t)b * SEQ + t0 + lrow + j) * HS + (MIXER == 0 ? 0 : 2824) + hh * 64 + nt * 16 + (lane & 15)];
    {
        const bf16x8 q0 = ldfrag(Qs, 16 * w, 72, 0, lane), q1 = ldfrag(Qs, 16 * w, 72, 32, lane);
        float al[4];
#pragma unroll
        for (int j = 0; j < 4; ++j) al[j] = acs[lrow + j];
        for (int nt = 0; nt < 2 * nks; ++nt) { f32x4 sacc = {0.f, 0.f, 0.f, 0.f};
            sacc = MFMA16(q0, ldfrag(Ks, nt * 16, 72, 0, lane), sacc); sacc = MFMA16(q1, ldfrag(Ks, nt * 16, 72, 32, lane), sacc);
            const int s = nt * 16 + (lane & 15); const float as = acs[s], ds = dts[s];
#pragma unroll
            for (int j = 0; j < 4; ++j) { const float pv = (s <= lrow + j) ? sacc[j] * __expf(al[j] - as) * ds : 0.f; Ps[(lrow + j) * 136 + s] = f2bf(pv); } }
    }
    __syncthreads();
    f32x4 yd[4], yo[4];
#pragma unroll
    for (int nt = 0; nt < 4; ++nt) { yd[nt] = (f32x4){0.f, 0.f, 0.f, 0.f}; yo[nt] = (f32x4){0.f, 0.f, 0.f, 0.f}; }
    for (int ks = 0; ks < nks; ++ks) { const bf16x8 pf = ldfrag(Ps, 16 * w, 136, ks * 32, lane);
#pragma unroll
        for (int nt = 0; nt < 4; ++nt) yd[nt] = MFMA16(pf, ldfrag(Vt, nt * 16, 136, ks * 32, lane), yd[nt]); }
#pragma unroll
    for (int ks = 0; ks < 2; ++ks) { const bf16x8 qf = ldfrag(Qs, 16 * w, 72, ks * 32, lane);
#pragma unroll
        for (int nt = 0; nt < 4; ++nt) yo[nt] = MFMA16(qf, ldfrag(Rt, nt * 16, 72, ks * 32, lane), yo[nt]); }
    float ea[4];
#pragma unroll
    for (int j = 0; j < 4; ++j) ea[j] = __expf(acs[lrow + j]);
    if (MIXER == 0) {
        const float dsk = p.ev_d[hh];
#pragma unroll
        for (int nt = 0; nt < 4; ++nt) { const int pc = nt * 16 + (lane & 15);
#pragma unroll
            for (int j = 0; j < 4; ++j) { const size_t r = (size_t)b * SEQ + t0 + lrow + j;
                const float y = yd[nt][j] + ea[j] * yo[nt][j] + dsk * bf2f(Vt[pc * 136 + lrow + j]);
                const float z = bf2f(gate[nt][j]); const float yg = y * silu_(z); ssq[j] += yg * yg; YG[r * 512 + hh * 64 + pc] = yg; } }
    } else {
        float s2[4];
#pragma unroll
        for (int j = 0; j < 4; ++j) { float a = 0.f;
#pragma unroll
            for (int nt = 0; nt < 4; ++nt) { const float y = yd[nt][j] + ea[j] * yo[nt][j]; yd[nt][j] = y; a += y * y; }
            s2[j] = rsqrtf(red16(a) * (1.f / 64.f) + 1e-6f); }
#pragma unroll
        for (int nt = 0; nt < 4; ++nt) { const int pc = nt * 16 + (lane & 15); const float nw = p.ev_ret_norm_w[hh * 64 + pc];
#pragma unroll
            for (int j = 0; j < 4; ++j) { const size_t r = (size_t)b * SEQ + t0 + lrow + j; const float g = bf2f(gate[nt][j]);
                Y[r * DM + 512 + hh * 64 + pc] = f2bf(silu_(g) * yd[nt][j] * s2[j] * nw); } }
    }
}
DI void phase_m3(const Params& p, unsigned char* smem) {
    const int lane = otid() & 63, w = otid() >> 6;
    for (int u = obid(); u < 256; u += gridDim.x) {
        const int mixer = u >> 7, b = (u >> 6) & 1, c = u & 63; float ssq[4] = {0.f, 0.f, 0.f, 0.f};
        if (mixer == 0) {
            M3Pre R; m3_issue<0>(p, b, c, 0, R);
            for (int hh = 0; hh < 8; ++hh) m3_head<0>(p, smem, b, c, hh, ssq, R);
            float* YG = (float*)(p.ws + O_YG); bf16_t* Y = (bf16_t*)(p.ws + O_XN); const int lrow = 16 * w + (lane >> 4) * 4;
            float rstd[4];
#pragma unroll
            for (int j = 0; j < 4; ++j) rstd[j] = rsqrtf(red16(ssq[j]) * (1.f / 512.f) + 1e-6f);
            for (int cc = 0; cc < 32; ++cc) { const int col = cc * 16 + (lane & 15); const float nw = p.ev_ssd_norm_w[col];
#pragma unroll
                for (int j = 0; j < 4; ++j) { const size_t r = (size_t)b * SEQ + c * 128 + lrow + j;
                    const float v = __hip_atomic_load(YG + r * 512 + col, __ATOMIC_RELAXED, __HIP_MEMORY_SCOPE_AGENT); Y[r * DM + col] = f2bf(v * rstd[j] * nw); } }
        } else {
            M3Pre R; m3_issue<1>(p, b, c, 0, R);
            for (int hh = 0; hh < 8; ++hh) m3_head<1>(p, smem, b, c, hh, ssq, R);
        }
    }
}
DI void phase_ffn_fix(const Params& p, int layer) {
    const bf16_t* GC = (const bf16_t*)(p.ws + O_G); bf16_t* U = (bf16_t*)(p.ws + O_U);
    const float* cw = p.ffn_conv_w + (size_t)layer * 3 * DFF; const float* cb = p.ffn_conv_b + (size_t)layer * DFF;
    for (int idx = obid() * 512 + otid(); idx < 256 * 2 * (DFF / 8); idx += gridDim.x * 512) {
        const int c8 = (idx % (DFF / 8)) * 8, ri = idx / (DFF / 8), k = ri >> 1, i = ri & 1, r = k * 64 + i, t = r & (SEQ - 1);
        const int kp = k > 0 ? k - 1 : 0;
        const bf16_t* s0 = GC + ((size_t)kp * 4 + (i == 0 ? 0 : 1)) * DFF + c8;
        const bf16_t* s1 = i == 0 ? GC + ((size_t)kp * 4 + 1) * DFF + c8 : GC + ((size_t)k * 4 + 2) * DFF + c8;
        const bf16_t* s2 = GC + ((size_t)k * 4 + 2 + i) * DFF + c8;
        const float m0 = (t - 2 >= 0) ? 1.f : 0.f, m1 = (t - 1 >= 0) ? 1.f : 0.f;
        const uint4 r0 = *(const uint4*)s0, r1 = *(const uint4*)s1, r2 = *(const uint4*)s2, ru = *(const uint4*)(U + (size_t)r * DFF + c8);
        float acc[8], g[8], uv[8];
        { const f32x4 b0 = *(const f32x4*)(cb + c8), b1 = *(const f32x4*)(cb + c8 + 4); acc[0] = b0[0]; acc[1] = b0[1]; acc[2] = b0[2]; acc[3] = b0[3]; acc[4] = b1[0]; acc[5] = b1[1]; acc[6] = b1[2]; acc[7] = b1[3]; }
#define FIX_TAP(kk, raw, msk) { unpack8(raw, g); const f32x4 w0 = *(const f32x4*)(cw + (kk) * DFF + c8) * (msk), w1 = *(const f32x4*)(cw + (kk) * DFF + c8 + 4) * (msk); \
            acc[0] += w0[0] * g[0]; acc[1] += w0[1] * g[1]; acc[2] += w0[2] * g[2]; acc[3] += w0[3] * g[3]; acc[4] += w1[0] * g[4]; acc[5] += w1[1] * g[5]; acc[6] += w1[2] * g[6]; acc[7] += w1[3] * g[7]; }
        FIX_TAP(0, r0, m0) FIX_TAP(1, r1, m1) FIX_TAP(2, r2, 1.f)
        unpack8(ru, uv);
#pragma unroll
        for (int e2 = 0; e2 < 8; ++e2) acc[e2] = silu_(acc[e2]) * uv[e2];
        *(uint4*)(U + (size_t)r * DFF + c8) = pack8(acc);
    }
}
DI void phase_l1_prep(const Params& p, unsigned char* smem) {
    const bf16_t* H = (const bf16_t*)(p.ws + O_H); const float* aux = (const float*)(p.ws + O_AUX); float* FC = (float*)(p.ws + O_FC);
    bf16_t* KN = (bf16_t*)(p.ws + O_KN); bf16_t* VT = (bf16_t*)(p.ws + O_VT); bf16_t* AP = (bf16_t*)(p.ws + O_AP);
    const int tid = otid();
    for (int u = obid(); u < 16 + 1024; u += gridDim.x) {
        __syncthreads();
        if (u < 16) {
            float* tot = (float*)smem; const int bh = u, b = bh >> 3, hh = bh & 7; const float fb = p.od_f_bias[hh]; float loc[16]; float run = 0.f;
#pragma unroll
            for (int i = 0; i < 16; ++i) { const float xv = aux[((size_t)b * SEQ + tid * 16 + i) * 8 + hh] + fb; run += -softplus_(-xv); loc[i] = run; }
            tot[tid] = run; __syncthreads();
            float off = 0.f; for (int i = 0; i < tid; ++i) off += tot[i];
#pragma unroll
            for (int i = 0; i < 16; ++i) FC[(size_t)bh * SEQ + tid * 16 + i] = off + loc[i];
        } else {
            bf16_t* Vl = (bf16_t*)smem; const int v2 = u - 16, bh = v2 >> 6, blk = v2 & 63, b = bh >> 3, hh = bh & 7, t0 = blk * 128;
            { const int l = tid >> 2, c16 = (tid & 3) * 16; const size_t r = (size_t)b * SEQ + t0 + l; float a[8], c[8];
              unpack8(*(const uint4*)(H + r * HS + 2304 + hh * 64 + c16), a); unpack8(*(const uint4*)(H + r * HS + 2304 + hh * 64 + c16 + 8), c);
              float ss = 0.f;
#pragma unroll
              for (int e = 0; e < 8; ++e) ss += a[e] * a[e] + c[e] * c[e];
              ss += __shfl_xor(ss, 1); ss += __shfl_xor(ss, 2); const float rstd = rsqrtf(ss * (1.f / 64.f) + 1e-6f);
#pragma unroll
              for (int e = 0; e < 8; ++e) { a[e] *= rstd * p.od_kn_w[c16 + e]; c[e] *= rstd * p.od_kn_w[c16 + 8 + e]; }
              bf16_t* dst = KN + ((size_t)bh * SEQ + t0 + l) * 64 + c16; *(uint4*)dst = pack8(a); *(uint4*)(dst + 8) = pack8(c); }
#pragma unroll
            for (int it = 0; it < 2; ++it) { const int g = tid + it * 512, s = g >> 3, c8 = (g & 7) * 8; const size_t r = (size_t)b * SEQ + t0 + s;
                *(uint4*)(Vl + s * 72 + c8) = *(const uint4*)(H + r * HS + 2816 + hh * 64 + c8); }
            __syncthreads();
#pragma unroll
            for (int it = 0; it < 2; ++it) { const int g = tid + it * 512, e = g >> 4, s8 = (g & 15) * 8; uint4 o;
                o.x = (unsigned)Vl[(s8 + 0) * 72 + e] | ((unsigned)Vl[(s8 + 1) * 72 + e] << 16); o.y = (unsigned)Vl[(s8 + 2) * 72 + e] | ((unsigned)Vl[(s8 + 3) * 72 + e] << 16);
                o.z = (unsigned)Vl[(s8 + 4) * 72 + e] | ((unsigned)Vl[(s8 + 5) * 72 + e] << 16); o.w = (unsigned)Vl[(s8 + 6) * 72 + e] | ((unsigned)Vl[(s8 + 7) * 72 + e] << 16);
                *(uint4*)(VT + ((size_t)bh * 64 + e) * SEQ + t0 + s8) = o; }
        }
    }
    {
        float* KNRM = (float*)(p.ws + O_KNRM);
#pragma unroll 4
        for (int idx = obid() * 512 + tid; idx < TOK * 64; idx += gridDim.x * 512) {
            const int r = idx >> 6, c8 = (idx & 63) * 8, t = r & (SEQ - 1); float cur[8], prv[8]; float ss = 0.f;
            { const uint4 rc = *(const uint4*)(H + (size_t)r * HS + 512 + c8), rp = *(const uint4*)(H + (size_t)(t > 0 ? r - 1 : r) * HS + 512 + c8); const float pm = t > 0 ? 1.f : 0.f;
              unpack8(rc, cur); unpack8(rp, prv);
#pragma unroll
              for (int e = 0; e < 8; ++e) prv[e] *= pm; }
#pragma unroll
            for (int e = 0; e < 8; ++e) { const float v = (cur[e] + (prv[e] - cur[e]) * p.od_mu[512 + c8 + e]) * p.od_k_k[c8 + e]; ss += v * v; }
            ss += __shfl_xor(ss, 1); ss += __shfl_xor(ss, 2); ss += __shfl_xor(ss, 4);
            if ((idx & 7) == 0) KNRM[(size_t)r * 8 + (c8 >> 6)] = 1.f / fmaxf(sqrtf(ss), 1e-12f);
        }
    }
#pragma unroll 4
    for (int idx = obid() * 512 + tid; idx < TOK * 32; idx += gridDim.x * 512) {
        const int r = idx >> 5, j8 = (idx & 31) * 8, t = r & (SEQ - 1); float cur[8], prv[8], o[8];
        { const uint4 rc = *(const uint4*)(H + (size_t)r * HS + 1536 + j8), rp = *(const uint4*)(H + (size_t)(t > 0 ? r - 1 : r) * HS + 1536 + j8); const float pm = t > 0 ? 1.f : 0.f;
          unpack8(rc, cur); unpack8(rp, prv);
#pragma unroll
          for (int e = 0; e < 8; ++e) prv[e] *= pm; }
#pragma unroll
        for (int e = 0; e < 8; ++e) { const float v = cur[e] + (prv[e] - cur[e]) * p.od_mu[1536 + j8 + e];
            o[e] = (j8 < 64) ? tanhf(v) : ((j8 < 128) ? v : sigm_(v)); }
        *(uint4*)(AP + (size_t)r * 256 + j8) = pack8(o);
    }
}
DI void fox_unit(const Params& p, unsigned char* smem, int bh, int qb) {
    bf16_t* Qs = (bf16_t*)smem; bf16_t* Ks = (bf16_t*)(smem + 18432); bf16_t* Vts = (bf16_t*)(smem + 36864); float* ck = (float*)(smem + 89600);
    const bf16_t* H = (const bf16_t*)(p.ws + O_H); const float* FC = (const float*)(p.ws + O_FC); const bf16_t* KN = (const bf16_t*)(p.ws + O_KN); const bf16_t* VT = (const bf16_t*)(p.ws + O_VT);
    bf16_t* Y = (bf16_t*)(p.ws + O_XN);
    const int tid = otid(), lane = tid & 63, w = tid >> 6, b = bh >> 3, hh = bh & 7; const size_t r0 = (size_t)b * SEQ + qb * 128;
    const float LOG2E = 1.4426950408889634f;
    __syncthreads();
    { const int l = tid >> 2, c16 = (tid & 3) * 16; float a[8], c[8];
      unpack8(*(const uint4*)(H + (r0 + l) * HS + 1792 + hh * 64 + c16), a); unpack8(*(const uint4*)(H + (r0 + l) * HS + 1792 + hh * 64 + c16 + 8), c);
      float ss = 0.f;
#pragma unroll
      for (int e = 0; e < 8; ++e) ss += a[e] * a[e] + c[e] * c[e];
      ss += __shfl_xor(ss, 1); ss += __shfl_xor(ss, 2); const float rstd = rsqrtf(ss * (1.f / 64.f) + 1e-6f) * (0.125f * LOG2E);
#pragma unroll
      for (int e = 0; e < 8; ++e) { a[e] *= rstd * p.od_qn_w[c16 + e]; c[e] *= rstd * p.od_qn_w[c16 + 8 + e]; }
      *(uint4*)(Qs + l * 72 + c16) = pack8(a); *(uint4*)(Qs + l * 72 + c16 + 8) = pack8(c); }
    float mrow = -1e30f, lsum = 0.f; f32x4 O[4];
#pragma unroll
    for (int j = 0; j < 4; ++j) O[j] = (f32x4){0.f, 0.f, 0.f, 0.f};
    const int q4 = (lane >> 4) * 4, lq = 16 * w + (lane & 15);
    uint4 kreg0, kreg1, vreg0, vreg1; float ckreg = 0.f;
    const int g0 = tid, g1 = tid + 512;
#define FOX_ISSUE(kb_) { \
        kreg0 = *(const uint4*)(KN + ((size_t)bh * SEQ + (kb_) * 128 + (g0 >> 3)) * 64 + (g0 & 7) * 8); \
        kreg1 = *(const uint4*)(KN + ((size_t)bh * SEQ + (kb_) * 128 + (g1 >> 3)) * 64 + (g1 & 7) * 8); \
        vreg0 = *(const uint4*)(VT + ((size_t)bh * 64 + (g0 >> 4)) * SEQ + (kb_) * 128 + (g0 & 15) * 8); \
        vreg1 = *(const uint4*)(VT + ((size_t)bh * 64 + (g1 >> 4)) * SEQ + (kb_) * 128 + (g1 & 15) * 8); \
        if (tid < 128) ckreg = FC[(size_t)bh * SEQ + (kb_) * 128 + tid]; }
    FOX_ISSUE(0)
    for (int kb = 0; kb <= qb; ++kb) {
        __syncthreads();
        *(uint4*)(Ks + (g0 >> 3) * 72 + (g0 & 7) * 8) = kreg0; *(uint4*)(Ks + (g1 >> 3) * 72 + (g1 & 7) * 8) = kreg1;
        *(uint4*)(Vts + (g0 >> 4) * 136 + (g0 & 15) * 8) = vreg0; *(uint4*)(Vts + (g1 >> 4) * 136 + (g1 & 15) * 8) = vreg1;
        if (tid < 128) ck[tid] = -ckreg * LOG2E;
        __syncthreads();
        if (kb < qb) FOX_ISSUE(kb + 1)
        f32x4 S[8];
        { const bf16x8 q0 = ldfrag(Qs, 16 * w, 72, 0, lane), q1 = ldfrag(Qs, 16 * w, 72, 32, lane);
#pragma unroll
          for (int nt = 0; nt < 8; ++nt) { f32x4 z = *(const f32x4*)(ck + nt * 16 + q4); z = MFMA16(ldfrag(Ks, nt * 16, 72, 0, lane), q0, z); S[nt] = MFMA16(ldfrag(Ks, nt * 16, 72, 32, lane), q1, z); } }
        if (kb == qb) {
#pragma unroll
            for (int nt = 0; nt < 8; ++nt)
#pragma unroll
                for (int j = 0; j < 4; ++j) if (nt * 16 + q4 + j > lq) S[nt][j] = -1e30f;
        }
        float mx = S[0][0];
#pragma unroll
        for (int nt = 0; nt < 8; ++nt)
#pragma unroll
            for (int j = 0; j < 4; ++j) mx = fmaxf(mx, S[nt][j]);
        mx = fmaxf(mx, __shfl_xor(mx, 16)); mx = fmaxf(mx, __shfl_xor(mx, 32));
        const float mnew = fmaxf(mrow, mx); const float alpha = __builtin_amdgcn_exp2f(mrow - mnew); mrow = mnew;
        float rs = 0.f;
#pragma unroll
        for (int nt = 0; nt < 8; ++nt)
#pragma unroll
            for (int j = 0; j < 4; ++j) { const float pv = __builtin_amdgcn_exp2f(S[nt][j] - mnew); S[nt][j] = pv; rs += pv; }
        lsum = lsum * alpha + rs;
#pragma unroll
        for (int et = 0; et < 4; ++et) O[et] = O[et] * alpha;
#pragma unroll
        for (int ks = 0; ks < 4; ++ks) {
            uint4 pw; pw.x = cvt_pk_bf16(S[2 * ks][0], S[2 * ks][1]); pw.y = cvt_pk_bf16(S[2 * ks][2], S[2 * ks][3]); pw.z = cvt_pk_bf16(S[2 * ks + 1][0], S[2 * ks + 1][1]); pw.w = cvt_pk_bf16(S[2 * ks + 1][2], S[2 * ks + 1][3]);
            const bf16x8 pf = __builtin_bit_cast(bf16x8, pw);
#pragma unroll
            for (int et = 0; et < 4; ++et) { const bf16_t* vp = Vts + (et * 16 + (lane & 15)) * 136 + ks * 32 + q4;
                uint4 vw; const uint2 lo = *(const uint2*)vp, hi = *(const uint2*)(vp + 16); vw.x = lo.x; vw.y = lo.y; vw.z = hi.x; vw.w = hi.y;
                O[et] = MFMA16(__builtin_bit_cast(bf16x8, vw), pf, O[et]); }
        }
    }
    lsum += __shfl_xor(lsum, 16); lsum += __shfl_xor(lsum, 32);
    const float inv = 1.f / lsum;
#pragma unroll
    for (int et = 0; et < 4; ++et) { uint2 o; o.x = pack2(O[et][0] * inv, O[et][1] * inv); o.y = pack2(O[et][2] * inv, O[et][3] * inv);
        *(uint2*)(Y + (r0 + lq) * DM + 512 + hh * 64 + et * 16 + q4) = o; }
}
constexpr int RW_T = 32, RW_BUF = 43008;
struct RwRegs { unsigned short r[9], k[9], v[9], om[8], a[8]; float kn[8]; };
#define RW_BAR() do { asm volatile("s_waitcnt lgkmcnt(0)" ::: "memory"); __builtin_amdgcn_s_barrier(); asm volatile("" ::: "memory"); } while (0)
DI void rwkv_unit(const Params& p, unsigned char* smem, int bh, int rg) {
    const bf16_t* H = (const bf16_t*)(p.ws + O_H); const bf16_t* LW = (const bf16_t*)(p.ws + O_LW); bf16_t* Y = (bf16_t*)(p.ws + O_XN); const float* KNRM = (const float*)(p.ws + O_KNRM);
    const int tid = otid(), lane = tid & 63, w = tid >> 6, b = bh >> 3, hh = bh & 7; const size_t rb = (size_t)b * SEQ;
    float* ysh = (float*)(smem + 2 * RW_BUF);
    const int NCH = SEQ / RW_T;
    __syncthreads();
    if (w < 2) {
        float S0 = 0.f, S1 = 0.f, S2 = 0.f, S3 = 0.f; const int kq = lane & 15, row = w * 4 + (lane >> 4);
        RW_BAR();
        for (int ch = 0; ch < NCH; ++ch) {
            const float* bufp = (const float*)(smem + (ch & 1) * RW_BUF) + kq * 4; const float* vp = (const float*)(smem + (ch & 1) * RW_BUF) + 10240 + row; float* yo = ysh + (ch & 1) * 256 + row;
#define RW_LOAD(R, W, K, Q, B, V, tt) { R = *(const f32x4*)(bufp + (tt) * 64); W = *(const f32x4*)(bufp + 2048 + (tt) * 64); K = *(const f32x4*)(bufp + 4096 + (tt) * 64); \
                Q = *(const f32x4*)(bufp + 6144 + (tt) * 64); B = *(const f32x4*)(bufp + 8192 + (tt) * 64); V = vp[(tt) * 8]; }
#define DPPF(x, ctrl) __builtin_bit_cast(float, __builtin_amdgcn_update_dpp(0, __builtin_bit_cast(int, (x)), (ctrl), 0xF, 0xF, true))
            f32x4 prevR = {0.f, 0.f, 0.f, 0.f}; float yacc = 0.f;
            f32x4 rN, wN, kN, qN, bN; float vN;
            RW_LOAD(rN, wN, kN, qN, bN, vN, 0)
            __builtin_amdgcn_sched_barrier(0);
#pragma unroll
            for (int tt = 0; tt < RW_T; ++tt) {
                const f32x4 R = rN, W = wN, K = kN, Q = qN, B = bN; const float V = vN;
                if (tt + 1 < RW_T) RW_LOAD(rN, wN, kN, qN, bN, vN, tt + 1)
                float d = S0 * Q[0] + S1 * Q[1] + S2 * Q[2] + S3 * Q[3];
                if (tt > 0) {
                    float y = S0 * prevR[0] + S1 * prevR[1] + S2 * prevR[2] + S3 * prevR[3];
                    d += DPPF(d, 0xB1); y += DPPF(y, 0xB1); d += DPPF(d, 0x4E); y += DPPF(y, 0x4E); d += DPPF(d, 0x141); y += DPPF(y, 0x141); d += DPPF(d, 0x140); y += DPPF(y, 0x140);
                    yacc = (kq == ((tt - 1) & 15)) ? y : yacc;
                    if (tt == 16) yo[kq * 8] = yacc;
                } else d = dpp_red16(d);
                const float sa = -d;
                S0 = (S0 * W[0] + V * K[0]) + sa * B[0]; S1 = (S1 * W[1] + V * K[1]) + sa * B[1]; S2 = (S2 * W[2] + V * K[2]) + sa * B[2]; S3 = (S3 * W[3] + V * K[3]) + sa * B[3];
                prevR = R;
                if (tt & 1) __builtin_amdgcn_sched_barrier(0);
            }
            { float y = S0 * prevR[0] + S1 * prevR[1] + S2 * prevR[2] + S3 * prevR[3]; y = dpp_red16(y); yacc = (kq == 15) ? y : yacc; yo[(16 + kq) * 8] = yacc; }
            RW_BAR();
        }
    } else if (w == 4 || w == 5) {
        const unsigned* ta0; const unsigned* ta1; const unsigned* ta2; size_t st0, st1, st2;
        { int L = lane; int tok = L / 5, which = L - tok * 5; ta0 = (const unsigned*)(which < 3 ? H + (rb + tok) * HS + which * 512 + hh * 64 : LW + (rb + tok) * 1536 + (which - 3) * 512 + hh * 64); st0 = which < 3 ? (size_t)HS * 2 : (size_t)1536 * 2;
          L = lane + 64; tok = L / 5; which = L - tok * 5; ta1 = (const unsigned*)(which < 3 ? H + (rb + tok) * HS + which * 512 + hh * 64 : LW + (rb + tok) * 1536 + (which - 3) * 512 + hh * 64); st1 = which < 3 ? (size_t)HS * 2 : (size_t)1536 * 2;
          L = lane + 128 > 159 ? 159 : lane + 128; tok = L / 5; which = L - tok * 5; ta2 = (const unsigned*)(which < 3 ? H + (rb + tok) * HS + which * 512 + hh * 64 : LW + (rb + tok) * 1536 + (which - 3) * 512 + hh * 64); st2 = which < 3 ? (size_t)HS * 2 : (size_t)1536 * 2; }
        unsigned x0 = 0, x1 = 0, x2 = 0, y0 = 0, y1 = 0, y2 = 0, z0 = 0, z1 = 0, z2 = 0, pacc = 0;
        RW_BAR();
        for (int ch = 0; ch < NCH; ++ch) {
            if (w == 4) { int cc = ch + 6; cc = cc > NCH - 1 ? NCH - 1 : cc; const size_t tb = (size_t)cc * RW_T;
                pacc ^= x0 ^ x1 ^ x2; x0 = y0; x1 = y1; x2 = y2; y0 = z0; y1 = z1; y2 = z2;
                z0 = *(const unsigned*)((const char*)ta0 + tb * st0); z1 = *(const unsigned*)((const char*)ta1 + tb * st1); z2 = *(const unsigned*)((const char*)ta2 + tb * st2); }
            RW_BAR();
        }
        pacc ^= x0 ^ x1 ^ x2 ^ y0 ^ y1 ^ y2 ^ z0 ^ z1 ^ z2; if (pacc == 0x9e3779b9u && rg == 77) Y[0] = 0;
    } else {
        const int lw = (w & 1) + ((w >> 2) << 1), col = hh * 64 + lane; RwRegs ra;
        const float mur = p.od_mu[col], muk = p.od_mu[512 + col], muv = p.od_mu[1024 + col], kk_w = p.od_k_k[col], ka_w = p.od_k_a[col];
        auto issue = [&](int ch, RwRegs& rr) {
            const int tbase = ch * RW_T + lw * 8;
#pragma unroll
            for (int i = 0; i < 9; ++i) { const int t = tbase + i - 1;
                if (t >= 0) { const bf16_t* hp = H + (rb + t) * HS; rr.r[i] = hp[col]; rr.k[i] = hp[512 + col]; rr.v[i] = hp[1024 + col]; } else { rr.r[i] = 0; rr.k[i] = 0; rr.v[i] = 0; }
                if (i > 0) { const bf16_t* lp = LW + (rb + t) * 1536; rr.om[i - 1] = lp[col]; rr.a[i - 1] = lp[512 + col]; rr.kn[i - 1] = KNRM[(rb + t) * 8 + hh]; } }
        };
        auto process = [&](int ch, const RwRegs& rr) {
            float* bufp = (float*)(smem + (ch & 1) * RW_BUF);
#pragma unroll
            for (int i = 1; i < 9; ++i) { const int tt = lw * 8 + i - 1;
                const float rc = bf2f(rr.r[i]), rp = bf2f(rr.r[i - 1]), kc = bf2f(rr.k[i]), kp = bf2f(rr.k[i - 1]), vc = bf2f(rr.v[i]), vp = bf2f(rr.v[i - 1]);
                const float rl = rc + (rp - rc) * mur, kl = kc + (kp - kc) * muk, vl = vc + (vp - vc) * muv; const float a = bf2f(rr.a[i - 1]), wv = 1.f - bf2f(rr.om[i - 1]);
                const float kk = kl * kk_w * rr.kn[i - 1];
                bufp[tt * 64 + lane] = rl; bufp[2048 + tt * 64 + lane] = wv; bufp[4096 + tt * 64 + lane] = kl * (1.f + (a - 1.f) * ka_w); bufp[6144 + tt * 64 + lane] = kk; bufp[8192 + tt * 64 + lane] = kk * a;
                if ((lane >> 3) == rg) bufp[10240 + tt * 8 + (lane & 7)] = vl; }
        };
        issue(0, ra); process(0, ra); issue(1, ra);
        RW_BAR();
        for (int ch = 0; ch < NCH; ++ch) {
            if (ch + 1 < NCH) { process(ch + 1, ra); if (ch + 2 < NCH) issue(ch + 2, ra); }
            if (ch > 0 && lw < 2) { const float* yi = ysh + ((ch - 1) & 1) * 256; const int t2 = lw * 64 + lane, tt = t2 >> 2, pr = (t2 & 3) * 2;
                *(unsigned*)(Y + (rb + (ch - 1) * RW_T + tt) * DM + hh * 64 + rg * 8 + pr) = pack2(yi[tt * 8 + pr], yi[tt * 8 + pr + 1]); }
            RW_BAR();
        }
        if (lw < 2) { const float* yi = ysh + ((NCH - 1) & 1) * 256; const int t2 = lw * 64 + lane, tt = t2 >> 2, pr = (t2 & 3) * 2;
          *(unsigned*)(Y + (rb + (NCH - 1) * RW_T + tt) * DM + hh * 64 + rg * 8 + pr) = pack2(yi[tt * 8 + pr], yi[tt * 8 + pr + 1]); }
    }
    __syncthreads();
}
DI void phase_l1_mix(const Params& p, unsigned char* smem, int pass) {
    unsigned* ctr = (unsigned*)(p.ws + O_CTL) + pass * 4; int* sh = (int*)(smem + 90112);
    if (obid() < 128 && pass != 2) rwkv_unit(p, smem, obid() >> 3, obid() & 7);
    for (;;) {
        __syncthreads(); if (otid() == 0) *sh = (int)atomicAdd(ctr, 1u); __syncthreads();
        const int u = *sh; if (u >= 1024) break;
        fox_unit(p, smem, u & 15, 63 - (u >> 4));
    }
}
DI void phase_rwkv_fin(const Params& p) {
    const bf16_t* H = (const bf16_t*)(p.ws + O_H); const bf16_t* LW = (const bf16_t*)(p.ws + O_LW); bf16_t* Y = (bf16_t*)(p.ws + O_XN);
    const int lane = otid() & 63, wv = otid() >> 6;
#pragma unroll 4
    for (int task = obid() * 8 + wv; task < TOK * 8; task += gridDim.x * 8) {
        const int r = task >> 3, hh = task & 7, t = r & (SEQ - 1), col = hh * 64 + lane; const bf16_t* hp = H + (size_t)r * HS;
        const float y = bf2f(Y[(size_t)r * DM + col]); const float mean = red64(y) * (1.f / 64.f); const float dy = y - mean; const float var = red64(dy * dy) * (1.f / 64.f);
        const float yln = dy * rsqrtf(var + 64e-5f) * p.od_ln_w[col] + p.od_ln_b[col];
        const bf16_t* hq = t > 0 ? hp - HS : hp; const float pm = t > 0 ? 1.f : 0.f;
        const float rc = bf2f(hp[col]), kc = bf2f(hp[512 + col]), vc = bf2f(hp[1024 + col]); const float rp = bf2f(hq[col]) * pm, kp = bf2f(hq[512 + col]) * pm, vp = bf2f(hq[1024 + col]) * pm;
        const float rl = rc + (rp - rc) * p.od_mu[col], kl = kc + (kp - kc) * p.od_mu[512 + col], vl = vc + (vp - vc) * p.od_mu[1024 + col];
        const float a = bf2f(LW[(size_t)r * 1536 + 512 + col]), g = bf2f(LW[(size_t)r * 1536 + 1024 + col]);
        const float kt = kl * (1.f + (a - 1.f) * p.od_k_a[col]); const float bonus = red64(rl * kt * p.od_r_k[col]) * vl;
        Y[(size_t)r * DM + col] = f2bf((yln + bonus) * g);
    }
}
#define XB_TMO      128
#define XB_XCNT(j)  (256  + 64 * (j))
#define XB_XSUB(j)  (1280 + 64 * (j))
#define XB_XGEN(j)  (2304 + 64 * (j))
#define XB_TOP      3328
#define XB_TOPGEN   3392
#define XCD_BAR_WORDS 3456
#define XB_SPIN_CAP (1u << 18)
#define LAS __attribute__((address_space(3)))

__device__ __forceinline__ unsigned xb_ld(unsigned* p)              { return __hip_atomic_load(p, __ATOMIC_RELAXED, __HIP_MEMORY_SCOPE_AGENT); }
__device__ __forceinline__ unsigned xb_add(unsigned* p, unsigned v) { return __hip_atomic_fetch_add(p, v, __ATOMIC_RELAXED, __HIP_MEMORY_SCOPE_AGENT); }
__device__ __forceinline__ unsigned xb_xcc_id() { return (unsigned)__builtin_amdgcn_s_getreg((3 << 11) | 20) & 0xFu; }
#define XB_SPIN(cond, bar) do { unsigned _sp = 0; while (cond) { __builtin_amdgcn_s_sleep(1); \
    if ((++_sp & 255u) == 0u) { if (xb_ld(&(bar)[XB_TMO])) break; if (_sp > XB_SPIN_CAP) { atomicAdd(&(bar)[XB_TMO], 1u); break; } } } } while (0)

struct XcdBarrier {
    unsigned* bar; unsigned x;
    volatile LAS unsigned* st;
};

__device__ __forceinline__ XcdBarrier xcd_barrier_post(unsigned* bar, volatile LAS unsigned* st) {
    XcdBarrier b; b.bar = bar; b.x = xb_xcc_id(); b.st = st;
    if (threadIdx.x == 0) (void)xb_add(&bar[XB_XCNT(b.x)], 1u);
    return b;
}
__device__ __forceinline__ void xcd_barrier_complete(unsigned* bar, unsigned x, unsigned& nloc, unsigned& nx) {
    const unsigned G = gridDim.x * gridDim.y * gridDim.z;
    unsigned sum, cnt, mine, sp = 0u;
    for (;;) {
        sum = 0u; cnt = 0u; mine = 0u;
#pragma unroll
        for (unsigned j = 0; j < 16; ++j) { const unsigned c = xb_ld(&bar[XB_XCNT(j)]); sum += c; cnt += (c > 0u) ? 1u : 0u; mine = (j == x) ? c : mine; }
        if (sum == G) break;
        __builtin_amdgcn_s_sleep(1);
        if ((++sp & 255u) == 0u) { if (xb_ld(&bar[XB_TMO])) break; if (sp > XB_SPIN_CAP) { atomicAdd(&bar[XB_TMO], 1u); break; } }
    }
    nloc = mine > 0u ? mine : 1u; nx = cnt > 0u ? cnt : 1u;
}

__device__ __forceinline__ void xcd_barrier(const XcdBarrier& b) {
    asm volatile("s_waitcnt vmcnt(0)" ::: "memory");
    __syncthreads();
    if (threadIdx.x == 0) {
        unsigned* bar = b.bar;
        __builtin_amdgcn_s_waitcnt(0);
        unsigned nloc = b.st[0], nx = b.st[1];
        if (nloc == 0u) { xcd_barrier_complete(bar, b.x, nloc, nx); b.st[0] = nloc; b.st[1] = nx; }
        const unsigned old = xb_add(&bar[XB_XSUB(b.x)], 1u);
        const unsigned gen = old / nloc;
        if (old + 1u == (gen + 1u) * nloc) {
            __builtin_amdgcn_fence(__ATOMIC_RELEASE, "agent");
            asm volatile("s_waitcnt vmcnt(0)" ::: "memory");
            const unsigned og = xb_add(&bar[XB_TOP], 1u);
            const unsigned tg = og / nx;
            if (og + 1u == (tg + 1u) * nx) xb_add(&bar[XB_TOPGEN], 1u);
            else XB_SPIN(xb_ld(&bar[XB_TOPGEN]) == tg, bar);
            __builtin_amdgcn_fence(__ATOMIC_ACQUIRE, "agent");
            xb_add(&bar[XB_XGEN(b.x)], 1u);
            asm volatile("s_waitcnt vmcnt(0)" ::: "memory");
        } else {
            XB_SPIN(xb_ld(&bar[XB_XGEN(b.x)]) == gen, bar);
            __builtin_amdgcn_fence(__ATOMIC_ACQUIRE, "agent");
            asm volatile("s_waitcnt vmcnt(0)" ::: "memory");
        }
    }
    __syncthreads();
}


__global__ void __launch_bounds__(512, 2) fwd_megakernel(Params p) {
    extern __shared__ __attribute__((aligned(16))) unsigned char smem[];
    cg::grid_group grid = cg::this_grid();
    unsigned char* ws = p.ws;
    bf16_t* XN = (bf16_t*)(ws + O_XN); bf16_t* Hb = (bf16_t*)(ws + O_H); float* aux = (float*)(ws + O_AUX);
    const bf16_t* t_in = (const bf16_t*)(ws + O_WT_IN); const bf16_t* t_out = (const bf16_t*)(ws + O_WT_OUT); const bf16_t* t_up = (const bf16_t*)(ws + O_WT_UP);
    const bf16_t* t_dn = (const bf16_t*)(ws + O_WT_DN); const bf16_t* t_lr = (const bf16_t*)(ws + O_WT_LR);
    if (blockIdx.x == 0 && threadIdx.x < 16) ((unsigned*)(ws + O_CTL))[threadIdx.x] = 0u;
    if (threadIdx.x == 0) *(uint4*)(smem + 131072) = make_uint4(0u, 0u, 0u, 0u);
    __syncthreads();
    const XcdBarrier xb = xcd_barrier_post((unsigned*)(ws + O_BAR), (volatile LAS unsigned*)(smem + 131072));
#define GSYNC() xcd_barrier(xb)
#define GEMM_H(layer) { EpiH E; E.H = Hb; E.aux = aux; E.auxc = layer ? 3328 : 1280; run_gemm(smem, XN, t_in, 3584, 1024, E); }
#define GEMM_OUT(layer) { EpiRes E; E.res = layer ? p.out : p.x; E.out = p.out; run_gemm(smem, XN, t_out, 1024, 1024, E); }
#define GEMM_UP(layer) { EpiGU E; E.GC = (bf16_t*)(ws + O_G); E.U = (bf16_t*)(ws + O_U); E.cw = p.ffn_conv_w + (size_t)(layer) * 3 * DFF; E.cb = p.ffn_conv_b + (size_t)(layer) * DFF; run_gemm(smem, XN, t_up, 2 * DFF, 1024, E); }
#define GEMM_DN() { EpiRes E; E.res = p.out; E.out = p.out; run_gemm(smem, (const bf16_t*)(ws + O_U), t_dn, 1024, DFF, E); }
    phase_weights(p, smem, 0, 0); phase_rmsnorm(p.x, p.ev_norm_w, XN);
    if (p.ws == nullptr) grid.sync();
    GSYNC();
    GEMM_H(0) phase_weights(p, smem, 0, 1); GSYNC();
#if PROBE == 2
    GEMM_H(0) GSYNC();
#endif
    phase_m1(p, smem); GSYNC();
#if PROBE == 3
    phase_m1(p, smem); GSYNC();
#endif
    phase_m2(p); GSYNC();
#if PROBE == 6
    GSYNC(); GSYNC(); GSYNC(); GSYNC(); GSYNC(); GSYNC(); GSYNC(); GSYNC(); GSYNC(); GSYNC();
#endif
#if PROBE == 7
    phase_weights(p, smem, 0, 0); GSYNC(); phase_rmsnorm(p.x, p.ev_norm_w, XN); GSYNC(); phase_rmsnorm(p.x, p.ev_norm_w, XN); GSYNC();
#endif
    phase_m3(p, smem); GSYNC();
#if PROBE == 3
    phase_m3(p, smem); GSYNC();
#endif
    GEMM_OUT(0) GSYNC();
#if PROBE == 2
    GEMM_OUT(0) GSYNC();
#endif
    phase_rmsnorm(p.out, p.ffn_norm_w, XN); GSYNC();
    GEMM_UP(0) phase_weights(p, smem, 0, 2); phase_weights(p, smem, 1, 0, 128); GSYNC();
    phase_ffn_fix(p, 0); GSYNC();
    GEMM_DN() GSYNC();
    phase_rmsnorm(p.out, p.od_norm_w, XN); GSYNC();
    GEMM_H(1) phase_weights(p, smem, 1, 1); GSYNC();
    phase_l1_prep(p, smem); GSYNC();
    { EpiLR E; E.LW = (bf16_t*)(ws + O_LW); E.w0 = p.od_w0; E.a0 = p.od_a0; run_gemm(smem, (const bf16_t*)(ws + O_AP), t_lr, 1536, 256, E); } GSYNC();
    phase_l1_mix(p, smem, 0); GSYNC();
#if PROBE == 4
    phase_l1_mix(p, smem, 1); GSYNC();
#endif
#if PROBE == 5
    phase_l1_mix(p, smem, 2); GSYNC();
#endif
    phase_rwkv_fin(p); GSYNC();
    GEMM_OUT(1) GSYNC();
    phase_rmsnorm(p.out, p.ffn_norm_w + DM, XN); GSYNC();
    GEMM_UP(1) phase_weights(p, smem, 1, 2); GSYNC();
    phase_ffn_fix(p, 1); GSYNC();
    GEMM_DN()
}

extern "C" void kernel_launch(void* const* d_in, const int* in_sizes, int n_in, void* d_out, int out_size, void* d_ws, size_t ws_size, hipStream_t stream) {
    static int grid_blocks = 0;
    if (grid_blocks == 0) {
        int dev = 0, cus = 0, per_cu = 0;
        hipGetDevice(&dev); hipDeviceGetAttribute(&cus, hipDeviceAttributeMultiprocessorCount, dev);
        if (hipFuncSetAttribute((const void*)fwd_megakernel, hipFuncAttributeMaxDynamicSharedMemorySize, LDS_BYTES) != hipSuccess) fprintf(stderr, "hipFuncSetAttribute failed\n");
        hipOccupancyMaxActiveBlocksPerMultiprocessor(&per_cu, (const void*)fwd_megakernel, 512, LDS_BYTES);
        (void)hipGetLastError();
        if (per_cu < 1) fprintf(stderr, "occupancy query says %d blocks per CU\n", per_cu);
        grid_blocks = cus > 0 ? cus : 256;
        if (ws_size < WS_NEED) fprintf(stderr, "workspace too small: %zu < %zu\n", ws_size, (size_t)WS_NEED);
    }
    Params p{};
    const float** pp = (const float**)&p;
    for (int i = 0; i < 33; ++i) pp[i] = (const float*)d_in[i];
    p.out = (float*)d_out; p.ws = (unsigned char*)d_ws;
    (void)hipMemsetAsync((char*)d_ws + O_BAR, 0, 16384, stream);
    void* args[] = {&p};
    hipError_t e = hipLaunchCooperativeKernel((const void*)fwd_megakernel, dim3(grid_blocks), dim3(512), args, LDS_BYTES, stream);
    if (e != hipSuccess) fprintf(stderr, "cooperative launch failed: %s (grid %d)\n", hipGetErrorString(e), grid_blocks);
}
```

```cpp
#include <hip/hip_runtime.h>
#include <hip/hip_cooperative_groups.h>
#include <cstdio>
#ifndef PROBE
#define PROBE 0
#endif
namespace cg = cooperative_groups;
namespace pg8 {
#define PG8_LAS __attribute__((address_space(3)))
typedef unsigned short bf16_t;
typedef short bf16x8 __attribute__((ext_vector_type(8)));
typedef float f32x4 __attribute__((ext_vector_type(4)));
typedef unsigned u32x4 __attribute__((ext_vector_type(4)));
constexpr int BM = 256, BK = 64, HALF = 128, HTB = HALF * BK * 2  , STAGE_BYTES = 8 * HTB, NXCD = 8, WGM = 8;

__host__ __device__ __forceinline__ int lds_byte(int r, int c) { const int st = (r >> 4) * 2 + (c >> 5), rr = r & 15, cc = c & 31, ob = rr * 64 + cc * 2; return st * 1024 + (ob ^ (((ob >> 9) & 1) << 5)); }
__host__ __device__ __forceinline__ void stage_rc(int b, int& R, int& C) { const int st = b / 1024, sb = b % 1024, swz = sb ^ (((sb >> 9) & 1) << 5); R = (st >> 1) * 16 + swz / 64; C = (st & 1) * 32 + (swz % 64) / 2; }
__host__ __device__ __forceinline__ int perm32(int rho) { const int n = rho >> 4, i = rho & 15; return 8 * (i >> 2) + 4 * n + (i & 3); }

struct Unit { int pm, pn; };
struct Gemm { const bf16_t* A; const bf16_t* Bt; int M, N, K; };

struct StaticOrder {
    int nM, nN, nwg, G, c;
    __host__ __device__ void init(int M, int N, int G_, int c_) { nM = M / BM; nN = N / BM; nwg = nM * nN; G = G_; c = c_; }
    __host__ __device__ bool next(int i, Unit& u) const {
        const long L = (long)i * G + c; if (L >= nwg) return false;
        int wgid = (int)L; { const int q = nwg / NXCD, r = nwg % NXCD, xcd = wgid % NXCD, off = wgid / NXCD; wgid = (xcd < r ? xcd * (q + 1) : r * (q + 1) + (xcd - r) * q) + off; }
        const int nig = WGM * nN, gid = wgid / nig, fm = gid * WGM, gsz = (nM - fm) < WGM ? (nM - fm) : WGM;
        u.pm = fm + ((wgid % nig) % gsz); u.pn = (wgid % nig) / gsz; return true;
    }
    __device__ __forceinline__ void a_ready(const Unit&) const {}
    __device__ __forceinline__ void done(const Unit&) const {}
};
__device__ __forceinline__ unsigned cvt_pk_bf16(float lo, float hi) { unsigned r; asm volatile("v_cvt_pk_bf16_f32 %0, %1, %2" : "=v"(r) : "v"(lo), "v"(hi)); return r; }

template <class Epi, class Sched, bool STAMP = false>
__device__ __forceinline__ void gemm_phase(PG8_LAS unsigned char* lds, const Gemm g, const Sched& S, const Epi& E, unsigned long long* stamps) {
    int tid_ = threadIdx.x; asm volatile("" : "+v"(tid_)); const int tid = tid_, wid = __builtin_amdgcn_readfirstlane(tid >> 6), lane = tid & 63, wr = wid >> 2, wc = wid & 3, fr = lane & 15, fq = lane >> 4;
    const int K = g.K, nt = K / BK;
    int ts_lo = 0, ts_hi = 0, nts = 0; const unsigned long long rt_entry = STAMP ? (unsigned long long)wall_clock64() : 0ull;
#define PG8_STAMP() do { if (STAMP && wid == 0 && nts < 64) { const unsigned long long _c = (unsigned long long)clock64(); \
        ts_lo = (lane == nts) ? (int)(unsigned)_c : ts_lo; ts_hi = (lane == nts) ? (int)(unsigned)(_c >> 32) : ts_hi; ++nts; } } while (0)
    PG8_STAMP();
    unsigned voffA[2], voffB[2];
#pragma unroll
    for (int i = 0; i < 2; ++i) { int R, C; stage_rc(tid * 16 + i * 8192, R, C); const int Rb = Epi::PERM ? ((R & ~31) + perm32(R & 31)) : R;
        voffA[i] = (unsigned)(R * K + C) * 2u; voffB[i] = (unsigned)(Rb * K + C) * 2u; }
    const size_t kstep = (size_t)(BK * 2);
    const size_t hstep = (size_t)HALF * K * 2;
    const size_t tstep = 2 * hstep;
    const unsigned ldsw = (unsigned)wid * 1024u;
    const int aoff = lds_byte(wr * 64 + fr, fq * 8), boff = lds_byte(wc * 32 + fr, fq * 8);
#define PG8_SA(b, h) (((b) * 2 + (h)) * HTB)
#define PG8_SB(b, h) ((4 + (b) * 2 + (h)) * HTB)
#define PG8_STAGE(bufoff, gbase, voff) do { _Pragma("unroll") for (int _i = 0; _i < 2; ++_i) \
        __builtin_amdgcn_global_load_lds((const unsigned*)((const char*)(gbase) + (voff)[_i]), (PG8_LAS unsigned*)(lds + (bufoff) + ldsw + _i * 8192), 16, 0, 0); } while (0)
#define PG8_LDA(dst, b, h) do { _Pragma("unroll") for (int m = 0; m < 4; ++m) _Pragma("unroll") for (int k = 0; k < 2; ++k) dst[m][k] = *(const PG8_LAS bf16x8*)(lds + PG8_SA(b, h) + aoff + m * 2048 + k * 1024); } while (0)
#define PG8_LDB(dst, b, h) do { _Pragma("unroll") for (int n = 0; n < 2; ++n) _Pragma("unroll") for (int k = 0; k < 2; ++k) dst[n][k] = *(const PG8_LAS bf16x8*)(lds + PG8_SB(b, h) + boff + n * 2048 + k * 1024); } while (0)
#define PG8_MMA(ai, bj, At, Bt) do { __builtin_amdgcn_s_setprio(1); _Pragma("unroll") for (int m = 0; m < 4; ++m) _Pragma("unroll") for (int n = 0; n < 2; ++n) _Pragma("unroll") for (int k = 0; k < 2; ++k) \
        acc[ai][bj][m][n] = __builtin_amdgcn_mfma_f32_16x16x32_bf16(Bt[n][k], At[m][k], acc[ai][bj][m][n], 0, 0, 0); __builtin_amdgcn_s_setprio(0); } while (0)
#define PG8_WAIT_V(n) asm volatile("s_waitcnt vmcnt(" #n ")" ::: "memory")
#define PG8_WAIT_L(n) asm volatile("s_waitcnt lgkmcnt(" #n ")" ::: "memory")
#define PG8_BAR __builtin_amdgcn_s_barrier()
#define PG8_SCHED __builtin_amdgcn_sched_barrier(0)
    Unit cur, nxt; int ui = 0;
    if (!S.next(0, cur)) return;
    f32x4 acc[2][2][4][2];
#pragma unroll
    for (int a = 0; a < 2; ++a)
#pragma unroll
        for (int b = 0; b < 2; ++b)
#pragma unroll
            for (int m = 0; m < 4; ++m)
#pragma unroll
                for (int n = 0; n < 2; ++n) acc[a][b][m][n] = (f32x4){0.f, 0.f, 0.f, 0.f};
    bf16x8 At[4][2], B0[2][2], B1[2][2];
    const char* cA = (const char*)g.A + (size_t)cur.pm * tstep; const char* cB = (const char*)g.Bt + (size_t)cur.pn * tstep;
    S.a_ready(cur);
    PG8_STAGE(PG8_SB(0, 0), cB, voffB); PG8_STAGE(PG8_SA(0, 0), cA, voffA); PG8_STAGE(PG8_SB(0, 1), cB + hstep, voffB); PG8_STAGE(PG8_SA(0, 1), cA + hstep, voffA);
    if (wr == 1) PG8_BAR;
    PG8_WAIT_V(4); PG8_BAR;
    PG8_STAGE(PG8_SB(1, 0), cB + kstep, voffB); PG8_STAGE(PG8_SA(1, 0), cA + kstep, voffA); PG8_STAGE(PG8_SB(1, 1), cB + hstep + kstep, voffB);
    PG8_WAIT_V(6); PG8_BAR;
    PG8_STAMP();
    for (;;) {
        const bool has_next = S.next(ui + 1, nxt);
        const char* nA = has_next ? (const char*)g.A + (size_t)nxt.pm * tstep : cA; const char* nB = has_next ? (const char*)g.Bt + (size_t)nxt.pn * tstep : cB;
        for (int t = 0; t < nt; t += 2) {
            const bool last = (t == nt - 2);
            const char* a1 = cA + (size_t)(t + 1) * kstep;
            const char* a2 = last ? nA : cA + (size_t)(t + 2) * kstep; const char* b2 = last ? nB : cB + (size_t)(t + 2) * kstep;
            const char* a3 = a2 + kstep; const char* b3 = b2 + kstep;
            if (last && has_next) S.a_ready(nxt);
            PG8_LDB(B0, 0, 0); PG8_SCHED; PG8_LDA(At, 0, 0); PG8_STAGE(PG8_SA(1, 1), a1 + hstep, voffA);
            PG8_WAIT_L(8); PG8_BAR; PG8_WAIT_L(0); PG8_MMA(0, 0, At, B0); PG8_BAR; PG8_SCHED;
            PG8_LDB(B1, 0, 1); PG8_STAGE(PG8_SB(0, 0), b2, voffB);
            PG8_BAR; PG8_WAIT_L(0); PG8_MMA(0, 1, At, B1); PG8_BAR;
            PG8_LDA(At, 0, 1); PG8_STAGE(PG8_SA(0, 0), a2, voffA);
            PG8_BAR; PG8_WAIT_L(0); PG8_MMA(1, 0, At, B0); PG8_BAR; PG8_SCHED;
            PG8_STAGE(PG8_SB(0, 1), b2 + hstep, voffB);
            PG8_WAIT_V(6); PG8_BAR; PG8_MMA(1, 1, At, B1); PG8_BAR;
            PG8_LDB(B0, 1, 0); PG8_SCHED; PG8_LDA(At, 1, 0); PG8_STAGE(PG8_SA(0, 1), a2 + hstep, voffA);
            PG8_WAIT_L(8); PG8_BAR; PG8_WAIT_L(0); PG8_MMA(0, 0, At, B0); PG8_BAR; PG8_SCHED;
            PG8_LDB(B1, 1, 1); PG8_STAGE(PG8_SB(1, 0), b3, voffB);
            PG8_BAR; PG8_WAIT_L(0); PG8_MMA(0, 1, At, B1); PG8_BAR;
            PG8_LDA(At, 1, 1); PG8_STAGE(PG8_SA(1, 0), a3, voffA);
            PG8_BAR; PG8_WAIT_L(0); PG8_MMA(1, 0, At, B0); PG8_BAR; PG8_SCHED;
            PG8_STAGE(PG8_SB(1, 1), b3 + hstep, voffB);
            PG8_WAIT_V(6); PG8_BAR; PG8_MMA(1, 1, At, B1); PG8_BAR;
        }
        PG8_STAMP();
        if constexpr (!Epi::AFTER_DRAIN) { E(acc, cur, wr, wc, fr, fq); S.done(cur); }
        PG8_STAMP();
        if (!has_next) break;
#pragma unroll
        for (int a = 0; a < 2; ++a)
#pragma unroll
            for (int b = 0; b < 2; ++b)
#pragma unroll
                for (int m = 0; m < 4; ++m)
#pragma unroll
                    for (int n = 0; n < 2; ++n) acc[a][b][m][n] = (f32x4){0.f, 0.f, 0.f, 0.f};
        cur = nxt; cA = nA; cB = nB; ++ui;
    }
    PG8_WAIT_V(0);
    if (wr == 0) PG8_BAR;
    PG8_BAR;
    if constexpr (Epi::AFTER_DRAIN) { E.fused(acc, cur, wr, wc, fr, fq, lds, wid, lane); S.done(cur); }
    PG8_STAMP();
    if (STAMP && wid == 0) { stamps[lane] = lane < nts ? (((unsigned long long)(unsigned)ts_hi << 32) | (unsigned)ts_lo) : 0ull;
        if (lane == 62) stamps[62] = rt_entry; if (lane == 63) stamps[63] = (unsigned long long)wall_clock64(); }
#undef PG8_STAMP
#undef PG8_SA
#undef PG8_SB
#undef PG8_STAGE
#undef PG8_LDA
#undef PG8_LDB
#undef PG8_MMA
#undef PG8_WAIT_V
#undef PG8_WAIT_L
#undef PG8_BAR
#undef PG8_SCHED
}
}

using pg8::bf16_t; using pg8::bf16x8; using pg8::f32x4; using pg8::Unit; using pg8::cvt_pk_bf16;
#define DI __device__ __forceinline__
constexpr int TOK = 16384, SEQ = 8192, DM = 1024, HS = 3336, DFF = 2816;
constexpr size_t O_CTL = 0, O_CD = 256, O_AUX = 4352, O_ROPE = 528640, O_FC = 2625792, O_WT = 3150080;
constexpr size_t O_WT_IN = O_WT, O_WT_OUT = O_WT_IN + 7340032, O_WT_UP = O_WT_OUT + 2097152, O_WT_DN = O_WT_UP + 11534336, O_WT_LR = O_WT_DN + 5767168;
constexpr size_t O_XN = O_WT + 27525120, O_R1 = O_XN + 33554432;
constexpr size_t O_H = O_R1, O_ST = O_R1 + 109314048, O_YG = O_ST + 33554432;
constexpr size_t O_G = O_R1, O_U = O_R1 + 92274688;
constexpr size_t O_LW = O_R1 + 109314048, O_KN = O_LW + 50331648, O_VT = O_KN + 16777216, O_AP = O_VT + 16777216;
constexpr size_t O_KNRM = O_AP + 8388608;
constexpr size_t O_BAR = O_KNRM + 524288;
constexpr size_t WS_NEED = O_BAR + 16384;
constexpr int LDS_BYTES = 131072 + 256;

struct Params {
    const float* x; const float* ev_norm_w; const float* ev_w_in; const float* ev_conv_w; const float* ev_conv_b; const float* ev_dt_bias; const float* ev_a_log;
    const float* ev_d; const float* ev_ssd_norm_w; const float* ev_ret_norm_w; const float* ev_w_out;
    const float* od_norm_w; const float* od_w_in; const float* od_mu; const float* od_w0; const float* od_w_up; const float* od_a0; const float* od_a_up;
    const float* od_g_up; const float* od_k_k; const float* od_k_a; const float* od_r_k; const float* od_ln_w; const float* od_ln_b;
    const float* od_qn_w; const float* od_kn_w; const float* od_f_bias; const float* od_w_out;
    const float* ffn_norm_w; const float* ffn_w_up; const float* ffn_conv_w; const float* ffn_conv_b; const float* ffn_w_down;
    float* out; unsigned char* ws;
};

DI unsigned cvtpk(float lo, float hi) { unsigned r; asm("v_cvt_pk_bf16_f32 %0, %1, %2" : "=v"(r) : "v"(lo), "v"(hi)); return r; }
DI unsigned short f2bf(float f) { return (unsigned short)(cvtpk(f, f) & 0xffffu); }
DI float bf2f(unsigned short b) { return __uint_as_float(((unsigned)b) << 16); }
DI unsigned pack2(float lo, float hi) { return cvtpk(lo, hi); }
DI float bflo(unsigned w) { return __uint_as_float(w << 16); }
DI float bfhi(unsigned w) { return __uint_as_float(w & 0xffff0000u); }
DI void unpack8(const uint4 r, float (&o)[8]) { o[0] = bflo(r.x); o[1] = bfhi(r.x); o[2] = bflo(r.y); o[3] = bfhi(r.y); o[4] = bflo(r.z); o[5] = bfhi(r.z); o[6] = bflo(r.w); o[7] = bfhi(r.w); }
DI uint4 pack8(const float (&o)[8]) { uint4 r; r.x = pack2(o[0], o[1]); r.y = pack2(o[2], o[3]); r.z = pack2(o[4], o[5]); r.w = pack2(o[6], o[7]); return r; }
DI float silu_(float x) { return x * __builtin_amdgcn_rcpf(1.f + __expf(-x)); }
DI float sigm_(float x) { return __builtin_amdgcn_rcpf(1.f + __expf(-x)); }
DI float softplus_(float x) { return fmaxf(x, 0.f) + log1pf(__expf(-fabsf(x))); }
DI bf16x8 ldfrag(const bf16_t* base, int row0, int ld, int k0, int lane) { return *(const bf16x8*)(base + (row0 + (lane & 15)) * ld + k0 + (lane >> 4) * 8); }
#define MFMA16(a, b, c) __builtin_amdgcn_mfma_f32_16x16x32_bf16((a), (b), (c), 0, 0, 0)
DI float red16(float v) { v += __shfl_xor(v, 1); v += __shfl_xor(v, 2); v += __shfl_xor(v, 4); v += __shfl_xor(v, 8); return v; }
DI float max16(float v) { v = fmaxf(v, __shfl_xor(v, 1)); v = fmaxf(v, __shfl_xor(v, 2)); v = fmaxf(v, __shfl_xor(v, 4)); v = fmaxf(v, __shfl_xor(v, 8)); return v; }
DI float red64(float v) { v += __shfl_xor(v, 32); v += __shfl_xor(v, 16); return red16(v); }
DI float dpp_red16(float x) {
    x += __builtin_bit_cast(float, __builtin_amdgcn_update_dpp(0, __builtin_bit_cast(int, x), 0xB1, 0xF, 0xF, true));
    x += __builtin_bit_cast(float, __builtin_amdgcn_update_dpp(0, __builtin_bit_cast(int, x), 0x4E, 0xF, 0xF, true));
    x += __builtin_bit_cast(float, __builtin_amdgcn_update_dpp(0, __builtin_bit_cast(int, x), 0x141, 0xF, 0xF, true));
    x += __builtin_bit_cast(float, __builtin_amdgcn_update_dpp(0, __builtin_bit_cast(int, x), 0x140, 0xF, 0xF, true));
    return x;
}

DI int otid() { int t = threadIdx.x; asm volatile("" : "+v"(t)); return t; }
DI int obid() { int b = blockIdx.x; asm volatile("" : "+s"(b)); return b; }
struct EpiH {
    static constexpr bool PERM = false, AFTER_DRAIN = false;
    bf16_t* H; float* aux; int auxc;
    DI void operator()(const f32x4 (&acc)[2][2][4][2], const Unit& u, int wr, int wc, int fr, int fq) const {
        const int row0 = u.pm * 256 + wr * 64 + fr, col0 = u.pn * 256 + wc * 32 + 4 * fq; const bool auxhere = (u.pn == (auxc >> 8));
#pragma unroll
        for (int ai = 0; ai < 2; ++ai)
#pragma unroll
            for (int m = 0; m < 4; ++m) { const size_t r = (size_t)(row0 + ai * 128 + m * 16);
#pragma unroll
                for (int bj = 0; bj < 2; ++bj)
#pragma unroll
                    for (int n = 0; n < 2; ++n) { const int c = col0 + bj * 128 + n * 16; const f32x4 v = acc[ai][bj][m][n];
                        if (c < HS) { uint2 w; w.x = cvt_pk_bf16(v[0], v[1]); w.y = cvt_pk_bf16(v[2], v[3]); *(uint2*)(H + r * HS + c) = w;
                            if (auxhere && (c == auxc || c == auxc + 4)) *(f32x4*)(aux + r * 8 + (c - auxc)) = v; } } }
    }
};
struct EpiRes {
    static constexpr bool PERM = false, AFTER_DRAIN = false;
    const float* res; float* out;
    DI void operator()(const f32x4 (&acc)[2][2][4][2], const Unit& u, int wr, int wc, int fr, int fq) const {
        const int row0 = u.pm * 256 + wr * 64 + fr, col0 = u.pn * 256 + wc * 32 + 4 * fq;
#pragma unroll
        for (int ai = 0; ai < 2; ++ai)
#pragma unroll
            for (int m = 0; m < 4; ++m) { const size_t r = (size_t)(row0 + ai * 128 + m * 16);
#pragma unroll
                for (int bj = 0; bj < 2; ++bj)
#pragma unroll
                    for (int n = 0; n < 2; ++n) { const int c = col0 + bj * 128 + n * 16;
                        const f32x4 rv = *(const f32x4*)(res + r * DM + c); *(f32x4*)(out + r * DM + c) = rv + acc[ai][bj][m][n]; } }
    }
};
DI float gu_ror1(float x) { float r; asm volatile("s_nop 1\n\tv_mov_b32_dpp %0, %1 row_ror:1 row_mask:0xf bank_mask:0xf bound_ctrl:1" : "=v"(r) : "v"(x)); return r; }
DI float gu_ror2(float x) { float r; asm volatile("s_nop 1\n\tv_mov_b32_dpp %0, %1 row_ror:2 row_mask:0xf bank_mask:0xf bound_ctrl:1" : "=v"(r) : "v"(x)); return r; }
struct EpiGU {
    static constexpr bool PERM = false, AFTER_DRAIN = false;
    bf16_t* GC; bf16_t* U; const float* cw; const float* cb;
    DI void operator()(const f32x4 (&acc)[2][2][4][2], const Unit& u, int wr, int wc, int fr, int fq) const {
        const int row0 = u.pm * 256 + wr * 64 + fr, col0 = u.pn * 128 + wc * 32 + 4 * fq;
#define GU_ROR(x, n) gu_ror##n(x)
#pragma unroll
        for (int n = 0; n < 2; ++n) { const int c = col0 + n * 16;
            const f32x4 w0 = *(const f32x4*)(cw + c), w1 = *(const f32x4*)(cw + DFF + c), w2 = *(const f32x4*)(cw + 2 * DFF + c), bb = *(const f32x4*)(cb + c);
#pragma unroll
            for (int ai = 0; ai < 2; ++ai)
#pragma unroll
                for (int m = 0; m < 4; ++m) { const size_t r = (size_t)(row0 + ai * 128 + m * 16); const size_t slab = r >> 6;
                    const f32x4 g = acc[ai][0][m][n], v = acc[ai][1][m][n]; const f32x4 gp = acc[ai][0][m > 0 ? m - 1 : 0][n];
                    f32x4 o;
                    f32x4 s1, s2; float g1a, g1b, g1c, g1d, g2a, g2b, g2c, g2d;
#pragma unroll
                    for (int j = 0; j < 4; ++j) { s1[j] = (m > 0 && fr == 15) ? gp[j] : g[j]; s2[j] = (m > 0 && fr >= 14) ? gp[j] : g[j]; }
                    asm("s_nop 1\n\tv_mov_b32_dpp %0, %4 row_ror:1 row_mask:0xf bank_mask:0xf bound_ctrl:1\n\tv_mov_b32_dpp %1, %5 row_ror:1 row_mask:0xf bank_mask:0xf bound_ctrl:1\n\t"
                                 "v_mov_b32_dpp %2, %6 row_ror:1 row_mask:0xf bank_mask:0xf bound_ctrl:1\n\tv_mov_b32_dpp %3, %7 row_ror:1 row_mask:0xf bank_mask:0xf bound_ctrl:1"
                                 : "=&v"(g1a), "=&v"(g1b), "=&v"(g1c), "=&v"(g1d) : "v"(s1[0]), "v"(s1[1]), "v"(s1[2]), "v"(s1[3]));
                    asm("s_nop 1\n\tv_mov_b32_dpp %0, %4 row_ror:2 row_mask:0xf bank_mask:0xf bound_ctrl:1\n\tv_mov_b32_dpp %1, %5 row_ror:2 row_mask:0xf bank_mask:0xf bound_ctrl:1\n\t"
                                 "v_mov_b32_dpp %2, %6 row_ror:2 row_mask:0xf bank_mask:0xf bound_ctrl:1\n\tv_mov_b32_dpp %3, %7 row_ror:2 row_mask:0xf bank_mask:0xf bound_ctrl:1"
                                 : "=&v"(g2a), "=&v"(g2b), "=&v"(g2c), "=&v"(g2d) : "v"(s2[0]), "v"(s2[1]), "v"(s2[2]), "v"(s2[3]));
                    const f32x4 g1v = {g1a, g1b, g1c, g1d}, g2v = {g2a, g2b, g2c, g2d};
#pragma unroll
                    for (int j = 0; j < 4; ++j) { const float g1 = g1v[j], g2 = g2v[j];
                        const float a = bb[j] + w0[j] * g2 + w1[j] * g1 + w2[j] * g[j]; o[j] = silu_(a) * v[j]; }
                    const bool defer = (m == 0) && (fr < 2);
                    uint2 w;
                    w.x = cvt_pk_bf16(defer ? v[0] : o[0], defer ? v[1] : o[1]); w.y = cvt_pk_bf16(defer ? v[2] : o[2], defer ? v[3] : o[3]);
                    *(uint2*)(U + r * DFF + c) = w;
                    if (defer || (m == 3 && fr >= 14)) { const int slot = defer ? 2 + fr : fr - 14; uint2 gw; gw.x = cvt_pk_bf16(g[0], g[1]); gw.y = cvt_pk_bf16(g[2], g[3]);
                        *(uint2*)(GC + (slab * 4 + slot) * DFF + c) = gw; } }
        }
#undef GU_ROR
    }
};
struct EpiLR {
    static constexpr bool PERM = false, AFTER_DRAIN = false;
    bf16_t* LW; const float* w0; const float* a0;
    DI void operator()(const f32x4 (&acc)[2][2][4][2], const Unit& u, int wr, int wc, int fr, int fq) const {
        const int row0 = u.pm * 256 + wr * 64 + fr, col0 = u.pn * 256 + wc * 32 + 4 * fq;
#pragma unroll
        for (int ai = 0; ai < 2; ++ai)
#pragma unroll
            for (int m = 0; m < 4; ++m) { const size_t r = (size_t)(row0 + ai * 128 + m * 16);
#pragma unroll
                for (int bj = 0; bj < 2; ++bj)
#pragma unroll
                    for (int n = 0; n < 2; ++n) { const int c = col0 + bj * 128 + n * 16; f32x4 v = acc[ai][bj][m][n];
                        if (c < 512) { const f32x4 b = *(const f32x4*)(w0 + c);
#pragma unroll
                            for (int j = 0; j < 4; ++j) v[j] = 1.f - __expf(-0.606531f * sigm_(b[j] + v[j])); }
                        else if (c < 1024) { const f32x4 b = *(const f32x4*)(a0 + c - 512);
#pragma unroll
                            for (int j = 0; j < 4; ++j) v[j] = sigm_(b[j] + v[j]); }
                        uint2 w; w.x = cvt_pk_bf16(v[0], v[1]); w.y = cvt_pk_bf16(v[2], v[3]); *(uint2*)(LW + r * 1536 + c) = w; } }
    }
};
template <class Epi> DI void run_gemm(unsigned char* smem, const bf16_t* A, const bf16_t* Bt, int N, int K, const Epi& E) {
    pg8::Gemm g; g.A = A; g.Bt = Bt; g.M = TOK; g.N = N; g.K = K;
    pg8::StaticOrder S; S.init(TOK, N, (int)gridDim.x, obid());
    pg8::gemm_phase<Epi, pg8::StaticOrder, false>((PG8_LAS unsigned char*)smem, g, S, E, nullptr);
}

DI void conv_tile4(const float* W, int Nsrc, int K, bf16_t* Wt, int nd0, int sc0, int nvalid, int k0, float* tile) {
    const int tid = otid(), j = tid & 63, kb = tid >> 6;
    float v[32];
#pragma unroll
    for (int i = 0; i < 32; ++i) { const int kk = kb + 8 * i; v[i] = (j < nvalid) ? W[(size_t)(k0 + kk) * Nsrc + sc0 + j] : 0.f; }
#pragma unroll
    for (int i = 0; i < 32; ++i) { const int kk = kb + 8 * i; tile[kk * 65 + j] = v[i]; }
    __syncthreads();
    const int nl = tid >> 3, ks = (tid & 7) * 8;
#pragma unroll
    for (int q = 0; q < 4; ++q) { const float* tq = tile + q * 64 * 65; uint4 o;
        o.x = pack2(tq[(ks + 0) * 65 + nl], tq[(ks + 1) * 65 + nl]); o.y = pack2(tq[(ks + 2) * 65 + nl], tq[(ks + 3) * 65 + nl]);
        o.z = pack2(tq[(ks + 4) * 65 + nl], tq[(ks + 5) * 65 + nl]); o.w = pack2(tq[(ks + 6) * 65 + nl], tq[(ks + 7) * 65 + nl]);
        *(uint4*)(Wt + (size_t)(nd0 + nl) * K + k0 + q * 64 + ks) = o; }
    __syncthreads();
}
DI void phase_weights(const Params& p, unsigned char* smem, int layer, int part, int b0 = 0) {
    float* tile = (float*)smem;
    const float* w_in = layer ? p.od_w_in : p.ev_w_in; const float* w_out = layer ? p.od_w_out : p.ev_w_out;
    const float* w_up = p.ffn_w_up + (size_t)layer * DM * 2 * DFF; const float* w_dn = p.ffn_w_down + (size_t)layer * DFF * DM;
    bf16_t* t_in = (bf16_t*)(p.ws + O_WT_IN); bf16_t* t_out = (bf16_t*)(p.ws + O_WT_OUT); bf16_t* t_up = (bf16_t*)(p.ws + O_WT_UP); bf16_t* t_dn = (bf16_t*)(p.ws + O_WT_DN);
    if (part == 0) {
        if (obid() < b0) return;
        for (int job = obid() - b0; job < 288; job += (int)gridDim.x - b0) {
            if (job < 224) { const int nt = job >> 2, kt = job & 3, nd0 = nt * 64; int nv = HS - nd0; nv = nv < 0 ? 0 : (nv > 64 ? 64 : nv);
                conv_tile4(w_in, HS, 1024, t_in, nd0, nd0, nv, kt * 256, tile); }
            else { const int j2 = job - 224, nt = j2 >> 2, kt = j2 & 3; conv_tile4(w_out, 1024, 1024, t_out, nt * 64, nt * 64, 64, kt * 256, tile); }
        }
    } else {
        const int nb = (int)gridDim.x - 128, lb = obid() - 128;
        if (lb < 0) return;
        if (part == 1) { for (int job = lb; job < 352; job += nb) { const int nt = job >> 2, kt = job & 3, nd0 = nt * 64; const int pn = nd0 >> 8, bj = (nd0 >> 7) & 1, j0 = nd0 & 127;
                conv_tile4(w_up, 2 * DFF, 1024, t_up, nd0, bj * DFF + 128 * pn + j0, 64, kt * 256, tile); } }
        else { for (int job = lb; job < 176; job += nb) { const int nt = job / 11, kt = job % 11; conv_tile4(w_dn, 1024, DFF, t_dn, nt * 64, nt * 64, 64, kt * 256, tile); } }
        return;
    }
    const int gtid = (obid() - b0) * 512 + otid(), gsz = ((int)gridDim.x - b0) * 512;
    if (layer == 0) {
        float* rc = (float*)(p.ws + O_ROPE); float* rs = rc + SEQ * 32;
        for (int idx = gtid; idx < SEQ * 32; idx += gsz) { const int pos = idx >> 5, i = idx & 31;
            const float inv = (float)exp(-(double)i * (9.210340371976184 / 32.0)); const float ang = (float)pos * inv;
            const double a = (double)ang; const double n = rint(a * 0.15915494309189535); const double r = a - n * 6.283185307179586; const double r2 = r * r;
            double sn = 1.0 / 121645100408832000.0, cs = 1.0 / 2432902008176640000.0;
            sn = sn * r2 - 1.0 / 355687428096000.0; sn = sn * r2 + 1.0 / 1307674368000.0; sn = sn * r2 - 1.0 / 6227020800.0; sn = sn * r2 + 1.0 / 39916800.0;
            sn = sn * r2 - 1.0 / 362880.0; sn = sn * r2 + 1.0 / 5040.0; sn = sn * r2 - 1.0 / 120.0; sn = sn * r2 + 1.0 / 6.0; sn = sn * r2 * -1.0 + 1.0; sn = sn * r;
            cs = cs * r2 - 1.0 / 6402373705728000.0; cs = cs * r2 + 1.0 / 20922789888000.0; cs = cs * r2 - 1.0 / 87178291200.0; cs = cs * r2 + 1.0 / 479001600.0;
            cs = cs * r2 - 1.0 / 3628800.0; cs = cs * r2 + 1.0 / 40320.0; cs = cs * r2 - 1.0 / 720.0; cs = cs * r2 + 1.0 / 24.0; cs = cs * r2 - 0.5; cs = cs * r2 + 1.0;
            rc[idx] = (float)cs; rs[idx] = (float)sn; }
    } else {
        bf16_t* t_lr = (bf16_t*)(p.ws + O_WT_LR);
        for (int idx = gtid; idx < 1536 * 256; idx += gsz) { const int n = idx >> 8, k = idx & 255; float v = 0.f;
            if (n < 512) { if (k < 64) v = p.od_w_up[k * 512 + n]; }
            else if (n < 1024) { if (k >= 64 && k < 128) v = p.od_a_up[(k - 64) * 512 + n - 512]; }
            else { if (k >= 128) v = p.od_g_up[(k - 128) * 512 + n - 1024]; }
            t_lr[idx] = f2bf(v); }
    }
}
DI void phase_rmsnorm(const float* x, const float* w, bf16_t* xn) {
    const int lane = otid() & 63, wv = otid() >> 6;
    f32x4 ww[4];
#pragma unroll
    for (int i = 0; i < 4; ++i) ww[i] = *(const f32x4*)(w + i * 256 + lane * 4);
    for (int r0 = (obid() * 8 + wv) * 4; r0 < TOK; r0 += gridDim.x * 8 * 4) {
        f32x4 v[4][4];
#pragma unroll
        for (int q = 0; q < 4; ++q)
#pragma unroll
            for (int i = 0; i < 4; ++i) v[q][i] = *(const f32x4*)(x + (size_t)(r0 + q) * DM + i * 256 + lane * 4);
#pragma unroll
        for (int q = 0; q < 4; ++q) { float ss = 0.f;
#pragma unroll
            for (int i = 0; i < 4; ++i) ss += v[q][i][0] * v[q][i][0] + v[q][i][1] * v[q][i][1] + v[q][i][2] * v[q][i][2] + v[q][i][3] * v[q][i][3];
            ss = red64(ss); const float rstd = rsqrtf(ss * (1.f / DM) + 1e-6f);
#pragma unroll
            for (int i = 0; i < 4; ++i) { uint2 o; o.x = pack2(v[q][i][0] * rstd * ww[i][0], v[q][i][1] * rstd * ww[i][1]); o.y = pack2(v[q][i][2] * rstd * ww[i][2], v[q][i][3] * rstd * ww[i][3]);
                *(uint2*)(xn + (size_t)(r0 + q) * DM + i * 256 + lane * 4) = o; } }
    }
}
DI void ssd_conv8_raw(const Params& p, const uint4 r0, const uint4 r1, const uint4 r2, const uint4 r3, int t, int ch, float (&o)[8]) {
    const float m0 = t >= 3 ? 1.f : 0.f, m1 = t >= 2 ? 1.f : 0.f, m2 = t >= 1 ? 1.f : 0.f;
    float acc[8], xv[8];
    { const f32x4 b0 = *(const f32x4*)(p.ev_conv_b + ch), b1 = *(const f32x4*)(p.ev_conv_b + ch + 4);
      acc[0] = b0[0]; acc[1] = b0[1]; acc[2] = b0[2]; acc[3] = b0[3]; acc[4] = b1[0]; acc[5] = b1[1]; acc[6] = b1[2]; acc[7] = b1[3]; }
#define SSD_TAP(k, raw, msk) { unpack8(raw, xv); const f32x4 w0 = *(const f32x4*)(p.ev_conv_w + (k) * 768 + ch) * (msk), w1 = *(const f32x4*)(p.ev_conv_w + (k) * 768 + ch + 4) * (msk); \
        acc[0] += w0[0] * xv[0]; acc[1] += w0[1] * xv[1]; acc[2] += w0[2] * xv[2]; acc[3] += w0[3] * xv[3]; acc[4] += w1[0] * xv[4]; acc[5] += w1[1] * xv[5]; acc[6] += w1[2] * xv[6]; acc[7] += w1[3] * xv[7]; }
    SSD_TAP(0, r0, m0) SSD_TAP(1, r1, m1) SSD_TAP(2, r2, m2) SSD_TAP(3, r3, 1.f)
#pragma unroll
    for (int e = 0; e < 8; ++e) o[e] = silu_(acc[e]);
}
DI void ssd_taps(const bf16_t* H, int b, int t, int ch, uint4& r0, uint4& r1, uint4& r2, uint4& r3) {
    const bf16_t* base = H + (size_t)b * SEQ * HS + 512 + ch;
    const int t0 = t - 3 < 0 ? 0 : t - 3, t1 = t - 2 < 0 ? 0 : t - 2, t2 = t - 1 < 0 ? 0 : t - 1;
    r0 = *(const uint4*)(base + (size_t)t0 * HS); r1 = *(const uint4*)(base + (size_t)t1 * HS); r2 = *(const uint4*)(base + (size_t)t2 * HS); r3 = *(const uint4*)(base + (size_t)t * HS);
}
DI void ssd_conv8(const Params& p, const bf16_t* H, int b, int t, int ch, float (&o)[8]) { uint4 r0, r1, r2, r3; ssd_taps(H, b, t, ch, r0, r1, r2, r3); ssd_conv8_raw(p, r0, r1, r2, r3, t, ch, o); }
DI float ret_lg(int hh) { return log1pf(-exp2f(-5.f - (float)hh)); }
DI float chunk_aux(const Params& p, int b, int hh, int t0) { const int tid = otid(); return tid < 128 ? ((const float*)(p.ws + O_AUX))[((size_t)b * SEQ + t0 + tid) * 8 + hh] : 0.f; }
DI void chunk_decay(const Params& p, int mixer, int hh, float auxv, float* acs, float* dts) {
    const int tid = otid(), lane = tid & 63;
    float v = 0.f;
    if (tid < 128) {
        if (mixer == 0) { const float dt = softplus_(auxv + p.ev_dt_bias[hh]); dts[tid] = dt; v = -expf(p.ev_a_log[hh]) * dt; }
        else { dts[tid] = 1.f; v = ret_lg(hh); }
    }
#pragma unroll
    for (int off = 1; off < 64; off <<= 1) { const float t = __shfl_up(v, off); if (lane >= off) v += t; }
    if (tid == 63) acs[256] = v;
    __syncthreads();
    if (tid >= 64 && tid < 128) v += acs[256];
    if (tid < 128) acs[tid] = v;
    __syncthreads();
}
DI void phase_m1(const Params& p, unsigned char* smem) {
    bf16_t* Kt = (bf16_t*)smem; bf16_t* Vt = (bf16_t*)(smem + 17408); float* acs = (float*)(smem + 34816); float* dts = acs + 128;
    const bf16_t* H = (const bf16_t*)(p.ws + O_H); float* ST = (float*)(p.ws + O_ST); float* CD = (float*)(p.ws + O_CD);
    const float* rc = (const float*)(p.ws + O_ROPE); const float* rs = rc + SEQ * 32;
    const int tid = otid(), lane = tid & 63, w = tid >> 6;
    for (int u = obid(); u < 2048; u += gridDim.x) {
        const int mixer = u >> 10, bh = (u >> 6) & 15, c = u & 63, b = bh >> 3, hh = bh & 7, t0 = c * 128;
        chunk_decay(p, mixer, hh, mixer == 0 ? chunk_aux(p, b, hh, t0) : 0.f, acs, dts);
        const float aend = acs[127];
        if (mixer == 0) {
#pragma unroll
            for (int it = 0; it < 2; ++it) { const int g = tid + it * 512, s = g >> 3, c8 = (g & 7) * 8; float o[8];
                const float sc = __expf(aend - acs[s]) * dts[s];
                ssd_conv8(p, H, b, t0 + s, 512 + (hh >> 2) * 64 + c8, o);
#pragma unroll
                for (int e = 0; e < 8; ++e) Kt[(c8 + e) * 136 + s] = f2bf(o[e] * sc);
                ssd_conv8(p, H, b, t0 + s, hh * 64 + c8, o);
#pragma unroll
                for (int e = 0; e < 8; ++e) Vt[(c8 + e) * 136 + s] = f2bf(o[e]); }
            if (tid == 0) CD[bh * 64 + c] = __expf(aend);
        } else {
            { const int s = tid >> 2, i0 = (tid & 3) * 8; const size_t r = (size_t)b * SEQ + t0 + s; float k1[8], k2[8];
              unpack8(*(const uint4*)(H + r * HS + 1800 + hh * 64 + i0), k1); unpack8(*(const uint4*)(H + r * HS + 1800 + hh * 64 + 32 + i0), k2);
              const float sc = __expf(aend - acs[s]) * 0.125f;
#pragma unroll
              for (int e = 0; e < 8; ++e) { const float cs = rc[(t0 + s) * 32 + i0 + e], sn = rs[(t0 + s) * 32 + i0 + e];
                  Kt[(i0 + e) * 136 + s] = f2bf((k1[e] * cs - k2[e] * sn) * sc); Kt[(32 + i0 + e) * 136 + s] = f2bf((k1[e] * sn + k2[e] * cs) * sc); } }
#pragma unroll
            for (int it = 0; it < 2; ++it) { const int g = tid + it * 512, s = g >> 3, c8 = (g & 7) * 8; const size_t r = (size_t)b * SEQ + t0 + s; float v[8];
                unpack8(*(const uint4*)(H + r * HS + 2312 + hh * 64 + c8), v);
#pragma unroll
                for (int e = 0; e < 8; ++e) Vt[(c8 + e) * 136 + s] = (unsigned short)f2bf(v[e]); }
        }
        __syncthreads();
        { const int mt = w & 3, nt0 = (w >> 2) * 2; f32x4 a0 = {0.f, 0.f, 0.f, 0.f}, a1 = {0.f, 0.f, 0.f, 0.f};
#pragma unroll
          for (int ks = 0; ks < 4; ++ks) { const bf16x8 af = ldfrag(Kt, mt * 16, 136, ks * 32, lane);
              a0 = MFMA16(af, ldfrag(Vt, nt0 * 16, 136, ks * 32, lane), a0); a1 = MFMA16(af, ldfrag(Vt, nt0 * 16 + 16, 136, ks * 32, lane), a1); }
          float* dst = ST + (size_t)u * 4096 + mt * 16 + (lane >> 4) * 4;
          *(f32x4*)(dst + (nt0 * 16 + (lane & 15)) * 64) = a0; *(f32x4*)(dst + (nt0 * 16 + 16 + (lane & 15)) * 64) = a1; }
        __syncthreads();
    }
}
DI void phase_m2(const Params& p) {
    float* ST = (float*)(p.ws + O_ST); const float* CD = (const float*)(p.ws + O_CD);
    for (int idx = obid() * 512 + otid(); idx < 32 * 4096; idx += gridDim.x * 512) {
        const int mb = idx >> 12, e = idx & 4095, mixer = mb >> 4, bh = mb & 15; float run = 0.f;
        const float gdec = __expf(128.f * ret_lg(bh & 7));
#pragma unroll 8
        for (int c = 0; c < 64; ++c) { const size_t o = ((size_t)(mb * 64 + c)) * 4096 + e; const float v = ST[o]; ST[o] = run;
            const float dec = mixer == 0 ? CD[bh * 64 + c] : gdec; run = run * dec + v; }
    }
}
struct M3Pre { uint4 a0, a1, a2, a3, a4, a5, a6, a7; f32x4 st0, st1; float aux; };
template <int MIXER> DI void m3_issue(const Params& p, int b, int c, int hh, M3Pre& R) {
    const bf16_t* H = (const bf16_t*)(p.ws + O_H); const float* ST = (const float*)(p.ws + O_ST);
    const int tid = otid(), t0 = c * 128, bh = b * 8 + hh; const size_t u = (size_t)((MIXER * 16 + bh) * 64 + c);
    if (MIXER == 0) {
        { const int g = tid, s = g >> 3, c8 = (g & 7) * 8; ssd_taps(H, b, t0 + s, hh * 64 + c8, R.a0, R.a1, R.a2, R.a3); }
        { const int g = tid + 512, s = g >> 3, c8 = (g & 7) * 8; ssd_taps(H, b, t0 + s, hh * 64 + c8, R.a4, R.a5, R.a6, R.a7); }
        R.aux = chunk_aux(p, b, hh, t0);
    } else {
        { const int s = tid >> 2, i0 = (tid & 3) * 8; const size_t r = (size_t)b * SEQ + t0 + s;
          R.a0 = *(const uint4*)(H + r * HS + 1288 + hh * 64 + i0); R.a1 = *(const uint4*)(H + r * HS + 1288 + hh * 64 + 32 + i0);
          R.a2 = *(const uint4*)(H + r * HS + 1800 + hh * 64 + i0); R.a3 = *(const uint4*)(H + r * HS + 1800 + hh * 64 + 32 + i0); }
        { const int g = tid, s = g >> 3, c8 = (g & 7) * 8; R.a4 = *(const uint4*)(H + ((size_t)b * SEQ + t0 + s) * HS + 2312 + hh * 64 + c8); }
        { const int g = tid + 512, s = g >> 3, c8 = (g & 7) * 8; R.a5 = *(const uint4*)(H + ((size_t)b * SEQ + t0 + s) * HS + 2312 + hh * 64 + c8); }
        R.aux = 0.f;
    }
    { const int pr = tid >> 3, n8 = (tid & 7) * 8; const float* src = ST + u * 4096 + pr * 64 + n8; R.st0 = *(const f32x4*)src; R.st1 = *(const f32x4*)(src + 4); }
}
template <int MIXER> DI void m3_head(const Params& p, unsigned char* smem, int b, int c, int hh, float (&ssq)[4], M3Pre& R) {
    bf16_t* Qs = (bf16_t*)smem; bf16_t* Ks = (bf16_t*)(smem + 18432); bf16_t* Vt = (bf16_t*)(smem + 36864); bf16_t* Rt = (bf16_t*)(smem + 54272); bf16_t* Ps = (bf16_t*)(smem + 63488);
    float* acs = (float*)(smem + 98304); float* dts = acs + 128;
    const bf16_t* H = (const bf16_t*)(p.ws + O_H); float* YG = (float*)(p.ws + O_YG); bf16_t* Y = (bf16_t*)(p.ws + O_XN);
    const float* rc = (const float*)(p.ws + O_ROPE); const float* rs = rc + SEQ * 32;
    const int tid = otid(), lane = tid & 63, w = tid >> 6, t0 = c * 128;
    __syncthreads();
    chunk_decay(p, MIXER, hh, R.aux, acs, dts);
    if (MIXER == 0) {
        if ((hh & 3) == 0) {
#pragma unroll
            for (int it = 0; it < 2; ++it) { const int g = tid + it * 512, s = g >> 3, c8 = (g & 7) * 8; float o[8];
                ssd_conv8(p, H, b, t0 + s, 640 + (hh >> 2) * 64 + c8, o); *(uint4*)(Qs + s * 72 + c8) = pack8(o);
                ssd_conv8(p, H, b, t0 + s, 512 + (hh >> 2) * 64 + c8, o); *(uint4*)(Ks + s * 72 + c8) = pack8(o); } }
        { const int g = tid, s = g >> 3, c8 = (g & 7) * 8; float o[8]; ssd_conv8_raw(p, R.a0, R.a1, R.a2, R.a3, t0 + s, hh * 64 + c8, o);
#pragma unroll
          for (int e = 0; e < 8; ++e) Vt[(c8 + e) * 136 + s] = f2bf(o[e]); }
        { const int g = tid + 512, s = g >> 3, c8 = (g & 7) * 8; float o[8]; ssd_conv8_raw(p, R.a4, R.a5, R.a6, R.a7, t0 + s, hh * 64 + c8, o);
#pragma unroll
          for (int e = 0; e < 8; ++e) Vt[(c8 + e) * 136 + s] = f2bf(o[e]); }
    } else {
        { const int s = tid >> 2, i0 = (tid & 3) * 8; float a1[8], a2[8], o1[8], o2[8];
          unpack8(R.a0, a1); unpack8(R.a1, a2);
#pragma unroll
          for (int e = 0; e < 8; ++e) { const float cs = rc[(t0 + s) * 32 + i0 + e], sn = rs[(t0 + s) * 32 + i0 + e]; o1[e] = a1[e] * cs - a2[e] * sn; o2[e] = a1[e] * sn + a2[e] * cs; }
          *(uint4*)(Qs + s * 72 + i0) = pack8(o1); *(uint4*)(Qs + s * 72 + 32 + i0) = pack8(o2);
          unpack8(R.a2, a1); unpack8(R.a3, a2);
#pragma unroll
          for (int e = 0; e < 8; ++e) { const float cs = rc[(t0 + s) * 32 + i0 + e], sn = rs[(t0 + s) * 32 + i0 + e]; o1[e] = (a1[e] * cs - a2[e] * sn) * 0.125f; o2[e] = (a1[e] * sn + a2[e] * cs) * 0.125f; }
          *(uint4*)(Ks + s * 72 + i0) = pack8(o1); *(uint4*)(Ks + s * 72 + 32 + i0) = pack8(o2); }
        { const int g = tid, s = g >> 3, c8 = (g & 7) * 8; const uint4 raw = R.a4; const unsigned short* rv = (const unsigned short*)&raw;
#pragma unroll
          for (int e = 0; e < 8; ++e) Vt[(c8 + e) * 136 + s] = rv[e]; }
        { const int g = tid + 512, s = g >> 3, c8 = (g & 7) * 8; const uint4 raw = R.a5; const unsigned short* rv = (const unsigned short*)&raw;
#pragma unroll
          for (int e = 0; e < 8; ++e) Vt[(c8 + e) * 136 + s] = rv[e]; }
    }
    { const int pr = tid >> 3, n8 = (tid & 7) * 8; const f32x4 x0 = R.st0, x1 = R.st1;
      uint4 o; o.x = pack2(x0[0], x0[1]); o.y = pack2(x0[2], x0[3]); o.z = pack2(x1[0], x1[1]); o.w = pack2(x1[2], x1[3]); *(uint4*)(Rt + pr * 72 + n8) = o; }
    __syncthreads();
    if (hh < 7) m3_issue<MIXER>(p, b, c, hh + 1, R);
    const int nks = (w >> 1) + 1;
    const int lrow = 16 * w + (lane >> 4) * 4;
    unsigned short gate[4][4];
#pragma unroll
    for (int nt = 0; nt < 4; ++nt)
#pragma unroll
        for (int j = 0; j < 4; ++j) gate[nt][j] = H[((size_t)b * SEQ + t0 + lrow + j) * HS + (MIXER == 0 ? 0 : 2824) + hh * 64 + nt * 16 + (lane & 15)];
    {
        const bf16x8 q0 = ldfrag(Qs, 16 * w, 72, 0, lane), q1 = ldfrag(Qs, 16 * w, 72, 32, lane);
        float al[4];
#pragma unroll
        for (int j = 0; j < 4; ++j) al[j] = acs[lrow + j];
        for (int nt = 0; nt < 2 * nks; ++nt) { f32x4 sacc = {0.f, 0.f, 0.f, 0.f};
            sacc = MFMA16(q0, ldfrag(Ks, nt * 16, 72, 0, lane), sacc); sacc = MFMA16(q1, ldfrag(Ks, nt * 16, 72, 32, lane), sacc);
            const int s = nt * 16 + (lane & 15); const float as = acs[s], ds = dts[s];
#pragma unroll
            for (int j = 0; j < 4; ++j) { const float pv = (s <= lrow + j) ? sacc[j] * __expf(al[j] - as) * ds : 0.f; Ps[(lrow + j) * 136 + s] = f2bf(pv); } }
    }
    __syncthreads();
    f32x4 yd[4], yo[4];
#pragma unroll
    for (int nt = 0; nt < 4; ++nt) { yd[nt] = (f32x4){0.f, 0.f, 0.f, 0.f}; yo[nt] = (f32x4){0.f, 0.f, 0.f, 0.f}; }
    for (int ks = 0; ks < nks; ++ks) { const bf16x8 pf = ldfrag(Ps, 16 * w, 136, ks * 32, lane);
#pragma unroll
        for (int nt = 0; nt < 4; ++nt) yd[nt] = MFMA16(pf, ldfrag(Vt, nt * 16, 136, ks * 32, lane), yd[nt]); }
#pragma unroll
    for (int ks = 0; ks < 2; ++ks) { const bf16x8 qf = ldfrag(Qs, 16 * w, 72, ks * 32, lane);
#pragma unroll
        for (int nt = 0; nt < 4; ++nt) yo[nt] = MFMA16(qf, ldfrag(Rt, nt * 16, 72, ks * 32, lane), yo[nt]); }
    float ea[4];
#pragma unroll
    for (int j = 0; j < 4; ++j) ea[j] = __expf(acs[lrow + j]);
    if (MIXER == 0) {
        const float dsk = p.ev_d[hh];
#pragma unroll
        for (int nt = 0; nt < 4; ++nt) { const int pc = nt * 16 + (lane & 15);
#pragma unroll
            for (int j = 0; j < 4; ++j) { const size_t r = (size_t)b * SEQ + t0 + lrow + j;
                const float y = yd[nt][j] + ea[j] * yo[nt][j] + dsk * bf2f(Vt[pc * 136 + lrow + j]);
                const float z = bf2f(gate[nt][j]); const float yg = y * silu_(z); ssq[j] += yg * yg; YG[r * 512 + hh * 64 + pc] = yg; } }
    } else {
        float s2[4];
#pragma unroll
        for (int j = 0; j < 4; ++j) { float a = 0.f;
#pragma unroll
            for (int nt = 0; nt < 4; ++nt) { const float y = yd[nt][j] + ea[j] * yo[nt][j]; yd[nt][j] = y; a += y * y; }
            s2[j] = rsqrtf(red16(a) * (1.f / 64.f) + 1e-6f); }
#pragma unroll
        for (int nt = 0; nt < 4; ++nt) { const int pc = nt * 16 + (lane & 15); const float nw = p.ev_ret_norm_w[hh * 64 + pc];
#pragma unroll
            for (int j = 0; j < 4; ++j) { const size_t r = (size_t)b * SEQ + t0 + lrow + j; const float g = bf2f(gate[nt][j]);
                Y[r * DM + 512 + hh * 64 + pc] = f2bf(silu_(g) * yd[nt][j] * s2[j] * nw); } }
    }
}
DI void phase_m3(const Params& p, unsigned char* smem) {
    const int lane = otid() & 63, w = otid() >> 6;
    for (int u = obid(); u < 256; u += gridDim.x) {
        const int mixer = u >> 7, b = (u >> 6) & 1, c = u & 63; float ssq[4] = {0.f, 0.f, 0.f, 0.f};
        if (mixer == 0) {
            M3Pre R; m3_issue<0>(p, b, c, 0, R);
            for (int hh = 0; hh < 8; ++hh) m3_head<0>(p, smem, b, c, hh, ssq, R);
            float* YG = (float*)(p.ws + O_YG); bf16_t* Y = (bf16_t*)(p.ws + O_XN); const int lrow = 16 * w + (lane >> 4) * 4;
            float rstd[4];
#pragma unroll
            for (int j = 0; j < 4; ++j) rstd[j] = rsqrtf(red16(ssq[j]) * (1.f / 512.f) + 1e-6f);
            for (int cc = 0; cc < 32; ++cc) { const int col = cc * 16 + (lane & 15); const float nw = p.ev_ssd_norm_w[col];
#pragma unroll
                for (int j = 0; j < 4; ++j) { const size_t r = (size_t)b * SEQ + c * 128 + lrow + j;
                    const float v = __hip_atomic_load(YG + r * 512 + col, __ATOMIC_RELAXED, __HIP_MEMORY_SCOPE_AGENT); Y[r * DM + col] = f2bf(v * rstd[j] * nw); } }
        } else {
            M3Pre R; m3_issue<1>(p, b, c, 0, R);
            for (int hh = 0; hh < 8; ++hh) m3_head<1>(p, smem, b, c, hh, ssq, R);
        }
    }
}
DI void phase_ffn_fix(const Params& p, int layer) {
    const bf16_t* GC = (const bf16_t*)(p.ws + O_G); bf16_t* U = (bf16_t*)(p.ws + O_U);
    const float* cw = p.ffn_conv_w + (size_t)layer * 3 * DFF; const float* cb = p.ffn_conv_b + (size_t)layer * DFF;
    for (int idx = obid() * 512 + otid(); idx < 256 * 2 * (DFF / 8); idx += gridDim.x * 512) {
        const int c8 = (idx % (DFF / 8)) * 8, ri = idx / (DFF / 8), k = ri >> 1, i = ri & 1, r = k * 64 + i, t = r & (SEQ - 1);
        const int kp = k > 0 ? k - 1 : 0;
        const bf16_t* s0 = GC + ((size_t)kp * 4 + (i == 0 ? 0 : 1)) * DFF + c8;
        const bf16_t* s1 = i == 0 ? GC + ((size_t)kp * 4 + 1) * DFF + c8 : GC + ((size_t)k * 4 + 2) * DFF + c8;
        const bf16_t* s2 = GC + ((size_t)k * 4 + 2 + i) * DFF + c8;
        const float m0 = (t - 2 >= 0) ? 1.f : 0.f, m1 = (t - 1 >= 0) ? 1.f : 0.f;
        const uint4 r0 = *(const uint4*)s0, r1 = *(const uint4*)s1, r2 = *(const uint4*)s2, ru = *(const uint4*)(U + (size_t)r * DFF + c8);
        float acc[8], g[8], uv[8];
        { const f32x4 b0 = *(const f32x4*)(cb + c8), b1 = *(const f32x4*)(cb + c8 + 4); acc[0] = b0[0]; acc[1] = b0[1]; acc[2] = b0[2]; acc[3] = b0[3]; acc[4] = b1[0]; acc[5] = b1[1]; acc[6] = b1[2]; acc[7] = b1[3]; }
#define FIX_TAP(kk, raw, msk) { unpack8(raw, g); const f32x4 w0 = *(const f32x4*)(cw + (kk) * DFF + c8) * (msk), w1 = *(const f32x4*)(cw + (kk) * DFF + c8 + 4) * (msk); \
            acc[0] += w0[0] * g[0]; acc[1] += w0[1] * g[1]; acc[2] += w0[2] * g[2]; acc[3] += w0[3] * g[3]; acc[4] += w1[0] * g[4]; acc[5] += w1[1] * g[5]; acc[6] += w1[2] * g[6]; acc[7] += w1[3] * g[7]; }
        FIX_TAP(0, r0, m0) FIX_TAP(1, r1, m1) FIX_TAP(2, r2, 1.f)
        unpack8(ru, uv);
#pragma unroll
        for (int e2 = 0; e2 < 8; ++e2) acc[e2] = silu_(acc[e2]) * uv[e2];
        *(uint4*)(U + (size_t)r * DFF + c8) = pack8(acc);
    }
}
DI void phase_l1_prep(const Params& p, unsigned char* smem) {
    const bf16_t* H = (const bf16_t*)(p.ws + O_H); const float* aux = (const float*)(p.ws + O_AUX); float* FC = (float*)(p.ws + O_FC);
    bf16_t* KN = (bf16_t*)(p.ws + O_KN); bf16_t* VT = (bf16_t*)(p.ws + O_VT); bf16_t* AP = (bf16_t*)(p.ws + O_AP);
    const int tid = otid();
    for (int u = obid(); u < 16 + 1024; u += gridDim.x) {
        __syncthreads();
        if (u < 16) {
            float* tot = (float*)smem; const int bh = u, b = bh >> 3, hh = bh & 7; const float fb = p.od_f_bias[hh]; float loc[16]; float run = 0.f;
#pragma unroll
            for (int i = 0; i < 16; ++i) { const float xv = aux[((size_t)b * SEQ + tid * 16 + i) * 8 + hh] + fb; run += -softplus_(-xv); loc[i] = run; }
            tot[tid] = run; __syncthreads();
            float off = 0.f; for (int i = 0; i < tid; ++i) off += tot[i];
#pragma unroll
            for (int i = 0; i < 16; ++i) FC[(size_t)bh * SEQ + tid * 16 + i] = off + loc[i];
        } else {
            bf16_t* Vl = (bf16_t*)smem; const int v2 = u - 16, bh = v2 >> 6, blk = v2 & 63, b = bh >> 3, hh = bh & 7, t0 = blk * 128;
            { const int l = tid >> 2, c16 = (tid & 3) * 16; const size_t r = (size_t)b * SEQ + t0 + l; float a[8], c[8];
              unpack8(*(const uint4*)(H + r * HS + 2304 + hh * 64 + c16), a); unpack8(*(const uint4*)(H + r * HS + 2304 + hh * 64 + c16 + 8), c);
              float ss = 0.f;
#pragma unroll
              for (int e = 0; e < 8; ++e) ss += a[e] * a[e] + c[e] * c[e];
              ss += __shfl_xor(ss, 1); ss += __shfl_xor(ss, 2); const float rstd = rsqrtf(ss * (1.f / 64.f) + 1e-6f);
#pragma unroll
              for (int e = 0; e < 8; ++e) { a[e] *= rstd * p.od_kn_w[c16 + e]; c[e] *= rstd * p.od_kn_w[c16 + 8 + e]; }
              bf16_t* dst = KN + ((size_t)bh * SEQ + t0 + l) * 64 + c16; *(uint4*)dst = pack8(a); *(uint4*)(dst + 8) = pack8(c); }
#pragma unroll
            for (int it = 0; it < 2; ++it) { const int g = tid + it * 512, s = g >> 3, c8 = (g & 7) * 8; const size_t r = (size_t)b * SEQ + t0 + s;
                *(uint4*)(Vl + s * 72 + c8) = *(const uint4*)(H + r * HS + 2816 + hh * 64 + c8); }
            __syncthreads();
#pragma unroll
            for (int it = 0; it < 2; ++it) { const int g = tid + it * 512, e = g >> 4, s8 = (g & 15) * 8; uint4 o;
                o.x = (unsigned)Vl[(s8 + 0) * 72 + e] | ((unsigned)Vl[(s8 + 1) * 72 + e] << 16); o.y = (unsigned)Vl[(s8 + 2) * 72 + e] | ((unsigned)Vl[(s8 + 3) * 72 + e] << 16);
                o.z = (unsigned)Vl[(s8 + 4) * 72 + e] | ((unsigned)Vl[(s8 + 5) * 72 + e] << 16); o.w = (unsigned)Vl[(s8 + 6) * 72 + e] | ((unsigned)Vl[(s8 + 7) * 72 + e] << 16);
                *(uint4*)(VT + ((size_t)bh * 64 + e) * SEQ + t0 + s8) = o; }
        }
    }
    {
        float* KNRM = (float*)(p.ws + O_KNRM);
#pragma unroll 4
        for (int idx = obid() * 512 + tid; idx < TOK * 64; idx += gridDim.x * 512) {
            const int r = idx >> 6, c8 = (idx & 63) * 8, t = r & (SEQ - 1); float cur[8], prv[8]; float ss = 0.f;
            { const uint4 rc = *(const uint4*)(H + (size_t)r * HS + 512 + c8), rp = *(const uint4*)(H + (size_t)(t > 0 ? r - 1 : r) * HS + 512 + c8); const float pm = t > 0 ? 1.f : 0.f;
              unpack8(rc, cur); unpack8(rp, prv);
#pragma unroll
              for (int e = 0; e < 8; ++e) prv[e] *= pm; }
#pragma unroll
            for (int e = 0; e < 8; ++e) { const float v = (cur[e] + (prv[e] - cur[e]) * p.od_mu[512 + c8 + e]) * p.od_k_k[c8 + e]; ss += v * v; }
            ss += __shfl_xor(ss, 1); ss += __shfl_xor(ss, 2); ss += __shfl_xor(ss, 4);
            if ((idx & 7) == 0) KNRM[(size_t)r * 8 + (c8 >> 6)] = 1.f / fmaxf(sqrtf(ss), 1e-12f);
        }
    }
#pragma unroll 4
    for (int idx = obid() * 512 + tid; idx < TOK * 32; idx += gridDim.x * 512) {
        const int r = idx >> 5, j8 = (idx & 31) * 8, t = r & (SEQ - 1); float cur[8], prv[8], o[8];
        { const uint4 rc = *(const uint4*)(H + (size_t)r * HS + 1536 + j8), rp = *(const uint4*)(H + (size_t)(t > 0 ? r - 1 : r) * HS + 1536 + j8); const float pm = t > 0 ? 1.f : 0.f;
          unpack8(rc, cur); unpack8(rp, prv);
#pragma unroll
          for (int e = 0; e < 8; ++e) prv[e] *= pm; }
#pragma unroll
        for (int e = 0; e < 8; ++e) { const float v = cur[e] + (prv[e] - cur[e]) * p.od_mu[1536 + j8 + e];
            o[e] = (j8 < 64) ? tanhf(v) : ((j8 < 128) ? v : sigm_(v)); }
        *(uint4*)(AP + (size_t)r * 256 + j8) = pack8(o);
    }
}
DI void fox_unit(const Params& p, unsigned char* smem, int bh, int qb) {
    bf16_t* Qs = (bf16_t*)smem; bf16_t* Ks = (bf16_t*)(smem + 18432); bf16_t* Vts = (bf16_t*)(smem + 36864); float* ck = (float*)(smem + 89600);
    const bf16_t* H = (const bf16_t*)(p.ws + O_H); const float* FC = (const float*)(p.ws + O_FC); const bf16_t* KN = (const bf16_t*)(p.ws + O_KN); const bf16_t* VT = (const bf16_t*)(p.ws + O_VT);
    bf16_t* Y = (bf16_t*)(p.ws + O_XN);
    const int tid = otid(), lane = tid & 63, w = tid >> 6, b = bh >> 3, hh = bh & 7; const size_t r0 = (size_t)b * SEQ + qb * 128;
    const float LOG2E = 1.4426950408889634f;
    __syncthreads();
    { const int l = tid >> 2, c16 = (tid & 3) * 16; float a[8], c[8];
      unpack8(*(const uint4*)(H + (r0 + l) * HS + 1792 + hh * 64 + c16), a); unpack8(*(const uint4*)(H + (r0 + l) * HS + 1792 + hh * 64 + c16 + 8), c);
      float ss = 0.f;
#pragma unroll
      for (int e = 0; e < 8; ++e) ss += a[e] * a[e] + c[e] * c[e];
      ss += __shfl_xor(ss, 1); ss += __shfl_xor(ss, 2); const float rstd = rsqrtf(ss * (1.f / 64.f) + 1e-6f) * (0.125f * LOG2E);
#pragma unroll
      for (int e = 0; e < 8; ++e) { a[e] *= rstd * p.od_qn_w[c16 + e]; c[e] *= rstd * p.od_qn_w[c16 + 8 + e]; }
      *(uint4*)(Qs + l * 72 + c16) = pack8(a); *(uint4*)(Qs + l * 72 + c16 + 8) = pack8(c); }
    float mrow = -1e30f, lsum = 0.f; f32x4 O[4];
#pragma unroll
    for (int j = 0; j < 4; ++j) O[j] = (f32x4){0.f, 0.f, 0.f, 0.f};
    const int q4 = (lane >> 4) * 4, lq = 16 * w + (lane & 15);
    uint4 kreg0, kreg1, vreg0, vreg1; float ckreg = 0.f;
    const int g0 = tid, g1 = tid + 512;
#define FOX_ISSUE(kb_) { \
        kreg0 = *(const uint4*)(KN + ((size_t)bh * SEQ + (kb_) * 128 + (g0 >> 3)) * 64 + (g0 & 7) * 8); \
        kreg1 = *(const uint4*)(KN + ((size_t)bh * SEQ + (kb_) * 128 + (g1 >> 3)) * 64 + (g1 & 7) * 8); \
        vreg0 = *(const uint4*)(VT + ((size_t)bh * 64 + (g0 >> 4)) * SEQ + (kb_) * 128 + (g0 & 15) * 8); \
        vreg1 = *(const uint4*)(VT + ((size_t)bh * 64 + (g1 >> 4)) * SEQ + (kb_) * 128 + (g1 & 15) * 8); \
        if (tid < 128) ckreg = FC[(size_t)bh * SEQ + (kb_) * 128 + tid]; }
    FOX_ISSUE(0)
    for (int kb = 0; kb <= qb; ++kb) {
        __syncthreads();
        *(uint4*)(Ks + (g0 >> 3) * 72 + (g0 & 7) * 8) = kreg0; *(uint4*)(Ks + (g1 >> 3) * 72 + (g1 & 7) * 8) = kreg1;
        *(uint4*)(Vts + (g0 >> 4) * 136 + (g0 & 15) * 8) = vreg0; *(uint4*)(Vts + (g1 >> 4) * 136 + (g1 & 15) * 8) = vreg1;
        if (tid < 128) ck[tid] = -ckreg * LOG2E;
        __syncthreads();
        if (kb < qb) FOX_ISSUE(kb + 1)
        f32x4 S[8];
        { const bf16x8 q0 = ldfrag(Qs, 16 * w, 72, 0, lane), q1 = ldfrag(Qs, 16 * w, 72, 32, lane);
#pragma unroll
          for (int nt = 0; nt < 8; ++nt) { f32x4 z = *(const f32x4*)(ck + nt * 16 + q4); z = MFMA16(ldfrag(Ks, nt * 16, 72, 0, lane), q0, z); S[nt] = MFMA16(ldfrag(Ks, nt * 16, 72, 32, lane), q1, z); } }
        if (kb == qb) {
#pragma unroll
            for (int nt = 0; nt < 8; ++nt)
#pragma unroll
                for (int j = 0; j < 4; ++j) if (nt * 16 + q4 + j > lq) S[nt][j] = -1e30f;
        }
        float mx = S[0][0];
#pragma unroll
        for (int nt = 0; nt < 8; ++nt)
#pragma unroll
            for (int j = 0; j < 4; ++j) mx = fmaxf(mx, S[nt][j]);
        mx = fmaxf(mx, __shfl_xor(mx, 16)); mx = fmaxf(mx, __shfl_xor(mx, 32));
        const float mnew = fmaxf(mrow, mx); const float alpha = __builtin_amdgcn_exp2f(mrow - mnew); mrow = mnew;
        float rs = 0.f;
#pragma unroll
        for (int nt = 0; nt < 8; ++nt)
#pragma unroll
            for (int j = 0; j < 4; ++j) { const float pv = __builtin_amdgcn_exp2f(S[nt][j] - mnew); S[nt][j] = pv; rs += pv; }
        lsum = lsum * alpha + rs;
#pragma unroll
        for (int et = 0; et < 4; ++et) O[et] = O[et] * alpha;
#pragma unroll
        for (int ks = 0; ks < 4; ++ks) {
            uint4 pw; pw.x = cvt_pk_bf16(S[2 * ks][0], S[2 * ks][1]); pw.y = cvt_pk_bf16(S[2 * ks][2], S[2 * ks][3]); pw.z = cvt_pk_bf16(S[2 * ks + 1][0], S[2 * ks + 1][1]); pw.w = cvt_pk_bf16(S[2 * ks + 1][2], S[2 * ks + 1][3]);
            const bf16x8 pf = __builtin_bit_cast(bf16x8, pw);
#pragma unroll
            for (int et = 0; et < 4; ++et) { const bf16_t* vp = Vts + (et * 16 + (lane & 15)) * 136 + ks * 32 + q4;
                uint4 vw; const uint2 lo = *(const uint2*)vp, hi = *(const uint2*)(vp + 16); vw.x = lo.x; vw.y = lo.y; vw.z = hi.x; vw.w = hi.y;
                O[et] = MFMA16(__builtin_bit_cast(bf16x8, vw), pf, O[et]); }
        }
    }
    lsum += __shfl_xor(lsum, 16); lsum += __shfl_xor(lsum, 32);
    const float inv = 1.f / lsum;
#pragma unroll
    for (int et = 0; et < 4; ++et) { uint2 o; o.x = pack2(O[et][0] * inv, O[et][1] * inv); o.y = pack2(O[et][2] * inv, O[et][3] * inv);
        *(uint2*)(Y + (r0 + lq) * DM + 512 + hh * 64 + et * 16 + q4) = o; }
}
constexpr int RW_T = 32, RW_BUF = 43008;
struct RwRegs { unsigned short r[9], k[9], v[9], om[8], a[8]; float kn[8]; };
#define RW_BAR() do { asm volatile("s_waitcnt lgkmcnt(0)" ::: "memory"); __builtin_amdgcn_s_barrier(); asm volatile("" ::: "memory"); } while (0)
DI void rwkv_unit(const Params& p, unsigned char* smem, int bh, int rg) {
    const bf16_t* H = (const bf16_t*)(p.ws + O_H); const bf16_t* LW = (const bf16_t*)(p.ws + O_LW); bf16_t* Y = (bf16_t*)(p.ws + O_XN); const float* KNRM = (const float*)(p.ws + O_KNRM);
    const int tid = otid(), lane = tid & 63, w = tid >> 6, b = bh >> 3, hh = bh & 7; const size_t rb = (size_t)b * SEQ;
    float* ysh = (float*)(smem + 2 * RW_BUF);
    const int NCH = SEQ / RW_T;
    __syncthreads();
    if (w < 2) {
        float S0 = 0.f, S1 = 0.f, S2 = 0.f, S3 = 0.f; const int kq = lane & 15, row = w * 4 + (lane >> 4);
        RW_BAR();
        for (int ch = 0; ch < NCH; ++ch) {
            const float* bufp = (const float*)(smem + (ch & 1) * RW_BUF) + kq * 4; const float* vp = (const float*)(smem + (ch & 1) * RW_BUF) + 10240 + row; float* yo = ysh + (ch & 1) * 256 + row;
#define RW_LOAD(R, W, K, Q, B, V, tt) { R = *(const f32x4*)(bufp + (tt) * 64); W = *(const f32x4*)(bufp + 2048 + (tt) * 64); K = *(const f32x4*)(bufp + 4096 + (tt) * 64); \
                Q = *(const f32x4*)(bufp + 6144 + (tt) * 64); B = *(const f32x4*)(bufp + 8192 + (tt) * 64); V = vp[(tt) * 8]; }
#define DPPF(x, ctrl) __builtin_bit_cast(float, __builtin_amdgcn_update_dpp(0, __builtin_bit_cast(int, (x)), (ctrl), 0xF, 0xF, true))
            f32x4 prevR = {0.f, 0.f, 0.f, 0.f}; float yacc = 0.f;
            f32x4 rN, wN, kN, qN, bN; float vN;
            RW_LOAD(rN, wN, kN, qN, bN, vN, 0)
            __builtin_amdgcn_sched_barrier(0);
#pragma unroll
            for (int tt = 0; tt < RW_T; ++tt) {
                const f32x4 R = rN, W = wN, K = kN, Q = qN, B = bN; const float V = vN;
                if (tt + 1 < RW_T) RW_LOAD(rN, wN, kN, qN, bN, vN, tt + 1)
                float d = S0 * Q[0] + S1 * Q[1] + S2 * Q[2] + S3 * Q[3];
                if (tt > 0) {
                    float y = S0 * prevR[0] + S1 * prevR[1] + S2 * prevR[2] + S3 * prevR[3];
                    d += DPPF(d, 0xB1); y += DPPF(y, 0xB1); d += DPPF(d, 0x4E); y += DPPF(y, 0x4E); d += DPPF(d, 0x141); y += DPPF(y, 0x141); d += DPPF(d, 0x140); y += DPPF(y, 0x140);
                    yacc = (kq == ((tt - 1) & 15)) ? y : yacc;
                    if (tt == 16) yo[kq * 8] = yacc;
                } else d = dpp_red16(d);
                const float sa = -d;
                S0 = (S0 * W[0] + V * K[0]) + sa * B[0]; S1 = (S1 * W[1] + V * K[1]) + sa * B[1]; S2 = (S2 * W[2] + V * K[2]) + sa * B[2]; S3 = (S3 * W[3] + V * K[3]) + sa * B[3];
                prevR = R;
                if (tt & 1) __builtin_amdgcn_sched_barrier(0);
            }
            { float y = S0 * prevR[0] + S1 * prevR[1] + S2 * prevR[2] + S3 * prevR[3]; y = dpp_red16(y); yacc = (kq == 15) ? y : yacc; yo[(16 + kq) * 8] = yacc; }
            RW_BAR();
        }
    } else if (w == 4 || w == 5) {
        const unsigned* ta0; const unsigned* ta1; const unsigned* ta2; size_t st0, st1, st2;
        { int L = lane; int tok = L / 5, which = L - tok * 5; ta0 = (const unsigned*)(which < 3 ? H + (rb + tok) * HS + which * 512 + hh * 64 : LW + (rb + tok) * 1536 + (which - 3) * 512 + hh * 64); st0 = which < 3 ? (size_t)HS * 2 : (size_t)1536 * 2;
          L = lane + 64; tok = L / 5; which = L - tok * 5; ta1 = (const unsigned*)(which < 3 ? H + (rb + tok) * HS + which * 512 + hh * 64 : LW + (rb + tok) * 1536 + (which - 3) * 512 + hh * 64); st1 = which < 3 ? (size_t)HS * 2 : (size_t)1536 * 2;
          L = lane + 128 > 159 ? 159 : lane + 128; tok = L / 5; which = L - tok * 5; ta2 = (const unsigned*)(which < 3 ? H + (rb + tok) * HS + which * 512 + hh * 64 : LW + (rb + tok) * 1536 + (which - 3) * 512 + hh * 64); st2 = which < 3 ? (size_t)HS * 2 : (size_t)1536 * 2; }
        unsigned x0 = 0, x1 = 0, x2 = 0, y0 = 0, y1 = 0, y2 = 0, z0 = 0, z1 = 0, z2 = 0, pacc = 0;
        RW_BAR();
        for (int ch = 0; ch < NCH; ++ch) {
            if (w == 4) { int cc = ch + 6; cc = cc > NCH - 1 ? NCH - 1 : cc; const size_t tb = (size_t)cc * RW_T;
                pacc ^= x0 ^ x1 ^ x2; x0 = y0; x1 = y1; x2 = y2; y0 = z0; y1 = z1; y2 = z2;
                z0 = *(const unsigned*)((const char*)ta0 + tb * st0); z1 = *(const unsigned*)((const char*)ta1 + tb * st1); z2 = *(const unsigned*)((const char*)ta2 + tb * st2); }
            RW_BAR();
        }
        pacc ^= x0 ^ x1 ^ x2 ^ y0 ^ y1 ^ y2 ^ z0 ^ z1 ^ z2; if (pacc == 0x9e3779b9u && rg == 77) Y[0] = 0;
    } else {
        const int lw = (w & 1) + ((w >> 2) << 1), col = hh * 64 + lane; RwRegs ra;
        const float mur = p.od_mu[col], muk = p.od_mu[512 + col], muv = p.od_mu[1024 + col], kk_w = p.od_k_k[col], ka_w = p.od_k_a[col];
        auto issue = [&](int ch, RwRegs& rr) {
            const int tbase = ch * RW_T + lw * 8;
#pragma unroll
            for (int i = 0; i < 9; ++i) { const int t = tbase + i - 1;
                if (t >= 0) { const bf16_t* hp = H + (rb + t) * HS; rr.r[i] = hp[col]; rr.k[i] = hp[512 + col]; rr.v[i] = hp[1024 + col]; } else { rr.r[i] = 0; rr.k[i] = 0; rr.v[i] = 0; }
                if (i > 0) { const bf16_t* lp = LW + (rb + t) * 1536; rr.om[i - 1] = lp[col]; rr.a[i - 1] = lp[512 + col]; rr.kn[i - 1] = KNRM[(rb + t) * 8 + hh]; } }
        };
        auto process = [&](int ch, const RwRegs& rr) {
            float* bufp = (float*)(smem + (ch & 1) * RW_BUF);
#pragma unroll
            for (int i = 1; i < 9; ++i) { const int tt = lw * 8 + i - 1;
                const float rc = bf2f(rr.r[i]), rp = bf2f(rr.r[i - 1]), kc = bf2f(rr.k[i]), kp = bf2f(rr.k[i - 1]), vc = bf2f(rr.v[i]), vp = bf2f(rr.v[i - 1]);
                const float rl = rc + (rp - rc) * mur, kl = kc + (kp - kc) * muk, vl = vc + (vp - vc) * muv; const float a = bf2f(rr.a[i - 1]), wv = 1.f - bf2f(rr.om[i - 1]);
                const float kk = kl * kk_w * rr.kn[i - 1];
                bufp[tt * 64 + lane] = rl; bufp[2048 + tt * 64 + lane] = wv; bufp[4096 + tt * 64 + lane] = kl * (1.f + (a - 1.f) * ka_w); bufp[6144 + tt * 64 + lane] = kk; bufp[8192 + tt * 64 + lane] = kk * a;
                if ((lane >> 3) == rg) bufp[10240 + tt * 8 + (lane & 7)] = vl; }
        };
        issue(0, ra); process(0, ra); issue(1, ra);
        RW_BAR();
        for (int ch = 0; ch < NCH; ++ch) {
            if (ch + 1 < NCH) { process(ch + 1, ra); if (ch + 2 < NCH) issue(ch + 2, ra); }
            if (ch > 0 && lw < 2) { const float* yi = ysh + ((ch - 1) & 1) * 256; const int t2 = lw * 64 + lane, tt = t2 >> 2, pr = (t2 & 3) * 2;
                *(unsigned*)(Y + (rb + (ch - 1) * RW_T + tt) * DM + hh * 64 + rg * 8 + pr) = pack2(yi[tt * 8 + pr], yi[tt * 8 + pr + 1]); }
            RW_BAR();
        }
        if (lw < 2) { const float* yi = ysh + ((NCH - 1) & 1) * 256; const int t2 = lw * 64 + lane, tt = t2 >> 2, pr = (t2 & 3) * 2;
          *(unsigned*)(Y + (rb + (NCH - 1) * RW_T + tt) * DM + hh * 64 + rg * 8 + pr) = pack2(yi[tt * 8 + pr], yi[tt * 8 + pr + 1]); }
    }
    __syncthreads();
}
DI void phase_l1_mix(const Params& p, unsigned char* smem, int pass) {
    unsigned* ctr = (unsigned*)(p.ws + O_CTL) + pass * 4; int* sh = (int*)(smem + 90112);
    if (obid() < 128 && pass != 2) rwkv_unit(p, smem, obid() >> 3, obid() & 7);
    for (;;) {
        __syncthreads(); if (otid() == 0) *sh = (int)atomicAdd(ctr, 1u); __syncthreads();
        const int u = *sh; if (u >= 1024) break;
        fox_unit(p, smem, u & 15, 63 - (u >> 4));
    }
}
DI void phase_rwkv_fin(const Params& p) {
    const bf16_t* H = (const bf16_t*)(p.ws + O_H); const bf16_t* LW = (const bf16_t*)(p.ws + O_LW); bf16_t* Y = (bf16_t*)(p.ws + O_XN);
    const int lane = otid() & 63, wv = otid() >> 6;
#pragma unroll 4
    for (int task = obid() * 8 + wv; task < TOK * 8; task += gridDim.x * 8) {
        const int r = task >> 3, hh = task & 7, t = r & (SEQ - 1), col = hh * 64 + lane; const bf16_t* hp = H + (size_t)r * HS;
        const float y = bf2f(Y[(size_t)r * DM + col]); const float mean = red64(y) * (1.f / 64.f); const float dy = y - mean; const float var = red64(dy * dy) * (1.f / 64.f);
        const float yln = dy * rsqrtf(var + 64e-5f) * p.od_ln_w[col] + p.od_ln_b[col];
        const bf16_t* hq = t > 0 ? hp - HS : hp; const float pm = t > 0 ? 1.f : 0.f;
        const float rc = bf2f(hp[col]), kc = bf2f(hp[512 + col]), vc = bf2f(hp[1024 + col]); const float rp = bf2f(hq[col]) * pm, kp = bf2f(hq[512 + col]) * pm, vp = bf2f(hq[1024 + col]) * pm;
        const float rl = rc + (rp - rc) * p.od_mu[col], kl = kc + (kp - kc) * p.od_mu[512 + col], vl = vc + (vp - vc) * p.od_mu[1024 + col];
        const float a = bf2f(LW[(size_t)r * 1536 + 512 + col]), g = bf2f(LW[(size_t)r * 1536 + 1024 + col]);
        const float kt = kl * (1.f + (a - 1.f) * p.od_k_a[col]); const float bonus = red64(rl * kt * p.od_r_k[col]) * vl;
        Y[(size_t)r * DM + col] = f2bf((yln + bonus) * g);
    }
}
#define XB_TMO      128
#define XB_XCNT(j)  (256  + 64 * (j))
#define XB_XSUB(j)  (1280 + 64 * (j))
#define XB_XGEN(j)  (2304 + 64 * (j))
#define XB_TOP      3328
#define XB_TOPGEN   3392
#define XCD_BAR_WORDS 3456
#define XB_SPIN_CAP (1u << 18)
#define LAS __attribute__((address_space(3)))

__device__ __forceinline__ unsigned xb_ld(unsigned* p)              { return __hip_atomic_load(p, __ATOMIC_RELAXED, __HIP_MEMORY_SCOPE_AGENT); }
__device__ __forceinline__ unsigned xb_add(unsigned* p, unsigned v) { return __hip_atomic_fetch_add(p, v, __ATOMIC_RELAXED, __HIP_MEMORY_SCOPE_AGENT); }
__device__ __forceinline__ unsigned xb_xcc_id() { return (unsigned)__builtin_amdgcn_s_getreg((3 << 11) | 20) & 0xFu; }
#define XB_SPIN(cond, bar) do { unsigned _sp = 0; while (cond) { __builtin_amdgcn_s_sleep(1); \
    if ((++_sp & 255u) == 0u) { if (xb_ld(&(bar)[XB_TMO])) break; if (_sp > XB_SPIN_CAP) { atomicAdd(&(bar)[XB_TMO], 1u); break; } } } } while (0)

struct XcdBarrier {
    unsigned* bar; unsigned x;
    volatile LAS unsigned* st;
};

__device__ __forceinline__ XcdBarrier xcd_barrier_post(unsigned* bar, volatile LAS unsigned* st) {
    XcdBarrier b; b.bar = bar; b.x = xb_xcc_id(); b.st = st;
    if (threadIdx.x == 0) (void)xb_add(&bar[XB_XCNT(b.x)], 1u);
    return b;
}
__device__ __forceinline__ void xcd_barrier_complete(unsigned* bar, unsigned x, unsigned& nloc, unsigned& nx) {
    const unsigned G = gridDim.x * gridDim.y * gridDim.z;
    unsigned sum, cnt, mine, sp = 0u;
    for (;;) {
        sum = 0u; cnt = 0u; mine = 0u;
#pragma unroll
        for (unsigned j = 0; j < 16; ++j) { const unsigned c = xb_ld(&bar[XB_XCNT(j)]); sum += c; cnt += (c > 0u) ? 1u : 0u; mine = (j == x) ? c : mine; }
        if (sum == G) break;
        __builtin_amdgcn_s_sleep(1);
        if ((++sp & 255u) == 0u) { if (xb_ld(&bar[XB_TMO])) break; if (sp > XB_SPIN_CAP) { atomicAdd(&bar[XB_TMO], 1u); break; } }
    }
    nloc = mine > 0u ? mine : 1u; nx = cnt > 0u ? cnt : 1u;
}

__device__ __forceinline__ void xcd_barrier(const XcdBarrier& b) {
    asm volatile("s_waitcnt vmcnt(0)" ::: "memory");
    __syncthreads();
    if (threadIdx.x == 0) {
        unsigned* bar = b.bar;
        __builtin_amdgcn_s_waitcnt(0);
        unsigned nloc = b.st[0], nx = b.st[1];
        if (nloc == 0u) { xcd_barrier_complete(bar, b.x, nloc, nx); b.st[0] = nloc; b.st[1] = nx; }
        const unsigned old = xb_add(&bar[XB_XSUB(b.x)], 1u);
        const unsigned gen = old / nloc;
        if (old + 1u == (gen + 1u) * nloc) {
            __builtin_amdgcn_fence(__ATOMIC_RELEASE, "agent");
            asm volatile("s_waitcnt vmcnt(0)" ::: "memory");
            const unsigned og = xb_add(&bar[XB_TOP], 1u);
            const unsigned tg = og / nx;
            if (og + 1u == (tg + 1u) * nx) xb_add(&bar[XB_TOPGEN], 1u);
            else XB_SPIN(xb_ld(&bar[XB_TOPGEN]) == tg, bar);
            __builtin_amdgcn_fence(__ATOMIC_ACQUIRE, "agent");
            xb_add(&bar[XB_XGEN(b.x)], 1u);
            asm volatile("s_waitcnt vmcnt(0)" ::: "memory");
        } else {
            XB_SPIN(xb_ld(&bar[XB_XGEN(b.x)]) == gen, bar);
            __builtin_amdgcn_fence(__ATOMIC_ACQUIRE, "agent");
            asm volatile("s_waitcnt vmcnt(0)" ::: "memory");
        }
    }
    __syncthreads();
}


__global__ void __launch_bounds__(512, 2) fwd_megakernel(Params p) {
    extern __shared__ __attribute__((aligned(16))) unsigned char smem[];
    cg::grid_group grid = cg::this_grid();
    unsigned char* ws = p.ws;
    bf16_t* XN = (bf16_t*)(ws + O_XN); bf16_t* Hb = (bf16_t*)(ws + O_H); float* aux = (float*)(ws + O_AUX);
    const bf16_t* t_in = (const bf16_t*)(ws + O_WT_IN); const bf16_t* t_out = (const bf16_t*)(ws + O_WT_OUT); const bf16_t* t_up = (const bf16_t*)(ws + O_WT_UP);
    const bf16_t* t_dn = (const bf16_t*)(ws + O_WT_DN); const bf16_t* t_lr = (const bf16_t*)(ws + O_WT_LR);
    if (blockIdx.x == 0 && threadIdx.x < 16) ((unsigned*)(ws + O_CTL))[threadIdx.x] = 0u;
    if (threadIdx.x == 0) *(uint4*)(smem + 131072) = make_uint4(0u, 0u, 0u, 0u);
    __syncthreads();
    const XcdBarrier xb = xcd_barrier_post((unsigned*)(ws + O_BAR), (volatile LAS unsigned*)(smem + 131072));
#define GSYNC() xcd_barrier(xb)
#define GEMM_H(layer) { EpiH E; E.H = Hb; E.aux = aux; E.auxc = layer ? 3328 : 1280; run_gemm(smem, XN, t_in, 3584, 1024, E); }
#define GEMM_OUT(layer) { EpiRes E; E.res = layer ? p.out : p.x; E.out = p.out; run_gemm(smem, XN, t_out, 1024, 1024, E); }
#define GEMM_UP(layer) { EpiGU E; E.GC = (bf16_t*)(ws + O_G); E.U = (bf16_t*)(ws + O_U); E.cw = p.ffn_conv_w + (size_t)(layer) * 3 * DFF; E.cb = p.ffn_conv_b + (size_t)(layer) * DFF; run_gemm(smem, XN, t_up, 2 * DFF, 1024, E); }
#define GEMM_DN() { EpiRes E; E.res = p.out; E.out = p.out; run_gemm(smem, (const bf16_t*)(ws + O_U), t_dn, 1024, DFF, E); }
    phase_weights(p, smem, 0, 0); phase_rmsnorm(p.x, p.ev_norm_w, XN);
    if (p.ws == nullptr) grid.sync();
    GSYNC();
    GEMM_H(0) phase_weights(p, smem, 0, 1); GSYNC();
#if PROBE == 2
    GEMM_H(0) GSYNC();
#endif
    phase_m1(p, smem); GSYNC();
#if PROBE == 3
    phase_m1(p, smem); GSYNC();
#endif
    phase_m2(p); GSYNC();
#if PROBE == 6
    GSYNC(); GSYNC(); GSYNC(); GSYNC(); GSYNC(); GSYNC(); GSYNC(); GSYNC(); GSYNC(); GSYNC();
#endif
#if PROBE == 7
    phase_weights(p, smem, 0, 0); GSYNC(); phase_rmsnorm(p.x, p.ev_norm_w, XN); GSYNC(); phase_rmsnorm(p.x, p.ev_norm_w, XN); GSYNC();
#endif
    phase_m3(p, smem); GSYNC();
#if PROBE == 3
    phase_m3(p, smem); GSYNC();
#endif
    GEMM_OUT(0) GSYNC();
#if PROBE == 2
    GEMM_OUT(0) GSYNC();
#endif
    phase_rmsnorm(p.out, p.ffn_norm_w, XN); GSYNC();
    GEMM_UP(0) phase_weights(p, smem, 0, 2); phase_weights(p, smem, 1, 0, 128); GSYNC();
    phase_ffn_fix(p, 0); GSYNC();
    GEMM_DN() GSYNC();
    phase_rmsnorm(p.out, p.od_norm_w, XN); GSYNC();
    GEMM_H(1) phase_weights(p, smem, 1, 1); GSYNC();
    phase_l1_prep(p, smem); GSYNC();
    { EpiLR E; E.LW = (bf16_t*)(ws + O_LW); E.w0 = p.od_w0; E.a0 = p.od_a0; run_gemm(smem, (const bf16_t*)(ws + O_AP), t_lr, 1536, 256, E); } GSYNC();
    phase_l1_mix(p, smem, 0); GSYNC();
#if PROBE == 4
    phase_l1_mix(p, smem, 1); GSYNC();
#endif
#if PROBE == 5
    phase_l1_mix(p, smem, 2); GSYNC();
#endif
    phase_rwkv_fin(p); GSYNC();
    GEMM_OUT(1) GSYNC();
    phase_rmsnorm(p.out, p.ffn_norm_w + DM, XN); GSYNC();
    GEMM_UP(1) phase_weights(p, smem, 1, 2); GSYNC();
    phase_ffn_fix(p, 1); GSYNC();
    GEMM_DN()
}

extern "C" void kernel_launch(void* const* d_in, const int* in_sizes, int n_in, void* d_out, int out_size, void* d_ws, size_t ws_size, hipStream_t stream) {
    static int grid_blocks = 0;
    if (grid_blocks == 0) {
        int dev = 0, cus = 0, per_cu = 0;
        hipGetDevice(&dev); hipDeviceGetAttribute(&cus, hipDeviceAttributeMultiprocessorCount, dev);
        if (hipFuncSetAttribute((const void*)fwd_megakernel, hipFuncAttributeMaxDynamicSharedMemorySize, LDS_BYTES) != hipSuccess) fprintf(stderr, "hipFuncSetAttribute failed\n");
        hipOccupancyMaxActiveBlocksPerMultiprocessor(&per_cu, (const void*)fwd_megakernel, 512, LDS_BYTES);
        (void)hipGetLastError();
        if (per_cu < 1) fprintf(stderr, "occupancy query says %d blocks per CU\n", per_cu);
        grid_blocks = cus > 0 ? cus : 256;
        if (ws_size < WS_NEED) fprintf(stderr, "workspace too small: %zu < %zu\n", ws_size, (size_t)WS_NEED);
    }
    Params p{};
    const float** pp = (const float**)&p;
    for (int i = 0; i < 33; ++i) pp[i] = (const float*)d_in[i];
    p.out = (float*)d_out; p.ws = (unsigned char*)d_ws;
    (void)hipMemsetAsync((char*)d_ws + O_BAR, 0, 16384, stream);
    void* args[] = {&p};
    hipError_t e = hipLaunchCooperativeKernel((const void*)fwd_megakernel, dim3(grid_blocks), dim3(512), args, LDS_BYTES, stream);
    if (e != hipSuccess) fprintf(stderr, "cooperative launch failed: %s (grid %d)\n", hipGetErrorString(e), grid_blocks);
}
```
